# Optimizing an MI355X kernel written in HIP

```python
import jax, jax.numpy as jnp
from jax import lax
import numpy as np

D_MODEL = 2048
BATCH = 2
SEQ = 16384
DEPTH = 2

GRID_W = 64
Q_BLOCK = 128
NORM_EPS = 1e-6
ROPE_THETA = 10000.0

HEAD_DIM = 128
ATTN_HEADS = D_MODEL // (2 * HEAD_DIM)
ATTN_KV_HEADS = ATTN_HEADS // 4
ATTN_WIDTH = ATTN_HEADS * HEAD_DIM
KV_WIDTH = ATTN_KV_HEADS * HEAD_DIM
CONV_GROUPS = 8
CONV_WIDTH = D_MODEL // 2
CONV_K = 3
IN0_WIDTH = ATTN_WIDTH + 2 * KV_WIDTH + 3 * CONV_WIDTH
MIX0_WIDTH = ATTN_WIDTH + CONV_WIDTH
MLA_HEADS = D_MODEL // 128
MLA_NOPE = 128
MLA_ROPE = 64
MLA_V = 128
Q_LORA = 512
KV_LORA = 512
MLA_DOWN_WIDTH = Q_LORA + KV_LORA + MLA_ROPE
D_FF = 4 * D_MODEL

N_EVEN = (DEPTH + 1) // 2
N_ODD = DEPTH // 2

kernel_name = 'hybrid_gqa_shortconv_mla_encoder'


def rms_norm(x, g):
    xf = x.astype(jnp.float32)
    y = xf * lax.rsqrt(jnp.mean(xf * xf, axis=-1, keepdims=True) + NORM_EPS)
    return (y * g.astype(jnp.float32)).astype(x.dtype)


def axial_rope_angles(seq, rot_dim):
    rows = seq // GRID_W
    row = jnp.repeat(jnp.arange(rows, dtype=jnp.float32), GRID_W)
    col = jnp.tile(jnp.arange(GRID_W, dtype=jnp.float32), rows)
    axis_dim = rot_dim // 2
    inv_freq = ROPE_THETA ** (-jnp.arange(0, axis_dim, 2, dtype=jnp.float32) / axis_dim)
    ang = jnp.concatenate([row[:, None] * inv_freq, col[:, None] * inv_freq], axis=-1)
    return jnp.cos(ang), jnp.sin(ang)


def apply_rope(x, cos, sin):
    xf = x.astype(jnp.float32).reshape(x.shape[:-1] + (-1, 2))
    x1, x2 = xf[..., 0], xf[..., 1]
    out = jnp.stack([x1 * cos - x2 * sin, x1 * sin + x2 * cos], axis=-1)
    return out.reshape(x.shape).astype(x.dtype)


def gqa_attention(q, k, v):
    b, s, h, dh = q.shape
    kvh = k.shape[2]
    g = h // kvh
    nblk = s // Q_BLOCK
    qb = q.reshape(b, nblk, Q_BLOCK, kvh, g, dh).transpose(1, 0, 2, 3, 4, 5)
    scale = dh ** -0.5

    def block(q_blk):
        sc = jnp.einsum('bqkgd,bskd->bkgqs', q_blk, k).astype(jnp.float32) * scale
        p = jax.nn.softmax(sc, axis=-1).astype(v.dtype)
        return jnp.einsum('bkgqs,bskd->bqkgd', p, v)

    out = lax.map(block, qb)
    return out.transpose(1, 0, 2, 3, 4, 5).reshape(b, s, h * dh)


def mla_attention(q_nope, q_rope, k_nope, k_rope, v):
    b, s, h, dn = q_nope.shape
    dr = q_rope.shape[-1]
    nblk = s // Q_BLOCK
    qn = q_nope.reshape(b, nblk, Q_BLOCK, h, dn).transpose(1, 0, 2, 3, 4)
    qr = q_rope.reshape(b, nblk, Q_BLOCK, h, dr).transpose(1, 0, 2, 3, 4)
    scale = (dn + dr) ** -0.5

    def block(args):
        qn_blk, qr_blk = args
        sc = (jnp.einsum('bqhd,bshd->bhqs', qn_blk, k_nope)
              + jnp.einsum('bqhr,bsr->bhqs', qr_blk, k_rope)).astype(jnp.float32) * scale
        p = jax.nn.softmax(sc, axis=-1).astype(v.dtype)
        return jnp.einsum('bhqs,bshd->bqhd', p, v)

    out = lax.map(block, (qn, qr))
    return out.transpose(1, 0, 2, 3, 4).reshape(b, s, h * v.shape[-1])


def even_mixer(h, w_in, q_norm_g, k_norm_g, conv_w, w_out, cos, sin):
    b, s, _ = h.shape
    proj = h @ w_in
    o1 = ATTN_WIDTH
    o2 = o1 + KV_WIDTH
    o3 = o2 + KV_WIDTH
    o4 = o3 + CONV_WIDTH
    o5 = o4 + CONV_WIDTH
    q, k, v, gate_b, gate_c, u = jnp.split(proj, [o1, o2, o3, o4, o5], axis=-1)
    cos_h, sin_h = cos[:, None, :], sin[:, None, :]
    q = apply_rope(rms_norm(q.reshape(b, s, ATTN_HEADS, HEAD_DIM), q_norm_g), cos_h, sin_h)
    k = apply_rope(rms_norm(k.reshape(b, s, ATTN_KV_HEADS, HEAD_DIM), k_norm_g), cos_h, sin_h)
    v = v.reshape(b, s, ATTN_KV_HEADS, HEAD_DIM)
    attn = gqa_attention(q, k, v)
    conv_in = gate_c * u
    conv = lax.conv_general_dilated(
        conv_in, conv_w[:, None, :].astype(conv_in.dtype), window_strides=(1,), padding='SAME',
        dimension_numbers=('NWC', 'WIO', 'NWC'), feature_group_count=CONV_WIDTH)
    sconv = gate_b * conv
    return jnp.concatenate([attn, sconv], axis=-1) @ w_out


def odd_mixer(h, w_down, q_lat_g, kv_lat_g, w_uq, w_ukv, w_o, cos, sin):
    b, s, _ = h.shape
    lat = h @ w_down
    c_q, c_kv, k_rope = jnp.split(lat, [Q_LORA, Q_LORA + KV_LORA], axis=-1)
    q = (rms_norm(c_q, q_lat_g) @ w_uq).reshape(b, s, MLA_HEADS, MLA_NOPE + MLA_ROPE)
    q_nope, q_rope = q[..., :MLA_NOPE], q[..., MLA_NOPE:]
    q_rope = apply_rope(q_rope, cos[:, None, :], sin[:, None, :])
    k_rope = apply_rope(k_rope, cos, sin)
    kv = (rms_norm(c_kv, kv_lat_g) @ w_ukv).reshape(b, s, MLA_HEADS, MLA_NOPE + MLA_V)
    k_nope, v = kv[..., :MLA_NOPE], kv[..., MLA_NOPE:]
    attn = mla_attention(q_nope, q_rope, k_nope, k_rope, v)
    return attn @ w_o


def squared_relu_mlp(h, w_up, w_dn):
    return jnp.square(jax.nn.relu(h @ w_up)) @ w_dn


def setup_inputs(seed: int = 0) -> dict:
    key = jax.random.key(seed)
    ks = jax.random.split(key, 20)

    def w(k, shape, fan_in):
        return jax.random.normal(k, shape, jnp.float32) * (fan_in ** -0.5)

    def gain(k, shape):
        return 1.0 + 0.02 * jax.random.normal(k, shape, jnp.float32)

    return {
        'x': jax.random.normal(ks[0], (BATCH, SEQ, D_MODEL), jnp.float32),
        'even_norm_g': gain(ks[1], (N_EVEN, D_MODEL)),
        'even_w_in': w(ks[2], (N_EVEN, D_MODEL, IN0_WIDTH), D_MODEL),
        'even_q_norm_g': gain(ks[3], (N_EVEN, HEAD_DIM)),
        'even_k_norm_g': gain(ks[4], (N_EVEN, HEAD_DIM)),
        'even_conv_w': w(ks[5], (N_EVEN, CONV_K, CONV_WIDTH), CONV_K),
        'even_w_out': w(ks[6], (N_EVEN, MIX0_WIDTH, D_MODEL), MIX0_WIDTH),
        'odd_norm_g': gain(ks[7], (N_ODD, D_MODEL)),
        'odd_w_down': w(ks[8], (N_ODD, D_MODEL, MLA_DOWN_WIDTH), D_MODEL),
        'odd_q_lat_g': gain(ks[9], (N_ODD, Q_LORA)),
        'odd_kv_lat_g': gain(ks[10], (N_ODD, KV_LORA)),
        'odd_w_uq': w(ks[11], (N_ODD, Q_LORA, MLA_HEADS * (MLA_NOPE + MLA_ROPE)), Q_LORA),
        'odd_w_ukv': w(ks[12], (N_ODD, KV_LORA, MLA_HEADS * (MLA_NOPE + MLA_V)), KV_LORA),
        'odd_w_o': w(ks[13], (N_ODD, MLA_HEADS * MLA_V, D_MODEL), MLA_HEADS * MLA_V),
        'mlp_norm_g': gain(ks[14], (DEPTH, D_MODEL)),
        'mlp_w_up': w(ks[15], (DEPTH, D_MODEL, D_FF), D_MODEL),
        'mlp_w_down': w(ks[16], (DEPTH, D_FF, D_MODEL), D_FF),
        'final_norm_g': gain(ks[17], (D_MODEL,)),
    }


def reference(x, even_norm_g, even_w_in, even_q_norm_g, even_k_norm_g, even_conv_w, even_w_out,
              odd_norm_g, odd_w_down, odd_q_lat_g, odd_kv_lat_g, odd_w_uq, odd_w_ukv, odd_w_o,
              mlp_norm_g, mlp_w_up, mlp_w_down, final_norm_g):
    s = x.shape[1]
    cos_a, sin_a = axial_rope_angles(s, HEAD_DIM)
    cos_c, sin_c = axial_rope_angles(s, MLA_ROPE)
    h = x
    for layer in range(DEPTH):
        i = layer // 2
        if layer % 2 == 0:
            h = h + even_mixer(rms_norm(h, even_norm_g[i]), even_w_in[i], even_q_norm_g[i],
                               even_k_norm_g[i], even_conv_w[i], even_w_out[i], cos_a, sin_a)
        else:
            h = h + odd_mixer(rms_norm(h, odd_norm_g[i]), odd_w_down[i], odd_q_lat_g[i],
                              odd_kv_lat_g[i], odd_w_uq[i], odd_w_ukv[i], odd_w_o[i], cos_c, sin_c)
        h = h + squared_relu_mlp(rms_norm(h, mlp_norm_g[layer]), mlp_w_up[layer], mlp_w_down[layer])
    return rms_norm(h, final_norm_g)
```

```cpp
#include <hip/hip_runtime.h>
#include <hip/hip_cooperative_groups.h>
#include <cstdio>
#include <cstdint>
namespace cg = cooperative_groups;
#ifndef MLA_SD
#define MLA_SD 1
#endif
#ifndef MLA_QREG
#define MLA_QREG 8
#endif
#ifndef N_LAUNCH_SPLIT
#define N_LAUNCH_SPLIT 0
#endif
namespace pg8 {
#define PG8_LAS __attribute__((address_space(3)))
typedef unsigned short bf16_t;
typedef short bf16x8 __attribute__((ext_vector_type(8)));
typedef float f32x4 __attribute__((ext_vector_type(4)));
typedef unsigned u32x4 __attribute__((ext_vector_type(4)));
constexpr int BM = 256, BK = 64, HALF = 128, HTB = HALF * BK * 2  , STAGE_BYTES = 8 * HTB, NXCD = 8, WGM = 8;

__host__ __device__ __forceinline__ int lds_byte(int r, int c) { const int st = (r >> 4) * 2 + (c >> 5), rr = r & 15, cc = c & 31, ob = rr * 64 + cc * 2; return st * 1024 + (ob ^ (((ob >> 9) & 1) << 5)); }
__host__ __device__ __forceinline__ void stage_rc(int b, int& R, int& C) { const int st = b / 1024, sb = b % 1024, swz = sb ^ (((sb >> 9) & 1) << 5); R = (st >> 1) * 16 + swz / 64; C = (st & 1) * 32 + (swz % 64) / 2; }
__host__ __device__ __forceinline__ int perm32(int rho) { const int n = rho >> 4, i = rho & 15; return 8 * (i >> 2) + 4 * n + (i & 3); }

struct Unit { int pm, pn; };
struct Gemm { const bf16_t* A; const bf16_t* Bt; int M, N, K; };

struct StaticOrder {
    int nM, nN, nwg, G, c;
    __host__ __device__ void init(int M, int N, int G_, int c_) { nM = M / BM; nN = N / BM; nwg = nM * nN; G = G_; c = c_; }
    __host__ __device__ bool next(int i, Unit& u) const {
        const long L = (long)i * G + c; if (L >= nwg) return false;
        int wgid = (int)L; { const int q = nwg / NXCD, r = nwg % NXCD, xcd = wgid % NXCD, off = wgid / NXCD; wgid = (xcd < r ? xcd * (q + 1) : r * (q + 1) + (xcd - r) * q) + off; }
        const int nig = WGM * nN, gid = wgid / nig, fm = gid * WGM, gsz = (nM - fm) < WGM ? (nM - fm) : WGM;
        u.pm = fm + ((wgid % nig) % gsz); u.pn = (wgid % nig) / gsz; return true;
    }
    __device__ __forceinline__ void a_ready(const Unit&) const {}
    __device__ __forceinline__ void done(const Unit&) const {}
};
__device__ __forceinline__ unsigned cvt_pk_bf16(float lo, float hi) { unsigned r; asm volatile("v_cvt_pk_bf16_f32 %0, %1, %2" : "=v"(r) : "v"(lo), "v"(hi)); return r; }
template <int ACT> struct EpiBf16 {
    static constexpr bool PERM = true, AFTER_DRAIN = false;
    bf16_t* O; int ldc;
    __device__ __forceinline__ void operator()(const f32x4 (&acc)[2][2][4][2], const Unit& u, int wr, int wc, int fr, int fq) const {
        const int row0 = u.pm * BM + wr * 64 + fr; const int col0 = u.pn * BM + wc * 32 + 8 * fq;
#pragma unroll
        for (int ai = 0; ai < 2; ++ai)
#pragma unroll
            for (int m = 0; m < 4; ++m) { bf16_t* rowp = O + (size_t)(row0 + ai * HALF + m * 16) * ldc + col0;
#pragma unroll
                for (int bj = 0; bj < 2; ++bj) { f32x4 v0 = acc[ai][bj][m][0], v1 = acc[ai][bj][m][1];
                    if (ACT == 2) {
#pragma unroll
                        for (int e = 0; e < 4; ++e) { float a = v0[e] > 0.f ? v0[e] : 0.f; v0[e] = a * a; float b = v1[e] > 0.f ? v1[e] : 0.f; v1[e] = b * b; } }
                    u32x4 w; w.x = cvt_pk_bf16(v0[0], v0[1]); w.y = cvt_pk_bf16(v0[2], v0[3]); w.z = cvt_pk_bf16(v1[0], v1[1]); w.w = cvt_pk_bf16(v1[2], v1[3]);
                    *(u32x4*)(rowp + bj * HALF) = w; } }
    }
};
struct EpiRes {
    static constexpr bool PERM = false, AFTER_DRAIN = false;
    const float* base; float* out; int ldc;
    __device__ __forceinline__ void operator()(const f32x4 (&acc)[2][2][4][2], const Unit& u, int wr, int wc, int fr, int fq) const {
        const int row0 = u.pm * BM + wr * 64 + fr; const int col0 = u.pn * BM + wc * 32 + 4 * fq;
#pragma unroll
        for (int ai = 0; ai < 2; ++ai)
#pragma unroll
            for (int m = 0; m < 4; ++m) { const size_t off = (size_t)(row0 + ai * HALF + m * 16) * ldc + col0;
#pragma unroll
                for (int bj = 0; bj < 2; ++bj)
#pragma unroll
                    for (int n = 0; n < 2; ++n) { const size_t o = off + bj * HALF + n * 16; const f32x4 b = *(const f32x4*)(base + o); *(f32x4*)(out + o) = b + acc[ai][bj][m][n]; }
                asm volatile("" ::: "memory"); }
    }
};
template <class Epi, class Sched, bool ALIGN_EPI = false, bool SP2 = false>
__device__ __forceinline__ void gemm_phase(PG8_LAS unsigned char* lds, const Gemm g, const Sched& S, const Epi& E) {
    const int tid = threadIdx.x, wid = __builtin_amdgcn_readfirstlane(tid >> 6), lane = tid & 63, wr = wid >> 2, wc = wid & 3, fr = lane & 15, fq = lane >> 4;
    const int K = g.K, nt = K / BK;
    unsigned voffA[2], voffB[2];
#pragma unroll
    for (int i = 0; i < 2; ++i) { int R, C; stage_rc(tid * 16 + i * 8192, R, C); const int Rb = Epi::PERM ? ((R & ~31) + perm32(R & 31)) : R;
        voffA[i] = (unsigned)(R * K + C) * 2u; voffB[i] = (unsigned)(Rb * K + C) * 2u; }
    const size_t kstep = (size_t)(BK * 2);
    const size_t hstep = (size_t)HALF * K * 2;
    const size_t tstep = 2 * hstep;
    const unsigned ldsw = (unsigned)wid * 1024u;
    const int aoff = lds_byte(wr * 64 + fr, fq * 8), boff = lds_byte(wc * 32 + fr, fq * 8);
#define PG8_SA(b, h) (((b) * 2 + (h)) * HTB)
#define PG8_SB(b, h) ((4 + (b) * 2 + (h)) * HTB)
#define PG8_STAGE(bufoff, gbase, voff) do { _Pragma("unroll") for (int _i = 0; _i < 2; ++_i) \
        __builtin_amdgcn_global_load_lds((const unsigned*)((const char*)(gbase) + (voff)[_i]), (PG8_LAS unsigned*)(lds + (bufoff) + ldsw + _i * 8192), 16, 0, 0); } while (0)
#define PG8_LDA(dst, b, h) do { _Pragma("unroll") for (int m = 0; m < 4; ++m) _Pragma("unroll") for (int k = 0; k < 2; ++k) dst[m][k] = *(const PG8_LAS bf16x8*)(lds + PG8_SA(b, h) + aoff + m * 2048 + k * 1024); } while (0)
#define PG8_LDB(dst, b, h) do { _Pragma("unroll") for (int n = 0; n < 2; ++n) _Pragma("unroll") for (int k = 0; k < 2; ++k) dst[n][k] = *(const PG8_LAS bf16x8*)(lds + PG8_SB(b, h) + boff + n * 2048 + k * 1024); } while (0)
#define PG8_MMA(ai, bj, At, Bt) do { __builtin_amdgcn_s_setprio(1); _Pragma("unroll") for (int m = 0; m < 4; ++m) _Pragma("unroll") for (int n = 0; n < 2; ++n) _Pragma("unroll") for (int k = 0; k < 2; ++k) \
        acc[ai][bj][m][n] = __builtin_amdgcn_mfma_f32_16x16x32_bf16(Bt[n][k], At[m][k], acc[ai][bj][m][n], 0, 0, 0); __builtin_amdgcn_s_setprio(0); } while (0)
#define PG8_WAIT_V(n) asm volatile("s_waitcnt vmcnt(" #n ")" ::: "memory")
#define PG8_WAIT_L(n) asm volatile("s_waitcnt lgkmcnt(" #n ")" ::: "memory")
#define PG8_BAR __builtin_amdgcn_s_barrier()
#define PG8_SCHED __builtin_amdgcn_sched_barrier(0)
    Unit cur, nxt; int ui = 0;
    if (!S.next(0, cur)) return;
    f32x4 acc[2][2][4][2];
#pragma unroll
    for (int a = 0; a < 2; ++a)
#pragma unroll
        for (int b = 0; b < 2; ++b)
#pragma unroll
            for (int m = 0; m < 4; ++m)
#pragma unroll
                for (int n = 0; n < 2; ++n) acc[a][b][m][n] = (f32x4){0.f, 0.f, 0.f, 0.f};
    bf16x8 At[4][2], B0[2][2], B1[2][2];
    const char* cA = (const char*)g.A + (size_t)cur.pm * tstep; const char* cB = (const char*)g.Bt + (size_t)cur.pn * tstep;
    S.a_ready(cur);
    if constexpr (SP2) {
        PG8_STAGE(PG8_SB(0, 0), cB, voffB); PG8_STAGE(PG8_SB(0, 1), cB + hstep, voffB); PG8_STAGE(PG8_SA(0, 0), cA, voffA); PG8_STAGE(PG8_SA(0, 1), cA + hstep, voffA);
        if (wr == 1) PG8_BAR;
        PG8_WAIT_V(2); PG8_BAR;
        PG8_STAGE(PG8_SB(1, 0), cB + kstep, voffB); PG8_STAGE(PG8_SA(1, 0), cA + kstep, voffA); PG8_STAGE(PG8_SB(1, 1), cB + hstep + kstep, voffB);
        PG8_WAIT_V(6); PG8_BAR;
    } else {
        PG8_STAGE(PG8_SB(0, 0), cB, voffB); PG8_STAGE(PG8_SA(0, 0), cA, voffA); PG8_STAGE(PG8_SB(0, 1), cB + hstep, voffB); PG8_STAGE(PG8_SA(0, 1), cA + hstep, voffA);
        if (wr == 1) PG8_BAR;
        PG8_WAIT_V(4); PG8_BAR;
        PG8_STAGE(PG8_SB(1, 0), cB + kstep, voffB); PG8_STAGE(PG8_SA(1, 0), cA + kstep, voffA); PG8_STAGE(PG8_SB(1, 1), cB + hstep + kstep, voffB);
        PG8_WAIT_V(6); PG8_BAR;
    }
    for (;;) {
        const bool has_next = S.next(ui + 1, nxt);
        const char* nA = has_next ? (const char*)g.A + (size_t)nxt.pm * tstep : cA; const char* nB = has_next ? (const char*)g.Bt + (size_t)nxt.pn * tstep : cB;
        for (int t = 0; t < nt; t += 2) {
            const bool last = (t == nt - 2);
            const char* a1 = cA + (size_t)(t + 1) * kstep;
            const char* a2 = last ? nA : cA + (size_t)(t + 2) * kstep; const char* b2 = last ? nB : cB + (size_t)(t + 2) * kstep;
            const char* a3 = a2 + kstep; const char* b3 = b2 + kstep;
            if (last && has_next) S.a_ready(nxt);
            if constexpr (SP2) {
            PG8_LDB(B0, 0, 0); PG8_LDB(B1, 0, 1); PG8_SCHED; PG8_LDA(At, 0, 0); PG8_STAGE(PG8_SA(1, 1), a1 + hstep, voffA);
            PG8_WAIT_V(8); PG8_WAIT_L(0); PG8_BAR; PG8_MMA(0, 0, At, B0); PG8_MMA(0, 1, At, B1); PG8_BAR; PG8_SCHED;
            PG8_LDA(At, 0, 1); PG8_STAGE(PG8_SB(0, 0), b2, voffB); PG8_STAGE(PG8_SB(0, 1), b2 + hstep, voffB); PG8_STAGE(PG8_SA(0, 0), a2, voffA);
            PG8_WAIT_V(8); PG8_WAIT_L(0); PG8_BAR; PG8_MMA(1, 0, At, B0); PG8_MMA(1, 1, At, B1); PG8_BAR; PG8_SCHED;
            PG8_LDB(B0, 1, 0); PG8_LDB(B1, 1, 1); PG8_SCHED; PG8_LDA(At, 1, 0); PG8_STAGE(PG8_SA(0, 1), a2 + hstep, voffA);
            PG8_WAIT_V(8); PG8_WAIT_L(0); PG8_BAR; PG8_MMA(0, 0, At, B0); PG8_MMA(0, 1, At, B1); PG8_BAR; PG8_SCHED;
            PG8_LDA(At, 1, 1); PG8_STAGE(PG8_SB(1, 0), b3, voffB); PG8_STAGE(PG8_SB(1, 1), b3 + hstep, voffB); PG8_STAGE(PG8_SA(1, 0), a3, voffA);
            PG8_WAIT_V(8); PG8_WAIT_L(0); PG8_BAR; PG8_MMA(1, 0, At, B0); PG8_MMA(1, 1, At, B1); PG8_BAR; PG8_SCHED;
            } else {
            PG8_LDB(B0, 0, 0); PG8_SCHED; PG8_LDA(At, 0, 0); PG8_STAGE(PG8_SA(1, 1), a1 + hstep, voffA);
            PG8_WAIT_L(8); PG8_BAR; PG8_WAIT_L(0); PG8_MMA(0, 0, At, B0); PG8_BAR; PG8_SCHED;
            PG8_LDB(B1, 0, 1); PG8_STAGE(PG8_SB(0, 0), b2, voffB);
            PG8_BAR; PG8_WAIT_L(0); PG8_MMA(0, 1, At, B1); PG8_BAR;
            PG8_LDA(At, 0, 1); PG8_STAGE(PG8_SA(0, 0), a2, voffA);
            PG8_BAR; PG8_WAIT_L(0); PG8_MMA(1, 0, At, B0); PG8_BAR; PG8_SCHED;
            PG8_STAGE(PG8_SB(0, 1), b2 + hstep, voffB);
            PG8_WAIT_V(6); PG8_BAR; PG8_MMA(1, 1, At, B1); PG8_BAR;
            PG8_LDB(B0, 1, 0); PG8_SCHED; PG8_LDA(At, 1, 0); PG8_STAGE(PG8_SA(0, 1), a2 + hstep, voffA);
            PG8_WAIT_L(8); PG8_BAR; PG8_WAIT_L(0); PG8_MMA(0, 0, At, B0); PG8_BAR; PG8_SCHED;
            PG8_LDB(B1, 1, 1); PG8_STAGE(PG8_SB(1, 0), b3, voffB);
            PG8_BAR; PG8_WAIT_L(0); PG8_MMA(0, 1, At, B1); PG8_BAR;
            PG8_LDA(At, 1, 1); PG8_STAGE(PG8_SA(1, 0), a3, voffA);
            PG8_BAR; PG8_WAIT_L(0); PG8_MMA(1, 0, At, B0); PG8_BAR; PG8_SCHED;
            PG8_STAGE(PG8_SB(1, 1), b3 + hstep, voffB);
            PG8_WAIT_V(6); PG8_BAR; PG8_MMA(1, 1, At, B1); PG8_BAR;
            }
        }
        if constexpr (ALIGN_EPI) { if (wr == 0) PG8_BAR; }
        if constexpr (!Epi::AFTER_DRAIN) { E(acc, cur, wr, wc, fr, fq); S.done(cur); }
        if (!has_next) break;
#pragma unroll
        for (int a = 0; a < 2; ++a)
#pragma unroll
            for (int b = 0; b < 2; ++b)
#pragma unroll
                for (int m = 0; m < 4; ++m)
#pragma unroll
                    for (int n = 0; n < 2; ++n) acc[a][b][m][n] = (f32x4){0.f, 0.f, 0.f, 0.f};
        cur = nxt; cA = nA; cB = nB; ++ui;
        if constexpr (ALIGN_EPI) { if (wr == 1) PG8_BAR; }
    }
    PG8_WAIT_V(0);
    if constexpr (!ALIGN_EPI) { if (wr == 0) PG8_BAR; }
    PG8_BAR;
    if constexpr (Epi::AFTER_DRAIN) { E.fused(acc, cur, wr, wc, fr, fq, lds, wid, lane); S.done(cur); }
#undef PG8_SA
#undef PG8_SB
#undef PG8_STAGE
#undef PG8_LDA
#undef PG8_LDB
#undef PG8_MMA
#undef PG8_WAIT_V
#undef PG8_WAIT_L
#undef PG8_BAR
#undef PG8_SCHED
}
}
namespace att {
typedef unsigned short bf16;
using bf16x8 = __attribute__((ext_vector_type(8))) short;
using s16x4  = __attribute__((ext_vector_type(4))) short;
using f32x16 = __attribute__((ext_vector_type(16))) float;
using u32x4  = __attribute__((ext_vector_type(4))) unsigned;
constexpr int NW = 8, QBLK = 32, KVBLK = 64;
constexpr float THR = 8.f;
#define ATT_SBAR() __builtin_amdgcn_sched_barrier(0)
__device__ __forceinline__ int crow(int r, int hi) { return (r & 3) + 8 * (r >> 2) + 4 * hi; }
__device__ __forceinline__ unsigned cvtpk(float lo, float hi) { unsigned r; asm volatile("v_cvt_pk_bf16_f32 %0, %1, %2" : "=v"(r) : "v"(lo), "v"(hi)); return r; }
__device__ __forceinline__ bf16x8 ld8(const bf16* p) { return *reinterpret_cast<const bf16x8*>(p); }

template <int DQK> struct Cfg {
  static constexpr float SCALE = (DQK == 128) ? 0.088388347648318440f : 0.072168783648703220f;
  static constexpr float C = SCALE * 1.4426950408889634f;
  static constexpr int KROWB = DQK * 2, SHM_K = KVBLK * KROWB, SHM_V = KVBLK * 128 * 2, ND0 = DQK / 16;
  static constexpr int QREG = (DQK > 128) ? MLA_QREG : 8;
  static constexpr int QXW = (ND0 - QREG) * 1024, SHM_QX = NW * QXW;
  static constexpr int SHM_TOTAL = 2 * SHM_V + 2 * SHM_K + NW * 64 * 4 + SHM_QX;
};

template <int DQK> __device__ __forceinline__ void partialSM(f32x16& p0, f32x16& p1, float& m_reg, float& mn, float& alpha) {
  constexpr float C = Cfg<DQK>::C, SCALE = Cfg<DQK>::SCALE;
  float pmax = p0[0];
#pragma unroll
  for (int r = 1; r < 16; ++r) pmax = fmaxf(pmax, p0[r]);
#pragma unroll
  for (int r = 0; r < 16; ++r) pmax = fmaxf(pmax, p1[r]);
  { auto rr = __builtin_amdgcn_permlane32_swap(__float_as_uint(pmax), __float_as_uint(pmax), false, false);
    pmax = fmaxf(__uint_as_float(rr[0]), __uint_as_float(rr[1])); }
  if (__builtin_expect(__all(pmax - m_reg <= THR / SCALE), 1)) { mn = m_reg; alpha = 1.f; }
  else { mn = fmaxf(m_reg, pmax); alpha = __builtin_amdgcn_exp2f((m_reg - mn) * C); m_reg = mn; }
  float mnC = -mn * C;
#pragma unroll
  for (int r = 0; r < 16; ++r) p0[r] = fmaf(p0[r], C, mnC);
#pragma unroll
  for (int r = 0; r < 16; ++r) p1[r] = fmaf(p1[r], C, mnC);
#pragma unroll
  for (int r = 0; r < 16; ++r) p0[r] = __builtin_amdgcn_exp2f(p0[r]);
}
__device__ __forceinline__ void finishSM(f32x16& p0, f32x16& p1, float alpha, float& l_reg, bf16x8& pa0, bf16x8& pa1, bf16x8& pa2, bf16x8& pa3) {
#pragma unroll
  for (int r = 0; r < 16; ++r) p1[r] = __builtin_amdgcn_exp2f(p1[r]);
  float ps = 0;
#pragma unroll
  for (int r = 0; r < 16; ++r) ps += p0[r];
#pragma unroll
  for (int r = 0; r < 16; ++r) ps += p1[r];
  { auto rr = __builtin_amdgcn_permlane32_swap(__float_as_uint(ps), __float_as_uint(ps), false, false);
    ps = __uint_as_float(rr[0]) + __uint_as_float(rr[1]); }
  l_reg = l_reg * alpha + ps;
#define ATT_PK4(P, BASE, OUT) do { unsigned a0 = cvtpk(P[BASE + 0], P[BASE + 1]), a1 = cvtpk(P[BASE + 2], P[BASE + 3]);   \
    unsigned b0 = cvtpk(P[BASE + 4], P[BASE + 5]), b1 = cvtpk(P[BASE + 6], P[BASE + 7]);                              \
    auto r0 = __builtin_amdgcn_permlane32_swap(a0, b0, false, false); auto r1 = __builtin_amdgcn_permlane32_swap(a1, b1, false, false); \
    u32x4 w = {r0[0], r1[0], r0[1], r1[1]}; OUT = *reinterpret_cast<bf16x8*>(&w); } while (0)
  ATT_PK4(p0, 0, pa0); ATT_PK4(p0, 8, pa1); ATT_PK4(p1, 0, pa2); ATT_PK4(p1, 8, pa3);
#undef ATT_PK4
}
#define ATT_KSWZ(row, colB) ((row) * KROWB + ((colB) ^ (((row) & 7) << 4)))
template <int DQK> __device__ __forceinline__ void qkt(f32x16& p0, f32x16& p1, const char* Ks, const int* kb, const bf16x8* qr, const char* qx, int r32, int hi) {
  constexpr int KROWB = Cfg<DQK>::KROWB, ND0 = Cfg<DQK>::ND0, QREG = Cfg<DQK>::QREG;
  p0 = f32x16{}; p1 = f32x16{};
#pragma unroll
  for (int d0 = 0; d0 < ND0; ++d0) {
    bf16x8 b0 = *reinterpret_cast<const bf16x8*>(Ks + kb[d0 & 3] + (d0 >> 2) * 128);
    bf16x8 b1 = *reinterpret_cast<const bf16x8*>(Ks + kb[d0 & 3] + (d0 >> 2) * 128 + 32 * KROWB);
    bf16x8 q; if (d0 < QREG) q = qr[d0]; else q = *reinterpret_cast<const bf16x8*>(qx + (d0 - QREG) * 1024);
    p0 = __builtin_amdgcn_mfma_f32_32x32x16_bf16(b0, q, p0, 0, 0, 0);
    p1 = __builtin_amdgcn_mfma_f32_32x32x16_bf16(b1, q, p1, 0, 0, 0); }
}
__device__ __forceinline__ int v_st(int k, int c) { const int kk = (k & ~0xC) | ((k & 4) << 1) | ((k & 8) >> 1); return ((kk >> 3) * 4 + (c >> 5)) * 512 + ((kk & 7) * 32 + (c & 31)) * 2; }
__device__ __forceinline__ int v_rd_base(int lane) { return ((lane & 3) << 3) | (((lane >> 2) & 3) << 6) | (((lane >> 4) & 1) << 5) | (((lane >> 5) & 1) << 8); }
constexpr int v_rd_off(int d0, int ks, int half) { return d0 * 512 + ks * 4096 + half * 2048; }
template <int OFF> __device__ __forceinline__ s16x4 tr_read(int vb) {
  s16x4 r; asm volatile("ds_read_b64_tr_b16 %0, %1 offset:%2" : "=&v"(r) : "v"(vb), "i"(OFF) : "memory"); return r;
}
template <int D0> __device__ __forceinline__ void pv_one(f32x16& od, int vb, bf16x8 pa0, bf16x8 pa1, bf16x8 pa2, bf16x8 pa3) {
  const s16x4 l0 = tr_read<v_rd_off(D0, 0, 0)>(vb), h0 = tr_read<v_rd_off(D0, 0, 1)>(vb), l1 = tr_read<v_rd_off(D0, 1, 0)>(vb), h1 = tr_read<v_rd_off(D0, 1, 1)>(vb);
  const s16x4 l2 = tr_read<v_rd_off(D0, 2, 0)>(vb), h2 = tr_read<v_rd_off(D0, 2, 1)>(vb), l3 = tr_read<v_rd_off(D0, 3, 0)>(vb), h3 = tr_read<v_rd_off(D0, 3, 1)>(vb);
  asm volatile("s_waitcnt lgkmcnt(0)" ::: "memory"); ATT_SBAR();
#define ATT_PK(L, H) (bf16x8){L[0], L[1], L[2], L[3], H[0], H[1], H[2], H[3]}
  od = __builtin_amdgcn_mfma_f32_32x32x16_bf16(pa0, ATT_PK(l0, h0), od, 0, 0, 0);
  od = __builtin_amdgcn_mfma_f32_32x32x16_bf16(pa1, ATT_PK(l1, h1), od, 0, 0, 0);
  od = __builtin_amdgcn_mfma_f32_32x32x16_bf16(pa2, ATT_PK(l2, h2), od, 0, 0, 0);
  od = __builtin_amdgcn_mfma_f32_32x32x16_bf16(pa3, ATT_PK(l3, h3), od, 0, 0, 0);
#undef ATT_PK
}
__device__ __forceinline__ void pv_d0(f32x16* o, int vb, bf16x8 pa0, bf16x8 pa1, bf16x8 pa2, bf16x8 pa3) {
  pv_one<0>(o[0], vb, pa0, pa1, pa2, pa3); pv_one<1>(o[1], vb, pa0, pa1, pa2, pa3); pv_one<2>(o[2], vb, pa0, pa1, pa2, pa3); pv_one<3>(o[3], vb, pa0, pa1, pa2, pa3);
}

template <int DQK, int LDQ, int LDK, int LDV, int LDO, int SD>
__device__ __forceinline__ void attn_unit(const bf16* __restrict__ Qb, const bf16* __restrict__ Kh, const bf16* __restrict__ Kr, const bf16* __restrict__ Vh,
                                          bf16* __restrict__ Ob, int seq, char* lds) {
  constexpr int KROWB = Cfg<DQK>::KROWB, SHM_K = Cfg<DQK>::SHM_K, SHM_V = Cfg<DQK>::SHM_V, ND0 = Cfg<DQK>::ND0;
  const int tid = threadIdx.x, wid = tid >> 6, lane = tid & 63, r32 = lane & 31, hi = lane >> 5;
  char* V_lds = lds; char* K_lds = lds + 2 * SHM_V;
  float* ws = (float*)(lds + 2 * SHM_V + 2 * SHM_K) + wid * 64; float* li_l = ws; float* al_l = ws + 32;
  float m_reg = -1e30f, l_reg = 0; f32x16 o[4] = {}; constexpr int QREG = Cfg<DQK>::QREG; bf16x8 qr[QREG];
  const bf16* Qw = Qb + (long)(wid * QBLK + r32) * LDQ + hi * 8;
  char* qx = lds + 2 * SHM_V + 2 * SHM_K + NW * 64 * 4 + wid * Cfg<DQK>::QXW + lane * 16;
#pragma unroll
  for (int d0 = 0; d0 < QREG; ++d0) qr[d0] = ld8(Qw + d0 * 16);
  if constexpr (QREG < ND0) {
#pragma unroll
    for (int d0 = QREG; d0 < ND0; ++d0) *(bf16x8*)(qx + (d0 - QREG) * 1024) = ld8(Qw + d0 * 16);
  }
  const int sr = tid >> 4, sc = (tid & 15) * 8, vst0 = v_st(sr, sc), vst1 = v_st(32 + sr, sc);
  const int krr = tid >> 3, krc = (tid & 7) * 8;
  const int vb0 = (int)(uintptr_t)V_lds + v_rd_base(lane);
  int kb[4];
#pragma unroll
  for (int dl = 0; dl < 4; ++dl) kb[dl] = r32 * KROWB + ((dl * 32 + hi * 16) ^ ((r32 & 7) << 4));
  const unsigned boV = (unsigned)(sr * LDV + sc) * 2u, boK = (unsigned)(sr * LDK + sc) * 2u, boR = (unsigned)(krr * 64 + krc) * 2u;
  struct { bf16x8 vs0, vs1, ks0, ks1, kr; } sr_[SD];
#define SLOAD(i, k0) do { const char* vt_ = (const char*)(Vh + (long)(k0) * LDV); const char* kt_ = (const char*)(Kh + (long)(k0) * LDK); \
    sr_[i].vs0 = *(const bf16x8*)(vt_ + boV); sr_[i].vs1 = *(const bf16x8*)(vt_ + 32 * LDV * 2 + boV); \
    sr_[i].ks0 = *(const bf16x8*)(kt_ + boK); sr_[i].ks1 = *(const bf16x8*)(kt_ + 32 * LDK * 2 + boK); \
    if constexpr (DQK == 192) { const char* rt_ = (const char*)(Kr + (long)(k0) * 64); sr_[i].kr = *(const bf16x8*)(rt_ + boR); } } while (0)
#define SWRITE(b, i) do { *(bf16x8*)(V_lds + (b) * SHM_V + vst0) = sr_[i].vs0;          \
    *(bf16x8*)(V_lds + (b) * SHM_V + vst1) = sr_[i].vs1; int kc = sc * 2;               \
    *(bf16x8*)(K_lds + (b) * SHM_K + ATT_KSWZ(sr, kc)) = sr_[i].ks0;                       \
    *(bf16x8*)(K_lds + (b) * SHM_K + ATT_KSWZ(32 + sr, kc)) = sr_[i].ks1;                  \
    if constexpr (DQK == 192) *(bf16x8*)(K_lds + (b) * SHM_K + ATT_KSWZ(krr, 256 + krc * 2)) = sr_[i].kr; } while (0)
#define SWAIT() do { if constexpr (SD == 2) { if constexpr (DQK == 192) asm volatile("s_waitcnt vmcnt(5)" ::: "memory"); else asm volatile("s_waitcnt vmcnt(4)" ::: "memory"); } \
    else asm volatile("s_waitcnt vmcnt(0)" ::: "memory"); } while (0)
#define RESC(a) do { if (__any((a) < 1.f)) { if (hi == 0) al_l[r32] = (a); asm volatile("s_waitcnt lgkmcnt(0)" ::: "memory"); \
    _Pragma("unroll") for (int d = 0; d < 4; ++d) _Pragma("unroll") for (int r = 0; r < 16; ++r) o[d][r] *= al_l[crow(r, hi)]; } } while (0)
  f32x16 pA0, pA1, pB0, pB1; float mnA, mnB, alA, alB; bf16x8 pa0, pa1, pa2, pa3; const int NT = seq / KVBLK;
  constexpr int SE = 0, SO = SD - 1;
  SLOAD(SE, 0); asm volatile("s_waitcnt vmcnt(0)" ::: "memory"); SWRITE(0, SE); __syncthreads();
  qkt<DQK>(pA0, pA1, K_lds, kb, qr, qx, r32, hi); partialSM<DQK>(pA0, pA1, m_reg, mnA, alA);
  SLOAD(SO, KVBLK); if constexpr (SD == 2) { if (2 < NT) SLOAD(SE, 2 * KVBLK); }
  SWAIT(); SWRITE(1, SO); __syncthreads();
  for (int j = 1; j + 1 < NT; j += 2) {
    ATT_SBAR(); qkt<DQK>(pB0, pB1, K_lds + SHM_K, kb, qr, qx, r32, hi);
    finishSM(pA0, pA1, alA, l_reg, pa0, pa1, pa2, pa3); ATT_SBAR();
    SLOAD(SO, (j + SD) * KVBLK); ATT_SBAR();
    pv_d0(o, vb0, pa0, pa1, pa2, pa3); partialSM<DQK>(pB0, pB1, m_reg, mnB, alB);
    __syncthreads(); SWAIT(); SWRITE(0, SE);
    RESC(alB); __syncthreads();
    ATT_SBAR(); qkt<DQK>(pA0, pA1, K_lds, kb, qr, qx, r32, hi);
    finishSM(pB0, pB1, alB, l_reg, pa0, pa1, pa2, pa3); ATT_SBAR();
    if (SD == 1 || j + 3 < NT) SLOAD(SE, (j + 1 + SD) * KVBLK); ATT_SBAR();
    pv_d0(o, vb0 + (int)SHM_V, pa0, pa1, pa2, pa3); partialSM<DQK>(pA0, pA1, m_reg, mnA, alA);
    __syncthreads(); SWAIT(); SWRITE(1, SO);
    RESC(alA); __syncthreads();
  }
  ATT_SBAR(); qkt<DQK>(pB0, pB1, K_lds + SHM_K, kb, qr, qx, r32, hi);
  finishSM(pA0, pA1, alA, l_reg, pa0, pa1, pa2, pa3); ATT_SBAR();
  pv_d0(o, vb0, pa0, pa1, pa2, pa3); partialSM<DQK>(pB0, pB1, m_reg, mnB, alB);
  __syncthreads(); RESC(alB);
  finishSM(pB0, pB1, alB, l_reg, pa0, pa1, pa2, pa3); ATT_SBAR();
  pv_d0(o, vb0 + (int)SHM_V, pa0, pa1, pa2, pa3);
  if (hi == 0) li_l[r32] = l_reg; asm volatile("s_waitcnt lgkmcnt(0)" ::: "memory");
  float rli[16];
#pragma unroll
  for (int r = 0; r < 16; ++r) rli[r] = __builtin_amdgcn_rcpf(li_l[crow(r, hi)]);
  bf16* Ow = Ob + (long)(wid * QBLK) * LDO;
#pragma unroll
  for (int r = 0; r < 16; ++r) { int orow = crow(r, hi);
#pragma unroll
    for (int d0 = 0; d0 < 4; ++d0) Ow[(long)orow * LDO + d0 * 32 + r32] = (bf16)(cvtpk(o[d0][r] * rli[r], 0.f) & 0xffffu); }
  asm volatile("s_waitcnt vmcnt(0) lgkmcnt(0)" ::: "memory"); __syncthreads();
#undef SLOAD
#undef SWRITE
#undef SWAIT
#undef RESC
}
#undef ATT_KSWZ
#undef ATT_SBAR
}
#define LAS __attribute__((address_space(3)))
typedef unsigned short u16;
typedef float f32x4 __attribute__((ext_vector_type(4)));
typedef short bf16x8 __attribute__((ext_vector_type(8)));
typedef unsigned u32x4 __attribute__((ext_vector_type(4)));
typedef unsigned u32x2 __attribute__((ext_vector_type(2)));
constexpr int DM = 2048, BATCH = 2, SEQ = 16384, T = BATCH * SEQ;
constexpr int IN0 = 4608, NLAT = 1088, NLATP = 1280, NQ = 3072, NKV = 4096, DFF = 8192;
constexpr float EPS = 1e-6f;
constexpr int NWAVES = 8, NTHREADS = 512;
constexpr int LDS_BYTES = 155648;
constexpr float LOG2_THETA = 13.287712379549449f;

constexpr size_t MiB = 1u << 20;
constexpr size_t WS_WIN = 0, WS_WOUT = 18 * MiB, WS_WDOWN = 26 * MiB, WS_WUQ = 31 * MiB, WS_WUKV = 34 * MiB, WS_WO = 38 * MiB;
constexpr size_t WS_WUP = 46 * MiB  , WS_WDN = 110 * MiB  ;
constexpr size_t WS_XN = 176 * MiB;
constexpr size_t WS_BIG = 304 * MiB;
constexpr size_t WS_PROJ = WS_BIG, WS_MIX = WS_BIG + 288 * MiB;
constexpr size_t WS_HID = WS_BIG;
constexpr size_t WS_LAT = WS_BIG, WS_CQN = WS_BIG + 80 * MiB, WS_CKVN = WS_BIG + 112 * MiB, WS_KROPE = WS_BIG + 144 * MiB;
constexpr size_t WS_Q = WS_BIG + 148 * MiB, WS_KV = WS_BIG + 340 * MiB, WS_AO = WS_BIG;
constexpr size_t WS_END = WS_BIG + 596 * MiB;

__device__ __forceinline__ float bflo(unsigned u) { return __uint_as_float(u << 16); }
__device__ __forceinline__ float bfhi(unsigned u) { return __uint_as_float(u & 0xffff0000u); }
__device__ __forceinline__ unsigned pk2(float lo, float hi) { unsigned r; asm volatile("v_cvt_pk_bf16_f32 %0, %1, %2" : "=v"(r) : "v"(lo), "v"(hi)); return r; }
__device__ __forceinline__ float wave_sum(float v) {
#pragma unroll
    for (int o = 1; o < 64; o <<= 1) v += __shfl_xor(v, o);
    return v;
}
__device__ __forceinline__ void rope_cs(float pos, float invf, float& c, float& s) {
    const float a = pos * invf;
    double rev = (double)a * 0.15915494309189535;
    rev -= __builtin_rint(rev);
    const float fr = (float)rev;
    c = __builtin_amdgcn_cosf(fr); s = __builtin_amdgcn_sinf(fr);
}

__device__ __forceinline__ void transpose_item(const float* __restrict__ W, const float* __restrict__ gain, int K, int N, u16* __restrict__ WT, LAS float* scr, int item, int lane) {
    const int nblk = N / 32, kb = item / nblk, nb = item % nblk, k0 = 64 * kb, n0 = 32 * nb;
#pragma unroll 8
    for (int i = 0; i < 32; ++i) { const int kk = 2 * i + (lane >> 5); float w = W[(size_t)(k0 + kk) * N + n0 + (lane & 31)]; if (gain) w *= gain[k0 + kk]; scr[kk * 33 + (lane & 31)] = w; }
    asm volatile("s_waitcnt lgkmcnt(0)" ::: "memory");
    const int c = lane & 7;
#pragma unroll
    for (int j = 0; j < 4; ++j) { const int n = (lane >> 3) + 8 * j; const LAS float* s = scr + (8 * c) * 33 + n;
        u32x4 o; o.x = pk2(s[0 * 33], s[1 * 33]); o.y = pk2(s[2 * 33], s[3 * 33]); o.z = pk2(s[4 * 33], s[5 * 33]); o.w = pk2(s[6 * 33], s[7 * 33]);
        *(u32x4*)(WT + (size_t)(n0 + n) * K + k0 + 8 * c) = o; }
    asm volatile("s_waitcnt lgkmcnt(0)" ::: "memory");
}

__device__ __forceinline__ void norm_row_bf16(const float* __restrict__ xrow, u16* __restrict__ orow, int lane) {
    const f32x4* xr = (const f32x4*)xrow + lane;
    f32x4 v[8]; float s = 0.f;
#pragma unroll
    for (int j = 0; j < 8; ++j) { v[j] = xr[64 * j]; s += (v[j].x * v[j].x + v[j].y * v[j].y) + (v[j].z * v[j].z + v[j].w * v[j].w); }
    const float r = 1.0f / sqrtf(wave_sum(s) * (1.f / DM) + EPS);
    u32x2* o8 = (u32x2*)orow + lane;
#pragma unroll
    for (int j = 0; j < 8; ++j) { u32x2 w; w.x = pk2(v[j].x * r, v[j].y * r); w.y = pk2(v[j].z * r, v[j].w * r); o8[64 * j] = w; }
}
__device__ __forceinline__ void norm_row_f32(float* xrow, const float* __restrict__ g, int lane) {
    f32x4* xr = (f32x4*)xrow + lane; const f32x4* gr = (const f32x4*)g + lane;
    f32x4 v[8]; float s = 0.f;
#pragma unroll
    for (int j = 0; j < 8; ++j) { v[j] = xr[64 * j]; s += (v[j].x * v[j].x + v[j].y * v[j].y) + (v[j].z * v[j].z + v[j].w * v[j].w); }
    const float r = 1.0f / sqrtf(wave_sum(s) * (1.f / DM) + EPS);
#pragma unroll
    for (int j = 0; j < 8; ++j) xr[64 * j] = (v[j] * r) * gr[64 * j];
}

__device__ __forceinline__ void ld8f(const u16* p, float* f) {
    const u32x4 w = *(const u32x4*)p;
    f[0] = bflo(w.x); f[1] = bfhi(w.x); f[2] = bflo(w.y); f[3] = bfhi(w.y); f[4] = bflo(w.z); f[5] = bfhi(w.z); f[6] = bflo(w.w); f[7] = bfhi(w.w);
}

__device__ __forceinline__ void ew0_token(int t, u16* __restrict__ PROJ, u16* __restrict__ MIX, const float* __restrict__ qg, const float* __restrict__ kg, const float* __restrict__ cw, int lane) {
    const int s = t & (SEQ - 1), row = s >> 6, col = s & 63;
    float c, sn; { const int j = lane & 31; const float invf = __builtin_amdgcn_exp2f(-(float)j * (LOG2_THETA / 32.f)); rope_cs((float)(lane < 32 ? row : col), invf, c, sn); }
    unsigned* pr = (unsigned*)(PROJ + (size_t)t * IN0);
    const float qg0 = qg[2 * lane], qg1 = qg[2 * lane + 1], kg0 = kg[2 * lane], kg1 = kg[2 * lane + 1];
#pragma unroll
    for (int h = 0; h < 10; ++h) {
        const unsigned u = pr[h * 64 + lane]; const float x1 = bflo(u), x2 = bfhi(u);
        const float ss = wave_sum(x1 * x1 + x2 * x2); const float r = 1.0f / sqrtf(ss * (1.f / 128.f) + EPS);
        const float y1 = x1 * r * (h < 8 ? qg0 : kg0), y2 = x2 * r * (h < 8 ? qg1 : kg1);
        pr[h * 64 + lane] = pk2(y1 * c - y2 * sn, y1 * sn + y2 * c);
    }
    const u16* p0 = PROJ + (size_t)t * IN0;
#pragma unroll
    for (int ch = 0; ch < 2; ++ch) {
        const int cc = ch * 512 + lane * 8;
        float gb[8], g0[8], u0[8], gm[8], um[8], gp[8], up[8];
        ld8f(p0 + 1536 + cc, gb); ld8f(p0 + 2560 + cc, g0); ld8f(p0 + 3584 + cc, u0);
        if (s > 0) { ld8f(p0 - IN0 + 2560 + cc, gm); ld8f(p0 - IN0 + 3584 + cc, um); } else {
#pragma unroll
            for (int e = 0; e < 8; ++e) { gm[e] = 0.f; um[e] = 0.f; } }
        if (s < SEQ - 1) { ld8f(p0 + IN0 + 2560 + cc, gp); ld8f(p0 + IN0 + 3584 + cc, up); } else {
#pragma unroll
            for (int e = 0; e < 8; ++e) { gp[e] = 0.f; up[e] = 0.f; } }
        float o[8];
#pragma unroll
        for (int e = 0; e < 8; ++e) o[e] = gb[e] * (cw[cc + e] * (gm[e] * um[e]) + cw[1024 + cc + e] * (g0[e] * u0[e]) + cw[2048 + cc + e] * (gp[e] * up[e]));
        u32x4 w; w.x = pk2(o[0], o[1]); w.y = pk2(o[2], o[3]); w.z = pk2(o[4], o[5]); w.w = pk2(o[6], o[7]);
        *(u32x4*)(MIX + (size_t)t * DM + 1024 + cc) = w;
    }
}
__device__ __forceinline__ void ew1_token(int t, const u16* __restrict__ LAT, u16* __restrict__ CQN, u16* __restrict__ CKVN, u16* __restrict__ KROPE, int lane) {
    const u16* p0 = LAT + (size_t)t * NLATP;
#pragma unroll
    for (int part = 0; part < 2; ++part) {
        float x[8]; ld8f(p0 + part * 512 + lane * 8, x);
        float ss = 0.f;
#pragma unroll
        for (int e = 0; e < 8; ++e) ss += x[e] * x[e];
        const float r = 1.0f / sqrtf(wave_sum(ss) * (1.f / 512.f) + EPS);
        u32x4 w; w.x = pk2(x[0] * r, x[1] * r); w.y = pk2(x[2] * r, x[3] * r); w.z = pk2(x[4] * r, x[5] * r); w.w = pk2(x[6] * r, x[7] * r);
        *(u32x4*)((part ? CKVN : CQN) + (size_t)t * 512 + lane * 8) = w;
    }
    if (lane < 32) {
        const int s = t & (SEQ - 1), row = s >> 6, col = s & 63; const int j = lane & 15;
        const float invf = __builtin_amdgcn_exp2f(-(float)j * (LOG2_THETA / 16.f)); float c, sn; rope_cs((float)(lane < 16 ? row : col), invf, c, sn);
        const unsigned u = *(const unsigned*)(p0 + 1024 + 2 * lane); const float x1 = bflo(u), x2 = bfhi(u);
        *(unsigned*)(KROPE + (size_t)t * 64 + 2 * lane) = pk2(x1 * c - x2 * sn, x1 * sn + x2 * c);
    }
}
__device__ __forceinline__ void ew2_token(int t, u16* __restrict__ Q, int lane) {
    const int s = t & (SEQ - 1), row = s >> 6, col = s & 63;
    const int h = lane >> 2, part = lane & 3; const float pos = (float)(part < 2 ? row : col);
    u16* p = Q + (size_t)t * NQ + h * 192 + 128 + part * 16;
    float x[16]; ld8f(p, x); ld8f(p + 8, x + 8);
    unsigned w[8];
#pragma unroll
    for (int i = 0; i < 8; ++i) { const int j = (part & 1) * 8 + i; const float invf = __builtin_amdgcn_exp2f(-(float)j * (LOG2_THETA / 16.f)); float c, sn; rope_cs(pos, invf, c, sn);
        w[i] = pk2(x[2 * i] * c - x[2 * i + 1] * sn, x[2 * i] * sn + x[2 * i + 1] * c); }
    *(u32x4*)p = (u32x4){w[0], w[1], w[2], w[3]}; *(u32x4*)(p + 8) = (u32x4){w[4], w[5], w[6], w[7]};
}

struct Params { const float* in[18]; float* out; unsigned char* ws; int ph_lo, ph_hi; };
enum { I_X = 0, I_ENG, I_EWIN, I_EQG, I_EKG, I_ECW, I_EWOUT, I_ONG, I_OWDOWN, I_OQG, I_OKVG, I_OWUQ, I_OWUKV, I_OWO, I_MNG, I_MWUP, I_MWDN, I_FNG };
constexpr int NPHASE = 19;

template <int DQK> __device__ __forceinline__ bool attn_next(int i, int NU, int& unit) {
    const int G = gridDim.x, bx = blockIdx.x;
    if ((G & 7) == 0 && (NU & 7) == 0) { const int x = bx & 7, j = bx >> 3, per = G >> 3, upx = NU >> 3; const int k = i * per + j; if (k >= upx) return false; unit = x * upx + k; return true; }
    const int k = i * G + bx; if (k >= NU) return false; unit = k; return true;
}

__global__ void __launch_bounds__(NTHREADS, 2) fwd_mega(Params P) {
    extern __shared__ __attribute__((aligned(16))) unsigned char lds[];
    cg::grid_group grid = cg::this_grid();
    const int tid = threadIdx.x, lane = tid & 63, wave = __builtin_amdgcn_readfirstlane(tid >> 6);
    const int G = gridDim.x, gw = blockIdx.x * NWAVES + wave, NGW = G * NWAVES;
    unsigned char* ws = P.ws;
    u16* Win = (u16*)(ws + WS_WIN); u16* Wout = (u16*)(ws + WS_WOUT); u16* Wdown = (u16*)(ws + WS_WDOWN); u16* Wuq = (u16*)(ws + WS_WUQ); u16* Wukv = (u16*)(ws + WS_WUKV); u16* Wo = (u16*)(ws + WS_WO);
    u16* Wup = (u16*)(ws + WS_WUP); u16* Wdn = (u16*)(ws + WS_WDN);
    u16* XN = (u16*)(ws + WS_XN); u16* PROJ = (u16*)(ws + WS_PROJ); u16* MIX = (u16*)(ws + WS_MIX); u16* HID = (u16*)(ws + WS_HID);
    u16* LAT = (u16*)(ws + WS_LAT); u16* CQN = (u16*)(ws + WS_CQN); u16* CKVN = (u16*)(ws + WS_CKVN); u16* KROPE = (u16*)(ws + WS_KROPE);
    u16* Qm = (u16*)(ws + WS_Q); u16* KVm = (u16*)(ws + WS_KV); u16* AO = (u16*)(ws + WS_AO);
    float* H = P.out;
    LAS unsigned char* ldsl = (LAS unsigned char*)lds;
    const int lo = P.ph_lo, hi = P.ph_hi;
#define PH(k) if (lo <= (k) && (k) < hi)
#define SEAM(k) do { if (lo <= (k) && (k) + 1 < hi) grid.sync(); } while (0)
#define GEMM_BF16(ACT, Aptr, Bptr, Mv, Nv, Kv, Optr, ldc) do { pg8::Gemm g{Aptr, Bptr, Mv, Nv, Kv}; pg8::StaticOrder S; S.init(Mv, Nv, G, (int)blockIdx.x); \
        pg8::EpiBf16<ACT> E{Optr, ldc}; pg8::gemm_phase<pg8::EpiBf16<ACT>, pg8::StaticOrder, true, true>(ldsl, g, S, E); } while (0)
#define GEMM_RES(Aptr, Bptr, Mv, Nv, Kv, baseptr, outptr) do { pg8::Gemm g{Aptr, Bptr, Mv, Nv, Kv}; pg8::StaticOrder S; S.init(Mv, Nv, G, (int)blockIdx.x); \
        pg8::EpiRes E{baseptr, outptr, Nv}; pg8::gemm_phase<pg8::EpiRes, pg8::StaticOrder, true, true>(ldsl, g, S, E); } while (0)
#define NORM_PHASE(src) do { for (int m = gw; m < T; m += NGW) norm_row_bf16((src) + (size_t)m * DM, XN + (size_t)m * DM, lane); } while (0)

    PH(0) {
        LAS float* scr = (LAS float*)(ldsl + wave * 16384);
        constexpr int I0 = (DM / 64) * (IN0 / 32), I1 = (DM / 64) * (DM / 32), I2 = (DM / 64) * (NLAT / 32), I3 = (512 / 64) * (NQ / 32), I4 = (512 / 64) * (NKV / 32), I5 = I1;
        constexpr int I6 = (DM / 64) * (DFF / 32), I7 = (DFF / 64) * (DM / 32);
        constexpr int NITEMS = I0 + I1 + I2 + I3 + I4 + I5 + 2 * I6 + 2 * I7;
        for (int it = gw; it < NITEMS; it += NGW) {
            int r = it;
            if (r < I0) { transpose_item(P.in[I_EWIN], P.in[I_ENG], DM, IN0, Win, scr, r, lane); continue; } r -= I0;
            if (r < I1) { transpose_item(P.in[I_EWOUT], nullptr, DM, DM, Wout, scr, r, lane); continue; } r -= I1;
            if (r < I2) { transpose_item(P.in[I_OWDOWN], P.in[I_ONG], DM, NLAT, Wdown, scr, r, lane); continue; } r -= I2;
            if (r < I3) { transpose_item(P.in[I_OWUQ], P.in[I_OQG], 512, NQ, Wuq, scr, r, lane); continue; } r -= I3;
            if (r < I4) { transpose_item(P.in[I_OWUKV], P.in[I_OKVG], 512, NKV, Wukv, scr, r, lane); continue; } r -= I4;
            if (r < I5) { transpose_item(P.in[I_OWO], nullptr, DM, DM, Wo, scr, r, lane); continue; } r -= I5;
            if (r < I6) { transpose_item(P.in[I_MWUP], P.in[I_MNG], DM, DFF, Wup, scr, r, lane); continue; } r -= I6;
            if (r < I6) { transpose_item(P.in[I_MWUP] + (size_t)DM * DFF, P.in[I_MNG] + DM, DM, DFF, Wup + (size_t)DM * DFF, scr, r, lane); continue; } r -= I6;
            if (r < I7) { transpose_item(P.in[I_MWDN], nullptr, DFF, DM, Wdn, scr, r, lane); continue; } r -= I7;
            transpose_item(P.in[I_MWDN] + (size_t)DM * DFF, nullptr, DFF, DM, Wdn + (size_t)DM * DFF, scr, r, lane);
        }
        { const size_t n16 = (size_t)(NLATP - NLAT) * DM * 2 / 16; u32x4* z = (u32x4*)(Wdown + (size_t)NLAT * DM);
          for (size_t i = (size_t)blockIdx.x * NTHREADS + tid; i < n16; i += (size_t)G * NTHREADS) z[i] = (u32x4){0u, 0u, 0u, 0u}; }
        NORM_PHASE(P.in[I_X]);
    }
    SEAM(0);
    PH(1) { GEMM_BF16(0, XN, Win, T, IN0, DM, PROJ, IN0); }
    SEAM(1);
    PH(2) { const int per = (T + NGW - 1) / NGW; const int t0 = gw * per; for (int t = t0; t < t0 + per && t < T; ++t) ew0_token(t, PROJ, MIX, P.in[I_EQG], P.in[I_EKG], P.in[I_ECW], lane); }
    SEAM(2);
    PH(3) {
        constexpr int NU = BATCH * 8 * (SEQ / 256); int unit;
        for (int i = 0; attn_next<128>(i, NU, unit); ++i) {
            const int bh = unit / (SEQ / 256), qb = unit % (SEQ / 256), b = bh >> 3, hq = bh & 7, kvh = hq >> 2;
            const size_t tb = (size_t)b * SEQ;
#ifndef NO_GQA
            att::attn_unit<128, IN0, IN0, IN0, DM, 2>(PROJ + (tb + (size_t)qb * 256) * IN0 + hq * 128, PROJ + tb * IN0 + 1024 + kvh * 128, nullptr, PROJ + tb * IN0 + 1280 + kvh * 128,
                                                      MIX + (tb + (size_t)qb * 256) * DM + hq * 128, SEQ, (char*)lds);
#endif
        }
    }
    SEAM(3);
    PH(4) { GEMM_RES(MIX, Wout, T, DM, DM, P.in[I_X], H); }
    SEAM(4);
    PH(5) { NORM_PHASE(H); }
    SEAM(5);
    PH(6) { GEMM_BF16(2, XN, Wup, T, DFF, DM, HID, DFF); }
    SEAM(6);
    PH(7) { GEMM_RES(HID, Wdn, T, DM, DFF, H, H); }
    SEAM(7);
    PH(8) { NORM_PHASE(H); }
    SEAM(8);
    PH(9) { GEMM_BF16(0, XN, Wdown, T, NLATP, DM, LAT, NLATP); }
    SEAM(9);
    PH(10) { for (int t = gw; t < T; t += NGW) ew1_token(t, LAT, CQN, CKVN, KROPE, lane); }
    SEAM(10);
    PH(11) { GEMM_BF16(0, CQN, Wuq, T, NQ, 512, Qm, NQ); GEMM_BF16(0, CKVN, Wukv, T, NKV, 512, KVm, NKV); }
    SEAM(11);
    PH(12) { for (int t = gw; t < T; t += NGW) ew2_token(t, Qm, lane); }
    SEAM(12);
    PH(13) {
        constexpr int NU = BATCH * 16 * (SEQ / 256); int unit;
        for (int i = 0; attn_next<192>(i, NU, unit); ++i) {
            const int bh = unit / (SEQ / 256), qb = unit % (SEQ / 256), b = bh >> 4, h = bh & 15;
            const size_t tb = (size_t)b * SEQ;
#ifndef NO_MLA
            att::attn_unit<192, NQ, NKV, NKV, DM, MLA_SD>(Qm + (tb + (size_t)qb * 256) * NQ + h * 192, KVm + tb * NKV + h * 256, KROPE + tb * 64, KVm + tb * NKV + h * 256 + 128,
                                                          AO + (tb + (size_t)qb * 256) * DM + h * 128, SEQ, (char*)lds);
#endif
        }
    }
    SEAM(13);
    PH(14) { GEMM_RES(AO, Wo, T, DM, DM, H, H); }
    SEAM(14);
    PH(15) { NORM_PHASE(H); }
    SEAM(15);
    PH(16) { GEMM_BF16(2, XN, Wup + (size_t)DM * DFF, T, DFF, DM, HID, DFF); }
    SEAM(16);
    PH(17) { GEMM_RES(HID, Wdn + (size_t)DM * DFF, T, DM, DFF, H, H); }
    SEAM(17);
    PH(18) { for (int m = gw; m < T; m += NGW) norm_row_f32(H + (size_t)m * DM, P.in[I_FNG], lane); }
#undef PH
#undef SEAM
}

extern "C" void kernel_launch(void* const* d_in, const int* in_sizes, int n_in, void* d_out, int out_size, void* d_ws, size_t ws_size, hipStream_t stream) {
    static int grid = 0;
    if (grid == 0) {
        if (n_in != 18 || in_sizes[0] != T * DM || out_size != T * DM || ws_size < WS_END) {
            fprintf(stderr, "kernel_launch: shape mismatch (n_in %d in0 %d out %d ws %zu need %zu)\n", n_in, n_in > 0 ? in_sizes[0] : -1, out_size, ws_size, (size_t)WS_END); grid = -1; return; }
        int dev = 0, cus = 0, per_cu = 0;
        hipGetDevice(&dev); hipDeviceGetAttribute(&cus, hipDeviceAttributeMultiprocessorCount, dev);
        if (hipFuncSetAttribute((const void*)fwd_mega, hipFuncAttributeMaxDynamicSharedMemorySize, LDS_BYTES) != hipSuccess) { fprintf(stderr, "kernel_launch: hipFuncSetAttribute failed\n"); grid = -1; return; }
        if (hipOccupancyMaxActiveBlocksPerMultiprocessor(&per_cu, (const void*)fwd_mega, NTHREADS, LDS_BYTES) != hipSuccess || per_cu < 1) { fprintf(stderr, "kernel_launch: occupancy query says %d\n", per_cu); per_cu = 1; }
        (void)hipGetLastError();
        grid = cus * per_cu;
        fprintf(stderr, "kernel_launch: grid %d (cus %d x %d)\n", grid, cus, per_cu);
    }
    if (grid < 0) return;
    Params p{};
    for (int i = 0; i < 18; ++i) p.in[i] = (const float*)d_in[i];
    p.out = (float*)d_out; p.ws = (unsigned char*)d_ws;
#if N_LAUNCH_SPLIT
    for (int k = 0; k < NPHASE; ++k) { p.ph_lo = k; p.ph_hi = k + 1; void* args[] = {&p};
        hipError_t e = hipLaunchCooperativeKernel((const void*)fwd_mega, dim3(grid), dim3(NTHREADS), args, LDS_BYTES, stream);
        if (e != hipSuccess) { fprintf(stderr, "cooperative launch failed: %s (grid %d)\n", hipGetErrorString(e), grid); break; } }
#else
    p.ph_lo = 0; p.ph_hi = NPHASE; void* args[] = {&p};
    hipError_t e = hipLaunchCooperativeKernel((const void*)fwd_mega, dim3(grid), dim3(NTHREADS), args, LDS_BYTES, stream);
    if (e != hipSuccess) fprintf(stderr, "cooperative launch failed: %s (grid %d)\n", hipGetErrorString(e), grid);
#endif
}
```

```cpp
#include <hip/hip_runtime.h>
#include <hip/hip_cooperative_groups.h>
#include <cstdio>
#include <cstdint>
namespace cg = cooperative_groups;
#ifndef MLA_SD
#define MLA_SD 1
#endif
#ifndef MLA_QREG
#define MLA_QREG 8
#endif
#ifndef REP_MASK
#define REP_MASK 0u
#endif
#ifndef N_LAUNCH_SPLIT
#define N_LAUNCH_SPLIT 0
#endif
namespace pg8 {
#define PG8_LAS __attribute__((address_space(3)))
typedef unsigned short bf16_t;
typedef short bf16x8 __attribute__((ext_vector_type(8)));
typedef float f32x4 __attribute__((ext_vector_type(4)));
typedef unsigned u32x4 __attribute__((ext_vector_type(4)));
constexpr int BM = 256, BK = 64, HALF = 128, HTB = HALF * BK * 2  , STAGE_BYTES = 8 * HTB, NXCD = 8, WGM = 8;

__host__ __device__ __forceinline__ int lds_byte(int r, int c) { const int st = (r >> 4) * 2 + (c >> 5), rr = r & 15, cc = c & 31, ob = rr * 64 + cc * 2; return st * 1024 + (ob ^ (((ob >> 9) & 1) << 5)); }
__host__ __device__ __forceinline__ void stage_rc(int b, int& R, int& C) { const int st = b / 1024, sb = b % 1024, swz = sb ^ (((sb >> 9) & 1) << 5); R = (st >> 1) * 16 + swz / 64; C = (st & 1) * 32 + (swz % 64) / 2; }
__host__ __device__ __forceinline__ int perm32(int rho) { const int n = rho >> 4, i = rho & 15; return 8 * (i >> 2) + 4 * n + (i & 3); }

struct Unit { int pm, pn; };
struct Gemm { const bf16_t* A; const bf16_t* Bt; int M, N, K; };

struct StaticOrder {
    int nM, nN, nwg, G, c;
    __host__ __device__ void init(int M, int N, int G_, int c_) { nM = M / BM; nN = N / BM; nwg = nM * nN; G = G_; c = c_; }
    __host__ __device__ bool next(int i, Unit& u) const {
        const long L = (long)i * G + c; if (L >= nwg) return false;
        int wgid = (int)L; { const int q = nwg / NXCD, r = nwg % NXCD, xcd = wgid % NXCD, off = wgid / NXCD; wgid = (xcd < r ? xcd * (q + 1) : r * (q + 1) + (xcd - r) * q) + off; }
        const int nig = WGM * nN, gid = wgid / nig, fm = gid * WGM, gsz = (nM - fm) < WGM ? (nM - fm) : WGM;
        u.pm = fm + ((wgid % nig) % gsz); u.pn = (wgid % nig) / gsz; return true;
    }
    __device__ __forceinline__ void a_ready(const Unit&) const {}
    __device__ __forceinline__ void done(const Unit&) const {}
};
__device__ __forceinline__ unsigned cvt_pk_bf16(float lo, float hi) { unsigned r; asm volatile("v_cvt_pk_bf16_f32 %0, %1, %2" : "=v"(r) : "v"(lo), "v"(hi)); return r; }
template <int ACT> struct EpiBf16 {
    static constexpr bool PERM = true, AFTER_DRAIN = false;
    bf16_t* O; int ldc;
    __device__ __forceinline__ void operator()(const f32x4 (&acc)[2][2][4][2], const Unit& u, int wr, int wc, int fr, int fq) const {
        const int row0 = u.pm * BM + wr * 64 + fr; const int col0 = u.pn * BM + wc * 32 + 8 * fq;
#pragma unroll
        for (int ai = 0; ai < 2; ++ai)
#pragma unroll
            for (int m = 0; m < 4; ++m) { bf16_t* rowp = O + (size_t)(row0 + ai * HALF + m * 16) * ldc + col0;
#pragma unroll
                for (int bj = 0; bj < 2; ++bj) { f32x4 v0 = acc[ai][bj][m][0], v1 = acc[ai][bj][m][1];
                    if (ACT == 2) {
#pragma unroll
                        for (int e = 0; e < 4; ++e) { float a = v0[e] > 0.f ? v0[e] : 0.f; v0[e] = a * a; float b = v1[e] > 0.f ? v1[e] : 0.f; v1[e] = b * b; } }
                    u32x4 w; w.x = cvt_pk_bf16(v0[0], v0[1]); w.y = cvt_pk_bf16(v0[2], v0[3]); w.z = cvt_pk_bf16(v1[0], v1[1]); w.w = cvt_pk_bf16(v1[2], v1[3]);
                    *(u32x4*)(rowp + bj * HALF) = w; } }
    }
};
struct EpiRes {
    static constexpr bool PERM = false, AFTER_DRAIN = false;
    const float* base; float* out; int ldc;
    __device__ __forceinline__ void operator()(const f32x4 (&acc)[2][2][4][2], const Unit& u, int wr, int wc, int fr, int fq) const {
        const int row0 = u.pm * BM + wr * 64 + fr; const int col0 = u.pn * BM + wc * 32 + 4 * fq;
#pragma unroll
        for (int ai = 0; ai < 2; ++ai)
#pragma unroll
            for (int m = 0; m < 4; ++m) { const size_t off = (size_t)(row0 + ai * HALF + m * 16) * ldc + col0;
#pragma unroll
                for (int bj = 0; bj < 2; ++bj)
#pragma unroll
                    for (int n = 0; n < 2; ++n) { const size_t o = off + bj * HALF + n * 16; const f32x4 b = *(const f32x4*)(base + o); *(f32x4*)(out + o) = b + acc[ai][bj][m][n]; }
                asm volatile("" ::: "memory"); }
    }
};
template <class Epi, class Sched, bool ALIGN_EPI = false, bool SP2 = false>
__device__ __forceinline__ void gemm_phase(PG8_LAS unsigned char* lds, const Gemm g, const Sched& S, const Epi& E) {
    const int tid = threadIdx.x, wid = __builtin_amdgcn_readfirstlane(tid >> 6), lane = tid & 63, wr = wid >> 2, wc = wid & 3, fr = lane & 15, fq = lane >> 4;
    const int K = g.K, nt = K / BK;
    unsigned voffA[2], voffB[2];
#pragma unroll
    for (int i = 0; i < 2; ++i) { int R, C; stage_rc(tid * 16 + i * 8192, R, C); const int Rb = Epi::PERM ? ((R & ~31) + perm32(R & 31)) : R;
        voffA[i] = (unsigned)(R * K + C) * 2u; voffB[i] = (unsigned)(Rb * K + C) * 2u; }
    const size_t kstep = (size_t)(BK * 2);
    const size_t hstep = (size_t)HALF * K * 2;
    const size_t tstep = 2 * hstep;
    const unsigned ldsw = (unsigned)wid * 1024u;
    const int aoff = lds_byte(wr * 64 + fr, fq * 8), boff = lds_byte(wc * 32 + fr, fq * 8);
#define PG8_SA(b, h) (((b) * 2 + (h)) * HTB)
#define PG8_SB(b, h) ((4 + (b) * 2 + (h)) * HTB)
#define PG8_STAGE(bufoff, gbase, voff) do { _Pragma("unroll") for (int _i = 0; _i < 2; ++_i) \
        __builtin_amdgcn_global_load_lds((const unsigned*)((const char*)(gbase) + (voff)[_i]), (PG8_LAS unsigned*)(lds + (bufoff) + ldsw + _i * 8192), 16, 0, 0); } while (0)
#define PG8_LDA(dst, b, h) do { _Pragma("unroll") for (int m = 0; m < 4; ++m) _Pragma("unroll") for (int k = 0; k < 2; ++k) dst[m][k] = *(const PG8_LAS bf16x8*)(lds + PG8_SA(b, h) + aoff + m * 2048 + k * 1024); } while (0)
#define PG8_LDB(dst, b, h) do { _Pragma("unroll") for (int n = 0; n < 2; ++n) _Pragma("unroll") for (int k = 0; k < 2; ++k) dst[n][k] = *(const PG8_LAS bf16x8*)(lds + PG8_SB(b, h) + boff + n * 2048 + k * 1024); } while (0)
#define PG8_MMA(ai, bj, At, Bt) do { __builtin_amdgcn_s_setprio(1); _Pragma("unroll") for (int m = 0; m < 4; ++m) _Pragma("unroll") for (int n = 0; n < 2; ++n) _Pragma("unroll") for (int k = 0; k < 2; ++k) \
        acc[ai][bj][m][n] = __builtin_amdgcn_mfma_f32_16x16x32_bf16(Bt[n][k], At[m][k], acc[ai][bj][m][n], 0, 0, 0); __builtin_amdgcn_s_setprio(0); } while (0)
#define PG8_WAIT_V(n) asm volatile("s_waitcnt vmcnt(" #n ")" ::: "memory")
#define PG8_WAIT_L(n) asm volatile("s_waitcnt lgkmcnt(" #n ")" ::: "memory")
#define PG8_BAR __builtin_amdgcn_s_barrier()
#define PG8_SCHED __builtin_amdgcn_sched_barrier(0)
    Unit cur, nxt; int ui = 0;
    if (!S.next(0, cur)) return;
    f32x4 acc[2][2][4][2];
#pragma unroll
    for (int a = 0; a < 2; ++a)
#pragma unroll
        for (int b = 0; b < 2; ++b)
#pragma unroll
            for (int m = 0; m < 4; ++m)
#pragma unroll
                for (int n = 0; n < 2; ++n) acc[a][b][m][n] = (f32x4){0.f, 0.f, 0.f, 0.f};
    bf16x8 At[4][2], B0[2][2], B1[2][2];
    const char* cA = (const char*)g.A + (size_t)cur.pm * tstep; const char* cB = (const char*)g.Bt + (size_t)cur.pn * tstep;
    S.a_ready(cur);
    if constexpr (SP2) {
        PG8_STAGE(PG8_SB(0, 0), cB, voffB); PG8_STAGE(PG8_SB(0, 1), cB + hstep, voffB); PG8_STAGE(PG8_SA(0, 0), cA, voffA); PG8_STAGE(PG8_SA(0, 1), cA + hstep, voffA);
        if (wr == 1) PG8_BAR;
        PG8_WAIT_V(2); PG8_BAR;
        PG8_STAGE(PG8_SB(1, 0), cB + kstep, voffB); PG8_STAGE(PG8_SA(1, 0), cA + kstep, voffA); PG8_STAGE(PG8_SB(1, 1), cB + hstep + kstep, voffB);
        PG8_WAIT_V(6); PG8_BAR;
    } else {
        PG8_STAGE(PG8_SB(0, 0), cB, voffB); PG8_STAGE(PG8_SA(0, 0), cA, voffA); PG8_STAGE(PG8_SB(0, 1), cB + hstep, voffB); PG8_STAGE(PG8_SA(0, 1), cA + hstep, voffA);
        if (wr == 1) PG8_BAR;
        PG8_WAIT_V(4); PG8_BAR;
        PG8_STAGE(PG8_SB(1, 0), cB + kstep, voffB); PG8_STAGE(PG8_SA(1, 0), cA + kstep, voffA); PG8_STAGE(PG8_SB(1, 1), cB + hstep + kstep, voffB);
        PG8_WAIT_V(6); PG8_BAR;
    }
    for (;;) {
        const bool has_next = S.next(ui + 1, nxt);
        const char* nA = has_next ? (const char*)g.A + (size_t)nxt.pm * tstep : cA; const char* nB = has_next ? (const char*)g.Bt + (size_t)nxt.pn * tstep : cB;
        for (int t = 0; t < nt; t += 2) {
            const bool last = (t == nt - 2);
            const char* a1 = cA + (size_t)(t + 1) * kstep;
            const char* a2 = last ? nA : cA + (size_t)(t + 2) * kstep; const char* b2 = last ? nB : cB + (size_t)(t + 2) * kstep;
            const char* a3 = a2 + kstep; const char* b3 = b2 + kstep;
            if (last && has_next) S.a_ready(nxt);
            if constexpr (SP2) {
            PG8_LDB(B0, 0, 0); PG8_LDB(B1, 0, 1); PG8_SCHED; PG8_LDA(At, 0, 0); PG8_STAGE(PG8_SA(1, 1), a1 + hstep, voffA);
            PG8_WAIT_V(8); PG8_WAIT_L(0); PG8_BAR; PG8_MMA(0, 0, At, B0); PG8_MMA(0, 1, At, B1); PG8_BAR; PG8_SCHED;
            PG8_LDA(At, 0, 1); PG8_STAGE(PG8_SB(0, 0), b2, voffB); PG8_STAGE(PG8_SB(0, 1), b2 + hstep, voffB); PG8_STAGE(PG8_SA(0, 0), a2, voffA);
            PG8_WAIT_V(8); PG8_WAIT_L(0); PG8_BAR; PG8_MMA(1, 0, At, B0); PG8_MMA(1, 1, At, B1); PG8_BAR; PG8_SCHED;
            PG8_LDB(B0, 1, 0); PG8_LDB(B1, 1, 1); PG8_SCHED; PG8_LDA(At, 1, 0); PG8_STAGE(PG8_SA(0, 1), a2 + hstep, voffA);
            PG8_WAIT_V(8); PG8_WAIT_L(0); PG8_BAR; PG8_MMA(0, 0, At, B0); PG8_MMA(0, 1, At, B1); PG8_BAR; PG8_SCHED;
            PG8_LDA(At, 1, 1); PG8_STAGE(PG8_SB(1, 0), b3, voffB); PG8_STAGE(PG8_SB(1, 1), b3 + hstep, voffB); PG8_STAGE(PG8_SA(1, 0), a3, voffA);
            PG8_WAIT_V(8); PG8_WAIT_L(0); PG8_BAR; PG8_MMA(1, 0, At, B0); PG8_MMA(1, 1, At, B1); PG8_BAR; PG8_SCHED;
            } else {
            PG8_LDB(B0, 0, 0); PG8_SCHED; PG8_LDA(At, 0, 0); PG8_STAGE(PG8_SA(1, 1), a1 + hstep, voffA);
            PG8_WAIT_L(8); PG8_BAR; PG8_WAIT_L(0); PG8_MMA(0, 0, At, B0); PG8_BAR; PG8_SCHED;
            PG8_LDB(B1, 0, 1); PG8_STAGE(PG8_SB(0, 0), b2, voffB);
            PG8_BAR; PG8_WAIT_L(0); PG8_MMA(0, 1, At, B1); PG8_BAR;
            PG8_LDA(At, 0, 1); PG8_STAGE(PG8_SA(0, 0), a2, voffA);
            PG8_BAR; PG8_WAIT_L(0); PG8_MMA(1, 0, At, B0); PG8_BAR; PG8_SCHED;
            PG8_STAGE(PG8_SB(0, 1), b2 + hstep, voffB);
            PG8_WAIT_V(6); PG8_BAR; PG8_MMA(1, 1, At, B1); PG8_BAR;
            PG8_LDB(B0, 1, 0); PG8_SCHED; PG8_LDA(At, 1, 0); PG8_STAGE(PG8_SA(0, 1), a2 + hstep, voffA);
            PG8_WAIT_L(8); PG8_BAR; PG8_WAIT_L(0); PG8_MMA(0, 0, At, B0); PG8_BAR; PG8_SCHED;
            PG8_LDB(B1, 1, 1); PG8_STAGE(PG8_SB(1, 0), b3, voffB);
            PG8_BAR; PG8_WAIT_L(0); PG8_MMA(0, 1, At, B1); PG8_BAR;
            PG8_LDA(At, 1, 1); PG8_STAGE(PG8_SA(1, 0), a3, voffA);
            PG8_BAR; PG8_WAIT_L(0); PG8_MMA(1, 0, At, B0); PG8_BAR; PG8_SCHED;
            PG8_STAGE(PG8_SB(1, 1), b3 + hstep, voffB);
            PG8_WAIT_V(6); PG8_BAR; PG8_MMA(1, 1, At, B1); PG8_BAR;
            }
        }
        if constexpr (ALIGN_EPI) { if (wr == 0) PG8_BAR; }
        if constexpr (!Epi::AFTER_DRAIN) { E(acc, cur, wr, wc, fr, fq); S.done(cur); }
        if (!has_next) break;
#pragma unroll
        for (int a = 0; a < 2; ++a)
#pragma unroll
            for (int b = 0; b < 2; ++b)
#pragma unroll
                for (int m = 0; m < 4; ++m)
#pragma unroll
                    for (int n = 0; n < 2; ++n) acc[a][b][m][n] = (f32x4){0.f, 0.f, 0.f, 0.f};
        cur = nxt; cA = nA; cB = nB; ++ui;
        if constexpr (ALIGN_EPI) { if (wr == 1) PG8_BAR; }
    }
    PG8_WAIT_V(0);
    if constexpr (!ALIGN_EPI) { if (wr == 0) PG8_BAR; }
    PG8_BAR;
    if constexpr (Epi::AFTER_DRAIN) { E.fused(acc, cur, wr, wc, fr, fq, lds, wid, lane); S.done(cur); }
#undef PG8_SA
#undef PG8_SB
#undef PG8_STAGE
#undef PG8_LDA
#undef PG8_LDB
#undef PG8_MMA
#undef PG8_WAIT_V
#undef PG8_WAIT_L
#undef PG8_BAR
#undef PG8_SCHED
}
}
namespace att {
typedef unsigned short bf16;
using bf16x8 = __attribute__((ext_vector_type(8))) short;
using s16x4  = __attribute__((ext_vector_type(4))) short;
using f32x16 = __attribute__((ext_vector_type(16))) float;
using u32x4  = __attribute__((ext_vector_type(4))) unsigned;
constexpr int NW = 8, QBLK = 32, KVBLK = 64;
constexpr float THR = 8.f;
#define ATT_SBAR() __builtin_amdgcn_sched_barrier(0)
__device__ __forceinline__ int crow(int r, int hi) { return (r & 3) + 8 * (r >> 2) + 4 * hi; }
__device__ __forceinline__ unsigned cvtpk(float lo, float hi) { unsigned r; asm volatile("v_cvt_pk_bf16_f32 %0, %1, %2" : "=v"(r) : "v"(lo), "v"(hi)); return r; }
__device__ __forceinline__ bf16x8 ld8(const bf16* p) { return *reinterpret_cast<const bf16x8*>(p); }

template <int DQK> struct Cfg {
  static constexpr float SCALE = (DQK == 128) ? 0.088388347648318440f : 0.072168783648703220f;
  static constexpr float C = SCALE * 1.4426950408889634f;
  static constexpr int KROWB = DQK * 2, SHM_K = KVBLK * KROWB, SHM_V = KVBLK * 128 * 2, ND0 = DQK / 16;
  static constexpr int QREG = (DQK > 128) ? MLA_QREG : 8;
  static constexpr int QXW = (ND0 - QREG) * 1024, SHM_QX = NW * QXW;
  static constexpr int SHM_TOTAL = 2 * SHM_V + 2 * SHM_K + NW * 64 * 4 + SHM_QX;
};

template <int DQK> __device__ __forceinline__ void partialSM(f32x16& p0, f32x16& p1, float& m_reg, float& mn, float& alpha) {
  constexpr float C = Cfg<DQK>::C, SCALE = Cfg<DQK>::SCALE;
  float pmax = p0[0];
#pragma unroll
  for (int r = 1; r < 16; ++r) pmax = fmaxf(pmax, p0[r]);
#pragma unroll
  for (int r = 0; r < 16; ++r) pmax = fmaxf(pmax, p1[r]);
  { auto rr = __builtin_amdgcn_permlane32_swap(__float_as_uint(pmax), __float_as_uint(pmax), false, false);
    pmax = fmaxf(__uint_as_float(rr[0]), __uint_as_float(rr[1])); }
  if (__builtin_expect(__all(pmax - m_reg <= THR / SCALE), 1)) { mn = m_reg; alpha = 1.f; }
  else { mn = fmaxf(m_reg, pmax); alpha = __builtin_amdgcn_exp2f((m_reg - mn) * C); m_reg = mn; }
  float mnC = -mn * C;
#pragma unroll
  for (int r = 0; r < 16; ++r) p0[r] = fmaf(p0[r], C, mnC);
#pragma unroll
  for (int r = 0; r < 16; ++r) p1[r] = fmaf(p1[r], C, mnC);
#pragma unroll
  for (int r = 0; r < 16; ++r) p0[r] = __builtin_amdgcn_exp2f(p0[r]);
}
__device__ __forceinline__ void finishSM(f32x16& p0, f32x16& p1, float alpha, float& l_reg, bf16x8& pa0, bf16x8& pa1, bf16x8& pa2, bf16x8& pa3) {
#pragma unroll
  for (int r = 0; r < 16; ++r) p1[r] = __builtin_amdgcn_exp2f(p1[r]);
  float ps = 0;
#pragma unroll
  for (int r = 0; r < 16; ++r) ps += p0[r];
#pragma unroll
  for (int r = 0; r < 16; ++r) ps += p1[r];
  { auto rr = __builtin_amdgcn_permlane32_swap(__float_as_uint(ps), __float_as_uint(ps), false, false);
    ps = __uint_as_float(rr[0]) + __uint_as_float(rr[1]); }
  l_reg = l_reg * alpha + ps;
#define ATT_PK4(P, BASE, OUT) do { unsigned a0 = cvtpk(P[BASE + 0], P[BASE + 1]), a1 = cvtpk(P[BASE + 2], P[BASE + 3]);   \
    unsigned b0 = cvtpk(P[BASE + 4], P[BASE + 5]), b1 = cvtpk(P[BASE + 6], P[BASE + 7]);                              \
    auto r0 = __builtin_amdgcn_permlane32_swap(a0, b0, false, false); auto r1 = __builtin_amdgcn_permlane32_swap(a1, b1, false, false); \
    u32x4 w = {r0[0], r1[0], r0[1], r1[1]}; OUT = *reinterpret_cast<bf16x8*>(&w); } while (0)
  ATT_PK4(p0, 0, pa0); ATT_PK4(p0, 8, pa1); ATT_PK4(p1, 0, pa2); ATT_PK4(p1, 8, pa3);
#undef ATT_PK4
}
#define ATT_KSWZ(row, colB) ((row) * KROWB + ((colB) ^ (((row) & 7) << 4)))
template <int DQK> __device__ __forceinline__ void qkt(f32x16& p0, f32x16& p1, const char* Ks, const int* kb, const bf16x8* qr, const char* qx, int r32, int hi) {
  constexpr int KROWB = Cfg<DQK>::KROWB, ND0 = Cfg<DQK>::ND0, QREG = Cfg<DQK>::QREG;
  p0 = f32x16{}; p1 = f32x16{};
#pragma unroll
  for (int d0 = 0; d0 < ND0; ++d0) {
    bf16x8 b0 = *reinterpret_cast<const bf16x8*>(Ks + kb[d0 & 3] + (d0 >> 2) * 128);
    bf16x8 b1 = *reinterpret_cast<const bf16x8*>(Ks + kb[d0 & 3] + (d0 >> 2) * 128 + 32 * KROWB);
    bf16x8 q; if (d0 < QREG) q = qr[d0]; else q = *reinterpret_cast<const bf16x8*>(qx + (d0 - QREG) * 1024);
    p0 = __builtin_amdgcn_mfma_f32_32x32x16_bf16(b0, q, p0, 0, 0, 0);
    p1 = __builtin_amdgcn_mfma_f32_32x32x16_bf16(b1, q, p1, 0, 0, 0); }
}
__device__ __forceinline__ int v_st(int k, int c) { const int kk = (k & ~0xC) | ((k & 4) << 1) | ((k & 8) >> 1); return ((kk >> 3) * 4 + (c >> 5)) * 512 + ((kk & 7) * 32 + (c & 31)) * 2; }
__device__ __forceinline__ int v_rd_base(int lane) { return ((lane & 3) << 3) | (((lane >> 2) & 3) << 6) | (((lane >> 4) & 1) << 5) | (((lane >> 5) & 1) << 8); }
constexpr int v_rd_off(int d0, int ks, int half) { return d0 * 512 + ks * 4096 + half * 2048; }
template <int OFF> __device__ __forceinline__ s16x4 tr_read(int vb) {
  s16x4 r; asm volatile("ds_read_b64_tr_b16 %0, %1 offset:%2" : "=&v"(r) : "v"(vb), "i"(OFF) : "memory"); return r;
}
template <int D0> __device__ __forceinline__ void pv_one(f32x16& od, int vb, bf16x8 pa0, bf16x8 pa1, bf16x8 pa2, bf16x8 pa3) {
  const s16x4 l0 = tr_read<v_rd_off(D0, 0, 0)>(vb), h0 = tr_read<v_rd_off(D0, 0, 1)>(vb), l1 = tr_read<v_rd_off(D0, 1, 0)>(vb), h1 = tr_read<v_rd_off(D0, 1, 1)>(vb);
  const s16x4 l2 = tr_read<v_rd_off(D0, 2, 0)>(vb), h2 = tr_read<v_rd_off(D0, 2, 1)>(vb), l3 = tr_read<v_rd_off(D0, 3, 0)>(vb), h3 = tr_read<v_rd_off(D0, 3, 1)>(vb);
  asm volatile("s_waitcnt lgkmcnt(0)" ::: "memory"); ATT_SBAR();
#define ATT_PK(L, H) (bf16x8){L[0], L[1], L[2], L[3], H[0], H[1], H[2], H[3]}
  od = __builtin_amdgcn_mfma_f32_32x32x16_bf16(pa0, ATT_PK(l0, h0), od, 0, 0, 0);
  od = __builtin_amdgcn_mfma_f32_32x32x16_bf16(pa1, ATT_PK(l1, h1), od, 0, 0, 0);
  od = __builtin_amdgcn_mfma_f32_32x32x16_bf16(pa2, ATT_PK(l2, h2), od, 0, 0, 0);
  od = __builtin_amdgcn_mfma_f32_32x32x16_bf16(pa3, ATT_PK(l3, h3), od, 0, 0, 0);
#undef ATT_PK
}
__device__ __forceinline__ void pv_d0(f32x16* o, int vb, bf16x8 pa0, bf16x8 pa1, bf16x8 pa2, bf16x8 pa3) {
  pv_one<0>(o[0], vb, pa0, pa1, pa2, pa3); pv_one<1>(o[1], vb, pa0, pa1, pa2, pa3); pv_one<2>(o[2], vb, pa0, pa1, pa2, pa3); pv_one<3>(o[3], vb, pa0, pa1, pa2, pa3);
}

template <int DQK, int LDQ, int LDK, int LDV, int LDO, int SD>
__device__ __forceinline__ void attn_unit(const bf16* __restrict__ Qb, const bf16* __restrict__ Kh, const bf16* __restrict__ Kr, const bf16* __restrict__ Vh,
                                          bf16* __restrict__ Ob, int seq, char* lds) {
  constexpr int KROWB = Cfg<DQK>::KROWB, SHM_K = Cfg<DQK>::SHM_K, SHM_V = Cfg<DQK>::SHM_V, ND0 = Cfg<DQK>::ND0;
  const int tid = threadIdx.x, wid = tid >> 6, lane = tid & 63, r32 = lane & 31, hi = lane >> 5;
  char* V_lds = lds; char* K_lds = lds + 2 * SHM_V;
  float* ws = (float*)(lds + 2 * SHM_V + 2 * SHM_K) + wid * 64; float* li_l = ws; float* al_l = ws + 32;
  float m_reg = -1e30f, l_reg = 0; f32x16 o[4] = {}; constexpr int QREG = Cfg<DQK>::QREG; bf16x8 qr[QREG];
  const bf16* Qw = Qb + (long)(wid * QBLK + r32) * LDQ + hi * 8;
  char* qx = lds + 2 * SHM_V + 2 * SHM_K + NW * 64 * 4 + wid * Cfg<DQK>::QXW + lane * 16;
#pragma unroll
  for (int d0 = 0; d0 < QREG; ++d0) qr[d0] = ld8(Qw + d0 * 16);
  if constexpr (QREG < ND0) {
#pragma unroll
    for (int d0 = QREG; d0 < ND0; ++d0) *(bf16x8*)(qx + (d0 - QREG) * 1024) = ld8(Qw + d0 * 16);
  }
  const int sr = tid >> 4, sc = (tid & 15) * 8, vst0 = v_st(sr, sc), vst1 = v_st(32 + sr, sc);
  const int krr = tid >> 3, krc = (tid & 7) * 8;
  const int vb0 = (int)(uintptr_t)V_lds + v_rd_base(lane);
  int kb[4];
#pragma unroll
  for (int dl = 0; dl < 4; ++dl) kb[dl] = r32 * KROWB + ((dl * 32 + hi * 16) ^ ((r32 & 7) << 4));
  const unsigned boV = (unsigned)(sr * LDV + sc) * 2u, boK = (unsigned)(sr * LDK + sc) * 2u, boR = (unsigned)(krr * 64 + krc) * 2u;
  struct { bf16x8 vs0, vs1, ks0, ks1, kr; } sr_[SD];
#define SLOAD(i, k0) do { const char* vt_ = (const char*)(Vh + (long)(k0) * LDV); const char* kt_ = (const char*)(Kh + (long)(k0) * LDK); \
    sr_[i].vs0 = *(const bf16x8*)(vt_ + boV); sr_[i].vs1 = *(const bf16x8*)(vt_ + 32 * LDV * 2 + boV); \
    sr_[i].ks0 = *(const bf16x8*)(kt_ + boK); sr_[i].ks1 = *(const bf16x8*)(kt_ + 32 * LDK * 2 + boK); \
    if constexpr (DQK == 192) { const char* rt_ = (const char*)(Kr + (long)(k0) * 64); sr_[i].kr = *(const bf16x8*)(rt_ + boR); } } while (0)
#define SWRITE(b, i) do { *(bf16x8*)(V_lds + (b) * SHM_V + vst0) = sr_[i].vs0;          \
    *(bf16x8*)(V_lds + (b) * SHM_V + vst1) = sr_[i].vs1; int kc = sc * 2;               \
    *(bf16x8*)(K_lds + (b) * SHM_K + ATT_KSWZ(sr, kc)) = sr_[i].ks0;                       \
    *(bf16x8*)(K_lds + (b) * SHM_K + ATT_KSWZ(32 + sr, kc)) = sr_[i].ks1;                  \
    if constexpr (DQK == 192) *(bf16x8*)(K_lds + (b) * SHM_K + ATT_KSWZ(krr, 256 + krc * 2)) = sr_[i].kr; } while (0)
#define SWAIT() do { if constexpr (SD == 2) { if constexpr (DQK == 192) asm volatile("s_waitcnt vmcnt(5)" ::: "memory"); else asm volatile("s_waitcnt vmcnt(4)" ::: "memory"); } \
    else asm volatile("s_waitcnt vmcnt(0)" ::: "memory"); } while (0)
#define RESC(a) do { if (__any((a) < 1.f)) { if (hi == 0) al_l[r32] = (a); asm volatile("s_waitcnt lgkmcnt(0)" ::: "memory"); \
    _Pragma("unroll") for (int d = 0; d < 4; ++d) _Pragma("unroll") for (int r = 0; r < 16; ++r) o[d][r] *= al_l[crow(r, hi)]; } } while (0)
  f32x16 pA0, pA1, pB0, pB1; float mnA, mnB, alA, alB; bf16x8 pa0, pa1, pa2, pa3; const int NT = seq / KVBLK;
  constexpr int SE = 0, SO = SD - 1;
  SLOAD(SE, 0); asm volatile("s_waitcnt vmcnt(0)" ::: "memory"); SWRITE(0, SE); __syncthreads();
  qkt<DQK>(pA0, pA1, K_lds, kb, qr, qx, r32, hi); partialSM<DQK>(pA0, pA1, m_reg, mnA, alA);
  SLOAD(SO, KVBLK); if constexpr (SD == 2) { if (2 < NT) SLOAD(SE, 2 * KVBLK); }
  SWAIT(); SWRITE(1, SO); __syncthreads();
  for (int j = 1; j + 1 < NT; j += 2) {
    ATT_SBAR(); qkt<DQK>(pB0, pB1, K_lds + SHM_K, kb, qr, qx, r32, hi);
    finishSM(pA0, pA1, alA, l_reg, pa0, pa1, pa2, pa3); ATT_SBAR();
    SLOAD(SO, (j + SD) * KVBLK); ATT_SBAR();
    pv_d0(o, vb0, pa0, pa1, pa2, pa3); partialSM<DQK>(pB0, pB1, m_reg, mnB, alB);
    __syncthreads(); SWAIT(); SWRITE(0, SE);
    RESC(alB); __syncthreads();
    ATT_SBAR(); qkt<DQK>(pA0, pA1, K_lds, kb, qr, qx, r32, hi);
    finishSM(pB0, pB1, alB, l_reg, pa0, pa1, pa2, pa3); ATT_SBAR();
    if (SD == 1 || j + 3 < NT) SLOAD(SE, (j + 1 + SD) * KVBLK); ATT_SBAR();
    pv_d0(o, vb0 + (int)SHM_V, pa0, pa1, pa2, pa3); partialSM<DQK>(pA0, pA1, m_reg, mnA, alA);
    __syncthreads(); SWAIT(); SWRITE(1, SO);
    RESC(alA); __syncthreads();
  }
  ATT_SBAR(); qkt<DQK>(pB0, pB1, K_lds + SHM_K, kb, qr, qx, r32, hi);
  finishSM(pA0, pA1, alA, l_reg, pa0, pa1, pa2, pa3); ATT_SBAR();
  pv_d0(o, vb0, pa0, pa1, pa2, pa3); partialSM<DQK>(pB0, pB1, m_reg, mnB, alB);
  __syncthreads(); RESC(alB);
  finishSM(pB0, pB1, alB, l_reg, pa0, pa1, pa2, pa3); ATT_SBAR();
  pv_d0(o, vb0 + (int)SHM_V, pa0, pa1, pa2, pa3);
  if (hi == 0) li_l[r32] = l_reg; asm volatile("s_waitcnt lgkmcnt(0)" ::: "memory");
  float rli[16];
#pragma unroll
  for (int r = 0; r < 16; ++r) rli[r] = __builtin_amdgcn_rcpf(li_l[crow(r, hi)]);
  bf16* Ow = Ob + (long)(wid * QBLK) * LDO;
#pragma unroll
  for (int r = 0; r < 16; ++r) { int orow = crow(r, hi);
#pragma unroll
    for (int d0 = 0; d0 < 4; ++d0) Ow[(long)orow * LDO + d0 * 32 + r32] = (bf16)(cvtpk(o[d0][r] * rli[r], 0.f) & 0xffffu); }
  asm volatile("s_waitcnt vmcnt(0) lgkmcnt(0)" ::: "memory"); __syncthreads();
#undef SLOAD
#undef SWRITE
#undef SWAIT
#undef RESC
}
#undef ATT_KSWZ
#undef ATT_SBAR
}
#define LAS __attribute__((address_space(3)))
typedef unsigned short u16;
typedef float f32x4 __attribute__((ext_vector_type(4)));
typedef short bf16x8 __attribute__((ext_vector_type(8)));
typedef unsigned u32x4 __attribute__((ext_vector_type(4)));
typedef unsigned u32x2 __attribute__((ext_vector_type(2)));
constexpr int DM = 2048, BATCH = 2, SEQ = 16384, T = BATCH * SEQ;
constexpr int IN0 = 4608, NLAT = 1088, NLATP = 1280, NQ = 3072, NKV = 4096, DFF = 8192;
constexpr float EPS = 1e-6f;
constexpr int NWAVES = 8, NTHREADS = 512;
constexpr int LDS_BYTES = 155648;
constexpr float LOG2_THETA = 13.287712379549449f;

constexpr size_t MiB = 1u << 20;
constexpr size_t WS_WIN = 0, WS_WOUT = 18 * MiB, WS_WDOWN = 26 * MiB, WS_WUQ = 31 * MiB, WS_WUKV = 34 * MiB, WS_WO = 38 * MiB;
constexpr size_t WS_WUP = 46 * MiB  , WS_WDN = 110 * MiB  ;
constexpr size_t WS_XN = 176 * MiB;
constexpr size_t WS_BIG = 304 * MiB;
constexpr size_t WS_PROJ = WS_BIG, WS_MIX = WS_BIG + 288 * MiB;
constexpr size_t WS_HID = WS_BIG;
constexpr size_t WS_LAT = WS_BIG, WS_CQN = WS_BIG + 80 * MiB, WS_CKVN = WS_BIG + 112 * MiB, WS_KROPE = WS_BIG + 144 * MiB;
constexpr size_t WS_Q = WS_BIG + 148 * MiB, WS_KV = WS_BIG + 340 * MiB, WS_AO = WS_BIG;
constexpr size_t WS_CTL = WS_BIG + 596 * MiB, CTL_BYTES = 65536;
constexpr size_t WS_END = WS_CTL + CTL_BYTES;

__device__ __forceinline__ float bflo(unsigned u) { return __uint_as_float(u << 16); }
__device__ __forceinline__ float bfhi(unsigned u) { return __uint_as_float(u & 0xffff0000u); }
__device__ __forceinline__ unsigned pk2(float lo, float hi) { unsigned r; asm volatile("v_cvt_pk_bf16_f32 %0, %1, %2" : "=v"(r) : "v"(lo), "v"(hi)); return r; }
__device__ __forceinline__ float wave_sum(float v) {
#pragma unroll
    for (int o = 1; o < 64; o <<= 1) v += __shfl_xor(v, o);
    return v;
}
__device__ __forceinline__ void rope_cs(float pos, float invf, float& c, float& s) {
    const float a = pos * invf;
    double rev = (double)a * 0.15915494309189535;
    rev -= __builtin_rint(rev);
    const float fr = (float)rev;
    c = __builtin_amdgcn_cosf(fr); s = __builtin_amdgcn_sinf(fr);
}

__device__ __forceinline__ void transpose_item(const float* __restrict__ W, const float* __restrict__ gain, int K, int N, u16* __restrict__ WT, LAS float* scr, int item, int lane) {
    const int nblk = N / 32, kb = item / nblk, nb = item % nblk, k0 = 64 * kb, n0 = 32 * nb;
#pragma unroll 8
    for (int i = 0; i < 32; ++i) { const int kk = 2 * i + (lane >> 5); float w = W[(size_t)(k0 + kk) * N + n0 + (lane & 31)]; if (gain) w *= gain[k0 + kk]; scr[kk * 33 + (lane & 31)] = w; }
    asm volatile("s_waitcnt lgkmcnt(0)" ::: "memory");
    const int c = lane & 7;
#pragma unroll
    for (int j = 0; j < 4; ++j) { const int n = (lane >> 3) + 8 * j; const LAS float* s = scr + (8 * c) * 33 + n;
        u32x4 o; o.x = pk2(s[0 * 33], s[1 * 33]); o.y = pk2(s[2 * 33], s[3 * 33]); o.z = pk2(s[4 * 33], s[5 * 33]); o.w = pk2(s[6 * 33], s[7 * 33]);
        *(u32x4*)(WT + (size_t)(n0 + n) * K + k0 + 8 * c) = o; }
    asm volatile("s_waitcnt lgkmcnt(0)" ::: "memory");
}

__device__ __forceinline__ void norm_row_bf16(const float* __restrict__ xrow, u16* __restrict__ orow, int lane) {
    const f32x4* xr = (const f32x4*)xrow + lane;
    f32x4 v[8]; float s = 0.f;
#pragma unroll
    for (int j = 0; j < 8; ++j) { v[j] = xr[64 * j]; s += (v[j].x * v[j].x + v[j].y * v[j].y) + (v[j].z * v[j].z + v[j].w * v[j].w); }
    const float r = 1.0f / sqrtf(wave_sum(s) * (1.f / DM) + EPS);
    u32x2* o8 = (u32x2*)orow + lane;
#pragma unroll
    for (int j = 0; j < 8; ++j) { u32x2 w; w.x = pk2(v[j].x * r, v[j].y * r); w.y = pk2(v[j].z * r, v[j].w * r); o8[64 * j] = w; }
}
__device__ __forceinline__ void norm_row_f32(float* xrow, const float* __restrict__ g, int lane) {
    f32x4* xr = (f32x4*)xrow + lane; const f32x4* gr = (const f32x4*)g + lane;
    f32x4 v[8]; float s = 0.f;
#pragma unroll
    for (int j = 0; j < 8; ++j) { v[j] = xr[64 * j]; s += (v[j].x * v[j].x + v[j].y * v[j].y) + (v[j].z * v[j].z + v[j].w * v[j].w); }
    const float r = 1.0f / sqrtf(wave_sum(s) * (1.f / DM) + EPS);
#pragma unroll
    for (int j = 0; j < 8; ++j) xr[64 * j] = (v[j] * r) * gr[64 * j];
}

__device__ __forceinline__ void ld8f(const u16* p, float* f) {
    const u32x4 w = *(const u32x4*)p;
    f[0] = bflo(w.x); f[1] = bfhi(w.x); f[2] = bflo(w.y); f[3] = bfhi(w.y); f[4] = bflo(w.z); f[5] = bfhi(w.z); f[6] = bflo(w.w); f[7] = bfhi(w.w);
}

__device__ __forceinline__ void ew0_token(int t, u16* __restrict__ PROJ, u16* __restrict__ MIX, const float* __restrict__ qg, const float* __restrict__ kg, const float* __restrict__ cw, int lane) {
    const int s = t & (SEQ - 1), row = s >> 6, col = s & 63;
    float c, sn; { const int j = lane & 31; const float invf = __builtin_amdgcn_exp2f(-(float)j * (LOG2_THETA / 32.f)); rope_cs((float)(lane < 32 ? row : col), invf, c, sn); }
    unsigned* pr = (unsigned*)(PROJ + (size_t)t * IN0);
    const float qg0 = qg[2 * lane], qg1 = qg[2 * lane + 1], kg0 = kg[2 * lane], kg1 = kg[2 * lane + 1];
#pragma unroll
    for (int h = 0; h < 10; ++h) {
        const unsigned u = pr[h * 64 + lane]; const float x1 = bflo(u), x2 = bfhi(u);
        const float ss = wave_sum(x1 * x1 + x2 * x2); const float r = 1.0f / sqrtf(ss * (1.f / 128.f) + EPS);
        const float y1 = x1 * r * (h < 8 ? qg0 : kg0), y2 = x2 * r * (h < 8 ? qg1 : kg1);
        pr[h * 64 + lane] = pk2(y1 * c - y2 * sn, y1 * sn + y2 * c);
    }
    const u16* p0 = PROJ + (size_t)t * IN0;
#pragma unroll
    for (int ch = 0; ch < 2; ++ch) {
        const int cc = ch * 512 + lane * 8;
        float gb[8], g0[8], u0[8], gm[8], um[8], gp[8], up[8];
        ld8f(p0 + 1536 + cc, gb); ld8f(p0 + 2560 + cc, g0); ld8f(p0 + 3584 + cc, u0);
        if (s > 0) { ld8f(p0 - IN0 + 2560 + cc, gm); ld8f(p0 - IN0 + 3584 + cc, um); } else {
#pragma unroll
            for (int e = 0; e < 8; ++e) { gm[e] = 0.f; um[e] = 0.f; } }
        if (s < SEQ - 1) { ld8f(p0 + IN0 + 2560 + cc, gp); ld8f(p0 + IN0 + 3584 + cc, up); } else {
#pragma unroll
            for (int e = 0; e < 8; ++e) { gp[e] = 0.f; up[e] = 0.f; } }
        float o[8];
#pragma unroll
        for (int e = 0; e < 8; ++e) o[e] = gb[e] * (cw[cc + e] * (gm[e] * um[e]) + cw[1024 + cc + e] * (g0[e] * u0[e]) + cw[2048 + cc + e] * (gp[e] * up[e]));
        u32x4 w; w.x = pk2(o[0], o[1]); w.y = pk2(o[2], o[3]); w.z = pk2(o[4], o[5]); w.w = pk2(o[6], o[7]);
        *(u32x4*)(MIX + (size_t)t * DM + 1024 + cc) = w;
    }
}
__device__ __forceinline__ void ew1_token(int t, const u16* __restrict__ LAT, u16* __restrict__ CQN, u16* __restrict__ CKVN, u16* __restrict__ KROPE, int lane) {
    const u16* p0 = LAT + (size_t)t * NLATP;
#pragma unroll
    for (int part = 0; part < 2; ++part) {
        float x[8]; ld8f(p0 + part * 512 + lane * 8, x);
        float ss = 0.f;
#pragma unroll
        for (int e = 0; e < 8; ++e) ss += x[e] * x[e];
        const float r = 1.0f / sqrtf(wave_sum(ss) * (1.f / 512.f) + EPS);
        u32x4 w; w.x = pk2(x[0] * r, x[1] * r); w.y = pk2(x[2] * r, x[3] * r); w.z = pk2(x[4] * r, x[5] * r); w.w = pk2(x[6] * r, x[7] * r);
        *(u32x4*)((part ? CKVN : CQN) + (size_t)t * 512 + lane * 8) = w;
    }
    if (lane < 32) {
        const int s = t & (SEQ - 1), row = s >> 6, col = s & 63; const int j = lane & 15;
        const float invf = __builtin_amdgcn_exp2f(-(float)j * (LOG2_THETA / 16.f)); float c, sn; rope_cs((float)(lane < 16 ? row : col), invf, c, sn);
        const unsigned u = *(const unsigned*)(p0 + 1024 + 2 * lane); const float x1 = bflo(u), x2 = bfhi(u);
        *(unsigned*)(KROPE + (size_t)t * 64 + 2 * lane) = pk2(x1 * c - x2 * sn, x1 * sn + x2 * c);
    }
}
__device__ __forceinline__ void ew2_token(int t, u16* __restrict__ Q, int lane) {
    const int s = t & (SEQ - 1), row = s >> 6, col = s & 63;
    const int h = lane >> 2, part = lane & 3; const float pos = (float)(part < 2 ? row : col);
    u16* p = Q + (size_t)t * NQ + h * 192 + 128 + part * 16;
    float x[16]; ld8f(p, x); ld8f(p + 8, x + 8);
    unsigned w[8];
#pragma unroll
    for (int i = 0; i < 8; ++i) { const int j = (part & 1) * 8 + i; const float invf = __builtin_amdgcn_exp2f(-(float)j * (LOG2_THETA / 16.f)); float c, sn; rope_cs(pos, invf, c, sn);
        w[i] = pk2(x[2 * i] * c - x[2 * i + 1] * sn, x[2 * i] * sn + x[2 * i + 1] * c); }
    *(u32x4*)p = (u32x4){w[0], w[1], w[2], w[3]}; *(u32x4*)(p + 8) = (u32x4){w[4], w[5], w[6], w[7]};
}

#define RLX_AGENT __ATOMIC_RELAXED, __HIP_MEMORY_SCOPE_AGENT
#define XB_TMO      128
#define XB_XCNT(j)  (256  + 64 * (j))
#define XB_XSUB(j)  (1280 + 64 * (j))
#define XB_XGEN(j)  (2304 + 64 * (j))
#define XB_TOP      3328
#define XB_TOPGEN   3392
#define XCD_BAR_WORDS 3456
#define XB_SPIN_CAP (1u << 22)

__device__ __forceinline__ unsigned xb_ld(unsigned* p)              { return __hip_atomic_load(p, __ATOMIC_RELAXED, __HIP_MEMORY_SCOPE_AGENT); }
__device__ __forceinline__ unsigned xb_add(unsigned* p, unsigned v) { return __hip_atomic_fetch_add(p, v, __ATOMIC_RELAXED, __HIP_MEMORY_SCOPE_AGENT); }
__device__ __forceinline__ unsigned xb_xcc_id() { return (unsigned)__builtin_amdgcn_s_getreg((3 << 11) | 20) & 0xFu; }
#define XB_SPIN(cond, bar) do { unsigned _sp = 0; while (cond) { __builtin_amdgcn_s_sleep(1); \
    if ((++_sp & 255u) == 0u) { if (xb_ld(&(bar)[XB_TMO])) break; if (_sp > XB_SPIN_CAP) { atomicAdd(&(bar)[XB_TMO], 1u); break; } } } } while (0)

struct XcdBarrier {
    unsigned* bar; unsigned x;
    volatile LAS unsigned* st;
};

__device__ __forceinline__ XcdBarrier xcd_barrier_post(unsigned* bar, volatile LAS unsigned* st) {
    XcdBarrier b; b.bar = bar; b.x = xb_xcc_id(); b.st = st;
    if (threadIdx.x == 0) (void)xb_add(&bar[XB_XCNT(b.x)], 1u);
    return b;
}
__device__ __forceinline__ void xcd_barrier_complete(unsigned* bar, unsigned x, unsigned& nloc, unsigned& nx) {
    const unsigned G = gridDim.x * gridDim.y * gridDim.z;
    unsigned sum, cnt, mine, sp = 0u;
    for (;;) {
        sum = 0u; cnt = 0u; mine = 0u;
#pragma unroll
        for (unsigned j = 0; j < 16; ++j) { const unsigned c = xb_ld(&bar[XB_XCNT(j)]); sum += c; cnt += (c > 0u) ? 1u : 0u; mine = (j == x) ? c : mine; }
        if (sum == G) break;
        __builtin_amdgcn_s_sleep(1);
        if ((++sp & 255u) == 0u) { if (xb_ld(&bar[XB_TMO])) break; if (sp > XB_SPIN_CAP) { atomicAdd(&bar[XB_TMO], 1u); break; } }
    }
    nloc = mine > 0u ? mine : 1u; nx = cnt > 0u ? cnt : 1u;
}

__device__ __forceinline__ void xcd_barrier(const XcdBarrier& b) {
    asm volatile("s_waitcnt vmcnt(0)" ::: "memory");
    __syncthreads();
    if (threadIdx.x == 0) {
        unsigned* bar = b.bar;
        __builtin_amdgcn_s_waitcnt(0);
        unsigned nloc = b.st[0], nx = b.st[1];
        if (nloc == 0u) { xcd_barrier_complete(bar, b.x, nloc, nx); b.st[0] = nloc; b.st[1] = nx; }
        const unsigned old = xb_add(&bar[XB_XSUB(b.x)], 1u);
        const unsigned gen = old / nloc;
        if (old + 1u == (gen + 1u) * nloc) {
            __builtin_amdgcn_fence(__ATOMIC_RELEASE, "agent");
            asm volatile("s_waitcnt vmcnt(0)" ::: "memory");
            const unsigned og = xb_add(&bar[XB_TOP], 1u);
            const unsigned tg = og / nx;
            if (og + 1u == (tg + 1u) * nx) xb_add(&bar[XB_TOPGEN], 1u);
            else XB_SPIN(xb_ld(&bar[XB_TOPGEN]) == tg, bar);
            __builtin_amdgcn_fence(__ATOMIC_ACQUIRE, "agent");
            xb_add(&bar[XB_XGEN(b.x)], 1u);
            asm volatile("s_waitcnt vmcnt(0)" ::: "memory");
        } else {
            XB_SPIN(xb_ld(&bar[XB_XGEN(b.x)]) == gen, bar);
            __builtin_amdgcn_fence(__ATOMIC_ACQUIRE, "agent");
            asm volatile("s_waitcnt vmcnt(0)" ::: "memory");
        }
    }
    __syncthreads();
}

struct Params { const float* in[18]; float* out; unsigned char* ws; int ph_lo, ph_hi; };
enum { I_X = 0, I_ENG, I_EWIN, I_EQG, I_EKG, I_ECW, I_EWOUT, I_ONG, I_OWDOWN, I_OQG, I_OKVG, I_OWUQ, I_OWUKV, I_OWO, I_MNG, I_MWUP, I_MWDN, I_FNG };
constexpr int NPHASE = 19;

template <int DQK> __device__ __forceinline__ bool attn_next(int i, int NU, int& unit) {
    const int G = gridDim.x, bx = blockIdx.x;
    if ((G & 7) == 0 && (NU & 7) == 0) { const int x = bx & 7, j = bx >> 3, per = G >> 3, upx = NU >> 3; const int k = i * per + j; if (k >= upx) return false; unit = x * upx + k; return true; }
    const int k = i * G + bx; if (k >= NU) return false; unit = k; return true;
}

__global__ void __launch_bounds__(NTHREADS, 2) fwd_mega(Params P) {
    extern __shared__ __attribute__((aligned(16))) unsigned char lds[];
    cg::grid_group grid = cg::this_grid();
    const int tid = threadIdx.x, lane = tid & 63, wave = __builtin_amdgcn_readfirstlane(tid >> 6);
    const int G = gridDim.x, gw = blockIdx.x * NWAVES + wave, NGW = G * NWAVES;
    unsigned char* ws = P.ws;
    u16* Win = (u16*)(ws + WS_WIN); u16* Wout = (u16*)(ws + WS_WOUT); u16* Wdown = (u16*)(ws + WS_WDOWN); u16* Wuq = (u16*)(ws + WS_WUQ); u16* Wukv = (u16*)(ws + WS_WUKV); u16* Wo = (u16*)(ws + WS_WO);
    u16* Wup = (u16*)(ws + WS_WUP); u16* Wdn = (u16*)(ws + WS_WDN);
    u16* XN = (u16*)(ws + WS_XN); u16* PROJ = (u16*)(ws + WS_PROJ); u16* MIX = (u16*)(ws + WS_MIX); u16* HID = (u16*)(ws + WS_HID);
    u16* LAT = (u16*)(ws + WS_LAT); u16* CQN = (u16*)(ws + WS_CQN); u16* CKVN = (u16*)(ws + WS_CKVN); u16* KROPE = (u16*)(ws + WS_KROPE);
    u16* Qm = (u16*)(ws + WS_Q); u16* KVm = (u16*)(ws + WS_KV); u16* AO = (u16*)(ws + WS_AO);
    float* H = P.out;
    LAS unsigned char* ldsl = (LAS unsigned char*)lds;
    const int lo = P.ph_lo, hi = P.ph_hi;
    volatile LAS unsigned* xst = (volatile LAS unsigned*)(ldsl + LDS_BYTES - 16);
    if (tid < 4) xst[tid] = 0u;
    __syncthreads();
    XcdBarrier xbar = xcd_barrier_post((unsigned*)(ws + WS_CTL), xst);
#define PH(k) if (lo <= (k) && (k) < hi) _Pragma("unroll") for (int rep_ = 0; rep_ <= (int)((REP_MASK >> (k)) & 1u); ++rep_)
#define SEAM(k) do { if (lo <= (k) && (k) + 1 < hi) { if ((k) == 0) grid.sync(); else xcd_barrier(xbar); } } while (0)
#define GEMM_BF16(ACT, Aptr, Bptr, Mv, Nv, Kv, Optr, ldc) do { pg8::Gemm g{Aptr, Bptr, Mv, Nv, Kv}; pg8::StaticOrder S; S.init(Mv, Nv, G, (int)blockIdx.x); \
        pg8::EpiBf16<ACT> E{Optr, ldc}; pg8::gemm_phase<pg8::EpiBf16<ACT>, pg8::StaticOrder, true, true>(ldsl, g, S, E); } while (0)
#define GEMM_RES(Aptr, Bptr, Mv, Nv, Kv, baseptr, outptr) do { pg8::Gemm g{Aptr, Bptr, Mv, Nv, Kv}; pg8::StaticOrder S; S.init(Mv, Nv, G, (int)blockIdx.x); \
        pg8::EpiRes E{baseptr, outptr, Nv}; pg8::gemm_phase<pg8::EpiRes, pg8::StaticOrder, true, true>(ldsl, g, S, E); } while (0)
#define NORM_PHASE(src) do { for (int m = gw; m < T; m += NGW) norm_row_bf16((src) + (size_t)m * DM, XN + (size_t)m * DM, lane); } while (0)

    PH(0) {
        LAS float* scr = (LAS float*)(ldsl + wave * 16384);
        constexpr int I0 = (DM / 64) * (IN0 / 32), I1 = (DM / 64) * (DM / 32), I2 = (DM / 64) * (NLAT / 32), I3 = (512 / 64) * (NQ / 32), I4 = (512 / 64) * (NKV / 32), I5 = I1;
        constexpr int I6 = (DM / 64) * (DFF / 32), I7 = (DFF / 64) * (DM / 32);
        constexpr int NITEMS = I0 + I1 + I2 + I3 + I4 + I5 + 2 * I6 + 2 * I7;
        for (int it = gw; it < NITEMS; it += NGW) {
            int r = it;
            if (r < I0) { transpose_item(P.in[I_EWIN], P.in[I_ENG], DM, IN0, Win, scr, r, lane); continue; } r -= I0;
            if (r < I1) { transpose_item(P.in[I_EWOUT], nullptr, DM, DM, Wout, scr, r, lane); continue; } r -= I1;
            if (r < I2) { transpose_item(P.in[I_OWDOWN], P.in[I_ONG], DM, NLAT, Wdown, scr, r, lane); continue; } r -= I2;
            if (r < I3) { transpose_item(P.in[I_OWUQ], P.in[I_OQG], 512, NQ, Wuq, scr, r, lane); continue; } r -= I3;
            if (r < I4) { transpose_item(P.in[I_OWUKV], P.in[I_OKVG], 512, NKV, Wukv, scr, r, lane); continue; } r -= I4;
            if (r < I5) { transpose_item(P.in[I_OWO], nullptr, DM, DM, Wo, scr, r, lane); continue; } r -= I5;
            if (r < I6) { transpose_item(P.in[I_MWUP], P.in[I_MNG], DM, DFF, Wup, scr, r, lane); continue; } r -= I6;
            if (r < I6) { transpose_item(P.in[I_MWUP] + (size_t)DM * DFF, P.in[I_MNG] + DM, DM, DFF, Wup + (size_t)DM * DFF, scr, r, lane); continue; } r -= I6;
            if (r < I7) { transpose_item(P.in[I_MWDN], nullptr, DFF, DM, Wdn, scr, r, lane); continue; } r -= I7;
            transpose_item(P.in[I_MWDN] + (size_t)DM * DFF, nullptr, DFF, DM, Wdn + (size_t)DM * DFF, scr, r, lane);
        }
        { const size_t n16 = (size_t)(NLATP - NLAT) * DM * 2 / 16; u32x4* z = (u32x4*)(Wdown + (size_t)NLAT * DM);
          for (size_t i = (size_t)blockIdx.x * NTHREADS + tid; i < n16; i += (size_t)G * NTHREADS) z[i] = (u32x4){0u, 0u, 0u, 0u}; }
        NORM_PHASE(P.in[I_X]);
    }
    SEAM(0);
    PH(1) { GEMM_BF16(0, XN, Win, T, IN0, DM, PROJ, IN0); }
    SEAM(1);
    PH(2) { const int per = (T + NGW - 1) / NGW; const int t0 = gw * per; for (int t = t0; t < t0 + per && t < T; ++t) ew0_token(t, PROJ, MIX, P.in[I_EQG], P.in[I_EKG], P.in[I_ECW], lane); }
    SEAM(2);
    PH(3) {
        constexpr int NU = BATCH * 8 * (SEQ / 256); int unit;
        for (int i = 0; attn_next<128>(i, NU, unit); ++i) {
            const int bh = unit / (SEQ / 256), qb = unit % (SEQ / 256), b = bh >> 3, hq = bh & 7, kvh = hq >> 2;
            const size_t tb = (size_t)b * SEQ;
#ifndef NO_GQA
            att::attn_unit<128, IN0, IN0, IN0, DM, 2>(PROJ + (tb + (size_t)qb * 256) * IN0 + hq * 128, PROJ + tb * IN0 + 1024 + kvh * 128, nullptr, PROJ + tb * IN0 + 1280 + kvh * 128,
                                                      MIX + (tb + (size_t)qb * 256) * DM + hq * 128, SEQ, (char*)lds);
#endif
        }
    }
    SEAM(3);
    PH(4) { GEMM_RES(MIX, Wout, T, DM, DM, P.in[I_X], H); }
    SEAM(4);
    PH(5) { NORM_PHASE(H); }
    SEAM(5);
    PH(6) { GEMM_BF16(2, XN, Wup, T, DFF, DM, HID, DFF); }
    SEAM(6);
    PH(7) { GEMM_RES(HID, Wdn, T, DM, DFF, H, H); }
    SEAM(7);
    PH(8) { NORM_PHASE(H); }
    SEAM(8);
    PH(9) { GEMM_BF16(0, XN, Wdown, T, NLATP, DM, LAT, NLATP); }
    SEAM(9);
    PH(10) { for (int t = gw; t < T; t += NGW) ew1_token(t, LAT, CQN, CKVN, KROPE, lane); }
    SEAM(10);
    PH(11) { GEMM_BF16(0, CQN, Wuq, T, NQ, 512, Qm, NQ); GEMM_BF16(0, CKVN, Wukv, T, NKV, 512, KVm, NKV); }
    SEAM(11);
    PH(12) { for (int t = gw; t < T; t += NGW) ew2_token(t, Qm, lane); }
    SEAM(12);
    PH(13) {
        constexpr int NU = BATCH * 16 * (SEQ / 256); int unit;
        for (int i = 0; attn_next<192>(i, NU, unit); ++i) {
            const int bh = unit / (SEQ / 256), qb = unit % (SEQ / 256), b = bh >> 4, h = bh & 15;
            const size_t tb = (size_t)b * SEQ;
#ifndef NO_MLA
            att::attn_unit<192, NQ, NKV, NKV, DM, MLA_SD>(Qm + (tb + (size_t)qb * 256) * NQ + h * 192, KVm + tb * NKV + h * 256, KROPE + tb * 64, KVm + tb * NKV + h * 256 + 128,
                                                          AO + (tb + (size_t)qb * 256) * DM + h * 128, SEQ, (char*)lds);
#endif
        }
    }
    SEAM(13);
    PH(14) { GEMM_RES(AO, Wo, T, DM, DM, H, H); }
    SEAM(14);
    PH(15) { NORM_PHASE(H); }
    SEAM(15);
    PH(16) { GEMM_BF16(2, XN, Wup + (size_t)DM * DFF, T, DFF, DM, HID, DFF); }
    SEAM(16);
    PH(17) { GEMM_RES(HID, Wdn + (size_t)DM * DFF, T, DM, DFF, H, H); }
    SEAM(17);
    PH(18) { for (int m = gw; m < T; m += NGW) norm_row_f32(H + (size_t)m * DM, P.in[I_FNG], lane); }
#undef PH
#undef SEAM
}

extern "C" void kernel_launch(void* const* d_in, const int* in_sizes, int n_in, void* d_out, int out_size, void* d_ws, size_t ws_size, hipStream_t stream) {
    static int grid = 0;
    if (grid == 0) {
        if (n_in != 18 || in_sizes[0] != T * DM || out_size != T * DM || ws_size < WS_END) {
            fprintf(stderr, "kernel_launch: shape mismatch (n_in %d in0 %d out %d ws %zu need %zu)\n", n_in, n_in > 0 ? in_sizes[0] : -1, out_size, ws_size, (size_t)WS_END); grid = -1; return; }
        int dev = 0, cus = 0, per_cu = 0;
        hipGetDevice(&dev); hipDeviceGetAttribute(&cus, hipDeviceAttributeMultiprocessorCount, dev);
        if (hipFuncSetAttribute((const void*)fwd_mega, hipFuncAttributeMaxDynamicSharedMemorySize, LDS_BYTES) != hipSuccess) { fprintf(stderr, "kernel_launch: hipFuncSetAttribute failed\n"); grid = -1; return; }
        if (hipOccupancyMaxActiveBlocksPerMultiprocessor(&per_cu, (const void*)fwd_mega, NTHREADS, LDS_BYTES) != hipSuccess || per_cu < 1) { fprintf(stderr, "kernel_launch: occupancy query says %d\n", per_cu); per_cu = 1; }
        (void)hipGetLastError();
        grid = cus * per_cu;
        fprintf(stderr, "kernel_launch: grid %d (cus %d x %d)\n", grid, cus, per_cu);
    }
    if (grid < 0) return;
    if (hipMemsetAsync((char*)d_ws + WS_CTL, 0, CTL_BYTES, stream) != hipSuccess) { fprintf(stderr, "kernel_launch: memset failed\n"); return; }
    Params p{};
    for (int i = 0; i < 18; ++i) p.in[i] = (const float*)d_in[i];
    p.out = (float*)d_out; p.ws = (unsigned char*)d_ws;
#if N_LAUNCH_SPLIT
    for (int k = 0; k < NPHASE; ++k) { p.ph_lo = k; p.ph_hi = k + 1; void* args[] = {&p};
        hipError_t e = hipLaunchCooperativeKernel((const void*)fwd_mega, dim3(grid), dim3(NTHREADS), args, LDS_BYTES, stream);
        if (e != hipSuccess) { fprintf(stderr, "cooperative launch failed: %s (grid %d)\n", hipGetErrorString(e), grid); break; } }
#else
    p.ph_lo = 0; p.ph_hi = NPHASE; void* args[] = {&p};
    hipError_t e = hipLaunchCooperativeKernel((const void*)fwd_mega, dim3(grid), dim3(NTHREADS), args, LDS_BYTES, stream);
    if (e != hipSuccess) fprintf(stderr, "cooperative launch failed: %s (grid %d)\n", hipGetErrorString(e), grid);
#endif
}
```

```cpp
#include <hip/hip_runtime.h>
#include <hip/hip_cooperative_groups.h>
#include <cstdio>
#include <cstdint>
namespace cg = cooperative_groups;
#ifndef GQA_SD
#define GQA_SD 1
#endif
#ifndef MLA_SD
#define MLA_SD 1
#endif
#ifndef MLA_QREG
#define MLA_QREG 4
#endif
#ifndef REP_MASK
#define REP_MASK 0u
#endif
#ifndef ATT_NVA128
#define ATT_NVA128 5
#endif
#ifndef ATT_NVA192
#define ATT_NVA192 3
#endif
#ifndef ATT_NVB
#define ATT_NVB 1
#endif
#ifndef ATT_PREA
#define ATT_PREA 4
#endif
#ifndef ATT_PREB
#define ATT_PREB 8
#endif
#ifndef ATT_KEYMASK128
#define ATT_KEYMASK128 7
#endif
#ifndef ATT_MG192
#define ATT_MG192 2
#endif
#ifndef ATT_DS192
#define ATT_DS192 2
#endif
#ifndef N_LAUNCH_SPLIT
#define N_LAUNCH_SPLIT 0
#endif
namespace pg8 {
#define PG8_LAS __attribute__((address_space(3)))
typedef unsigned short bf16_t;
typedef short bf16x8 __attribute__((ext_vector_type(8)));
typedef float f32x4 __attribute__((ext_vector_type(4)));
typedef unsigned u32x4 __attribute__((ext_vector_type(4)));
constexpr int BM = 256, BK = 64, HALF = 128, HTB = HALF * BK * 2  , STAGE_BYTES = 8 * HTB, NXCD = 8, WGM = 8;

__host__ __device__ __forceinline__ int lds_byte(int r, int c) { const int st = (r >> 4) * 2 + (c >> 5), rr = r & 15, cc = c & 31, ob = rr * 64 + cc * 2; return st * 1024 + (ob ^ (((ob >> 9) & 1) << 5)); }
__host__ __device__ __forceinline__ void stage_rc(int b, int& R, int& C) { const int st = b / 1024, sb = b % 1024, swz = sb ^ (((sb >> 9) & 1) << 5); R = (st >> 1) * 16 + swz / 64; C = (st & 1) * 32 + (swz % 64) / 2; }
__host__ __device__ __forceinline__ int perm32(int rho) { const int n = rho >> 4, i = rho & 15; return 8 * (i >> 2) + 4 * n + (i & 3); }

struct Unit { int pm, pn; };
struct Gemm { const bf16_t* A; const bf16_t* Bt; int M, N, K; };

struct StaticOrder {
    int nM, nN, nwg, G, c;
    __host__ __device__ void init(int M, int N, int G_, int c_) { nM = M / BM; nN = N / BM; nwg = nM * nN; G = G_; c = c_; }
    __host__ __device__ bool next(int i, Unit& u) const {
        const long L = (long)i * G + c; if (L >= nwg) return false;
        int wgid = (int)L; { const int q = nwg / NXCD, r = nwg % NXCD, xcd = wgid % NXCD, off = wgid / NXCD; wgid = (xcd < r ? xcd * (q + 1) : r * (q + 1) + (xcd - r) * q) + off; }
        const int nig = WGM * nN, gid = wgid / nig, fm = gid * WGM, gsz = (nM - fm) < WGM ? (nM - fm) : WGM;
        u.pm = fm + ((wgid % nig) % gsz); u.pn = (wgid % nig) / gsz; return true;
    }
    __device__ __forceinline__ void a_ready(const Unit&) const {}
    __device__ __forceinline__ void done(const Unit&) const {}
};
__device__ __forceinline__ unsigned cvt_pk_bf16(float lo, float hi) { unsigned r; asm volatile("v_cvt_pk_bf16_f32 %0, %1, %2" : "=v"(r) : "v"(lo), "v"(hi)); return r; }
template <int ACT> struct EpiBf16 {
    static constexpr bool PERM = true, AFTER_DRAIN = false;
    bf16_t* O; int ldc;
    __device__ __forceinline__ void operator()(const f32x4 (&acc)[2][2][4][2], const Unit& u, int wr, int wc, int fr, int fq) const {
        const int row0 = u.pm * BM + wr * 64 + fr; const int col0 = u.pn * BM + wc * 32 + 8 * fq;
#pragma unroll
        for (int ai = 0; ai < 2; ++ai)
#pragma unroll
            for (int m = 0; m < 4; ++m) { bf16_t* rowp = O + (size_t)(row0 + ai * HALF + m * 16) * ldc + col0;
#pragma unroll
                for (int bj = 0; bj < 2; ++bj) { f32x4 v0 = acc[ai][bj][m][0], v1 = acc[ai][bj][m][1];
                    if (ACT == 2) {
#pragma unroll
                        for (int e = 0; e < 4; ++e) { float a = v0[e] > 0.f ? v0[e] : 0.f; v0[e] = a * a; float b = v1[e] > 0.f ? v1[e] : 0.f; v1[e] = b * b; } }
                    u32x4 w; w.x = cvt_pk_bf16(v0[0], v0[1]); w.y = cvt_pk_bf16(v0[2], v0[3]); w.z = cvt_pk_bf16(v1[0], v1[1]); w.w = cvt_pk_bf16(v1[2], v1[3]);
                    *(u32x4*)(rowp + bj * HALF) = w; } }
    }
};
struct EpiRes {
    static constexpr bool PERM = false, AFTER_DRAIN = false;
    const float* base; float* out; int ldc;
    __device__ __forceinline__ void operator()(const f32x4 (&acc)[2][2][4][2], const Unit& u, int wr, int wc, int fr, int fq) const {
        const int row0 = u.pm * BM + wr * 64 + fr; const int col0 = u.pn * BM + wc * 32 + 4 * fq;
#pragma unroll
        for (int ai = 0; ai < 2; ++ai)
#pragma unroll
            for (int m = 0; m < 4; ++m) { const size_t off = (size_t)(row0 + ai * HALF + m * 16) * ldc + col0;
#pragma unroll
                for (int bj = 0; bj < 2; ++bj)
#pragma unroll
                    for (int n = 0; n < 2; ++n) { const size_t o = off + bj * HALF + n * 16; const f32x4 b = *(const f32x4*)(base + o); *(f32x4*)(out + o) = b + acc[ai][bj][m][n]; }
                asm volatile("" ::: "memory"); }
    }
};
template <class Epi, class Sched, bool ALIGN_EPI = false, bool SP2 = false>
__device__ __forceinline__ void gemm_phase(PG8_LAS unsigned char* lds, const Gemm g, const Sched& S, const Epi& E) {
    const int tid = threadIdx.x, wid = __builtin_amdgcn_readfirstlane(tid >> 6), lane = tid & 63, wr = wid >> 2, wc = wid & 3, fr = lane & 15, fq = lane >> 4;
    const int K = g.K, nt = K / BK;
    unsigned voffA[2], voffB[2];
#pragma unroll
    for (int i = 0; i < 2; ++i) { int R, C; stage_rc(tid * 16 + i * 8192, R, C); const int Rb = Epi::PERM ? ((R & ~31) + perm32(R & 31)) : R;
        voffA[i] = (unsigned)(R * K + C) * 2u; voffB[i] = (unsigned)(Rb * K + C) * 2u; }
    const size_t kstep = (size_t)(BK * 2);
    const size_t hstep = (size_t)HALF * K * 2;
    const size_t tstep = 2 * hstep;
    const unsigned ldsw = (unsigned)wid * 1024u;
    const int aoff = lds_byte(wr * 64 + fr, fq * 8), boff = lds_byte(wc * 32 + fr, fq * 8);
#define PG8_SA(b, h) (((b) * 2 + (h)) * HTB)
#define PG8_SB(b, h) ((4 + (b) * 2 + (h)) * HTB)
#define PG8_STAGE(bufoff, gbase, voff) do { _Pragma("unroll") for (int _i = 0; _i < 2; ++_i) \
        __builtin_amdgcn_global_load_lds((const unsigned*)((const char*)(gbase) + (voff)[_i]), (PG8_LAS unsigned*)(lds + (bufoff) + ldsw + _i * 8192), 16, 0, 0); } while (0)
#define PG8_LDA(dst, b, h) do { _Pragma("unroll") for (int m = 0; m < 4; ++m) _Pragma("unroll") for (int k = 0; k < 2; ++k) dst[m][k] = *(const PG8_LAS bf16x8*)(lds + PG8_SA(b, h) + aoff + m * 2048 + k * 1024); } while (0)
#define PG8_LDB(dst, b, h) do { _Pragma("unroll") for (int n = 0; n < 2; ++n) _Pragma("unroll") for (int k = 0; k < 2; ++k) dst[n][k] = *(const PG8_LAS bf16x8*)(lds + PG8_SB(b, h) + boff + n * 2048 + k * 1024); } while (0)
#define PG8_MMA(ai, bj, At, Bt) do { __builtin_amdgcn_s_setprio(1); _Pragma("unroll") for (int m = 0; m < 4; ++m) _Pragma("unroll") for (int n = 0; n < 2; ++n) _Pragma("unroll") for (int k = 0; k < 2; ++k) \
        acc[ai][bj][m][n] = __builtin_amdgcn_mfma_f32_16x16x32_bf16(Bt[n][k], At[m][k], acc[ai][bj][m][n], 0, 0, 0); __builtin_amdgcn_s_setprio(0); } while (0)
#define PG8_WAIT_V(n) asm volatile("s_waitcnt vmcnt(" #n ")" ::: "memory")
#define PG8_WAIT_L(n) asm volatile("s_waitcnt lgkmcnt(" #n ")" ::: "memory")
#define PG8_BAR __builtin_amdgcn_s_barrier()
#define PG8_SCHED __builtin_amdgcn_sched_barrier(0)
    Unit cur, nxt; int ui = 0;
    if (!S.next(0, cur)) return;
    f32x4 acc[2][2][4][2];
#pragma unroll
    for (int a = 0; a < 2; ++a)
#pragma unroll
        for (int b = 0; b < 2; ++b)
#pragma unroll
            for (int m = 0; m < 4; ++m)
#pragma unroll
                for (int n = 0; n < 2; ++n) acc[a][b][m][n] = (f32x4){0.f, 0.f, 0.f, 0.f};
    bf16x8 At[4][2], B0[2][2], B1[2][2];
    const char* cA = (const char*)g.A + (size_t)cur.pm * tstep; const char* cB = (const char*)g.Bt + (size_t)cur.pn * tstep;
    S.a_ready(cur);
    if constexpr (SP2) {
        PG8_STAGE(PG8_SB(0, 0), cB, voffB); PG8_STAGE(PG8_SB(0, 1), cB + hstep, voffB); PG8_STAGE(PG8_SA(0, 0), cA, voffA); PG8_STAGE(PG8_SA(0, 1), cA + hstep, voffA);
        if (wr == 1) PG8_BAR;
        PG8_WAIT_V(2); PG8_BAR;
        PG8_STAGE(PG8_SB(1, 0), cB + kstep, voffB); PG8_STAGE(PG8_SA(1, 0), cA + kstep, voffA); PG8_STAGE(PG8_SB(1, 1), cB + hstep + kstep, voffB);
        PG8_WAIT_V(6); PG8_BAR;
    } else {
        PG8_STAGE(PG8_SB(0, 0), cB, voffB); PG8_STAGE(PG8_SA(0, 0), cA, voffA); PG8_STAGE(PG8_SB(0, 1), cB + hstep, voffB); PG8_STAGE(PG8_SA(0, 1), cA + hstep, voffA);
        if (wr == 1) PG8_BAR;
        PG8_WAIT_V(4); PG8_BAR;
        PG8_STAGE(PG8_SB(1, 0), cB + kstep, voffB); PG8_STAGE(PG8_SA(1, 0), cA + kstep, voffA); PG8_STAGE(PG8_SB(1, 1), cB + hstep + kstep, voffB);
        PG8_WAIT_V(6); PG8_BAR;
    }
    for (;;) {
        const bool has_next = S.next(ui + 1, nxt);
        const char* nA = has_next ? (const char*)g.A + (size_t)nxt.pm * tstep : cA; const char* nB = has_next ? (const char*)g.Bt + (size_t)nxt.pn * tstep : cB;
        for (int t = 0; t < nt; t += 2) {
            const bool last = (t == nt - 2);
            const char* a1 = cA + (size_t)(t + 1) * kstep;
            const char* a2 = last ? nA : cA + (size_t)(t + 2) * kstep; const char* b2 = last ? nB : cB + (size_t)(t + 2) * kstep;
            const char* a3 = a2 + kstep; const char* b3 = b2 + kstep;
            if (last && has_next) S.a_ready(nxt);
            if constexpr (SP2) {
            PG8_LDB(B0, 0, 0); PG8_LDB(B1, 0, 1); PG8_SCHED; PG8_LDA(At, 0, 0); PG8_STAGE(PG8_SA(1, 1), a1 + hstep, voffA);
            PG8_WAIT_V(8); PG8_WAIT_L(0); PG8_BAR; PG8_MMA(0, 0, At, B0); PG8_MMA(0, 1, At, B1); PG8_BAR; PG8_SCHED;
            PG8_LDA(At, 0, 1); PG8_STAGE(PG8_SB(0, 0), b2, voffB); PG8_STAGE(PG8_SB(0, 1), b2 + hstep, voffB); PG8_STAGE(PG8_SA(0, 0), a2, voffA);
            PG8_WAIT_V(8); PG8_WAIT_L(0); PG8_BAR; PG8_MMA(1, 0, At, B0); PG8_MMA(1, 1, At, B1); PG8_BAR; PG8_SCHED;
            PG8_LDB(B0, 1, 0); PG8_LDB(B1, 1, 1); PG8_SCHED; PG8_LDA(At, 1, 0); PG8_STAGE(PG8_SA(0, 1), a2 + hstep, voffA);
            PG8_WAIT_V(8); PG8_WAIT_L(0); PG8_BAR; PG8_MMA(0, 0, At, B0); PG8_MMA(0, 1, At, B1); PG8_BAR; PG8_SCHED;
            PG8_LDA(At, 1, 1); PG8_STAGE(PG8_SB(1, 0), b3, voffB); PG8_STAGE(PG8_SB(1, 1), b3 + hstep, voffB); PG8_STAGE(PG8_SA(1, 0), a3, voffA);
            PG8_WAIT_V(8); PG8_WAIT_L(0); PG8_BAR; PG8_MMA(1, 0, At, B0); PG8_MMA(1, 1, At, B1); PG8_BAR; PG8_SCHED;
            } else {
            PG8_LDB(B0, 0, 0); PG8_SCHED; PG8_LDA(At, 0, 0); PG8_STAGE(PG8_SA(1, 1), a1 + hstep, voffA);
            PG8_WAIT_L(8); PG8_BAR; PG8_WAIT_L(0); PG8_MMA(0, 0, At, B0); PG8_BAR; PG8_SCHED;
            PG8_LDB(B1, 0, 1); PG8_STAGE(PG8_SB(0, 0), b2, voffB);
            PG8_BAR; PG8_WAIT_L(0); PG8_MMA(0, 1, At, B1); PG8_BAR;
            PG8_LDA(At, 0, 1); PG8_STAGE(PG8_SA(0, 0), a2, voffA);
            PG8_BAR; PG8_WAIT_L(0); PG8_MMA(1, 0, At, B0); PG8_BAR; PG8_SCHED;
            PG8_STAGE(PG8_SB(0, 1), b2 + hstep, voffB);
            PG8_WAIT_V(6); PG8_BAR; PG8_MMA(1, 1, At, B1); PG8_BAR;
            PG8_LDB(B0, 1, 0); PG8_SCHED; PG8_LDA(At, 1, 0); PG8_STAGE(PG8_SA(0, 1), a2 + hstep, voffA);
            PG8_WAIT_L(8); PG8_BAR; PG8_WAIT_L(0); PG8_MMA(0, 0, At, B0); PG8_BAR; PG8_SCHED;
            PG8_LDB(B1, 1, 1); PG8_STAGE(PG8_SB(1, 0), b3, voffB);
            PG8_BAR; PG8_WAIT_L(0); PG8_MMA(0, 1, At, B1); PG8_BAR;
            PG8_LDA(At, 1, 1); PG8_STAGE(PG8_SA(1, 0), a3, voffA);
            PG8_BAR; PG8_WAIT_L(0); PG8_MMA(1, 0, At, B0); PG8_BAR; PG8_SCHED;
            PG8_STAGE(PG8_SB(1, 1), b3 + hstep, voffB);
            PG8_WAIT_V(6); PG8_BAR; PG8_MMA(1, 1, At, B1); PG8_BAR;
            }
        }
        if constexpr (ALIGN_EPI) { if (wr == 0) PG8_BAR; }
        if constexpr (!Epi::AFTER_DRAIN) { E(acc, cur, wr, wc, fr, fq); S.done(cur); }
        if (!has_next) break;
#pragma unroll
        for (int a = 0; a < 2; ++a)
#pragma unroll
            for (int b = 0; b < 2; ++b)
#pragma unroll
                for (int m = 0; m < 4; ++m)
#pragma unroll
                    for (int n = 0; n < 2; ++n) acc[a][b][m][n] = (f32x4){0.f, 0.f, 0.f, 0.f};
        cur = nxt; cA = nA; cB = nB; ++ui;
        if constexpr (ALIGN_EPI) { if (wr == 1) PG8_BAR; }
    }
    PG8_WAIT_V(0);
    if constexpr (!ALIGN_EPI) { if (wr == 0) PG8_BAR; }
    PG8_BAR;
    if constexpr (Epi::AFTER_DRAIN) { E.fused(acc, cur, wr, wc, fr, fq, lds, wid, lane); S.done(cur); }
#undef PG8_SA
#undef PG8_SB
#undef PG8_STAGE
#undef PG8_LDA
#undef PG8_LDB
#undef PG8_MMA
#undef PG8_WAIT_V
#undef PG8_WAIT_L
#undef PG8_BAR
#undef PG8_SCHED
}
}
namespace att {
typedef unsigned short bf16;
using bf16x8 = __attribute__((ext_vector_type(8))) short;
using s16x4  = __attribute__((ext_vector_type(4))) short;
using f32x16 = __attribute__((ext_vector_type(16))) float;
using u32x4  = __attribute__((ext_vector_type(4))) unsigned;
constexpr int NW = 8, QBLK = 32, KVBLK = 64;
constexpr float THR = 8.f;
#define ATT_SBAR() __builtin_amdgcn_sched_barrier(0)
__device__ __forceinline__ int crow(int r, int hi) { return (r & 3) + 8 * (r >> 2) + 4 * hi; }
typedef float f32x2_t __attribute__((ext_vector_type(2))); typedef __bf16 bf16x2_t __attribute__((ext_vector_type(2)));
__device__ __forceinline__ unsigned cvtpk(float lo, float hi) { f32x2_t v = {lo, hi}; bf16x2_t b = __builtin_convertvector(v, bf16x2_t); return __builtin_bit_cast(unsigned, b); }
typedef short v4i16_t __attribute__((ext_vector_type(4)));
typedef __attribute__((address_space(3))) const char* lds_cptr;
__device__ __forceinline__ s16x4 vtr(lds_cptr p) { return __builtin_bit_cast(s16x4, __builtin_amdgcn_ds_read_tr16_b64_v4i16((__attribute__((address_space(3))) v4i16_t*)p)); }
__device__ __forceinline__ bf16x8 ld8(const bf16* p) { return *reinterpret_cast<const bf16x8*>(p); }

template <int DQK> struct Cfg {
  static constexpr float SCALE = (DQK == 128) ? 0.088388347648318440f : 0.072168783648703220f;
  static constexpr float C = SCALE * 1.4426950408889634f;
  static constexpr int KROWB = DQK * 2, SHM_K = KVBLK * KROWB, SHM_V = KVBLK * 128 * 2, ND0 = DQK / 16;
  static constexpr int QREG = (DQK > 128) ? MLA_QREG : 8;
  static constexpr int QXW = (ND0 - QREG) * 1024, SHM_QX = NW * QXW;
  static constexpr int SHM_TOTAL = 2 * SHM_V + 2 * SHM_K + NW * 64 * 4 + SHM_QX;
};

constexpr float TRIG = 65536.f;
__device__ __forceinline__ void firstSM(f32x16& p0, f32x16& p1, float& m_ref, f32x16& negm) {
  float pmax = p0[0];
#pragma unroll
  for (int r = 1; r < 16; ++r) pmax = fmaxf(pmax, p0[r]);
#pragma unroll
  for (int r = 0; r < 16; ++r) pmax = fmaxf(pmax, p1[r]);
  { auto rr = __builtin_amdgcn_permlane32_swap(__float_as_uint(pmax), __float_as_uint(pmax), false, false);
    pmax = fmaxf(__uint_as_float(rr[0]), __uint_as_float(rr[1])); }
  m_ref = pmax;
#pragma unroll
  for (int r = 0; r < 16; ++r) { p0[r] -= pmax; p1[r] -= pmax; negm[r] = -pmax; }
#pragma unroll
  for (int r = 0; r < 16; ++r) p0[r] = __builtin_amdgcn_exp2f(p0[r]);
  asm volatile("" : "+v"(p0), "+v"(p1), "+v"(negm));
}
__device__ __forceinline__ void partialSM(f32x16& p0, f32x16& p1) {
#pragma unroll
  for (int r = 0; r < 16; ++r) p0[r] = __builtin_amdgcn_exp2f(p0[r]);
  asm volatile("" : "+v"(p0), "+v"(p1));
}
__device__ __forceinline__ void finishSM(f32x16& p0, f32x16& p1, float& ps, float& l_reg, bf16x8& pa0, bf16x8& pa1, bf16x8& pa2, bf16x8& pa3) {
#pragma unroll
  for (int r = 0; r < 16; ++r) p1[r] = __builtin_amdgcn_exp2f(p1[r]);
  float s0 = 0, s1 = 0;
#pragma unroll
  for (int r = 0; r < 16; ++r) s0 += p0[r];
#pragma unroll
  for (int r = 0; r < 16; ++r) s1 += p1[r];
  ps = s0 + s1;
  { auto rr = __builtin_amdgcn_permlane32_swap(__float_as_uint(ps), __float_as_uint(ps), false, false);
    ps = __uint_as_float(rr[0]) + __uint_as_float(rr[1]); }
  l_reg += ps;
#define ATT_PK4(P, BASE, OUT) do { unsigned a0 = cvtpk(P[BASE + 0], P[BASE + 1]), a1 = cvtpk(P[BASE + 2], P[BASE + 3]);   \
    unsigned b0 = cvtpk(P[BASE + 4], P[BASE + 5]), b1 = cvtpk(P[BASE + 6], P[BASE + 7]);                              \
    auto r0 = __builtin_amdgcn_permlane32_swap(a0, b0, false, false); auto r1 = __builtin_amdgcn_permlane32_swap(a1, b1, false, false); \
    u32x4 w = {r0[0], r1[0], r0[1], r1[1]}; OUT = *reinterpret_cast<bf16x8*>(&w); } while (0)
  ATT_PK4(p0, 0, pa0); ATT_PK4(p0, 8, pa1); ATT_PK4(p1, 0, pa2); ATT_PK4(p1, 8, pa3);
#undef ATT_PK4
}
#define ATT_KEY(row) ((KROWB == 256) ? ((row) & ATT_KEYMASK128) : (((row) >> 1) & 7))
#define ATT_KSWZ(row, colB) ((row) * KROWB + ((colB) ^ (ATT_KEY(row) << 4)))
template <int DQK> __device__ __forceinline__ void qkt(f32x16& p0, f32x16& p1, const f32x16& negm, const char* Ks, const int* kb, const bf16x8* qr, const char* qx, int r32, int hi) {
  constexpr int KROWB = Cfg<DQK>::KROWB, ND0 = Cfg<DQK>::ND0, QREG = Cfg<DQK>::QREG;
  p0 = negm; p1 = negm;
  constexpr int NB = (KROWB == 256 && ATT_KEYMASK128 == 15) ? 8 : 4;
#pragma unroll
  for (int d0 = 0; d0 < ND0; ++d0) {
    bf16x8 b0 = *reinterpret_cast<const bf16x8*>(Ks + kb[d0 % NB] + (d0 / NB) * (NB * 32));
    bf16x8 b1 = *reinterpret_cast<const bf16x8*>(Ks + kb[d0 % NB] + (d0 / NB) * (NB * 32) + 32 * KROWB);
    bf16x8 q; if (d0 < QREG) q = qr[d0]; else q = *reinterpret_cast<const bf16x8*>(qx + (d0 - QREG) * 1024);
    p0 = __builtin_amdgcn_mfma_f32_32x32x16_bf16(b0, q, p0, 0, 0, 0);
    p1 = __builtin_amdgcn_mfma_f32_32x32x16_bf16(b1, q, p1, 0, 0, 0); }
}
__device__ __forceinline__ int v_st(int k, int c) { const int kk = (k & ~0xC) | ((k & 4) << 1) | ((k & 8) >> 1); return ((kk >> 3) * 4 + (c >> 5)) * 512 + ((kk & 7) * 32 + (c & 31)) * 2; }
__device__ __forceinline__ int v_rd_base(int lane) { return ((lane & 3) << 3) | (((lane >> 2) & 3) << 6) | (((lane >> 4) & 1) << 5) | (((lane >> 5) & 1) << 8); }
constexpr int v_rd_off(int d0, int ks, int half) { return d0 * 512 + ks * 4096 + half * 2048; }
template <int OFF> __device__ __forceinline__ s16x4 tr_read(int vb) {
  s16x4 r; asm volatile("ds_read_b64_tr_b16 %0, %1 offset:%2" : "=&v"(r) : "v"(vb), "i"(OFF) : "memory"); return r;
}
#define ATT_PK(L, H) (bf16x8){L[0], L[1], L[2], L[3], H[0], H[1], H[2], H[3]}
template <int D0> __device__ __forceinline__ void pv_one(f32x16& od, lds_cptr vp, bf16x8 pa0, bf16x8 pa1, bf16x8 pa2, bf16x8 pa3) {
  const s16x4 l0 = vtr(vp + v_rd_off(D0, 0, 0)), h0 = vtr(vp + v_rd_off(D0, 0, 1)), l1 = vtr(vp + v_rd_off(D0, 1, 0)), h1 = vtr(vp + v_rd_off(D0, 1, 1));
  const s16x4 l2 = vtr(vp + v_rd_off(D0, 2, 0)), h2 = vtr(vp + v_rd_off(D0, 2, 1)), l3 = vtr(vp + v_rd_off(D0, 3, 0)), h3 = vtr(vp + v_rd_off(D0, 3, 1));
  od = __builtin_amdgcn_mfma_f32_32x32x16_bf16(pa0, ATT_PK(l0, h0), od, 0, 0, 0);
  od = __builtin_amdgcn_mfma_f32_32x32x16_bf16(pa1, ATT_PK(l1, h1), od, 0, 0, 0);
  od = __builtin_amdgcn_mfma_f32_32x32x16_bf16(pa2, ATT_PK(l2, h2), od, 0, 0, 0);
  od = __builtin_amdgcn_mfma_f32_32x32x16_bf16(pa3, ATT_PK(l3, h3), od, 0, 0, 0);
}
__device__ __forceinline__ void pv_d0(f32x16* o, lds_cptr vp, bf16x8 pa0, bf16x8 pa1, bf16x8 pa2, bf16x8 pa3) {
  pv_one<0>(o[0], vp, pa0, pa1, pa2, pa3); pv_one<1>(o[1], vp, pa0, pa1, pa2, pa3); pv_one<2>(o[2], vp, pa0, pa1, pa2, pa3); pv_one<3>(o[3], vp, pa0, pa1, pa2, pa3);
}
template <int NGRP, int MG, int NVALU, int NDS, int NPRE> __device__ __forceinline__ void sched_pipe() {
  __builtin_amdgcn_sched_group_barrier(0x100, NPRE, 0);
#pragma unroll
  for (int i = 0; i < NGRP; ++i) { __builtin_amdgcn_sched_group_barrier(0x008, MG, 0); __builtin_amdgcn_sched_group_barrier(0x002, NVALU, 0); __builtin_amdgcn_sched_group_barrier(0x100, NDS, 0); }
}

template <int DQK, int LDQ, int LDK, int LDV, int LDO, int SD>
__device__ __forceinline__ void attn_unit(const bf16* __restrict__ Qb, const bf16* __restrict__ Kh, const bf16* __restrict__ Kr, const bf16* __restrict__ Vh,
                                          bf16* __restrict__ Ob, int seq, char* lds) {
  constexpr int KROWB = Cfg<DQK>::KROWB, SHM_K = Cfg<DQK>::SHM_K, SHM_V = Cfg<DQK>::SHM_V, ND0 = Cfg<DQK>::ND0;
  const int tid = threadIdx.x, wid = tid >> 6, lane = tid & 63, r32 = lane & 31, hi = lane >> 5;
  char* V_lds = lds; char* K_lds = lds + 2 * SHM_V;
  float* ws = (float*)(lds + 2 * SHM_V + 2 * SHM_K) + wid * 64; float* li_l = ws; float* al_l = ws + 32;
  float m_ref = 0.f, l_reg = 0; f32x16 o[4] = {}; f32x16 negm = {}; constexpr int QREG = Cfg<DQK>::QREG; bf16x8 qr[QREG];
  const bf16* Qw = Qb + (long)(wid * QBLK + r32) * LDQ + hi * 8;
  char* qx = lds + 2 * SHM_V + 2 * SHM_K + NW * 64 * 4 + wid * Cfg<DQK>::QXW + lane * 16;
#pragma unroll
  for (int d0 = 0; d0 < QREG; ++d0) qr[d0] = ld8(Qw + d0 * 16);
  if constexpr (QREG < ND0) {
#pragma unroll
    for (int d0 = QREG; d0 < ND0; ++d0) *(bf16x8*)(qx + (d0 - QREG) * 1024) = ld8(Qw + d0 * 16);
  }
  const int sr = tid >> 4, sc = (tid & 15) * 8, vst0 = v_st(sr, sc), vst1 = v_st(32 + sr, sc);
  const int krr = tid >> 3, krc = (tid & 7) * 8;
  const lds_cptr vb0 = (lds_cptr)V_lds + v_rd_base(lane);
  constexpr int NB = (KROWB == 256 && ATT_KEYMASK128 == 15) ? 8 : 4; int kb[NB];
#pragma unroll
  for (int dl = 0; dl < NB; ++dl) kb[dl] = r32 * KROWB + ((dl * 32 + hi * 16) ^ (ATT_KEY(r32) << 4));
  const unsigned boV = (unsigned)(sr * LDV + sc) * 2u, boK = (unsigned)(sr * LDK + sc) * 2u, boR = (unsigned)(krr * 64 + krc) * 2u;
  struct { bf16x8 vs0, vs1, ks0, ks1, kr; } sr_[SD];
#define SLOAD(i, k0) do { const char* vt_ = (const char*)(Vh + (long)(k0) * LDV); const char* kt_ = (const char*)(Kh + (long)(k0) * LDK); \
    sr_[i].vs0 = *(const bf16x8*)(vt_ + boV); sr_[i].vs1 = *(const bf16x8*)(vt_ + 32 * LDV * 2 + boV); \
    sr_[i].ks0 = *(const bf16x8*)(kt_ + boK); sr_[i].ks1 = *(const bf16x8*)(kt_ + 32 * LDK * 2 + boK); \
    if constexpr (DQK == 192) { const char* rt_ = (const char*)(Kr + (long)(k0) * 64); sr_[i].kr = *(const bf16x8*)(rt_ + boR); } } while (0)
#define SWRITE(b, i) do { *(bf16x8*)(V_lds + (b) * SHM_V + vst0) = sr_[i].vs0;          \
    *(bf16x8*)(V_lds + (b) * SHM_V + vst1) = sr_[i].vs1; int kc = sc * 2;               \
    *(bf16x8*)(K_lds + (b) * SHM_K + ATT_KSWZ(sr, kc)) = sr_[i].ks0;                       \
    *(bf16x8*)(K_lds + (b) * SHM_K + ATT_KSWZ(32 + sr, kc)) = sr_[i].ks1;                  \
    if constexpr (DQK == 192) *(bf16x8*)(K_lds + (b) * SHM_K + ATT_KSWZ(krr, 256 + krc * 2)) = sr_[i].kr; } while (0)
#define SWAIT() do { if constexpr (SD == 2) { if constexpr (DQK == 192) asm volatile("s_waitcnt vmcnt(5)" ::: "memory"); else asm volatile("s_waitcnt vmcnt(4)" ::: "memory"); } \
    else asm volatile("s_waitcnt vmcnt(0)" ::: "memory"); } while (0)
#define RESC_APPLY() do { l_reg *= alp; if (hi == 0) al_l[r32] = alp; asm volatile("s_waitcnt lgkmcnt(0)" ::: "memory"); \
    _Pragma("unroll") for (int d = 0; d < 4; ++d) _Pragma("unroll") for (int r = 0; r < 16; ++r) o[d][r] *= al_l[crow(r, hi)]; pend = false; } while (0)
#define RESCN(ps_) do { if (pend) { RESC_APPLY(); } else { const bool t_ = (ps_) > TRIG; const float d_ = t_ ? __builtin_amdgcn_logf(ps_) : 0.f; alp = __builtin_amdgcn_exp2f(-d_); m_ref += d_; pend = __any(t_); } \
    _Pragma("unroll") for (int r = 0; r < 16; ++r) negm[r] = -m_ref; } while (0)
  float alp = 1.f; bool pend = false;
  f32x16 pA0, pA1, pB0, pB1; float psA, psB; bf16x8 pa0, pa1, pa2, pa3; const int NT = seq / KVBLK;
  constexpr int SE = 0, SO = SD - 1;
  SLOAD(SE, 0); asm volatile("s_waitcnt vmcnt(0)" ::: "memory"); SWRITE(0, SE); __syncthreads();
  qkt<DQK>(pA0, pA1, negm, K_lds, kb, qr, qx, r32, hi); firstSM(pA0, pA1, m_ref, negm);
  SLOAD(SO, KVBLK); if constexpr (SD == 2) { if (2 < NT) SLOAD(SE, 2 * KVBLK); }
  SWAIT(); SWRITE(1, SO); __syncthreads();
#define SCHED_A() do { if constexpr (DQK == 128) sched_pipe<16, 1, ATT_NVA128, 1, ATT_PREA>(); else sched_pipe<24 / ATT_MG192, ATT_MG192, ATT_NVA192 * ATT_MG192, ATT_DS192, ATT_PREA>(); } while (0)
#define SCHED_B() sched_pipe<16, 1, ATT_NVB, 2, ATT_PREB>()
  for (int j = 1; j + 1 < NT; j += 2) {
    ATT_SBAR(); qkt<DQK>(pB0, pB1, negm, K_lds + SHM_K, kb, qr, qx, r32, hi);
    finishSM(pA0, pA1, psA, l_reg, pa0, pa1, pa2, pa3); SCHED_A(); ATT_SBAR();
    SLOAD(SO, (j + SD) * KVBLK); ATT_SBAR();
    pv_d0(o, vb0, pa0, pa1, pa2, pa3); partialSM(pB0, pB1); SCHED_B(); ATT_SBAR();
    __syncthreads(); SWAIT(); SWRITE(0, SE);
    RESCN(psA); __syncthreads();
    ATT_SBAR(); qkt<DQK>(pA0, pA1, negm, K_lds, kb, qr, qx, r32, hi);
    finishSM(pB0, pB1, psB, l_reg, pa0, pa1, pa2, pa3); SCHED_A(); ATT_SBAR();
    if (SD == 1 || j + 3 < NT) SLOAD(SE, (j + 1 + SD) * KVBLK); ATT_SBAR();
    pv_d0(o, vb0 + SHM_V, pa0, pa1, pa2, pa3); partialSM(pA0, pA1); SCHED_B(); ATT_SBAR();
    __syncthreads(); SWAIT(); SWRITE(1, SO);
    RESCN(psB); __syncthreads();
  }
  ATT_SBAR(); qkt<DQK>(pB0, pB1, negm, K_lds + SHM_K, kb, qr, qx, r32, hi);
  finishSM(pA0, pA1, psA, l_reg, pa0, pa1, pa2, pa3); ATT_SBAR();
  pv_d0(o, vb0, pa0, pa1, pa2, pa3); partialSM(pB0, pB1);
  __syncthreads(); if (pend) { RESC_APPLY(); }
  finishSM(pB0, pB1, psB, l_reg, pa0, pa1, pa2, pa3); ATT_SBAR();
  pv_d0(o, vb0 + SHM_V, pa0, pa1, pa2, pa3);
#undef SCHED_A
#undef SCHED_B
  if (hi == 0) li_l[r32] = l_reg; asm volatile("s_waitcnt lgkmcnt(0)" ::: "memory");
  float rli[16];
#pragma unroll
  for (int r = 0; r < 16; ++r) rli[r] = __builtin_amdgcn_rcpf(li_l[crow(r, hi)]);
  { int r32e = r32, hie = hi; asm volatile("" : "+v"(r32e), "+v"(hie));
    char* Ow = (char*)(Ob + (long)(wid * QBLK) * LDO);
    const unsigned lo_ = (unsigned)(((r32e >> 5) + 4 * hie) * LDO + (r32e & 31)) * 2u;
#pragma unroll
    for (int r = 0; r < 16; ++r) {
#pragma unroll
      for (int d0 = 0; d0 < 4; ++d0) *(bf16*)(Ow + lo_ + (unsigned)((((r & 3) + 8 * (r >> 2)) * LDO + d0 * 32) * 2)) = (bf16)(cvtpk(o[d0][r] * rli[r], 0.f) & 0xffffu); } }
  asm volatile("s_waitcnt vmcnt(0) lgkmcnt(0)" ::: "memory"); __syncthreads();
#undef SLOAD
#undef SWRITE
#undef SWAIT
#undef RESCN
#undef RESC_APPLY
}
#undef ATT_KSWZ
#undef ATT_KEY
#undef ATT_PK
#undef ATT_SBAR
}
#define LAS __attribute__((address_space(3)))
typedef unsigned short u16;
typedef float f32x4 __attribute__((ext_vector_type(4)));
typedef short bf16x8 __attribute__((ext_vector_type(8)));
typedef unsigned u32x4 __attribute__((ext_vector_type(4)));
typedef unsigned u32x2 __attribute__((ext_vector_type(2)));
constexpr int DM = 2048, BATCH = 2, SEQ = 16384, T = BATCH * SEQ;
constexpr int IN0 = 4608, NLAT = 1088, NLATP = 1280, NQ = 3072, NKV = 4096, DFF = 8192;
constexpr float EPS = 1e-6f;
constexpr int NWAVES = 8, NTHREADS = 512;
constexpr int LDS_BYTES = 155648;
constexpr float LOG2_THETA = 13.287712379549449f;

constexpr size_t MiB = 1u << 20;
constexpr size_t WS_WIN = 0, WS_WOUT = 18 * MiB, WS_WDOWN = 26 * MiB, WS_WUQ = 31 * MiB, WS_WUKV = 34 * MiB, WS_WO = 38 * MiB;
constexpr size_t WS_WUP = 46 * MiB  , WS_WDN = 110 * MiB  ;
constexpr size_t WS_XN = 176 * MiB;
constexpr size_t WS_BIG = 304 * MiB;
constexpr size_t WS_PROJ = WS_BIG, WS_MIX = WS_BIG + 288 * MiB;
constexpr size_t WS_HID = WS_BIG;
constexpr size_t WS_LAT = WS_BIG, WS_CQN = WS_BIG + 80 * MiB, WS_CKVN = WS_BIG + 112 * MiB, WS_KROPE = WS_BIG + 144 * MiB;
constexpr size_t WS_Q = WS_BIG + 148 * MiB, WS_KV = WS_BIG + 340 * MiB, WS_AO = WS_BIG;
constexpr size_t WS_CTL = WS_BIG + 596 * MiB, CTL_BYTES = 65536;
constexpr size_t WS_END = WS_CTL + CTL_BYTES;

__device__ __forceinline__ float bflo(unsigned u) { return __uint_as_float(u << 16); }
__device__ __forceinline__ float bfhi(unsigned u) { return __uint_as_float(u & 0xffff0000u); }
__device__ __forceinline__ unsigned pk2(float lo, float hi) { unsigned r; asm volatile("v_cvt_pk_bf16_f32 %0, %1, %2" : "=v"(r) : "v"(lo), "v"(hi)); return r; }
__device__ __forceinline__ float wave_sum(float v) {
#pragma unroll
    for (int o = 1; o < 64; o <<= 1) v += __shfl_xor(v, o);
    return v;
}
__device__ __forceinline__ void rope_cs(float pos, float invf, float& c, float& s) {
    const float a = pos * invf;
    double rev = (double)a * 0.15915494309189535;
    rev -= __builtin_rint(rev);
    const float fr = (float)rev;
    c = __builtin_amdgcn_cosf(fr); s = __builtin_amdgcn_sinf(fr);
}

__device__ __forceinline__ void transpose_item(const float* __restrict__ W, const float* __restrict__ gain, float mul, int K, int N, u16* __restrict__ WT, LAS float* scr, int item, int lane) {
    const int nblk = N / 32, kb = item / nblk, nb = item % nblk, k0 = 64 * kb, n0 = 32 * nb;
#pragma unroll 8
    for (int i = 0; i < 32; ++i) { const int kk = 2 * i + (lane >> 5); float w = W[(size_t)(k0 + kk) * N + n0 + (lane & 31)]; if (gain) w *= gain[k0 + kk] * mul; scr[kk * 33 + (lane & 31)] = w; }
    asm volatile("s_waitcnt lgkmcnt(0)" ::: "memory");
    const int c = lane & 7;
#pragma unroll
    for (int j = 0; j < 4; ++j) { const int n = (lane >> 3) + 8 * j; const LAS float* s = scr + (8 * c) * 33 + n;
        u32x4 o; o.x = pk2(s[0 * 33], s[1 * 33]); o.y = pk2(s[2 * 33], s[3 * 33]); o.z = pk2(s[4 * 33], s[5 * 33]); o.w = pk2(s[6 * 33], s[7 * 33]);
        *(u32x4*)(WT + (size_t)(n0 + n) * K + k0 + 8 * c) = o; }
    asm volatile("s_waitcnt lgkmcnt(0)" ::: "memory");
}

__device__ __forceinline__ void norm_row_bf16(const float* __restrict__ xrow, u16* __restrict__ orow, int lane) {
    const f32x4* xr = (const f32x4*)xrow + lane;
    f32x4 v[8]; float s = 0.f;
#pragma unroll
    for (int j = 0; j < 8; ++j) { v[j] = xr[64 * j]; s += (v[j].x * v[j].x + v[j].y * v[j].y) + (v[j].z * v[j].z + v[j].w * v[j].w); }
    const float r = 1.0f / sqrtf(wave_sum(s) * (1.f / DM) + EPS);
    u32x2* o8 = (u32x2*)orow + lane;
#pragma unroll
    for (int j = 0; j < 8; ++j) { u32x2 w; w.x = pk2(v[j].x * r, v[j].y * r); w.y = pk2(v[j].z * r, v[j].w * r); o8[64 * j] = w; }
}
__device__ __forceinline__ void norm_row_f32(float* xrow, const float* __restrict__ g, int lane) {
    f32x4* xr = (f32x4*)xrow + lane; const f32x4* gr = (const f32x4*)g + lane;
    f32x4 v[8]; float s = 0.f;
#pragma unroll
    for (int j = 0; j < 8; ++j) { v[j] = xr[64 * j]; s += (v[j].x * v[j].x + v[j].y * v[j].y) + (v[j].z * v[j].z + v[j].w * v[j].w); }
    const float r = 1.0f / sqrtf(wave_sum(s) * (1.f / DM) + EPS);
#pragma unroll
    for (int j = 0; j < 8; ++j) xr[64 * j] = (v[j] * r) * gr[64 * j];
}

__device__ __forceinline__ void ld8f(const u16* p, float* f) {
    const u32x4 w = *(const u32x4*)p;
    f[0] = bflo(w.x); f[1] = bfhi(w.x); f[2] = bflo(w.y); f[3] = bfhi(w.y); f[4] = bflo(w.z); f[5] = bfhi(w.z); f[6] = bflo(w.w); f[7] = bfhi(w.w);
}

__device__ __forceinline__ void ew0_token(int t, u16* __restrict__ PROJ, u16* __restrict__ MIX, const float* __restrict__ qg, const float* __restrict__ kg, const float* __restrict__ cw, int lane) {
    const int s = t & (SEQ - 1), row = s >> 6, col = s & 63;
    float c, sn; { const int j = lane & 31; const float invf = __builtin_amdgcn_exp2f(-(float)j * (LOG2_THETA / 32.f)); rope_cs((float)(lane < 32 ? row : col), invf, c, sn); }
    unsigned* pr = (unsigned*)(PROJ + (size_t)t * IN0);
    const float qg0 = qg[2 * lane], qg1 = qg[2 * lane + 1], kg0 = kg[2 * lane], kg1 = kg[2 * lane + 1];
#pragma unroll
    for (int h = 0; h < 10; ++h) {
        const unsigned u = pr[h * 64 + lane]; const float x1 = bflo(u), x2 = bfhi(u);
        const float ss = wave_sum(x1 * x1 + x2 * x2); const float r = 1.0f / sqrtf(ss * (1.f / 128.f) + EPS);
        const float y1 = x1 * r * (h < 8 ? qg0 * att::Cfg<128>::C : kg0), y2 = x2 * r * (h < 8 ? qg1 * att::Cfg<128>::C : kg1);
        pr[h * 64 + lane] = pk2(y1 * c - y2 * sn, y1 * sn + y2 * c);
    }
    const u16* p0 = PROJ + (size_t)t * IN0;
#pragma unroll
    for (int ch = 0; ch < 2; ++ch) {
        const int cc = ch * 512 + lane * 8;
        float gb[8], g0[8], u0[8], gm[8], um[8], gp[8], up[8];
        ld8f(p0 + 1536 + cc, gb); ld8f(p0 + 2560 + cc, g0); ld8f(p0 + 3584 + cc, u0);
        if (s > 0) { ld8f(p0 - IN0 + 2560 + cc, gm); ld8f(p0 - IN0 + 3584 + cc, um); } else {
#pragma unroll
            for (int e = 0; e < 8; ++e) { gm[e] = 0.f; um[e] = 0.f; } }
        if (s < SEQ - 1) { ld8f(p0 + IN0 + 2560 + cc, gp); ld8f(p0 + IN0 + 3584 + cc, up); } else {
#pragma unroll
            for (int e = 0; e < 8; ++e) { gp[e] = 0.f; up[e] = 0.f; } }
        float o[8];
#pragma unroll
        for (int e = 0; e < 8; ++e) o[e] = gb[e] * (cw[cc + e] * (gm[e] * um[e]) + cw[1024 + cc + e] * (g0[e] * u0[e]) + cw[2048 + cc + e] * (gp[e] * up[e]));
        u32x4 w; w.x = pk2(o[0], o[1]); w.y = pk2(o[2], o[3]); w.z = pk2(o[4], o[5]); w.w = pk2(o[6], o[7]);
        *(u32x4*)(MIX + (size_t)t * DM + 1024 + cc) = w;
    }
}
__device__ __forceinline__ void ew1_token(int t, const u16* __restrict__ LAT, u16* __restrict__ CQN, u16* __restrict__ CKVN, u16* __restrict__ KROPE, int lane) {
    const u16* p0 = LAT + (size_t)t * NLATP;
#pragma unroll
    for (int part = 0; part < 2; ++part) {
        float x[8]; ld8f(p0 + part * 512 + lane * 8, x);
        float ss = 0.f;
#pragma unroll
        for (int e = 0; e < 8; ++e) ss += x[e] * x[e];
        const float r = 1.0f / sqrtf(wave_sum(ss) * (1.f / 512.f) + EPS);
        u32x4 w; w.x = pk2(x[0] * r, x[1] * r); w.y = pk2(x[2] * r, x[3] * r); w.z = pk2(x[4] * r, x[5] * r); w.w = pk2(x[6] * r, x[7] * r);
        *(u32x4*)((part ? CKVN : CQN) + (size_t)t * 512 + lane * 8) = w;
    }
    if (lane < 32) {
        const int s = t & (SEQ - 1), row = s >> 6, col = s & 63; const int j = lane & 15;
        const float invf = __builtin_amdgcn_exp2f(-(float)j * (LOG2_THETA / 16.f)); float c, sn; rope_cs((float)(lane < 16 ? row : col), invf, c, sn);
        const unsigned u = *(const unsigned*)(p0 + 1024 + 2 * lane); const float x1 = bflo(u), x2 = bfhi(u);
        *(unsigned*)(KROPE + (size_t)t * 64 + 2 * lane) = pk2(x1 * c - x2 * sn, x1 * sn + x2 * c);
    }
}
__device__ __forceinline__ void ew2_token(int t, u16* __restrict__ Q, int lane) {
    const int s = t & (SEQ - 1), row = s >> 6, col = s & 63;
    const int h = lane >> 2, part = lane & 3; const float pos = (float)(part < 2 ? row : col);
    u16* p = Q + (size_t)t * NQ + h * 192 + 128 + part * 16;
    float x[16]; ld8f(p, x); ld8f(p + 8, x + 8);
    unsigned w[8];
#pragma unroll
    for (int i = 0; i < 8; ++i) { const int j = (part & 1) * 8 + i; const float invf = __builtin_amdgcn_exp2f(-(float)j * (LOG2_THETA / 16.f)); float c, sn; rope_cs(pos, invf, c, sn);
        w[i] = pk2(x[2 * i] * c - x[2 * i + 1] * sn, x[2 * i] * sn + x[2 * i + 1] * c); }
    *(u32x4*)p = (u32x4){w[0], w[1], w[2], w[3]}; *(u32x4*)(p + 8) = (u32x4){w[4], w[5], w[6], w[7]};
}

#define RLX_AGENT __ATOMIC_RELAXED, __HIP_MEMORY_SCOPE_AGENT
#define XB_TMO      128
#define XB_XCNT(j)  (256  + 64 * (j))
#define XB_XSUB(j)  (1280 + 64 * (j))
#define XB_XGEN(j)  (2304 + 64 * (j))
#define XB_TOP      3328
#define XB_TOPGEN   3392
#define XCD_BAR_WORDS 3456
#define XB_SPIN_CAP (1u << 22)

__device__ __forceinline__ unsigned xb_ld(unsigned* p)              { return __hip_atomic_load(p, __ATOMIC_RELAXED, __HIP_MEMORY_SCOPE_AGENT); }
__device__ __forceinline__ unsigned xb_add(unsigned* p, unsigned v) { return __hip_atomic_fetch_add(p, v, __ATOMIC_RELAXED, __HIP_MEMORY_SCOPE_AGENT); }
__device__ __forceinline__ unsigned xb_xcc_id() { return (unsigned)__builtin_amdgcn_s_getreg((3 << 11) | 20) & 0xFu; }
#define XB_SPIN(cond, bar) do { unsigned _sp = 0; while (cond) { __builtin_amdgcn_s_sleep(1); \
    if ((++_sp & 255u) == 0u) { if (xb_ld(&(bar)[XB_TMO])) break; if (_sp > XB_SPIN_CAP) { atomicAdd(&(bar)[XB_TMO], 1u); break; } } } } while (0)

struct XcdBarrier {
    unsigned* bar; unsigned x;
    volatile LAS unsigned* st;
};

__device__ __forceinline__ XcdBarrier xcd_barrier_post(unsigned* bar, volatile LAS unsigned* st) {
    XcdBarrier b; b.bar = bar; b.x = xb_xcc_id(); b.st = st;
    if (threadIdx.x == 0) (void)xb_add(&bar[XB_XCNT(b.x)], 1u);
    return b;
}
__device__ __forceinline__ void xcd_barrier_complete(unsigned* bar, unsigned x, unsigned& nloc, unsigned& nx) {
    const unsigned G = gridDim.x * gridDim.y * gridDim.z;
    unsigned sum, cnt, mine, sp = 0u;
    for (;;) {
        sum = 0u; cnt = 0u; mine = 0u;
#pragma unroll
        for (unsigned j = 0; j < 16; ++j) { const unsigned c = xb_ld(&bar[XB_XCNT(j)]); sum += c; cnt += (c > 0u) ? 1u : 0u; mine = (j == x) ? c : mine; }
        if (sum == G) break;
        __builtin_amdgcn_s_sleep(1);
        if ((++sp & 255u) == 0u) { if (xb_ld(&bar[XB_TMO])) break; if (sp > XB_SPIN_CAP) { atomicAdd(&bar[XB_TMO], 1u); break; } }
    }
    nloc = mine > 0u ? mine : 1u; nx = cnt > 0u ? cnt : 1u;
}

__device__ __forceinline__ void xcd_barrier(const XcdBarrier& b) {
    asm volatile("s_waitcnt vmcnt(0)" ::: "memory");
    __syncthreads();
    if (threadIdx.x == 0) {
        unsigned* bar = b.bar;
        __builtin_amdgcn_s_waitcnt(0);
        unsigned nloc = b.st[0], nx = b.st[1];
        if (nloc == 0u) { xcd_barrier_complete(bar, b.x, nloc, nx); b.st[0] = nloc; b.st[1] = nx; }
        const unsigned old = xb_add(&bar[XB_XSUB(b.x)], 1u);
        const unsigned gen = old / nloc;
        if (old + 1u == (gen + 1u) * nloc) {
            __builtin_amdgcn_fence(__ATOMIC_RELEASE, "agent");
            asm volatile("s_waitcnt vmcnt(0)" ::: "memory");
            const unsigned og = xb_add(&bar[XB_TOP], 1u);
            const unsigned tg = og / nx;
            if (og + 1u == (tg + 1u) * nx) xb_add(&bar[XB_TOPGEN], 1u);
            else XB_SPIN(xb_ld(&bar[XB_TOPGEN]) == tg, bar);
            __builtin_amdgcn_fence(__ATOMIC_ACQUIRE, "agent");
            xb_add(&bar[XB_XGEN(b.x)], 1u);
            asm volatile("s_waitcnt vmcnt(0)" ::: "memory");
        } else {
            XB_SPIN(xb_ld(&bar[XB_XGEN(b.x)]) == gen, bar);
            __builtin_amdgcn_fence(__ATOMIC_ACQUIRE, "agent");
            asm volatile("s_waitcnt vmcnt(0)" ::: "memory");
        }
    }
    __syncthreads();
}

struct Params { const float* in[18]; float* out; unsigned char* ws; int ph_lo, ph_hi; };
enum { I_X = 0, I_ENG, I_EWIN, I_EQG, I_EKG, I_ECW, I_EWOUT, I_ONG, I_OWDOWN, I_OQG, I_OKVG, I_OWUQ, I_OWUKV, I_OWO, I_MNG, I_MWUP, I_MWDN, I_FNG };
constexpr int NPHASE = 19;

template <int DQK> __device__ __forceinline__ bool attn_next(int i, int NU, int& unit) {
    const int G = gridDim.x, bx = blockIdx.x;
    if ((G & 7) == 0 && (NU & 7) == 0) { const int x = bx & 7, j = bx >> 3, per = G >> 3, upx = NU >> 3; const int k = i * per + j; if (k >= upx) return false; unit = x * upx + k; return true; }
    const int k = i * G + bx; if (k >= NU) return false; unit = k; return true;
}

__global__ void __launch_bounds__(NTHREADS, 2) fwd_mega(Params P) {
    extern __shared__ __attribute__((aligned(16))) unsigned char lds[];
    cg::grid_group grid = cg::this_grid();
    const int tid = threadIdx.x, lane = tid & 63, wave = __builtin_amdgcn_readfirstlane(tid >> 6);
    const int G = gridDim.x, gw = blockIdx.x * NWAVES + wave, NGW = G * NWAVES;
    unsigned char* ws = P.ws;
    u16* Win = (u16*)(ws + WS_WIN); u16* Wout = (u16*)(ws + WS_WOUT); u16* Wdown = (u16*)(ws + WS_WDOWN); u16* Wuq = (u16*)(ws + WS_WUQ); u16* Wukv = (u16*)(ws + WS_WUKV); u16* Wo = (u16*)(ws + WS_WO);
    u16* Wup = (u16*)(ws + WS_WUP); u16* Wdn = (u16*)(ws + WS_WDN);
    u16* XN = (u16*)(ws + WS_XN); u16* PROJ = (u16*)(ws + WS_PROJ); u16* MIX = (u16*)(ws + WS_MIX); u16* HID = (u16*)(ws + WS_HID);
    u16* LAT = (u16*)(ws + WS_LAT); u16* CQN = (u16*)(ws + WS_CQN); u16* CKVN = (u16*)(ws + WS_CKVN); u16* KROPE = (u16*)(ws + WS_KROPE);
    u16* Qm = (u16*)(ws + WS_Q); u16* KVm = (u16*)(ws + WS_KV); u16* AO = (u16*)(ws + WS_AO);
    float* H = P.out;
    LAS unsigned char* ldsl = (LAS unsigned char*)lds;
    const int lo = P.ph_lo, hi = P.ph_hi;
    volatile LAS unsigned* xst = (volatile LAS unsigned*)(ldsl + LDS_BYTES - 16);
    if (tid < 4) xst[tid] = 0u;
    __syncthreads();
    XcdBarrier xbar = xcd_barrier_post((unsigned*)(ws + WS_CTL), xst);
#define PH(k) if (lo <= (k) && (k) < hi) _Pragma("unroll") for (int rep_ = 0; rep_ <= (int)((REP_MASK >> (k)) & 1u); ++rep_)
#define SEAM(k) do { if (lo <= (k) && (k) + 1 < hi) { if ((k) == 0) grid.sync(); else xcd_barrier(xbar); } } while (0)
#define GEMM_BF16(ACT, Aptr, Bptr, Mv, Nv, Kv, Optr, ldc) do { pg8::Gemm g{Aptr, Bptr, Mv, Nv, Kv}; pg8::StaticOrder S; S.init(Mv, Nv, G, (int)blockIdx.x); \
        pg8::EpiBf16<ACT> E{Optr, ldc}; pg8::gemm_phase<pg8::EpiBf16<ACT>, pg8::StaticOrder, true, true>(ldsl, g, S, E); } while (0)
#define GEMM_RES(Aptr, Bptr, Mv, Nv, Kv, baseptr, outptr) do { pg8::Gemm g{Aptr, Bptr, Mv, Nv, Kv}; pg8::StaticOrder S; S.init(Mv, Nv, G, (int)blockIdx.x); \
        pg8::EpiRes E{baseptr, outptr, Nv}; pg8::gemm_phase<pg8::EpiRes, pg8::StaticOrder, true, true>(ldsl, g, S, E); } while (0)
#define NORM_PHASE(src) do { for (int m = gw; m < T; m += NGW) norm_row_bf16((src) + (size_t)m * DM, XN + (size_t)m * DM, lane); } while (0)

    PH(0) {
        LAS float* scr = (LAS float*)(ldsl + wave * 16384);
        constexpr int I0 = (DM / 64) * (IN0 / 32), I1 = (DM / 64) * (DM / 32), I2 = (DM / 64) * (NLAT / 32), I3 = (512 / 64) * (NQ / 32), I4 = (512 / 64) * (NKV / 32), I5 = I1;
        constexpr int I6 = (DM / 64) * (DFF / 32), I7 = (DFF / 64) * (DM / 32);
        constexpr int NITEMS = I0 + I1 + I2 + I3 + I4 + I5 + 2 * I6 + 2 * I7;
        for (int it = gw; it < NITEMS; it += NGW) {
            int r = it;
            if (r < I0) { transpose_item(P.in[I_EWIN], P.in[I_ENG], 1.f, DM, IN0, Win, scr, r, lane); continue; } r -= I0;
            if (r < I1) { transpose_item(P.in[I_EWOUT], nullptr, 1.f, DM, DM, Wout, scr, r, lane); continue; } r -= I1;
            if (r < I2) { transpose_item(P.in[I_OWDOWN], P.in[I_ONG], 1.f, DM, NLAT, Wdown, scr, r, lane); continue; } r -= I2;
            if (r < I3) { transpose_item(P.in[I_OWUQ], P.in[I_OQG], att::Cfg<192>::C, 512, NQ, Wuq, scr, r, lane); continue; } r -= I3;
            if (r < I4) { transpose_item(P.in[I_OWUKV], P.in[I_OKVG], 1.f, 512, NKV, Wukv, scr, r, lane); continue; } r -= I4;
            if (r < I5) { transpose_item(P.in[I_OWO], nullptr, 1.f, DM, DM, Wo, scr, r, lane); continue; } r -= I5;
            if (r < I6) { transpose_item(P.in[I_MWUP], P.in[I_MNG], 1.f, DM, DFF, Wup, scr, r, lane); continue; } r -= I6;
            if (r < I6) { transpose_item(P.in[I_MWUP] + (size_t)DM * DFF, P.in[I_MNG] + DM, 1.f, DM, DFF, Wup + (size_t)DM * DFF, scr, r, lane); continue; } r -= I6;
            if (r < I7) { transpose_item(P.in[I_MWDN], nullptr, 1.f, DFF, DM, Wdn, scr, r, lane); continue; } r -= I7;
            transpose_item(P.in[I_MWDN] + (size_t)DM * DFF, nullptr, 1.f, DFF, DM, Wdn + (size_t)DM * DFF, scr, r, lane);
        }
        { const size_t n16 = (size_t)(NLATP - NLAT) * DM * 2 / 16; u32x4* z = (u32x4*)(Wdown + (size_t)NLAT * DM);
          for (size_t i = (size_t)blockIdx.x * NTHREADS + tid; i < n16; i += (size_t)G * NTHREADS) z[i] = (u32x4){0u, 0u, 0u, 0u}; }
        NORM_PHASE(P.in[I_X]);
    }
    SEAM(0);
    PH(1) { GEMM_BF16(0, XN, Win, T, IN0, DM, PROJ, IN0); }
    SEAM(1);
    PH(2) { const int per = (T + NGW - 1) / NGW; const int t0 = gw * per; for (int t = t0; t < t0 + per && t < T; ++t) ew0_token(t, PROJ, MIX, P.in[I_EQG], P.in[I_EKG], P.in[I_ECW], lane); }
    SEAM(2);
    PH(3) {
        constexpr int NU = BATCH * 8 * (SEQ / 256); int unit;
        for (int i = 0; attn_next<128>(i, NU, unit); ++i) {
            const int bh = unit / (SEQ / 256), qb = unit % (SEQ / 256), b = bh >> 3, hq = bh & 7, kvh = hq >> 2;
            const size_t tb = (size_t)b * SEQ;
#ifndef NO_GQA
            att::attn_unit<128, IN0, IN0, IN0, DM, GQA_SD>(PROJ + (tb + (size_t)qb * 256) * IN0 + hq * 128, PROJ + tb * IN0 + 1024 + kvh * 128, nullptr, PROJ + tb * IN0 + 1280 + kvh * 128,
                                                      MIX + (tb + (size_t)qb * 256) * DM + hq * 128, SEQ, (char*)lds);
#endif
        }
    }
    SEAM(3);
    PH(4) { GEMM_RES(MIX, Wout, T, DM, DM, P.in[I_X], H); }
    SEAM(4);
    PH(5) { NORM_PHASE(H); }
    SEAM(5);
    PH(6) { GEMM_BF16(2, XN, Wup, T, DFF, DM, HID, DFF); }
    SEAM(6);
    PH(7) { GEMM_RES(HID, Wdn, T, DM, DFF, H, H); }
    SEAM(7);
    PH(8) { NORM_PHASE(H); }
    SEAM(8);
    PH(9) { GEMM_BF16(0, XN, Wdown, T, NLATP, DM, LAT, NLATP); }
    SEAM(9);
    PH(10) { for (int t = gw; t < T; t += NGW) ew1_token(t, LAT, CQN, CKVN, KROPE, lane); }
    SEAM(10);
    PH(11) { GEMM_BF16(0, CQN, Wuq, T, NQ, 512, Qm, NQ); GEMM_BF16(0, CKVN, Wukv, T, NKV, 512, KVm, NKV); }
    SEAM(11);
    PH(12) { for (int t = gw; t < T; t += NGW) ew2_token(t, Qm, lane); }
    SEAM(12);
    PH(13) {
        constexpr int NU = BATCH * 16 * (SEQ / 256); int unit;
        for (int i = 0; attn_next<192>(i, NU, unit); ++i) {
            const int bh = unit / (SEQ / 256), qb = unit % (SEQ / 256), b = bh >> 4, h = bh & 15;
            const size_t tb = (size_t)b * SEQ;
#ifndef NO_MLA
            att::attn_unit<192, NQ, NKV, NKV, DM, MLA_SD>(Qm + (tb + (size_t)qb * 256) * NQ + h * 192, KVm + tb * NKV + h * 256, KROPE + tb * 64, KVm + tb * NKV + h * 256 + 128,
                                                          AO + (tb + (size_t)qb * 256) * DM + h * 128, SEQ, (char*)lds);
#endif
        }
    }
    SEAM(13);
    PH(14) { GEMM_RES(AO, Wo, T, DM, DM, H, H); }
    SEAM(14);
    PH(15) { NORM_PHASE(H); }
    SEAM(15);
    PH(16) { GEMM_BF16(2, XN, Wup + (size_t)DM * DFF, T, DFF, DM, HID, DFF); }
    SEAM(16);
    PH(17) { GEMM_RES(HID, Wdn + (size_t)DM * DFF, T, DM, DFF, H, H); }
    SEAM(17);
    PH(18) { for (int m = gw; m < T; m += NGW) norm_row_f32(H + (size_t)m * DM, P.in[I_FNG], lane); }
#undef PH
#undef SEAM
}

extern "C" void kernel_launch(void* const* d_in, const int* in_sizes, int n_in, void* d_out, int out_size, void* d_ws, size_t ws_size, hipStream_t stream) {
    static int grid = 0;
    if (grid == 0) {
        if (n_in != 18 || in_sizes[0] != T * DM || out_size != T * DM || ws_size < WS_END) {
            fprintf(stderr, "kernel_launch: shape mismatch (n_in %d in0 %d out %d ws %zu need %zu)\n", n_in, n_in > 0 ? in_sizes[0] : -1, out_size, ws_size, (size_t)WS_END); grid = -1; return; }
        int dev = 0, cus = 0, per_cu = 0;
        hipGetDevice(&dev); hipDeviceGetAttribute(&cus, hipDeviceAttributeMultiprocessorCount, dev);
        if (hipFuncSetAttribute((const void*)fwd_mega, hipFuncAttributeMaxDynamicSharedMemorySize, LDS_BYTES) != hipSuccess) { fprintf(stderr, "kernel_launch: hipFuncSetAttribute failed\n"); grid = -1; return; }
        if (hipOccupancyMaxActiveBlocksPerMultiprocessor(&per_cu, (const void*)fwd_mega, NTHREADS, LDS_BYTES) != hipSuccess || per_cu < 1) { fprintf(stderr, "kernel_launch: occupancy query says %d\n", per_cu); per_cu = 1; }
        (void)hipGetLastError();
        grid = cus * per_cu;
        fprintf(stderr, "kernel_launch: grid %d (cus %d x %d)\n", grid, cus, per_cu);
    }
    if (grid < 0) return;
    if (hipMemsetAsync((char*)d_ws + WS_CTL, 0, CTL_BYTES, stream) != hipSuccess) { fprintf(stderr, "kernel_launch: memset failed\n"); return; }
    Params p{};
    for (int i = 0; i < 18; ++i) p.in[i] = (const float*)d_in[i];
    p.out = (float*)d_out; p.ws = (unsigned char*)d_ws;
#if N_LAUNCH_SPLIT
    for (int k = 0; k < NPHASE; ++k) { p.ph_lo = k; p.ph_hi = k + 1; void* args[] = {&p};
        hipError_t e = hipLaunchCooperativeKernel((const void*)fwd_mega, dim3(grid), dim3(NTHREADS), args, LDS_BYTES, stream);
        if (e != hipSuccess) { fprintf(stderr, "cooperative launch failed: %s (grid %d)\n", hipGetErrorString(e), grid); break; } }
#else
    p.ph_lo = 0; p.ph_hi = NPHASE; void* args[] = {&p};
    hipError_t e = hipLaunchCooperativeKernel((const void*)fwd_mega, dim3(grid), dim3(NTHREADS), args, LDS_BYTES, stream);
    if (e != hipSuccess) fprintf(stderr, "cooperative launch failed: %s (grid %d)\n", hipGetErrorString(e), grid);
#endif
}
```

```cpp
#include <hip/hip_runtime.h>
#include <hip/hip_cooperative_groups.h>
#include <cstdio>
#include <cstdint>
namespace cg = cooperative_groups;
#ifndef GQA_SD
#define GQA_SD 1
#endif
#ifndef MLA_SD
#define MLA_SD 1
#endif
#ifndef MLA_QREG
#define MLA_QREG 4
#endif
#ifndef REP_MASK
#define REP_MASK 0u
#endif
#ifndef ATT_NVA128
#define ATT_NVA128 5
#endif
#ifndef ATT_NVA192
#define ATT_NVA192 3
#endif
#ifndef ATT_NVB
#define ATT_NVB 1
#endif
#ifndef ATT_PREA
#define ATT_PREA 4
#endif
#ifndef ATT_PREB
#define ATT_PREB 8
#endif
#ifndef ATT_PRIO
#define ATT_PRIO 0
#endif
#ifndef ATT_KEYMASK128
#define ATT_KEYMASK128 7
#endif
#ifndef ATT_MG192
#define ATT_MG192 2
#endif
#ifndef ATT_DS192
#define ATT_DS192 2
#endif
#ifndef N_LAUNCH_SPLIT
#define N_LAUNCH_SPLIT 0
#endif
namespace pg8 {
#define PG8_LAS __attribute__((address_space(3)))
typedef unsigned short bf16_t;
typedef short bf16x8 __attribute__((ext_vector_type(8)));
typedef float f32x4 __attribute__((ext_vector_type(4)));
typedef unsigned u32x4 __attribute__((ext_vector_type(4)));
constexpr int BM = 256, BK = 64, HALF = 128, HTB = HALF * BK * 2  , STAGE_BYTES = 8 * HTB, NXCD = 8, WGM = 8;

__host__ __device__ __forceinline__ int lds_byte(int r, int c) { const int st = (r >> 4) * 2 + (c >> 5), rr = r & 15, cc = c & 31, ob = rr * 64 + cc * 2; return st * 1024 + (ob ^ (((ob >> 9) & 1) << 5)); }
__host__ __device__ __forceinline__ void stage_rc(int b, int& R, int& C) { const int st = b / 1024, sb = b % 1024, swz = sb ^ (((sb >> 9) & 1) << 5); R = (st >> 1) * 16 + swz / 64; C = (st & 1) * 32 + (swz % 64) / 2; }
__host__ __device__ __forceinline__ int perm32(int rho) { const int n = rho >> 4, i = rho & 15; return 8 * (i >> 2) + 4 * n + (i & 3); }

struct Unit { int pm, pn; };
struct Gemm { const bf16_t* A; const bf16_t* Bt; int M, N, K; };

struct StaticOrder {
    int nM, nN, nwg, G, c;
    __host__ __device__ void init(int M, int N, int G_, int c_) { nM = M / BM; nN = N / BM; nwg = nM * nN; G = G_; c = c_; }
    __host__ __device__ bool next(int i, Unit& u) const {
        const long L = (long)i * G + c; if (L >= nwg) return false;
        int wgid = (int)L; { const int q = nwg / NXCD, r = nwg % NXCD, xcd = wgid % NXCD, off = wgid / NXCD; wgid = (xcd < r ? xcd * (q + 1) : r * (q + 1) + (xcd - r) * q) + off; }
        const int nig = WGM * nN, gid = wgid / nig, fm = gid * WGM, gsz = (nM - fm) < WGM ? (nM - fm) : WGM;
        u.pm = fm + ((wgid % nig) % gsz); u.pn = (wgid % nig) / gsz; return true;
    }
    __device__ __forceinline__ void a_ready(const Unit&) const {}
    __device__ __forceinline__ void done(const Unit&) const {}
};
__device__ __forceinline__ unsigned cvt_pk_bf16(float lo, float hi) { unsigned r; asm volatile("v_cvt_pk_bf16_f32 %0, %1, %2" : "=v"(r) : "v"(lo), "v"(hi)); return r; }
template <int ACT> struct EpiBf16 {
    static constexpr bool PERM = true, AFTER_DRAIN = false;
    bf16_t* O; int ldc;
    __device__ __forceinline__ void operator()(const f32x4 (&acc)[2][2][4][2], const Unit& u, int wr, int wc, int fr, int fq) const {
        const int row0 = u.pm * BM + wr * 64 + fr; const int col0 = u.pn * BM + wc * 32 + 8 * fq;
#pragma unroll
        for (int ai = 0; ai < 2; ++ai)
#pragma unroll
            for (int m = 0; m < 4; ++m) { bf16_t* rowp = O + (size_t)(row0 + ai * HALF + m * 16) * ldc + col0;
#pragma unroll
                for (int bj = 0; bj < 2; ++bj) { f32x4 v0 = acc[ai][bj][m][0], v1 = acc[ai][bj][m][1];
                    if (ACT == 2) {
#pragma unroll
                        for (int e = 0; e < 4; ++e) { float a = v0[e] > 0.f ? v0[e] : 0.f; v0[e] = a * a; float b = v1[e] > 0.f ? v1[e] : 0.f; v1[e] = b * b; } }
                    u32x4 w; w.x = cvt_pk_bf16(v0[0], v0[1]); w.y = cvt_pk_bf16(v0[2], v0[3]); w.z = cvt_pk_bf16(v1[0], v1[1]); w.w = cvt_pk_bf16(v1[2], v1[3]);
                    *(u32x4*)(rowp + bj * HALF) = w; } }
    }
};
template <bool BASE_F32> struct EpiResB {
    static constexpr bool PERM = true, AFTER_DRAIN = false;
    const void* base; bf16_t* out; int ldc;
    __device__ __forceinline__ void operator()(const f32x4 (&acc)[2][2][4][2], const Unit& u, int wr, int wc, int fr, int fq) const {
        const int row0 = u.pm * BM + wr * 64 + fr; const int col0 = u.pn * BM + wc * 32 + 8 * fq;
#pragma unroll
        for (int ai = 0; ai < 2; ++ai)
#pragma unroll
            for (int m = 0; m < 4; ++m) { const size_t off = (size_t)(row0 + ai * HALF + m * 16) * ldc + col0;
#pragma unroll
                for (int bj = 0; bj < 2; ++bj) { const size_t o = off + bj * HALF; f32x4 b0, b1;
                    if constexpr (BASE_F32) { b0 = *(const f32x4*)((const float*)base + o); b1 = *(const f32x4*)((const float*)base + o + 4); }
                    else { const u32x4 w = *(const u32x4*)((const bf16_t*)base + o);
                        b0 = (f32x4){__uint_as_float(w.x << 16), __uint_as_float(w.x & 0xffff0000u), __uint_as_float(w.y << 16), __uint_as_float(w.y & 0xffff0000u)};
                        b1 = (f32x4){__uint_as_float(w.z << 16), __uint_as_float(w.z & 0xffff0000u), __uint_as_float(w.w << 16), __uint_as_float(w.w & 0xffff0000u)}; }
                    const f32x4 v0 = b0 + acc[ai][bj][m][0], v1 = b1 + acc[ai][bj][m][1];
                    u32x4 r; r.x = cvt_pk_bf16(v0[0], v0[1]); r.y = cvt_pk_bf16(v0[2], v0[3]); r.z = cvt_pk_bf16(v1[0], v1[1]); r.w = cvt_pk_bf16(v1[2], v1[3]);
                    *(u32x4*)(out + o) = r; }
                asm volatile("" ::: "memory"); }
    }
};
template <class Epi, class Sched, bool ALIGN_EPI = false, bool SP2 = false>
__device__ __forceinline__ void gemm_phase(PG8_LAS unsigned char* lds, const Gemm g, const Sched& S, const Epi& E) {
    const int tid = threadIdx.x, wid = __builtin_amdgcn_readfirstlane(tid >> 6), lane = tid & 63, wr = wid >> 2, wc = wid & 3, fr = lane & 15, fq = lane >> 4;
    const int K = g.K, nt = K / BK;
    unsigned voffA[2], voffB[2];
#pragma unroll
    for (int i = 0; i < 2; ++i) { int R, C; stage_rc(tid * 16 + i * 8192, R, C); const int Rb = Epi::PERM ? ((R & ~31) + perm32(R & 31)) : R;
        voffA[i] = (unsigned)(R * K + C) * 2u; voffB[i] = (unsigned)(Rb * K + C) * 2u; }
    const size_t kstep = (size_t)(BK * 2);
    const size_t hstep = (size_t)HALF * K * 2;
    const size_t tstep = 2 * hstep;
    const unsigned ldsw = (unsigned)wid * 1024u;
    const int aoff = lds_byte(wr * 64 + fr, fq * 8), boff = lds_byte(wc * 32 + fr, fq * 8);
#define PG8_SA(b, h) (((b) * 2 + (h)) * HTB)
#define PG8_SB(b, h) ((4 + (b) * 2 + (h)) * HTB)
#define PG8_STAGE(bufoff, gbase, voff) do { _Pragma("unroll") for (int _i = 0; _i < 2; ++_i) \
        __builtin_amdgcn_global_load_lds((const unsigned*)((const char*)(gbase) + (voff)[_i]), (PG8_LAS unsigned*)(lds + (bufoff) + ldsw + _i * 8192), 16, 0, 0); } while (0)
#define PG8_LDA(dst, b, h) do { _Pragma("unroll") for (int m = 0; m < 4; ++m) _Pragma("unroll") for (int k = 0; k < 2; ++k) dst[m][k] = *(const PG8_LAS bf16x8*)(lds + PG8_SA(b, h) + aoff + m * 2048 + k * 1024); } while (0)
#define PG8_LDB(dst, b, h) do { _Pragma("unroll") for (int n = 0; n < 2; ++n) _Pragma("unroll") for (int k = 0; k < 2; ++k) dst[n][k] = *(const PG8_LAS bf16x8*)(lds + PG8_SB(b, h) + boff + n * 2048 + k * 1024); } while (0)
#define PG8_MMA(ai, bj, At, Bt) do { __builtin_amdgcn_s_setprio(1); _Pragma("unroll") for (int m = 0; m < 4; ++m) _Pragma("unroll") for (int n = 0; n < 2; ++n) _Pragma("unroll") for (int k = 0; k < 2; ++k) \
        acc[ai][bj][m][n] = __builtin_amdgcn_mfma_f32_16x16x32_bf16(Bt[n][k], At[m][k], acc[ai][bj][m][n], 0, 0, 0); __builtin_amdgcn_s_setprio(0); } while (0)
#define PG8_WAIT_V(n) asm volatile("s_waitcnt vmcnt(" #n ")" ::: "memory")
#define PG8_WAIT_L(n) asm volatile("s_waitcnt lgkmcnt(" #n ")" ::: "memory")
#define PG8_BAR __builtin_amdgcn_s_barrier()
#define PG8_SCHED __builtin_amdgcn_sched_barrier(0)
    Unit cur, nxt; int ui = 0;
    if (!S.next(0, cur)) return;
    f32x4 acc[2][2][4][2];
#pragma unroll
    for (int a = 0; a < 2; ++a)
#pragma unroll
        for (int b = 0; b < 2; ++b)
#pragma unroll
            for (int m = 0; m < 4; ++m)
#pragma unroll
                for (int n = 0; n < 2; ++n) acc[a][b][m][n] = (f32x4){0.f, 0.f, 0.f, 0.f};
    bf16x8 At[4][2], B0[2][2], B1[2][2];
    const char* cA = (const char*)g.A + (size_t)cur.pm * tstep; const char* cB = (const char*)g.Bt + (size_t)cur.pn * tstep;
    S.a_ready(cur);
    if constexpr (SP2) {
        PG8_STAGE(PG8_SB(0, 0), cB, voffB); PG8_STAGE(PG8_SB(0, 1), cB + hstep, voffB); PG8_STAGE(PG8_SA(0, 0), cA, voffA); PG8_STAGE(PG8_SA(0, 1), cA + hstep, voffA);
        if (wr == 1) PG8_BAR;
        PG8_WAIT_V(2); PG8_BAR;
        PG8_STAGE(PG8_SB(1, 0), cB + kstep, voffB); PG8_STAGE(PG8_SA(1, 0), cA + kstep, voffA); PG8_STAGE(PG8_SB(1, 1), cB + hstep + kstep, voffB);
        PG8_WAIT_V(6); PG8_BAR;
    } else {
        PG8_STAGE(PG8_SB(0, 0), cB, voffB); PG8_STAGE(PG8_SA(0, 0), cA, voffA); PG8_STAGE(PG8_SB(0, 1), cB + hstep, voffB); PG8_STAGE(PG8_SA(0, 1), cA + hstep, voffA);
        if (wr == 1) PG8_BAR;
        PG8_WAIT_V(4); PG8_BAR;
        PG8_STAGE(PG8_SB(1, 0), cB + kstep, voffB); PG8_STAGE(PG8_SA(1, 0), cA + kstep, voffA); PG8_STAGE(PG8_SB(1, 1), cB + hstep + kstep, voffB);
        PG8_WAIT_V(6); PG8_BAR;
    }
    for (;;) {
        const bool has_next = S.next(ui + 1, nxt);
        const char* nA = has_next ? (const char*)g.A + (size_t)nxt.pm * tstep : cA; const char* nB = has_next ? (const char*)g.Bt + (size_t)nxt.pn * tstep : cB;
        for (int t = 0; t < nt; t += 2) {
            const bool last = (t == nt - 2);
            const char* a1 = cA + (size_t)(t + 1) * kstep;
            const char* a2 = last ? nA : cA + (size_t)(t + 2) * kstep; const char* b2 = last ? nB : cB + (size_t)(t + 2) * kstep;
            const char* a3 = a2 + kstep; const char* b3 = b2 + kstep;
            if (last && has_next) S.a_ready(nxt);
            if constexpr (SP2) {
            PG8_LDB(B0, 0, 0); PG8_LDB(B1, 0, 1); PG8_SCHED; PG8_LDA(At, 0, 0); PG8_STAGE(PG8_SA(1, 1), a1 + hstep, voffA);
            PG8_WAIT_V(8); PG8_WAIT_L(0); PG8_BAR; PG8_MMA(0, 0, At, B0); PG8_MMA(0, 1, At, B1); PG8_BAR; PG8_SCHED;
            PG8_LDA(At, 0, 1); PG8_STAGE(PG8_SB(0, 0), b2, voffB); PG8_STAGE(PG8_SB(0, 1), b2 + hstep, voffB); PG8_STAGE(PG8_SA(0, 0), a2, voffA);
            PG8_WAIT_V(8); PG8_WAIT_L(0); PG8_BAR; PG8_MMA(1, 0, At, B0); PG8_MMA(1, 1, At, B1); PG8_BAR; PG8_SCHED;
            PG8_LDB(B0, 1, 0); PG8_LDB(B1, 1, 1); PG8_SCHED; PG8_LDA(At, 1, 0); PG8_STAGE(PG8_SA(0, 1), a2 + hstep, voffA);
            PG8_WAIT_V(8); PG8_WAIT_L(0); PG8_BAR; PG8_MMA(0, 0, At, B0); PG8_MMA(0, 1, At, B1); PG8_BAR; PG8_SCHED;
            PG8_LDA(At, 1, 1); PG8_STAGE(PG8_SB(1, 0), b3, voffB); PG8_STAGE(PG8_SB(1, 1), b3 + hstep, voffB); PG8_STAGE(PG8_SA(1, 0), a3, voffA);
            PG8_WAIT_V(8); PG8_WAIT_L(0); PG8_BAR; PG8_MMA(1, 0, At, B0); PG8_MMA(1, 1, At, B1); PG8_BAR; PG8_SCHED;
            } else {
            PG8_LDB(B0, 0, 0); PG8_SCHED; PG8_LDA(At, 0, 0); PG8_STAGE(PG8_SA(1, 1), a1 + hstep, voffA);
            PG8_WAIT_L(8); PG8_BAR; PG8_WAIT_L(0); PG8_MMA(0, 0, At, B0); PG8_BAR; PG8_SCHED;
            PG8_LDB(B1, 0, 1); PG8_STAGE(PG8_SB(0, 0), b2, voffB);
            PG8_BAR; PG8_WAIT_L(0); PG8_MMA(0, 1, At, B1); PG8_BAR;
            PG8_LDA(At, 0, 1); PG8_STAGE(PG8_SA(0, 0), a2, voffA);
            PG8_BAR; PG8_WAIT_L(0); PG8_MMA(1, 0, At, B0); PG8_BAR; PG8_SCHED;
            PG8_STAGE(PG8_SB(0, 1), b2 + hstep, voffB);
            PG8_WAIT_V(6); PG8_BAR; PG8_MMA(1, 1, At, B1); PG8_BAR;
            PG8_LDB(B0, 1, 0); PG8_SCHED; PG8_LDA(At, 1, 0); PG8_STAGE(PG8_SA(0, 1), a2 + hstep, voffA);
            PG8_WAIT_L(8); PG8_BAR; PG8_WAIT_L(0); PG8_MMA(0, 0, At, B0); PG8_BAR; PG8_SCHED;
            PG8_LDB(B1, 1, 1); PG8_STAGE(PG8_SB(1, 0), b3, voffB);
            PG8_BAR; PG8_WAIT_L(0); PG8_MMA(0, 1, At, B1); PG8_BAR;
            PG8_LDA(At, 1, 1); PG8_STAGE(PG8_SA(1, 0), a3, voffA);
            PG8_BAR; PG8_WAIT_L(0); PG8_MMA(1, 0, At, B0); PG8_BAR; PG8_SCHED;
            PG8_STAGE(PG8_SB(1, 1), b3 + hstep, voffB);
            PG8_WAIT_V(6); PG8_BAR; PG8_MMA(1, 1, At, B1); PG8_BAR;
            }
        }
        if constexpr (ALIGN_EPI) { if (wr == 0) PG8_BAR; }
        if constexpr (!Epi::AFTER_DRAIN) { E(acc, cur, wr, wc, fr, fq); S.done(cur); }
        if (!has_next) break;
#pragma unroll
        for (int a = 0; a < 2; ++a)
#pragma unroll
            for (int b = 0; b < 2; ++b)
#pragma unroll
                for (int m = 0; m < 4; ++m)
#pragma unroll
                    for (int n = 0; n < 2; ++n) acc[a][b][m][n] = (f32x4){0.f, 0.f, 0.f, 0.f};
        cur = nxt; cA = nA; cB = nB; ++ui;
        if constexpr (ALIGN_EPI) { if (wr == 1) PG8_BAR; }
    }
    PG8_WAIT_V(0);
    if constexpr (!ALIGN_EPI) { if (wr == 0) PG8_BAR; }
    PG8_BAR;
    if constexpr (Epi::AFTER_DRAIN) { E.fused(acc, cur, wr, wc, fr, fq, lds, wid, lane); S.done(cur); }
#undef PG8_SA
#undef PG8_SB
#undef PG8_STAGE
#undef PG8_LDA
#undef PG8_LDB
#undef PG8_MMA
#undef PG8_WAIT_V
#undef PG8_WAIT_L
#undef PG8_BAR
#undef PG8_SCHED
}
}
namespace att {
typedef unsigned short bf16;
using bf16x8 = __attribute__((ext_vector_type(8))) short;
using s16x4  = __attribute__((ext_vector_type(4))) short;
using f32x16 = __attribute__((ext_vector_type(16))) float;
using u32x4  = __attribute__((ext_vector_type(4))) unsigned;
constexpr int NW = 8, QBLK = 32, KVBLK = 64;
constexpr float THR = 8.f;
#define ATT_SBAR() __builtin_amdgcn_sched_barrier(0)
__device__ __forceinline__ int crow(int r, int hi) { return (r & 3) + 8 * (r >> 2) + 4 * hi; }
typedef float f32x2_t __attribute__((ext_vector_type(2))); typedef __bf16 bf16x2_t __attribute__((ext_vector_type(2)));
__device__ __forceinline__ unsigned cvtpk(float lo, float hi) { f32x2_t v = {lo, hi}; bf16x2_t b = __builtin_convertvector(v, bf16x2_t); return __builtin_bit_cast(unsigned, b); }
typedef short v4i16_t __attribute__((ext_vector_type(4)));
typedef __attribute__((address_space(3))) const char* lds_cptr;
__device__ __forceinline__ s16x4 vtr(lds_cptr p) { return __builtin_bit_cast(s16x4, __builtin_amdgcn_ds_read_tr16_b64_v4i16((__attribute__((address_space(3))) v4i16_t*)p)); }
__device__ __forceinline__ bf16x8 ld8(const bf16* p) { return *reinterpret_cast<const bf16x8*>(p); }

template <int DQK> struct Cfg {
  static constexpr float SCALE = (DQK == 128) ? 0.088388347648318440f : 0.072168783648703220f;
  static constexpr float C = SCALE * 1.4426950408889634f;
  static constexpr int KROWB = DQK * 2, SHM_K = KVBLK * KROWB, SHM_V = KVBLK * 128 * 2, ND0 = DQK / 16;
  static constexpr int QREG = (DQK > 128) ? MLA_QREG : 8;
  static constexpr int QXW = (ND0 - QREG) * 1024, SHM_QX = NW * QXW;
  static constexpr int SHM_TOTAL = 2 * SHM_V + 2 * SHM_K + NW * 64 * 4 + SHM_QX;
};

constexpr float TRIG = 65536.f;
__device__ __forceinline__ void firstSM(f32x16& p0, f32x16& p1, float& m_ref, f32x16& negm) {
  float pmax = p0[0];
#pragma unroll
  for (int r = 1; r < 16; ++r) pmax = fmaxf(pmax, p0[r]);
#pragma unroll
  for (int r = 0; r < 16; ++r) pmax = fmaxf(pmax, p1[r]);
  { auto rr = __builtin_amdgcn_permlane32_swap(__float_as_uint(pmax), __float_as_uint(pmax), false, false);
    pmax = fmaxf(__uint_as_float(rr[0]), __uint_as_float(rr[1])); }
  m_ref = pmax;
#pragma unroll
  for (int r = 0; r < 16; ++r) { p0[r] -= pmax; p1[r] -= pmax; negm[r] = -pmax; }
#pragma unroll
  for (int r = 0; r < 16; ++r) p0[r] = __builtin_amdgcn_exp2f(p0[r]);
  asm volatile("" : "+v"(p0), "+v"(p1), "+v"(negm));
}
__device__ __forceinline__ void partialSM(f32x16& p0, f32x16& p1) {
#pragma unroll
  for (int r = 0; r < 16; ++r) p0[r] = __builtin_amdgcn_exp2f(p0[r]);
  asm volatile("" : "+v"(p0), "+v"(p1));
}
__device__ __forceinline__ void finishSM(f32x16& p0, f32x16& p1, float& ps, float& l_reg, bf16x8& pa0, bf16x8& pa1, bf16x8& pa2, bf16x8& pa3) {
#pragma unroll
  for (int r = 0; r < 16; ++r) p1[r] = __builtin_amdgcn_exp2f(p1[r]);
  float s0 = 0, s1 = 0;
#pragma unroll
  for (int r = 0; r < 16; ++r) s0 += p0[r];
#pragma unroll
  for (int r = 0; r < 16; ++r) s1 += p1[r];
  ps = s0 + s1;
  { auto rr = __builtin_amdgcn_permlane32_swap(__float_as_uint(ps), __float_as_uint(ps), false, false);
    ps = __uint_as_float(rr[0]) + __uint_as_float(rr[1]); }
  l_reg += ps;
#define ATT_PK4(P, BASE, OUT) do { unsigned a0 = cvtpk(P[BASE + 0], P[BASE + 1]), a1 = cvtpk(P[BASE + 2], P[BASE + 3]);   \
    unsigned b0 = cvtpk(P[BASE + 4], P[BASE + 5]), b1 = cvtpk(P[BASE + 6], P[BASE + 7]);                              \
    auto r0 = __builtin_amdgcn_permlane32_swap(a0, b0, false, false); auto r1 = __builtin_amdgcn_permlane32_swap(a1, b1, false, false); \
    u32x4 w = {r0[0], r1[0], r0[1], r1[1]}; OUT = *reinterpret_cast<bf16x8*>(&w); } while (0)
  ATT_PK4(p0, 0, pa0); ATT_PK4(p0, 8, pa1); ATT_PK4(p1, 0, pa2); ATT_PK4(p1, 8, pa3);
#undef ATT_PK4
}
#define ATT_KEY(row) ((KROWB == 256) ? ((row) & ATT_KEYMASK128) : (((row) >> 1) & 7))
#define ATT_KSWZ(row, colB) ((row) * KROWB + ((colB) ^ (ATT_KEY(row) << 4)))
template <int DQK> __device__ __forceinline__ void qkt(f32x16& p0, f32x16& p1, const f32x16& negm, const char* Ks, const int* kb, const bf16x8* qr, const char* qx, int r32, int hi) {
  constexpr int KROWB = Cfg<DQK>::KROWB, ND0 = Cfg<DQK>::ND0, QREG = Cfg<DQK>::QREG;
  p0 = negm; p1 = negm;
  constexpr int NB = (KROWB == 256 && ATT_KEYMASK128 == 15) ? 8 : 4;
#pragma unroll
  for (int d0 = 0; d0 < ND0; ++d0) {
    bf16x8 b0 = *reinterpret_cast<const bf16x8*>(Ks + kb[d0 % NB] + (d0 / NB) * (NB * 32));
    bf16x8 b1 = *reinterpret_cast<const bf16x8*>(Ks + kb[d0 % NB] + (d0 / NB) * (NB * 32) + 32 * KROWB);
    bf16x8 q; if (d0 < QREG) q = qr[d0]; else q = *reinterpret_cast<const bf16x8*>(qx + (d0 - QREG) * 1024);
    p0 = __builtin_amdgcn_mfma_f32_32x32x16_bf16(b0, q, p0, 0, 0, 0);
    p1 = __builtin_amdgcn_mfma_f32_32x32x16_bf16(b1, q, p1, 0, 0, 0); }
}
__device__ __forceinline__ int v_st(int k, int c) { const int kk = (k & ~0xC) | ((k & 4) << 1) | ((k & 8) >> 1); return ((kk >> 3) * 4 + (c >> 5)) * 512 + ((kk & 7) * 32 + (c & 31)) * 2; }
__device__ __forceinline__ int v_rd_base(int lane) { return ((lane & 3) << 3) | (((lane >> 2) & 3) << 6) | (((lane >> 4) & 1) << 5) | (((lane >> 5) & 1) << 8); }
constexpr int v_rd_off(int d0, int ks, int half) { return d0 * 512 + ks * 4096 + half * 2048; }
template <int OFF> __device__ __forceinline__ s16x4 tr_read(int vb) {
  s16x4 r; asm volatile("ds_read_b64_tr_b16 %0, %1 offset:%2" : "=&v"(r) : "v"(vb), "i"(OFF) : "memory"); return r;
}
#define ATT_PK(L, H) (bf16x8){L[0], L[1], L[2], L[3], H[0], H[1], H[2], H[3]}
template <int D0> __device__ __forceinline__ void pv_one(f32x16& od, lds_cptr vp, bf16x8 pa0, bf16x8 pa1, bf16x8 pa2, bf16x8 pa3) {
  const s16x4 l0 = vtr(vp + v_rd_off(D0, 0, 0)), h0 = vtr(vp + v_rd_off(D0, 0, 1)), l1 = vtr(vp + v_rd_off(D0, 1, 0)), h1 = vtr(vp + v_rd_off(D0, 1, 1));
  const s16x4 l2 = vtr(vp + v_rd_off(D0, 2, 0)), h2 = vtr(vp + v_rd_off(D0, 2, 1)), l3 = vtr(vp + v_rd_off(D0, 3, 0)), h3 = vtr(vp + v_rd_off(D0, 3, 1));
  od = __builtin_amdgcn_mfma_f32_32x32x16_bf16(pa0, ATT_PK(l0, h0), od, 0, 0, 0);
  od = __builtin_amdgcn_mfma_f32_32x32x16_bf16(pa1, ATT_PK(l1, h1), od, 0, 0, 0);
  od = __builtin_amdgcn_mfma_f32_32x32x16_bf16(pa2, ATT_PK(l2, h2), od, 0, 0, 0);
  od = __builtin_amdgcn_mfma_f32_32x32x16_bf16(pa3, ATT_PK(l3, h3), od, 0, 0, 0);
}
__device__ __forceinline__ void pv_d0(f32x16* o, lds_cptr vp, bf16x8 pa0, bf16x8 pa1, bf16x8 pa2, bf16x8 pa3) {
  pv_one<0>(o[0], vp, pa0, pa1, pa2, pa3); pv_one<1>(o[1], vp, pa0, pa1, pa2, pa3); pv_one<2>(o[2], vp, pa0, pa1, pa2, pa3); pv_one<3>(o[3], vp, pa0, pa1, pa2, pa3);
}
template <int NGRP, int MG, int NVALU, int NDS, int NPRE> __device__ __forceinline__ void sched_pipe() {
  __builtin_amdgcn_sched_group_barrier(0x100, NPRE, 0);
#pragma unroll
  for (int i = 0; i < NGRP; ++i) { __builtin_amdgcn_sched_group_barrier(0x008, MG, 0); __builtin_amdgcn_sched_group_barrier(0x002, NVALU, 0); __builtin_amdgcn_sched_group_barrier(0x100, NDS, 0); }
}

template <int DQK, int LDQ, int LDK, int LDV, int LDO, int SD>
__device__ __forceinline__ void attn_unit(const bf16* __restrict__ Qb, const bf16* __restrict__ Kh, const bf16* __restrict__ Kr, const bf16* __restrict__ Vh,
                                          bf16* __restrict__ Ob, int seq, char* lds) {
  constexpr int KROWB = Cfg<DQK>::KROWB, SHM_K = Cfg<DQK>::SHM_K, SHM_V = Cfg<DQK>::SHM_V, ND0 = Cfg<DQK>::ND0;
  const int tid = threadIdx.x, wid = tid >> 6, lane = tid & 63, r32 = lane & 31, hi = lane >> 5;
  char* V_lds = lds; char* K_lds = lds + 2 * SHM_V;
  float* ws = (float*)(lds + 2 * SHM_V + 2 * SHM_K) + wid * 64; float* li_l = ws; float* al_l = ws + 32;
  float m_ref = 0.f, l_reg = 0; f32x16 o[4] = {}; f32x16 negm = {}; constexpr int QREG = Cfg<DQK>::QREG; bf16x8 qr[QREG];
  const bf16* Qw = Qb + (long)(wid * QBLK + r32) * LDQ + hi * 8;
  char* qx = lds + 2 * SHM_V + 2 * SHM_K + NW * 64 * 4 + wid * Cfg<DQK>::QXW + lane * 16;
#pragma unroll
  for (int d0 = 0; d0 < QREG; ++d0) qr[d0] = ld8(Qw + d0 * 16);
  if constexpr (QREG < ND0) {
#pragma unroll
    for (int d0 = QREG; d0 < ND0; ++d0) *(bf16x8*)(qx + (d0 - QREG) * 1024) = ld8(Qw + d0 * 16);
  }
  const int sr = tid >> 4, sc = (tid & 15) * 8, vst0 = v_st(sr, sc), vst1 = v_st(32 + sr, sc);
  const int krr = tid >> 3, krc = (tid & 7) * 8;
  const lds_cptr vb0 = (lds_cptr)V_lds + v_rd_base(lane);
  constexpr int NB = (KROWB == 256 && ATT_KEYMASK128 == 15) ? 8 : 4; int kb[NB];
#pragma unroll
  for (int dl = 0; dl < NB; ++dl) kb[dl] = r32 * KROWB + ((dl * 32 + hi * 16) ^ (ATT_KEY(r32) << 4));
  const unsigned boV = (unsigned)(sr * LDV + sc) * 2u, boK = (unsigned)(sr * LDK + sc) * 2u, boR = (unsigned)(krr * 64 + krc) * 2u;
  struct { bf16x8 vs0, vs1, ks0, ks1, kr; } sr_[SD];
#define SLOAD(i, k0) do { const char* vt_ = (const char*)(Vh + (long)(k0) * LDV); const char* kt_ = (const char*)(Kh + (long)(k0) * LDK); \
    sr_[i].vs0 = *(const bf16x8*)(vt_ + boV); sr_[i].vs1 = *(const bf16x8*)(vt_ + 32 * LDV * 2 + boV); \
    sr_[i].ks0 = *(const bf16x8*)(kt_ + boK); sr_[i].ks1 = *(const bf16x8*)(kt_ + 32 * LDK * 2 + boK); \
    if constexpr (DQK == 192) { const char* rt_ = (const char*)(Kr + (long)(k0) * 64); sr_[i].kr = *(const bf16x8*)(rt_ + boR); } } while (0)
#define SWRITE(b, i) do { *(bf16x8*)(V_lds + (b) * SHM_V + vst0) = sr_[i].vs0;          \
    *(bf16x8*)(V_lds + (b) * SHM_V + vst1) = sr_[i].vs1; int kc = sc * 2;               \
    *(bf16x8*)(K_lds + (b) * SHM_K + ATT_KSWZ(sr, kc)) = sr_[i].ks0;                       \
    *(bf16x8*)(K_lds + (b) * SHM_K + ATT_KSWZ(32 + sr, kc)) = sr_[i].ks1;                  \
    if constexpr (DQK == 192) *(bf16x8*)(K_lds + (b) * SHM_K + ATT_KSWZ(krr, 256 + krc * 2)) = sr_[i].kr; } while (0)
#define SWAIT() do { if constexpr (SD == 2) { if constexpr (DQK == 192) asm volatile("s_waitcnt vmcnt(5)" ::: "memory"); else asm volatile("s_waitcnt vmcnt(4)" ::: "memory"); } \
    else asm volatile("s_waitcnt vmcnt(0)" ::: "memory"); } while (0)
#define RESC_APPLY() do { l_reg *= alp; if (hi == 0) al_l[r32] = alp; asm volatile("s_waitcnt lgkmcnt(0)" ::: "memory"); \
    _Pragma("unroll") for (int d = 0; d < 4; ++d) _Pragma("unroll") for (int r = 0; r < 16; ++r) o[d][r] *= al_l[crow(r, hi)]; pend = false; } while (0)
#define RESCN(ps_) do { if (pend) { RESC_APPLY(); } else { const bool t_ = (ps_) > TRIG; const float d_ = t_ ? __builtin_amdgcn_logf(ps_) : 0.f; alp = __builtin_amdgcn_exp2f(-d_); m_ref += d_; pend = __any(t_); } \
    _Pragma("unroll") for (int r = 0; r < 16; ++r) negm[r] = -m_ref; } while (0)
  float alp = 1.f; bool pend = false;
  f32x16 pA0, pA1, pB0, pB1; float psA, psB; bf16x8 pa0, pa1, pa2, pa3; const int NT = seq / KVBLK;
  constexpr int SE = 0, SO = SD - 1;
  SLOAD(SE, 0); asm volatile("s_waitcnt vmcnt(0)" ::: "memory"); SWRITE(0, SE); __syncthreads();
  qkt<DQK>(pA0, pA1, negm, K_lds, kb, qr, qx, r32, hi); firstSM(pA0, pA1, m_ref, negm);
  SLOAD(SO, KVBLK); if constexpr (SD == 2) { if (2 < NT) SLOAD(SE, 2 * KVBLK); }
  SWAIT(); SWRITE(1, SO); __syncthreads();
#define SCHED_A() do { if constexpr (DQK == 128) sched_pipe<16, 1, ATT_NVA128, 1, ATT_PREA>(); else sched_pipe<24 / ATT_MG192, ATT_MG192, ATT_NVA192 * ATT_MG192, ATT_DS192, ATT_PREA>(); } while (0)
#define SCHED_B() sched_pipe<16, 1, ATT_NVB, 2, ATT_PREB>()
  for (int j = 1; j + 1 < NT; j += 2) {
    ATT_SBAR(); qkt<DQK>(pB0, pB1, negm, K_lds + SHM_K, kb, qr, qx, r32, hi);
    finishSM(pA0, pA1, psA, l_reg, pa0, pa1, pa2, pa3); SCHED_A(); ATT_SBAR();
    SLOAD(SO, (j + SD) * KVBLK); ATT_SBAR();
    pv_d0(o, vb0, pa0, pa1, pa2, pa3); partialSM(pB0, pB1); SCHED_B(); ATT_SBAR();
    __syncthreads(); SWAIT(); SWRITE(0, SE);
    RESCN(psA); __syncthreads();
    ATT_SBAR(); qkt<DQK>(pA0, pA1, negm, K_lds, kb, qr, qx, r32, hi);
    finishSM(pB0, pB1, psB, l_reg, pa0, pa1, pa2, pa3); SCHED_A(); ATT_SBAR();
    if (SD == 1 || j + 3 < NT) SLOAD(SE, (j + 1 + SD) * KVBLK); ATT_SBAR();
    pv_d0(o, vb0 + SHM_V, pa0, pa1, pa2, pa3); partialSM(pA0, pA1); SCHED_B(); ATT_SBAR();
    __syncthreads(); SWAIT(); SWRITE(1, SO);
    RESCN(psB); __syncthreads();
  }
  ATT_SBAR(); qkt<DQK>(pB0, pB1, negm, K_lds + SHM_K, kb, qr, qx, r32, hi);
  finishSM(pA0, pA1, psA, l_reg, pa0, pa1, pa2, pa3); ATT_SBAR();
  pv_d0(o, vb0, pa0, pa1, pa2, pa3); partialSM(pB0, pB1);
  __syncthreads(); if (pend) { RESC_APPLY(); }
  finishSM(pB0, pB1, psB, l_reg, pa0, pa1, pa2, pa3); ATT_SBAR();
  pv_d0(o, vb0 + SHM_V, pa0, pa1, pa2, pa3);
#undef SCHED_A
#undef SCHED_B
  if (hi == 0) li_l[r32] = l_reg; asm volatile("s_waitcnt lgkmcnt(0)" ::: "memory");
  float rli[16];
#pragma unroll
  for (int r = 0; r < 16; ++r) rli[r] = __builtin_amdgcn_rcpf(li_l[crow(r, hi)]);
  { int r32e = r32, hie = hi; asm volatile("" : "+v"(r32e), "+v"(hie));
    char* Ow = (char*)(Ob + (long)(wid * QBLK) * LDO);
    const unsigned lo_ = (unsigned)(((r32e >> 5) + 4 * hie) * LDO + (r32e & 31)) * 2u;
#pragma unroll
    for (int r = 0; r < 16; ++r) {
#pragma unroll
      for (int d0 = 0; d0 < 4; ++d0) *(bf16*)(Ow + lo_ + (unsigned)((((r & 3) + 8 * (r >> 2)) * LDO + d0 * 32) * 2)) = (bf16)(cvtpk(o[d0][r] * rli[r], 0.f) & 0xffffu); } }
  asm volatile("s_waitcnt vmcnt(0) lgkmcnt(0)" ::: "memory"); __syncthreads();
#undef SLOAD
#undef SWRITE
#undef SWAIT
#undef RESCN
#undef RESC_APPLY
}
#undef ATT_KSWZ
#undef ATT_KEY
#undef ATT_PK
#undef ATT_SBAR
}
#define LAS __attribute__((address_space(3)))
typedef unsigned short u16;
typedef float f32x4 __attribute__((ext_vector_type(4)));
typedef short bf16x8 __attribute__((ext_vector_type(8)));
typedef unsigned u32x4 __attribute__((ext_vector_type(4)));
typedef unsigned u32x2 __attribute__((ext_vector_type(2)));
constexpr int DM = 2048, BATCH = 2, SEQ = 16384, T = BATCH * SEQ;
constexpr int IN0 = 4608, NLAT = 1088, NLATP = 1280, NQ = 3072, NKV = 4096, DFF = 8192;
constexpr float EPS = 1e-6f;
constexpr int NWAVES = 8, NTHREADS = 512;
constexpr int LDS_BYTES = 155648;
constexpr float LOG2_THETA = 13.287712379549449f;

constexpr size_t MiB = 1u << 20;
constexpr size_t WS_WIN = 0, WS_WOUT = 18 * MiB, WS_WDOWN = 26 * MiB, WS_WUQ = 31 * MiB, WS_WUKV = 34 * MiB, WS_WO = 38 * MiB;
constexpr size_t WS_WUP = 46 * MiB  , WS_WDN = 110 * MiB  ;
constexpr size_t WS_XN = 176 * MiB;
constexpr size_t WS_HB = 304 * MiB;
constexpr size_t WS_BIG = 432 * MiB;
constexpr size_t WS_PROJ = WS_BIG, WS_MIX = WS_BIG + 288 * MiB;
constexpr size_t WS_HID = WS_BIG;
constexpr size_t WS_LAT = WS_BIG;
constexpr size_t WS_Q = WS_BIG, WS_KV = WS_BIG + 192 * MiB, WS_CQN = WS_BIG + 448 * MiB, WS_CKVN = WS_BIG + 480 * MiB, WS_KROPE = WS_BIG + 512 * MiB;
constexpr size_t WS_AO = WS_XN;
constexpr size_t WS_CTL = WS_BIG + 516 * MiB, CTL_BYTES = 65536;
constexpr size_t WS_END = WS_CTL + CTL_BYTES;

__device__ __forceinline__ float bflo(unsigned u) { return __uint_as_float(u << 16); }
__device__ __forceinline__ float bfhi(unsigned u) { return __uint_as_float(u & 0xffff0000u); }
__device__ __forceinline__ unsigned pk2(float lo, float hi) { unsigned r; asm volatile("v_cvt_pk_bf16_f32 %0, %1, %2" : "=v"(r) : "v"(lo), "v"(hi)); return r; }
__device__ __forceinline__ float wave_sum(float v) {
#pragma unroll
    for (int o = 1; o < 64; o <<= 1) v += __shfl_xor(v, o);
    return v;
}
__device__ __forceinline__ void rope_cs(float pos, float invf, float& c, float& s) {
    const float a = pos * invf;
    double rev = (double)a * 0.15915494309189535;
    rev -= __builtin_rint(rev);
    const float fr = (float)rev;
    c = __builtin_amdgcn_cosf(fr); s = __builtin_amdgcn_sinf(fr);
}

__device__ __forceinline__ void transpose_item(const float* __restrict__ W, const float* __restrict__ gain, float mul, int K, int N, u16* __restrict__ WT, LAS float* scr, int item, int lane) {
    const int nblk = N / 32, kb = item / nblk, nb = item % nblk, k0 = 64 * kb, n0 = 32 * nb;
#pragma unroll 8
    for (int i = 0; i < 32; ++i) { const int kk = 2 * i + (lane >> 5); float w = W[(size_t)(k0 + kk) * N + n0 + (lane & 31)]; if (gain) w *= gain[k0 + kk] * mul; scr[kk * 33 + (lane & 31)] = w; }
    asm volatile("s_waitcnt lgkmcnt(0)" ::: "memory");
    const int c = lane & 7;
#pragma unroll
    for (int j = 0; j < 4; ++j) { const int n = (lane >> 3) + 8 * j; const LAS float* s = scr + (8 * c) * 33 + n;
        u32x4 o; o.x = pk2(s[0 * 33], s[1 * 33]); o.y = pk2(s[2 * 33], s[3 * 33]); o.z = pk2(s[4 * 33], s[5 * 33]); o.w = pk2(s[6 * 33], s[7 * 33]);
        *(u32x4*)(WT + (size_t)(n0 + n) * K + k0 + 8 * c) = o; }
    asm volatile("s_waitcnt lgkmcnt(0)" ::: "memory");
}

__device__ __forceinline__ void norm_row_bf16(const float* __restrict__ xrow, u16* __restrict__ orow, int lane) {
    const f32x4* xr = (const f32x4*)xrow + lane;
    f32x4 v[8]; float s = 0.f;
#pragma unroll
    for (int j = 0; j < 8; ++j) { v[j] = xr[64 * j]; s += (v[j].x * v[j].x + v[j].y * v[j].y) + (v[j].z * v[j].z + v[j].w * v[j].w); }
    const float r = 1.0f / sqrtf(wave_sum(s) * (1.f / DM) + EPS);
    u32x2* o8 = (u32x2*)orow + lane;
#pragma unroll
    for (int j = 0; j < 8; ++j) { u32x2 w; w.x = pk2(v[j].x * r, v[j].y * r); w.y = pk2(v[j].z * r, v[j].w * r); o8[64 * j] = w; }
}
__device__ __forceinline__ void norm_row_b2b(const u16* __restrict__ hrow, u16* __restrict__ orow, int lane) {
    const u32x4* xr = (const u32x4*)hrow + lane;
    u32x4 w[4]; float s = 0.f;
#pragma unroll
    for (int j = 0; j < 4; ++j) { w[j] = xr[64 * j];
#pragma unroll
        for (int e = 0; e < 4; ++e) { const float a = bflo(w[j][e]), b = bfhi(w[j][e]); s += a * a + b * b; } }
    const float r = 1.0f / sqrtf(wave_sum(s) * (1.f / DM) + EPS);
    u32x4* o = (u32x4*)orow + lane;
#pragma unroll
    for (int j = 0; j < 4; ++j) { u32x4 v;
#pragma unroll
        for (int e = 0; e < 4; ++e) v[e] = pk2(bflo(w[j][e]) * r, bfhi(w[j][e]) * r);
        o[64 * j] = v; }
}
__device__ __forceinline__ void norm_row_final(const u16* __restrict__ hrow, float* __restrict__ orow, const float* __restrict__ g, int lane) {
    const u32x4* xr = (const u32x4*)hrow + lane;
    u32x4 w[4]; float s = 0.f;
#pragma unroll
    for (int j = 0; j < 4; ++j) { w[j] = xr[64 * j];
#pragma unroll
        for (int e = 0; e < 4; ++e) { const float a = bflo(w[j][e]), b = bfhi(w[j][e]); s += a * a + b * b; } }
    const float r = 1.0f / sqrtf(wave_sum(s) * (1.f / DM) + EPS);
#pragma unroll
    for (int j = 0; j < 4; ++j) { const int c = (64 * j + lane) * 8; const f32x4 g0 = *(const f32x4*)(g + c), g1 = *(const f32x4*)(g + c + 4);
        f32x4 o0 = {bflo(w[j][0]) * r * g0[0], bfhi(w[j][0]) * r * g0[1], bflo(w[j][1]) * r * g0[2], bfhi(w[j][1]) * r * g0[3]};
        f32x4 o1 = {bflo(w[j][2]) * r * g1[0], bfhi(w[j][2]) * r * g1[1], bflo(w[j][3]) * r * g1[2], bfhi(w[j][3]) * r * g1[3]};
        *(f32x4*)(orow + c) = o0; *(f32x4*)(orow + c + 4) = o1; }
}

__device__ __forceinline__ void ld8f(const u16* p, float* f) {
    const u32x4 w = *(const u32x4*)p;
    f[0] = bflo(w.x); f[1] = bfhi(w.x); f[2] = bflo(w.y); f[3] = bfhi(w.y); f[4] = bflo(w.z); f[5] = bfhi(w.z); f[6] = bflo(w.w); f[7] = bfhi(w.w);
}

__device__ __forceinline__ void ew0_token(int t, u16* __restrict__ PROJ, u16* __restrict__ MIX, const float* __restrict__ qg, const float* __restrict__ kg, const float* __restrict__ cw, int lane) {
    const int s = t & (SEQ - 1), row = s >> 6, col = s & 63;
    float c, sn; { const int j = lane & 31; const float invf = __builtin_amdgcn_exp2f(-(float)j * (LOG2_THETA / 32.f)); rope_cs((float)(lane < 32 ? row : col), invf, c, sn); }
    unsigned* pr = (unsigned*)(PROJ + (size_t)t * IN0);
    const float qg0 = qg[2 * lane], qg1 = qg[2 * lane + 1], kg0 = kg[2 * lane], kg1 = kg[2 * lane + 1];
#pragma unroll
    for (int h = 0; h < 10; ++h) {
        const unsigned u = pr[h * 64 + lane]; const float x1 = bflo(u), x2 = bfhi(u);
        const float ss = wave_sum(x1 * x1 + x2 * x2); const float r = 1.0f / sqrtf(ss * (1.f / 128.f) + EPS);
        const float y1 = x1 * r * (h < 8 ? qg0 * att::Cfg<128>::C : kg0), y2 = x2 * r * (h < 8 ? qg1 * att::Cfg<128>::C : kg1);
        pr[h * 64 + lane] = pk2(y1 * c - y2 * sn, y1 * sn + y2 * c);
    }
    const u16* p0 = PROJ + (size_t)t * IN0;
#pragma unroll
    for (int ch = 0; ch < 2; ++ch) {
        const int cc = ch * 512 + lane * 8;
        float gb[8], g0[8], u0[8], gm[8], um[8], gp[8], up[8];
        ld8f(p0 + 1536 + cc, gb); ld8f(p0 + 2560 + cc, g0); ld8f(p0 + 3584 + cc, u0);
        if (s > 0) { ld8f(p0 - IN0 + 2560 + cc, gm); ld8f(p0 - IN0 + 3584 + cc, um); } else {
#pragma unroll
            for (int e = 0; e < 8; ++e) { gm[e] = 0.f; um[e] = 0.f; } }
        if (s < SEQ - 1) { ld8f(p0 + IN0 + 2560 + cc, gp); ld8f(p0 + IN0 + 3584 + cc, up); } else {
#pragma unroll
            for (int e = 0; e < 8; ++e) { gp[e] = 0.f; up[e] = 0.f; } }
        float o[8];
#pragma unroll
        for (int e = 0; e < 8; ++e) o[e] = gb[e] * (cw[cc + e] * (gm[e] * um[e]) + cw[1024 + cc + e] * (g0[e] * u0[e]) + cw[2048 + cc + e] * (gp[e] * up[e]));
        u32x4 w; w.x = pk2(o[0], o[1]); w.y = pk2(o[2], o[3]); w.z = pk2(o[4], o[5]); w.w = pk2(o[6], o[7]);
        *(u32x4*)(MIX + (size_t)t * DM + 1024 + cc) = w;
    }
}
__device__ __forceinline__ void ew1_token(int t, const u16* __restrict__ LAT, u16* __restrict__ CQN, u16* __restrict__ CKVN, u16* __restrict__ KROPE, int lane) {
    const u16* p0 = LAT + (size_t)t * NLATP;
#pragma unroll
    for (int part = 0; part < 2; ++part) {
        float x[8]; ld8f(p0 + part * 512 + lane * 8, x);
        float ss = 0.f;
#pragma unroll
        for (int e = 0; e < 8; ++e) ss += x[e] * x[e];
        const float r = 1.0f / sqrtf(wave_sum(ss) * (1.f / 512.f) + EPS);
        u32x4 w; w.x = pk2(x[0] * r, x[1] * r); w.y = pk2(x[2] * r, x[3] * r); w.z = pk2(x[4] * r, x[5] * r); w.w = pk2(x[6] * r, x[7] * r);
        *(u32x4*)((part ? CKVN : CQN) + (size_t)t * 512 + lane * 8) = w;
    }
    if (lane < 32) {
        const int s = t & (SEQ - 1), row = s >> 6, col = s & 63; const int j = lane & 15;
        const float invf = __builtin_amdgcn_exp2f(-(float)j * (LOG2_THETA / 16.f)); float c, sn; rope_cs((float)(lane < 16 ? row : col), invf, c, sn);
        const unsigned u = *(const unsigned*)(p0 + 1024 + 2 * lane); const float x1 = bflo(u), x2 = bfhi(u);
        *(unsigned*)(KROPE + (size_t)t * 64 + 2 * lane) = pk2(x1 * c - x2 * sn, x1 * sn + x2 * c);
    }
}
__device__ __forceinline__ void ew2_token(int t, u16* __restrict__ Q, int lane) {
    const int s = t & (SEQ - 1), row = s >> 6, col = s & 63;
    const int h = lane >> 2, part = lane & 3; const float pos = (float)(part < 2 ? row : col);
    u16* p = Q + (size_t)t * NQ + h * 192 + 128 + part * 16;
    float x[16]; ld8f(p, x); ld8f(p + 8, x + 8);
    unsigned w[8];
#pragma unroll
    for (int i = 0; i < 8; ++i) { const int j = (part & 1) * 8 + i; const float invf = __builtin_amdgcn_exp2f(-(float)j * (LOG2_THETA / 16.f)); float c, sn; rope_cs(pos, invf, c, sn);
        w[i] = pk2(x[2 * i] * c - x[2 * i + 1] * sn, x[2 * i] * sn + x[2 * i + 1] * c); }
    *(u32x4*)p = (u32x4){w[0], w[1], w[2], w[3]}; *(u32x4*)(p + 8) = (u32x4){w[4], w[5], w[6], w[7]};
}

#define RLX_AGENT __ATOMIC_RELAXED, __HIP_MEMORY_SCOPE_AGENT
#define XB_TMO      128
#define XB_XCNT(j)  (256  + 64 * (j))
#define XB_XSUB(j)  (1280 + 64 * (j))
#define XB_XGEN(j)  (2304 + 64 * (j))
#define XB_TOP      3328
#define XB_TOPGEN   3392
#define XCD_BAR_WORDS 3456
#define XB_SPIN_CAP (1u << 22)

__device__ __forceinline__ unsigned xb_ld(unsigned* p)              { return __hip_atomic_load(p, __ATOMIC_RELAXED, __HIP_MEMORY_SCOPE_AGENT); }
__device__ __forceinline__ unsigned xb_add(unsigned* p, unsigned v) { return __hip_atomic_fetch_add(p, v, __ATOMIC_RELAXED, __HIP_MEMORY_SCOPE_AGENT); }
__device__ __forceinline__ unsigned xb_xcc_id() { return (unsigned)__builtin_amdgcn_s_getreg((3 << 11) | 20) & 0xFu; }
#define XB_SPIN(cond, bar) do { unsigned _sp = 0; while (cond) { __builtin_amdgcn_s_sleep(1); \
    if ((++_sp & 255u) == 0u) { if (xb_ld(&(bar)[XB_TMO])) break; if (_sp > XB_SPIN_CAP) { atomicAdd(&(bar)[XB_TMO], 1u); break; } } } } while (0)

struct XcdBarrier {
    unsigned* bar; unsigned x;
    volatile LAS unsigned* st;
};

__device__ __forceinline__ XcdBarrier xcd_barrier_post(unsigned* bar, volatile LAS unsigned* st) {
    XcdBarrier b; b.bar = bar; b.x = xb_xcc_id(); b.st = st;
    if (threadIdx.x == 0) (void)xb_add(&bar[XB_XCNT(b.x)], 1u);
    return b;
}
__device__ __forceinline__ void xcd_barrier_complete(unsigned* bar, unsigned x, unsigned& nloc, unsigned& nx) {
    const unsigned G = gridDim.x * gridDim.y * gridDim.z;
    unsigned sum, cnt, mine, sp = 0u;
    for (;;) {
        sum = 0u; cnt = 0u; mine = 0u;
#pragma unroll
        for (unsigned j = 0; j < 16; ++j) { const unsigned c = xb_ld(&bar[XB_XCNT(j)]); sum += c; cnt += (c > 0u) ? 1u : 0u; mine = (j == x) ? c : mine; }
        if (sum == G) break;
        __builtin_amdgcn_s_sleep(1);
        if ((++sp & 255u) == 0u) { if (xb_ld(&bar[XB_TMO])) break; if (sp > XB_SPIN_CAP) { atomicAdd(&bar[XB_TMO], 1u); break; } }
    }
    nloc = mine > 0u ? mine : 1u; nx = cnt > 0u ? cnt : 1u;
}

__device__ __forceinline__ void xcd_barrier(const XcdBarrier& b) {
    asm volatile("s_waitcnt vmcnt(0)" ::: "memory");
    __syncthreads();
    if (threadIdx.x == 0) {
        unsigned* bar = b.bar;
        __builtin_amdgcn_s_waitcnt(0);
        unsigned nloc = b.st[0], nx = b.st[1];
        if (nloc == 0u) { xcd_barrier_complete(bar, b.x, nloc, nx); b.st[0] = nloc; b.st[1] = nx; }
        const unsigned old = xb_add(&bar[XB_XSUB(b.x)], 1u);
        const unsigned gen = old / nloc;
        if (old + 1u == (gen + 1u) * nloc) {
            __builtin_amdgcn_fence(__ATOMIC_RELEASE, "agent");
            asm volatile("s_waitcnt vmcnt(0)" ::: "memory");
            const unsigned og = xb_add(&bar[XB_TOP], 1u);
            const unsigned tg = og / nx;
            if (og + 1u == (tg + 1u) * nx) xb_add(&bar[XB_TOPGEN], 1u);
            else XB_SPIN(xb_ld(&bar[XB_TOPGEN]) == tg, bar);
            __builtin_amdgcn_fence(__ATOMIC_ACQUIRE, "agent");
            xb_add(&bar[XB_XGEN(b.x)], 1u);
            asm volatile("s_waitcnt vmcnt(0)" ::: "memory");
        } else {
            XB_SPIN(xb_ld(&bar[XB_XGEN(b.x)]) == gen, bar);
            __builtin_amdgcn_fence(__ATOMIC_ACQUIRE, "agent");
            asm volatile("s_waitcnt vmcnt(0)" ::: "memory");
        }
    }
    __syncthreads();
}

struct Params { const float* in[18]; float* out; unsigned char* ws; int ph_lo, ph_hi; };
enum { I_X = 0, I_ENG, I_EWIN, I_EQG, I_EKG, I_ECW, I_EWOUT, I_ONG, I_OWDOWN, I_OQG, I_OKVG, I_OWUQ, I_OWUKV, I_OWO, I_MNG, I_MWUP, I_MWDN, I_FNG };
constexpr int NPHASE = 19;

template <int DQK> __device__ __forceinline__ bool attn_next(int i, int NU, int& unit) {
    const int G = gridDim.x, bx = blockIdx.x;
    if ((G & 7) == 0 && (NU & 7) == 0) { const int x = bx & 7, j = bx >> 3, per = G >> 3, upx = NU >> 3; const int k = i * per + j; if (k >= upx) return false; unit = x * upx + k; return true; }
    const int k = i * G + bx; if (k >= NU) return false; unit = k; return true;
}

__global__ void __launch_bounds__(NTHREADS, 2) fwd_mega(Params P) {
    extern __shared__ __attribute__((aligned(16))) unsigned char lds[];
    cg::grid_group grid = cg::this_grid();
    const int tid = threadIdx.x, lane = tid & 63, wave = __builtin_amdgcn_readfirstlane(tid >> 6);
    const int G = gridDim.x, gw = blockIdx.x * NWAVES + wave, NGW = G * NWAVES;
    unsigned char* ws = P.ws;
    u16* Win = (u16*)(ws + WS_WIN); u16* Wout = (u16*)(ws + WS_WOUT); u16* Wdown = (u16*)(ws + WS_WDOWN); u16* Wuq = (u16*)(ws + WS_WUQ); u16* Wukv = (u16*)(ws + WS_WUKV); u16* Wo = (u16*)(ws + WS_WO);
    u16* Wup = (u16*)(ws + WS_WUP); u16* Wdn = (u16*)(ws + WS_WDN);
    u16* XN = (u16*)(ws + WS_XN); u16* PROJ = (u16*)(ws + WS_PROJ); u16* MIX = (u16*)(ws + WS_MIX); u16* HID = (u16*)(ws + WS_HID);
    u16* LAT = (u16*)(ws + WS_LAT); u16* CQN = (u16*)(ws + WS_CQN); u16* CKVN = (u16*)(ws + WS_CKVN); u16* KROPE = (u16*)(ws + WS_KROPE);
    u16* Qm = (u16*)(ws + WS_Q); u16* KVm = (u16*)(ws + WS_KV); u16* AO = (u16*)(ws + WS_AO);
    u16* HB = (u16*)(ws + WS_HB);
    LAS unsigned char* ldsl = (LAS unsigned char*)lds;
    const int lo = P.ph_lo, hi = P.ph_hi;
    volatile LAS unsigned* xst = (volatile LAS unsigned*)(ldsl + LDS_BYTES - 16);
    if (tid < 4) xst[tid] = 0u;
    __syncthreads();
    XcdBarrier xbar = xcd_barrier_post((unsigned*)(ws + WS_CTL), xst);
#define PH(k) if (lo <= (k) && (k) < hi) _Pragma("unroll") for (int rep_ = 0; rep_ <= (int)((REP_MASK >> (k)) & 1u); ++rep_)
#define SEAM(k) do { if (lo <= (k) && (k) + 1 < hi) { if ((k) == 0) grid.sync(); else xcd_barrier(xbar); } } while (0)
#define GEMM_BF16(ACT, Aptr, Bptr, Mv, Nv, Kv, Optr, ldc) do { pg8::Gemm g{Aptr, Bptr, Mv, Nv, Kv}; pg8::StaticOrder S; S.init(Mv, Nv, G, (int)blockIdx.x); \
        pg8::EpiBf16<ACT> E{Optr, ldc}; pg8::gemm_phase<pg8::EpiBf16<ACT>, pg8::StaticOrder, true, true>(ldsl, g, S, E); } while (0)
#define GEMM_RES(F32B, Aptr, Bptr, Mv, Nv, Kv, baseptr) do { pg8::Gemm g{Aptr, Bptr, Mv, Nv, Kv}; pg8::StaticOrder S; S.init(Mv, Nv, G, (int)blockIdx.x); \
        pg8::EpiResB<F32B> E{baseptr, HB, Nv}; pg8::gemm_phase<pg8::EpiResB<F32B>, pg8::StaticOrder, true, true>(ldsl, g, S, E); } while (0)
#define NORM_PHASE() do { for (int m = gw; m < T; m += NGW) norm_row_b2b(HB + (size_t)m * DM, XN + (size_t)m * DM, lane); } while (0)

    PH(0) {
        LAS float* scr = (LAS float*)(ldsl + wave * 16384);
        constexpr int I0 = (DM / 64) * (IN0 / 32), I1 = (DM / 64) * (DM / 32), I2 = (DM / 64) * (NLAT / 32), I3 = (512 / 64) * (NQ / 32), I4 = (512 / 64) * (NKV / 32), I5 = I1;
        constexpr int I6 = (DM / 64) * (DFF / 32), I7 = (DFF / 64) * (DM / 32);
        constexpr int NITEMS = I0 + I1 + I2 + I3 + I4 + I5 + 2 * I6 + 2 * I7;
        for (int it = gw; it < NITEMS; it += NGW) {
            int r = it;
            if (r < I0) { transpose_item(P.in[I_EWIN], P.in[I_ENG], 1.f, DM, IN0, Win, scr, r, lane); continue; } r -= I0;
            if (r < I1) { transpose_item(P.in[I_EWOUT], nullptr, 1.f, DM, DM, Wout, scr, r, lane); continue; } r -= I1;
            if (r < I2) { transpose_item(P.in[I_OWDOWN], P.in[I_ONG], 1.f, DM, NLAT, Wdown, scr, r, lane); continue; } r -= I2;
            if (r < I3) { transpose_item(P.in[I_OWUQ], P.in[I_OQG], att::Cfg<192>::C, 512, NQ, Wuq, scr, r, lane); continue; } r -= I3;
            if (r < I4) { transpose_item(P.in[I_OWUKV], P.in[I_OKVG], 1.f, 512, NKV, Wukv, scr, r, lane); continue; } r -= I4;
            if (r < I5) { transpose_item(P.in[I_OWO], nullptr, 1.f, DM, DM, Wo, scr, r, lane); continue; } r -= I5;
            if (r < I6) { transpose_item(P.in[I_MWUP], P.in[I_MNG], 1.f, DM, DFF, Wup, scr, r, lane); continue; } r -= I6;
            if (r < I6) { transpose_item(P.in[I_MWUP] + (size_t)DM * DFF, P.in[I_MNG] + DM, 1.f, DM, DFF, Wup + (size_t)DM * DFF, scr, r, lane); continue; } r -= I6;
            if (r < I7) { transpose_item(P.in[I_MWDN], nullptr, 1.f, DFF, DM, Wdn, scr, r, lane); continue; } r -= I7;
            transpose_item(P.in[I_MWDN] + (size_t)DM * DFF, nullptr, 1.f, DFF, DM, Wdn + (size_t)DM * DFF, scr, r, lane);
        }
        { const size_t n16 = (size_t)(NLATP - NLAT) * DM * 2 / 16; u32x4* z = (u32x4*)(Wdown + (size_t)NLAT * DM);
          for (size_t i = (size_t)blockIdx.x * NTHREADS + tid; i < n16; i += (size_t)G * NTHREADS) z[i] = (u32x4){0u, 0u, 0u, 0u}; }
        for (int m = gw; m < T; m += NGW) norm_row_bf16(P.in[I_X] + (size_t)m * DM, XN + (size_t)m * DM, lane);
    }
    SEAM(0);
    PH(1) { GEMM_BF16(0, XN, Win, T, IN0, DM, PROJ, IN0); }
    SEAM(1);
    PH(2) { const int per = (T + NGW - 1) / NGW; const int t0 = gw * per; for (int t = t0; t < t0 + per && t < T; ++t) ew0_token(t, PROJ, MIX, P.in[I_EQG], P.in[I_EKG], P.in[I_ECW], lane); }
    SEAM(2);
    PH(3) {
        if (ATT_PRIO && wave >= 4) __builtin_amdgcn_s_setprio(1);
        constexpr int NU = BATCH * 8 * (SEQ / 256); int unit;
        for (int i = 0; attn_next<128>(i, NU, unit); ++i) {
            const int bh = unit / (SEQ / 256), qb = unit % (SEQ / 256), b = bh >> 3, hq = bh & 7, kvh = hq >> 2;
            const size_t tb = (size_t)b * SEQ;
#ifndef NO_GQA
            att::attn_unit<128, IN0, IN0, IN0, DM, GQA_SD>(PROJ + (tb + (size_t)qb * 256) * IN0 + hq * 128, PROJ + tb * IN0 + 1024 + kvh * 128, nullptr, PROJ + tb * IN0 + 1280 + kvh * 128,
                                                      MIX + (tb + (size_t)qb * 256) * DM + hq * 128, SEQ, (char*)lds);
#endif
        }
    }
    if (ATT_PRIO) __builtin_amdgcn_s_setprio(0);
    SEAM(3);
    PH(4) { GEMM_RES(true, MIX, Wout, T, DM, DM, (const void*)P.in[I_X]); }
    SEAM(4);
    PH(5) { NORM_PHASE(); }
    SEAM(5);
    PH(6) { GEMM_BF16(2, XN, Wup, T, DFF, DM, HID, DFF); }
    SEAM(6);
    PH(7) { GEMM_RES(false, HID, Wdn, T, DM, DFF, (const void*)HB); }
    SEAM(7);
    PH(8) { NORM_PHASE(); }
    SEAM(8);
    PH(9) { GEMM_BF16(0, XN, Wdown, T, NLATP, DM, LAT, NLATP); }
    SEAM(9);
    PH(10) { for (int t = gw; t < T; t += NGW) ew1_token(t, LAT, CQN, CKVN, KROPE, lane); }
    SEAM(10);
    PH(11) { GEMM_BF16(0, CQN, Wuq, T, NQ, 512, Qm, NQ); GEMM_BF16(0, CKVN, Wukv, T, NKV, 512, KVm, NKV); }
    SEAM(11);
    PH(12) { for (int t = gw; t < T; t += NGW) ew2_token(t, Qm, lane); }
    SEAM(12);
    PH(13) {
        if (ATT_PRIO && wave >= 4) __builtin_amdgcn_s_setprio(1);
        constexpr int NU = BATCH * 16 * (SEQ / 256); int unit;
        for (int i = 0; attn_next<192>(i, NU, unit); ++i) {
            const int bh = unit / (SEQ / 256), qb = unit % (SEQ / 256), b = bh >> 4, h = bh & 15;
            const size_t tb = (size_t)b * SEQ;
#ifndef NO_MLA
            att::attn_unit<192, NQ, NKV, NKV, DM, MLA_SD>(Qm + (tb + (size_t)qb * 256) * NQ + h * 192, KVm + tb * NKV + h * 256, KROPE + tb * 64, KVm + tb * NKV + h * 256 + 128,
                                                          AO + (tb + (size_t)qb * 256) * DM + h * 128, SEQ, (char*)lds);
#endif
        }
    }
    if (ATT_PRIO) __builtin_amdgcn_s_setprio(0);
    SEAM(13);
    PH(14) { GEMM_RES(false, AO, Wo, T, DM, DM, (const void*)HB); }
    SEAM(14);
    PH(15) { NORM_PHASE(); }
    SEAM(15);
    PH(16) { GEMM_BF16(2, XN, Wup + (size_t)DM * DFF, T, DFF, DM, HID, DFF); }
    SEAM(16);
    PH(17) { GEMM_RES(false, HID, Wdn + (size_t)DM * DFF, T, DM, DFF, (const void*)HB); }
    SEAM(17);
    PH(18) { for (int m = gw; m < T; m += NGW) norm_row_final(HB + (size_t)m * DM, P.out + (size_t)m * DM, P.in[I_FNG], lane); }
#undef PH
#undef SEAM
}

extern "C" void kernel_launch(void* const* d_in, const int* in_sizes, int n_in, void* d_out, int out_size, void* d_ws, size_t ws_size, hipStream_t stream) {
    static int grid = 0;
    if (grid == 0) {
        if (n_in != 18 || in_sizes[0] != T * DM || out_size != T * DM || ws_size < WS_END) {
            fprintf(stderr, "kernel_launch: shape mismatch (n_in %d in0 %d out %d ws %zu need %zu)\n", n_in, n_in > 0 ? in_sizes[0] : -1, out_size, ws_size, (size_t)WS_END); grid = -1; return; }
        int dev = 0, cus = 0, per_cu = 0;
        hipGetDevice(&dev); hipDeviceGetAttribute(&cus, hipDeviceAttributeMultiprocessorCount, dev);
        if (hipFuncSetAttribute((const void*)fwd_mega, hipFuncAttributeMaxDynamicSharedMemorySize, LDS_BYTES) != hipSuccess) { fprintf(stderr, "kernel_launch: hipFuncSetAttribute failed\n"); grid = -1; return; }
        if (hipOccupancyMaxActiveBlocksPerMultiprocessor(&per_cu, (const void*)fwd_mega, NTHREADS, LDS_BYTES) != hipSuccess || per_cu < 1) { fprintf(stderr, "kernel_launch: occupancy query says %d\n", per_cu); per_cu = 1; }
        (void)hipGetLastError();
        grid = cus * per_cu;
        fprintf(stderr, "kernel_launch: grid %d (cus %d x %d)\n", grid, cus, per_cu);
    }
    if (grid < 0) return;
    if (hipMemsetAsync((char*)d_ws + WS_CTL, 0, CTL_BYTES, stream) != hipSuccess) { fprintf(stderr, "kernel_launch: memset failed\n"); return; }
    Params p{};
    for (int i = 0; i < 18; ++i) p.in[i] = (const float*)d_in[i];
    p.out = (float*)d_out; p.ws = (unsigned char*)d_ws;
#if N_LAUNCH_SPLIT
    for (int k = 0; k < NPHASE; ++k) { p.ph_lo = k; p.ph_hi = k + 1; void* args[] = {&p};
        hipError_t e = hipLaunchCooperativeKernel((const void*)fwd_mega, dim3(grid), dim3(NTHREADS), args, LDS_BYTES, stream);
        if (e != hipSuccess) { fprintf(stderr, "cooperative launch failed: %s (grid %d)\n", hipGetErrorString(e), grid); break; } }
#else
    p.ph_lo = 0; p.ph_hi = NPHASE; void* args[] = {&p};
    hipError_t e = hipLaunchCooperativeKernel((const void*)fwd_mega, dim3(grid), dim3(NTHREADS), args, LDS_BYTES, stream);
    if (e != hipSuccess) fprintf(stderr, "cooperative launch failed: %s (grid %d)\n", hipGetErrorString(e), grid);
#endif
}
```

```cpp
#include <hip/hip_runtime.h>
#include <hip/hip_cooperative_groups.h>
#include <cstdio>
#include <cstdint>
namespace cg = cooperative_groups;
#ifndef GQA_SD
#define GQA_SD 1
#endif
#ifndef MLA_SD
#define MLA_SD 1
#endif
#ifndef MLA_QREG
#define MLA_QREG 4
#endif
#ifndef REP_MASK
#define REP_MASK 0u
#endif
#ifndef ATT_NVA128
#define ATT_NVA128 5
#endif
#ifndef ATT_NVA192
#define ATT_NVA192 3
#endif
#ifndef ATT_NVB
#define ATT_NVB 1
#endif
#ifndef ATT_PREA
#define ATT_PREA 4
#endif
#ifndef ATT_PREB
#define ATT_PREB 8
#endif
#ifndef ATT_PRIO
#define ATT_PRIO 0
#endif
#ifndef ATT_KEYMASK128
#define ATT_KEYMASK128 7
#endif
#ifndef ATT_MG192
#define ATT_MG192 2
#endif
#ifndef ATT_DS192
#define ATT_DS192 2
#endif
#ifndef N_LAUNCH_SPLIT
#define N_LAUNCH_SPLIT 0
#endif
namespace pg8 {
#define PG8_LAS __attribute__((address_space(3)))
typedef unsigned short bf16_t;
typedef short bf16x8 __attribute__((ext_vector_type(8)));
typedef float f32x4 __attribute__((ext_vector_type(4)));
typedef unsigned u32x4 __attribute__((ext_vector_type(4)));
constexpr int BM = 256, BK = 64, HALF = 128, HTB = HALF * BK * 2  , STAGE_BYTES = 8 * HTB, NXCD = 8, WGM = 8;

__host__ __device__ __forceinline__ int lds_byte(int r, int c) { const int st = (r >> 4) * 2 + (c >> 5), rr = r & 15, cc = c & 31, ob = rr * 64 + cc * 2; return st * 1024 + (ob ^ (((ob >> 9) & 1) << 5)); }
__host__ __device__ __forceinline__ void stage_rc(int b, int& R, int& C) { const int st = b / 1024, sb = b % 1024, swz = sb ^ (((sb >> 9) & 1) << 5); R = (st >> 1) * 16 + swz / 64; C = (st & 1) * 32 + (swz % 64) / 2; }
__host__ __device__ __forceinline__ int perm32(int rho) { const int n = rho >> 4, i = rho & 15; return 8 * (i >> 2) + 4 * n + (i & 3); }

struct Unit { int pm, pn; };
struct Gemm { const bf16_t* A; const bf16_t* Bt; int M, N, K; };

struct StaticOrder {
    int nM, nN, nwg, G, c;
    __host__ __device__ void init(int M, int N, int G_, int c_) { nM = M / BM; nN = N / BM; nwg = nM * nN; G = G_; c = c_; }
    __host__ __device__ bool next(int i, Unit& u) const {
        const long L = (long)i * G + c; if (L >= nwg) return false;
        int wgid = (int)L; { const int q = nwg / NXCD, r = nwg % NXCD, xcd = wgid % NXCD, off = wgid / NXCD; wgid = (xcd < r ? xcd * (q + 1) : r * (q + 1) + (xcd - r) * q) + off; }
        const int nig = WGM * nN, gid = wgid / nig, fm = gid * WGM, gsz = (nM - fm) < WGM ? (nM - fm) : WGM;
        u.pm = fm + ((wgid % nig) % gsz); u.pn = (wgid % nig) / gsz; return true;
    }
    __device__ __forceinline__ void a_ready(const Unit&) const {}
    __device__ __forceinline__ void done(const Unit&) const {}
};
__device__ __forceinline__ unsigned cvt_pk_bf16(float lo, float hi) { unsigned r; asm volatile("v_cvt_pk_bf16_f32 %0, %1, %2" : "=v"(r) : "v"(lo), "v"(hi)); return r; }
template <int ACT> struct EpiBf16 {
    static constexpr bool PERM = true, AFTER_DRAIN = false;
    bf16_t* O; int ldc; const float* ss; float inv_k, eps;
    __device__ __forceinline__ void operator()(const f32x4 (&acc)[2][2][4][2], const Unit& u, int wr, int wc, int fr, int fq) const {
        const int row0 = u.pm * BM + wr * 64 + fr; const int col0 = u.pn * BM + wc * 32 + 8 * fq;
#pragma unroll
        for (int ai = 0; ai < 2; ++ai)
#pragma unroll
            for (int m = 0; m < 4; ++m) { const int row = row0 + ai * HALF + m * 16; bf16_t* rowp = O + (size_t)row * ldc + col0;
                const float rs = ss ? (1.0f / sqrtf(ss[row] * inv_k + eps)) : 1.0f;
#pragma unroll
                for (int bj = 0; bj < 2; ++bj) { f32x4 v0 = acc[ai][bj][m][0] * rs, v1 = acc[ai][bj][m][1] * rs;
                    if (ACT == 2) {
#pragma unroll
                        for (int e = 0; e < 4; ++e) { float a = v0[e] > 0.f ? v0[e] : 0.f; v0[e] = a * a; float b = v1[e] > 0.f ? v1[e] : 0.f; v1[e] = b * b; } }
                    u32x4 w; w.x = cvt_pk_bf16(v0[0], v0[1]); w.y = cvt_pk_bf16(v0[2], v0[3]); w.z = cvt_pk_bf16(v1[0], v1[1]); w.w = cvt_pk_bf16(v1[2], v1[3]);
                    *(u32x4*)(rowp + bj * HALF) = w; } }
    }
};
template <bool BASE_F32> struct EpiResB {
    static constexpr bool PERM = true, AFTER_DRAIN = false;
    const void* base; bf16_t* out; int ldc; float* ss;
    __device__ __forceinline__ void operator()(const f32x4 (&acc)[2][2][4][2], const Unit& u, int wr, int wc, int fr, int fq) const {
        const int row0 = u.pm * BM + wr * 64 + fr; const int col0 = u.pn * BM + wc * 32 + 8 * fq;
#pragma unroll
        for (int ai = 0; ai < 2; ++ai)
#pragma unroll
            for (int m = 0; m < 4; ++m) { const size_t off = (size_t)(row0 + ai * HALF + m * 16) * ldc + col0; float q = 0.f;
#pragma unroll
                for (int bj = 0; bj < 2; ++bj) { const size_t o = off + bj * HALF; f32x4 b0, b1;
                    if constexpr (BASE_F32) { b0 = *(const f32x4*)((const float*)base + o); b1 = *(const f32x4*)((const float*)base + o + 4); }
                    else { const u32x4 w = *(const u32x4*)((const bf16_t*)base + o);
                        b0 = (f32x4){__uint_as_float(w.x << 16), __uint_as_float(w.x & 0xffff0000u), __uint_as_float(w.y << 16), __uint_as_float(w.y & 0xffff0000u)};
                        b1 = (f32x4){__uint_as_float(w.z << 16), __uint_as_float(w.z & 0xffff0000u), __uint_as_float(w.w << 16), __uint_as_float(w.w & 0xffff0000u)}; }
                    const f32x4 v0 = b0 + acc[ai][bj][m][0], v1 = b1 + acc[ai][bj][m][1];
                    q += (v0[0] * v0[0] + v0[1] * v0[1]) + (v0[2] * v0[2] + v0[3] * v0[3]) + (v1[0] * v1[0] + v1[1] * v1[1]) + (v1[2] * v1[2] + v1[3] * v1[3]);
                    u32x4 r; r.x = cvt_pk_bf16(v0[0], v0[1]); r.y = cvt_pk_bf16(v0[2], v0[3]); r.z = cvt_pk_bf16(v1[0], v1[1]); r.w = cvt_pk_bf16(v1[2], v1[3]);
                    *(u32x4*)(out + o) = r; }
                if (ss) { q += __shfl_xor(q, 16); q += __shfl_xor(q, 32); if (fq == 0) atomicAdd(ss + (row0 + ai * HALF + m * 16), q); }
                asm volatile("" ::: "memory"); }
    }
};
template <class Epi, class Sched, bool ALIGN_EPI = false, bool SP2 = false>
__device__ __forceinline__ void gemm_phase(PG8_LAS unsigned char* lds, const Gemm g, const Sched& S, const Epi& E) {
    const int tid = threadIdx.x, wid = __builtin_amdgcn_readfirstlane(tid >> 6), lane = tid & 63, wr = wid >> 2, wc = wid & 3, fr = lane & 15, fq = lane >> 4;
    const int K = g.K, nt = K / BK;
    unsigned voffA[2], voffB[2];
#pragma unroll
    for (int i = 0; i < 2; ++i) { int R, C; stage_rc(tid * 16 + i * 8192, R, C); const int Rb = Epi::PERM ? ((R & ~31) + perm32(R & 31)) : R;
        voffA[i] = (unsigned)(R * K + C) * 2u; voffB[i] = (unsigned)(Rb * K + C) * 2u; }
    const size_t kstep = (size_t)(BK * 2);
    const size_t hstep = (size_t)HALF * K * 2;
    const size_t tstep = 2 * hstep;
    const unsigned ldsw = (unsigned)wid * 1024u;
    const int aoff = lds_byte(wr * 64 + fr, fq * 8), boff = lds_byte(wc * 32 + fr, fq * 8);
#define PG8_SA(b, h) (((b) * 2 + (h)) * HTB)
#define PG8_SB(b, h) ((4 + (b) * 2 + (h)) * HTB)
#define PG8_STAGE(bufoff, gbase, voff) do { _Pragma("unroll") for (int _i = 0; _i < 2; ++_i) \
        __builtin_amdgcn_global_load_lds((const unsigned*)((const char*)(gbase) + (voff)[_i]), (PG8_LAS unsigned*)(lds + (bufoff) + ldsw + _i * 8192), 16, 0, 0); } while (0)
#define PG8_LDA(dst, b, h) do { _Pragma("unroll") for (int m = 0; m < 4; ++m) _Pragma("unroll") for (int k = 0; k < 2; ++k) dst[m][k] = *(const PG8_LAS bf16x8*)(lds + PG8_SA(b, h) + aoff + m * 2048 + k * 1024); } while (0)
#define PG8_LDB(dst, b, h) do { _Pragma("unroll") for (int n = 0; n < 2; ++n) _Pragma("unroll") for (int k = 0; k < 2; ++k) dst[n][k] = *(const PG8_LAS bf16x8*)(lds + PG8_SB(b, h) + boff + n * 2048 + k * 1024); } while (0)
#define PG8_MMA(ai, bj, At, Bt) do { __builtin_amdgcn_s_setprio(1); _Pragma("unroll") for (int m = 0; m < 4; ++m) _Pragma("unroll") for (int n = 0; n < 2; ++n) _Pragma("unroll") for (int k = 0; k < 2; ++k) \
        acc[ai][bj][m][n] = __builtin_amdgcn_mfma_f32_16x16x32_bf16(Bt[n][k], At[m][k], acc[ai][bj][m][n], 0, 0, 0); __builtin_amdgcn_s_setprio(0); } while (0)
#define PG8_WAIT_V(n) asm volatile("s_waitcnt vmcnt(" #n ")" ::: "memory")
#define PG8_WAIT_L(n) asm volatile("s_waitcnt lgkmcnt(" #n ")" ::: "memory")
#define PG8_BAR __builtin_amdgcn_s_barrier()
#define PG8_SCHED __builtin_amdgcn_sched_barrier(0)
    Unit cur, nxt; int ui = 0;
    if (!S.next(0, cur)) return;
    f32x4 acc[2][2][4][2];
#pragma unroll
    for (int a = 0; a < 2; ++a)
#pragma unroll
        for (int b = 0; b < 2; ++b)
#pragma unroll
            for (int m = 0; m < 4; ++m)
#pragma unroll
                for (int n = 0; n < 2; ++n) acc[a][b][m][n] = (f32x4){0.f, 0.f, 0.f, 0.f};
    bf16x8 At[4][2], B0[2][2], B1[2][2];
    const char* cA = (const char*)g.A + (size_t)cur.pm * tstep; const char* cB = (const char*)g.Bt + (size_t)cur.pn * tstep;
    S.a_ready(cur);
    if constexpr (SP2) {
        PG8_STAGE(PG8_SB(0, 0), cB, voffB); PG8_STAGE(PG8_SB(0, 1), cB + hstep, voffB); PG8_STAGE(PG8_SA(0, 0), cA, voffA); PG8_STAGE(PG8_SA(0, 1), cA + hstep, voffA);
        if (wr == 1) PG8_BAR;
        PG8_WAIT_V(2); PG8_BAR;
        PG8_STAGE(PG8_SB(1, 0), cB + kstep, voffB); PG8_STAGE(PG8_SA(1, 0), cA + kstep, voffA); PG8_STAGE(PG8_SB(1, 1), cB + hstep + kstep, voffB);
        PG8_WAIT_V(6); PG8_BAR;
    } else {
        PG8_STAGE(PG8_SB(0, 0), cB, voffB); PG8_STAGE(PG8_SA(0, 0), cA, voffA); PG8_STAGE(PG8_SB(0, 1), cB + hstep, voffB); PG8_STAGE(PG8_SA(0, 1), cA + hstep, voffA);
        if (wr == 1) PG8_BAR;
        PG8_WAIT_V(4); PG8_BAR;
        PG8_STAGE(PG8_SB(1, 0), cB + kstep, voffB); PG8_STAGE(PG8_SA(1, 0), cA + kstep, voffA); PG8_STAGE(PG8_SB(1, 1), cB + hstep + kstep, voffB);
        PG8_WAIT_V(6); PG8_BAR;
    }
    for (;;) {
        const bool has_next = S.next(ui + 1, nxt);
        const char* nA = has_next ? (const char*)g.A + (size_t)nxt.pm * tstep : cA; const char* nB = has_next ? (const char*)g.Bt + (size_t)nxt.pn * tstep : cB;
        for (int t = 0; t < nt; t += 2) {
            const bool last = (t == nt - 2);
            const char* a1 = cA + (size_t)(t + 1) * kstep;
            const char* a2 = last ? nA : cA + (size_t)(t + 2) * kstep; const char* b2 = last ? nB : cB + (size_t)(t + 2) * kstep;
            const char* a3 = a2 + kstep; const char* b3 = b2 + kstep;
            if (last && has_next) S.a_ready(nxt);
            if constexpr (SP2) {
            PG8_LDB(B0, 0, 0); PG8_LDB(B1, 0, 1); PG8_SCHED; PG8_LDA(At, 0, 0); PG8_STAGE(PG8_SA(1, 1), a1 + hstep, voffA);
            PG8_WAIT_V(8); PG8_WAIT_L(0); PG8_BAR; PG8_MMA(0, 0, At, B0); PG8_MMA(0, 1, At, B1); PG8_BAR; PG8_SCHED;
            PG8_LDA(At, 0, 1); PG8_STAGE(PG8_SB(0, 0), b2, voffB); PG8_STAGE(PG8_SB(0, 1), b2 + hstep, voffB); PG8_STAGE(PG8_SA(0, 0), a2, voffA);
            PG8_WAIT_V(8); PG8_WAIT_L(0); PG8_BAR; PG8_MMA(1, 0, At, B0); PG8_MMA(1, 1, At, B1); PG8_BAR; PG8_SCHED;
            PG8_LDB(B0, 1, 0); PG8_LDB(B1, 1, 1); PG8_SCHED; PG8_LDA(At, 1, 0); PG8_STAGE(PG8_SA(0, 1), a2 + hstep, voffA);
            PG8_WAIT_V(8); PG8_WAIT_L(0); PG8_BAR; PG8_MMA(0, 0, At, B0); PG8_MMA(0, 1, At, B1); PG8_BAR; PG8_SCHED;
            PG8_LDA(At, 1, 1); PG8_STAGE(PG8_SB(1, 0), b3, voffB); PG8_STAGE(PG8_SB(1, 1), b3 + hstep, voffB); PG8_STAGE(PG8_SA(1, 0), a3, voffA);
            PG8_WAIT_V(8); PG8_WAIT_L(0); PG8_BAR; PG8_MMA(1, 0, At, B0); PG8_MMA(1, 1, At, B1); PG8_BAR; PG8_SCHED;
            } else {
            PG8_LDB(B0, 0, 0); PG8_SCHED; PG8_LDA(At, 0, 0); PG8_STAGE(PG8_SA(1, 1), a1 + hstep, voffA);
            PG8_WAIT_L(8); PG8_BAR; PG8_WAIT_L(0); PG8_MMA(0, 0, At, B0); PG8_BAR; PG8_SCHED;
            PG8_LDB(B1, 0, 1); PG8_STAGE(PG8_SB(0, 0), b2, voffB);
            PG8_BAR; PG8_WAIT_L(0); PG8_MMA(0, 1, At, B1); PG8_BAR;
            PG8_LDA(At, 0, 1); PG8_STAGE(PG8_SA(0, 0), a2, voffA);
            PG8_BAR; PG8_WAIT_L(0); PG8_MMA(1, 0, At, B0); PG8_BAR; PG8_SCHED;
            PG8_STAGE(PG8_SB(0, 1), b2 + hstep, voffB);
            PG8_WAIT_V(6); PG8_BAR; PG8_MMA(1, 1, At, B1); PG8_BAR;
            PG8_LDB(B0, 1, 0); PG8_SCHED; PG8_LDA(At, 1, 0); PG8_STAGE(PG8_SA(0, 1), a2 + hstep, voffA);
            PG8_WAIT_L(8); PG8_BAR; PG8_WAIT_L(0); PG8_MMA(0, 0, At, B0); PG8_BAR; PG8_SCHED;
            PG8_LDB(B1, 1, 1); PG8_STAGE(PG8_SB(1, 0), b3, voffB);
            PG8_BAR; PG8_WAIT_L(0); PG8_MMA(0, 1, At, B1); PG8_BAR;
            PG8_LDA(At, 1, 1); PG8_STAGE(PG8_SA(1, 0), a3, voffA);
            PG8_BAR; PG8_WAIT_L(0); PG8_MMA(1, 0, At, B0); PG8_BAR; PG8_SCHED;
            PG8_STAGE(PG8_SB(1, 1), b3 + hstep, voffB);
            PG8_WAIT_V(6); PG8_BAR; PG8_MMA(1, 1, At, B1); PG8_BAR;
            }
        }
        if constexpr (ALIGN_EPI) { if (wr == 0) PG8_BAR; }
        if constexpr (!Epi::AFTER_DRAIN) { E(acc, cur, wr, wc, fr, fq); S.done(cur); }
        if (!has_next) break;
#pragma unroll
        for (int a = 0; a < 2; ++a)
#pragma unroll
            for (int b = 0; b < 2; ++b)
#pragma unroll
                for (int m = 0; m < 4; ++m)
#pragma unroll
                    for (int n = 0; n < 2; ++n) acc[a][b][m][n] = (f32x4){0.f, 0.f, 0.f, 0.f};
        cur = nxt; cA = nA; cB = nB; ++ui;
        if constexpr (ALIGN_EPI) { if (wr == 1) PG8_BAR; }
    }
    PG8_WAIT_V(0);
    if constexpr (!ALIGN_EPI) { if (wr == 0) PG8_BAR; }
    PG8_BAR;
    if constexpr (Epi::AFTER_DRAIN) { E.fused(acc, cur, wr, wc, fr, fq, lds, wid, lane); S.done(cur); }
#undef PG8_SA
#undef PG8_SB
#undef PG8_STAGE
#undef PG8_LDA
#undef PG8_LDB
#undef PG8_MMA
#undef PG8_WAIT_V
#undef PG8_WAIT_L
#undef PG8_BAR
#undef PG8_SCHED
}
}
namespace att {
typedef unsigned short bf16;
using bf16x8 = __attribute__((ext_vector_type(8))) short;
using s16x4  = __attribute__((ext_vector_type(4))) short;
using f32x16 = __attribute__((ext_vector_type(16))) float;
using u32x4  = __attribute__((ext_vector_type(4))) unsigned;
constexpr int NW = 8, QBLK = 32, KVBLK = 64;
constexpr float THR = 8.f;
#define ATT_SBAR() __builtin_amdgcn_sched_barrier(0)
__device__ __forceinline__ int crow(int r, int hi) { return (r & 3) + 8 * (r >> 2) + 4 * hi; }
typedef float f32x2_t __attribute__((ext_vector_type(2))); typedef __bf16 bf16x2_t __attribute__((ext_vector_type(2)));
__device__ __forceinline__ unsigned cvtpk(float lo, float hi) { f32x2_t v = {lo, hi}; bf16x2_t b = __builtin_convertvector(v, bf16x2_t); return __builtin_bit_cast(unsigned, b); }
typedef short v4i16_t __attribute__((ext_vector_type(4)));
typedef __attribute__((address_space(3))) const char* lds_cptr;
__device__ __forceinline__ s16x4 vtr(lds_cptr p) { return __builtin_bit_cast(s16x4, __builtin_amdgcn_ds_read_tr16_b64_v4i16((__attribute__((address_space(3))) v4i16_t*)p)); }
__device__ __forceinline__ bf16x8 ld8(const bf16* p) { return *reinterpret_cast<const bf16x8*>(p); }

template <int DQK> struct Cfg {
  static constexpr float SCALE = (DQK == 128) ? 0.088388347648318440f : 0.072168783648703220f;
  static constexpr float C = SCALE * 1.4426950408889634f;
  static constexpr int KROWB = DQK * 2, SHM_K = KVBLK * KROWB, SHM_V = KVBLK * 128 * 2, ND0 = DQK / 16;
  static constexpr int QREG = (DQK > 128) ? MLA_QREG : 8;
  static constexpr int QXW = (ND0 - QREG) * 1024, SHM_QX = NW * QXW;
  static constexpr int SHM_TOTAL = 2 * SHM_V + 2 * SHM_K + NW * 64 * 4 + SHM_QX;
};

constexpr float TRIG = 65536.f;
__device__ __forceinline__ void firstSM(f32x16& p0, f32x16& p1, float& m_ref, f32x16& negm) {
  float pmax = p0[0];
#pragma unroll
  for (int r = 1; r < 16; ++r) pmax = fmaxf(pmax, p0[r]);
#pragma unroll
  for (int r = 0; r < 16; ++r) pmax = fmaxf(pmax, p1[r]);
  { auto rr = __builtin_amdgcn_permlane32_swap(__float_as_uint(pmax), __float_as_uint(pmax), false, false);
    pmax = fmaxf(__uint_as_float(rr[0]), __uint_as_float(rr[1])); }
  m_ref = pmax;
#pragma unroll
  for (int r = 0; r < 16; ++r) { p0[r] -= pmax; p1[r] -= pmax; negm[r] = -pmax; }
#pragma unroll
  for (int r = 0; r < 16; ++r) p0[r] = __builtin_amdgcn_exp2f(p0[r]);
  asm volatile("" : "+v"(p0), "+v"(p1), "+v"(negm));
}
__device__ __forceinline__ void partialSM(f32x16& p0, f32x16& p1) {
#pragma unroll
  for (int r = 0; r < 16; ++r) p0[r] = __builtin_amdgcn_exp2f(p0[r]);
  asm volatile("" : "+v"(p0), "+v"(p1));
}
__device__ __forceinline__ void finishSM(f32x16& p0, f32x16& p1, float& ps, float& l_reg, bf16x8& pa0, bf16x8& pa1, bf16x8& pa2, bf16x8& pa3) {
#pragma unroll
  for (int r = 0; r < 16; ++r) p1[r] = __builtin_amdgcn_exp2f(p1[r]);
  float s0 = 0, s1 = 0;
#pragma unroll
  for (int r = 0; r < 16; ++r) s0 += p0[r];
#pragma unroll
  for (int r = 0; r < 16; ++r) s1 += p1[r];
  ps = s0 + s1;
  { auto rr = __builtin_amdgcn_permlane32_swap(__float_as_uint(ps), __float_as_uint(ps), false, false);
    ps = __uint_as_float(rr[0]) + __uint_as_float(rr[1]); }
  l_reg += ps;
#define ATT_PK4(P, BASE, OUT) do { unsigned a0 = cvtpk(P[BASE + 0], P[BASE + 1]), a1 = cvtpk(P[BASE + 2], P[BASE + 3]);   \
    unsigned b0 = cvtpk(P[BASE + 4], P[BASE + 5]), b1 = cvtpk(P[BASE + 6], P[BASE + 7]);                              \
    auto r0 = __builtin_amdgcn_permlane32_swap(a0, b0, false, false); auto r1 = __builtin_amdgcn_permlane32_swap(a1, b1, false, false); \
    u32x4 w = {r0[0], r1[0], r0[1], r1[1]}; OUT = *reinterpret_cast<bf16x8*>(&w); } while (0)
  ATT_PK4(p0, 0, pa0); ATT_PK4(p0, 8, pa1); ATT_PK4(p1, 0, pa2); ATT_PK4(p1, 8, pa3);
#undef ATT_PK4
}
#define ATT_KEY(row) ((KROWB == 256) ? ((row) & ATT_KEYMASK128) : (((row) >> 1) & 7))
#define ATT_KSWZ(row, colB) ((row) * KROWB + ((colB) ^ (ATT_KEY(row) << 4)))
template <int DQK> __device__ __forceinline__ void qkt(f32x16& p0, f32x16& p1, const f32x16& negm, const char* Ks, const int* kb, const bf16x8* qr, const char* qx, int r32, int hi) {
  constexpr int KROWB = Cfg<DQK>::KROWB, ND0 = Cfg<DQK>::ND0, QREG = Cfg<DQK>::QREG;
  p0 = negm; p1 = negm;
  constexpr int NB = (KROWB == 256 && ATT_KEYMASK128 == 15) ? 8 : 4;
#pragma unroll
  for (int d0 = 0; d0 < ND0; ++d0) {
    bf16x8 b0 = *reinterpret_cast<const bf16x8*>(Ks + kb[d0 % NB] + (d0 / NB) * (NB * 32));
    bf16x8 b1 = *reinterpret_cast<const bf16x8*>(Ks + kb[d0 % NB] + (d0 / NB) * (NB * 32) + 32 * KROWB);
    bf16x8 q; if (d0 < QREG) q = qr[d0]; else q = *reinterpret_cast<const bf16x8*>(qx + (d0 - QREG) * 1024);
    p0 = __builtin_amdgcn_mfma_f32_32x32x16_bf16(b0, q, p0, 0, 0, 0);
    p1 = __builtin_amdgcn_mfma_f32_32x32x16_bf16(b1, q, p1, 0, 0, 0); }
}
__device__ __forceinline__ int v_st(int k, int c) { const int kk = (k & ~0xC) | ((k & 4) << 1) | ((k & 8) >> 1); return ((kk >> 3) * 4 + (c >> 5)) * 512 + ((kk & 7) * 32 + (c & 31)) * 2; }
__device__ __forceinline__ int v_rd_base(int lane) { return ((lane & 3) << 3) | (((lane >> 2) & 3) << 6) | (((lane >> 4) & 1) << 5) | (((lane >> 5) & 1) << 8); }
constexpr int v_rd_off(int d0, int ks, int half) { return d0 * 512 + ks * 4096 + half * 2048; }
template <int OFF> __device__ __forceinline__ s16x4 tr_read(int vb) {
  s16x4 r; asm volatile("ds_read_b64_tr_b16 %0, %1 offset:%2" : "=&v"(r) : "v"(vb), "i"(OFF) : "memory"); return r;
}
#define ATT_PK(L, H) (bf16x8){L[0], L[1], L[2], L[3], H[0], H[1], H[2], H[3]}
template <int D0> __device__ __forceinline__ void pv_one(f32x16& od, lds_cptr vp, bf16x8 pa0, bf16x8 pa1, bf16x8 pa2, bf16x8 pa3) {
  const s16x4 l0 = vtr(vp + v_rd_off(D0, 0, 0)), h0 = vtr(vp + v_rd_off(D0, 0, 1)), l1 = vtr(vp + v_rd_off(D0, 1, 0)), h1 = vtr(vp + v_rd_off(D0, 1, 1));
  const s16x4 l2 = vtr(vp + v_rd_off(D0, 2, 0)), h2 = vtr(vp + v_rd_off(D0, 2, 1)), l3 = vtr(vp + v_rd_off(D0, 3, 0)), h3 = vtr(vp + v_rd_off(D0, 3, 1));
  od = __builtin_amdgcn_mfma_f32_32x32x16_bf16(pa0, ATT_PK(l0, h0), od, 0, 0, 0);
  od = __builtin_amdgcn_mfma_f32_32x32x16_bf16(pa1, ATT_PK(l1, h1), od, 0, 0, 0);
  od = __builtin_amdgcn_mfma_f32_32x32x16_bf16(pa2, ATT_PK(l2, h2), od, 0, 0, 0);
  od = __builtin_amdgcn_mfma_f32_32x32x16_bf16(pa3, ATT_PK(l3, h3), od, 0, 0, 0);
}
__device__ __forceinline__ void pv_d0(f32x16* o, lds_cptr vp, bf16x8 pa0, bf16x8 pa1, bf16x8 pa2, bf16x8 pa3) {
  pv_one<0>(o[0], vp, pa0, pa1, pa2, pa3); pv_one<1>(o[1], vp, pa0, pa1, pa2, pa3); pv_one<2>(o[2], vp, pa0, pa1, pa2, pa3); pv_one<3>(o[3], vp, pa0, pa1, pa2, pa3);
}
template <int NGRP, int MG, int NVALU, int NDS, int NPRE> __device__ __forceinline__ void sched_pipe() {
  __builtin_amdgcn_sched_group_barrier(0x100, NPRE, 0);
#pragma unroll
  for (int i = 0; i < NGRP; ++i) { __builtin_amdgcn_sched_group_barrier(0x008, MG, 0); __builtin_amdgcn_sched_group_barrier(0x002, NVALU, 0); __builtin_amdgcn_sched_group_barrier(0x100, NDS, 0); }
}

template <int DQK, int LDQ, int LDK, int LDV, int LDO, int SD>
__device__ __forceinline__ void attn_unit(const bf16* __restrict__ Qb, const bf16* __restrict__ Kh, const bf16* __restrict__ Kr, const bf16* __restrict__ Vh,
                                          bf16* __restrict__ Ob, int seq, char* lds) {
  constexpr int KROWB = Cfg<DQK>::KROWB, SHM_K = Cfg<DQK>::SHM_K, SHM_V = Cfg<DQK>::SHM_V, ND0 = Cfg<DQK>::ND0;
  const int tid = threadIdx.x, wid = tid >> 6, lane = tid & 63, r32 = lane & 31, hi = lane >> 5;
  char* V_lds = lds; char* K_lds = lds + 2 * SHM_V;
  float* ws = (float*)(lds + 2 * SHM_V + 2 * SHM_K) + wid * 64; float* li_l = ws; float* al_l = ws + 32;
  float m_ref = 0.f, l_reg = 0; f32x16 o[4] = {}; f32x16 negm = {}; constexpr int QREG = Cfg<DQK>::QREG; bf16x8 qr[QREG];
  const bf16* Qw = Qb + (long)(wid * QBLK + r32) * LDQ + hi * 8;
  char* qx = lds + 2 * SHM_V + 2 * SHM_K + NW * 64 * 4 + wid * Cfg<DQK>::QXW + lane * 16;
#pragma unroll
  for (int d0 = 0; d0 < QREG; ++d0) qr[d0] = ld8(Qw + d0 * 16);
  if constexpr (QREG < ND0) {
#pragma unroll
    for (int d0 = QREG; d0 < ND0; ++d0) *(bf16x8*)(qx + (d0 - QREG) * 1024) = ld8(Qw + d0 * 16);
  }
  const int sr = tid >> 4, sc = (tid & 15) * 8, vst0 = v_st(sr, sc), vst1 = v_st(32 + sr, sc);
  const int krr = tid >> 3, krc = (tid & 7) * 8;
  const lds_cptr vb0 = (lds_cptr)V_lds + v_rd_base(lane);
  constexpr int NB = (KROWB == 256 && ATT_KEYMASK128 == 15) ? 8 : 4; int kb[NB];
#pragma unroll
  for (int dl = 0; dl < NB; ++dl) kb[dl] = r32 * KROWB + ((dl * 32 + hi * 16) ^ (ATT_KEY(r32) << 4));
  const unsigned boV = (unsigned)(sr * LDV + sc) * 2u, boK = (unsigned)(sr * LDK + sc) * 2u, boR = (unsigned)(krr * 64 + krc) * 2u;
  struct { bf16x8 vs0, vs1, ks0, ks1, kr; } sr_[SD];
#define SLOAD(i, k0) do { const char* vt_ = (const char*)(Vh + (long)(k0) * LDV); const char* kt_ = (const char*)(Kh + (long)(k0) * LDK); \
    sr_[i].vs0 = *(const bf16x8*)(vt_ + boV); sr_[i].vs1 = *(const bf16x8*)(vt_ + 32 * LDV * 2 + boV); \
    sr_[i].ks0 = *(const bf16x8*)(kt_ + boK); sr_[i].ks1 = *(const bf16x8*)(kt_ + 32 * LDK * 2 + boK); \
    if constexpr (DQK == 192) { const char* rt_ = (const char*)(Kr + (long)(k0) * 64); sr_[i].kr = *(const bf16x8*)(rt_ + boR); } } while (0)
#define SWRITE(b, i) do { *(bf16x8*)(V_lds + (b) * SHM_V + vst0) = sr_[i].vs0;          \
    *(bf16x8*)(V_lds + (b) * SHM_V + vst1) = sr_[i].vs1; int kc = sc * 2;               \
    *(bf16x8*)(K_lds + (b) * SHM_K + ATT_KSWZ(sr, kc)) = sr_[i].ks0;                       \
    *(bf16x8*)(K_lds + (b) * SHM_K + ATT_KSWZ(32 + sr, kc)) = sr_[i].ks1;                  \
    if constexpr (DQK == 192) *(bf16x8*)(K_lds + (b) * SHM_K + ATT_KSWZ(krr, 256 + krc * 2)) = sr_[i].kr; } while (0)
#define SWAIT() do { if constexpr (SD == 2) { if constexpr (DQK == 192) asm volatile("s_waitcnt vmcnt(5)" ::: "memory"); else asm volatile("s_waitcnt vmcnt(4)" ::: "memory"); } \
    else asm volatile("s_waitcnt vmcnt(0)" ::: "memory"); } while (0)
#define RESC_APPLY() do { l_reg *= alp; if (hi == 0) al_l[r32] = alp; asm volatile("s_waitcnt lgkmcnt(0)" ::: "memory"); \
    _Pragma("unroll") for (int d = 0; d < 4; ++d) _Pragma("unroll") for (int r = 0; r < 16; ++r) o[d][r] *= al_l[crow(r, hi)]; pend = false; } while (0)
#define RESCN(ps_) do { if (pend) { RESC_APPLY(); } else { const bool t_ = (ps_) > TRIG; const float d_ = t_ ? __builtin_amdgcn_logf(ps_) : 0.f; alp = __builtin_amdgcn_exp2f(-d_); m_ref += d_; pend = __any(t_); } \
    _Pragma("unroll") for (int r = 0; r < 16; ++r) negm[r] = -m_ref; } while (0)
  float alp = 1.f; bool pend = false;
  f32x16 pA0, pA1, pB0, pB1; float psA, psB; bf16x8 pa0, pa1, pa2, pa3; const int NT = seq / KVBLK;
  constexpr int SE = 0, SO = SD - 1;
  SLOAD(SE, 0); asm volatile("s_waitcnt vmcnt(0)" ::: "memory"); SWRITE(0, SE); __syncthreads();
  qkt<DQK>(pA0, pA1, negm, K_lds, kb, qr, qx, r32, hi); firstSM(pA0, pA1, m_ref, negm);
  SLOAD(SO, KVBLK); if constexpr (SD == 2) { if (2 < NT) SLOAD(SE, 2 * KVBLK); }
  SWAIT(); SWRITE(1, SO); __syncthreads();
#define SCHED_A() do { if constexpr (DQK == 128) sched_pipe<16, 1, ATT_NVA128, 1, ATT_PREA>(); else sched_pipe<24 / ATT_MG192, ATT_MG192, ATT_NVA192 * ATT_MG192, ATT_DS192, ATT_PREA>(); } while (0)
#define SCHED_B() sched_pipe<16, 1, ATT_NVB, 2, ATT_PREB>()
  for (int j = 1; j + 1 < NT; j += 2) {
    ATT_SBAR(); qkt<DQK>(pB0, pB1, negm, K_lds + SHM_K, kb, qr, qx, r32, hi);
    finishSM(pA0, pA1, psA, l_reg, pa0, pa1, pa2, pa3); SCHED_A(); ATT_SBAR();
    SLOAD(SO, (j + SD) * KVBLK); ATT_SBAR();
    pv_d0(o, vb0, pa0, pa1, pa2, pa3); partialSM(pB0, pB1); SCHED_B(); ATT_SBAR();
    __syncthreads(); SWAIT(); SWRITE(0, SE);
    RESCN(psA); __syncthreads();
    ATT_SBAR(); qkt<DQK>(pA0, pA1, negm, K_lds, kb, qr, qx, r32, hi);
    finishSM(pB0, pB1, psB, l_reg, pa0, pa1, pa2, pa3); SCHED_A(); ATT_SBAR();
    if (SD == 1 || j + 3 < NT) SLOAD(SE, (j + 1 + SD) * KVBLK); ATT_SBAR();
    pv_d0(o, vb0 + SHM_V, pa0, pa1, pa2, pa3); partialSM(pA0, pA1); SCHED_B(); ATT_SBAR();
    __syncthreads(); SWAIT(); SWRITE(1, SO);
    RESCN(psB); __syncthreads();
  }
  ATT_SBAR(); qkt<DQK>(pB0, pB1, negm, K_lds + SHM_K, kb, qr, qx, r32, hi);
  finishSM(pA0, pA1, psA, l_reg, pa0, pa1, pa2, pa3); ATT_SBAR();
  pv_d0(o, vb0, pa0, pa1, pa2, pa3); partialSM(pB0, pB1);
  __syncthreads(); if (pend) { RESC_APPLY(); }
  finishSM(pB0, pB1, psB, l_reg, pa0, pa1, pa2, pa3); ATT_SBAR();
  pv_d0(o, vb0 + SHM_V, pa0, pa1, pa2, pa3);
#undef SCHED_A
#undef SCHED_B
  if (hi == 0) li_l[r32] = l_reg; asm volatile("s_waitcnt lgkmcnt(0)" ::: "memory");
  float rli[16];
#pragma unroll
  for (int r = 0; r < 16; ++r) rli[r] = __builtin_amdgcn_rcpf(li_l[crow(r, hi)]);
  { int r32e = r32, hie = hi; asm volatile("" : "+v"(r32e), "+v"(hie));
    char* Ow = (char*)(Ob + (long)(wid * QBLK) * LDO);
    const unsigned lo_ = (unsigned)(((r32e >> 5) + 4 * hie) * LDO + (r32e & 31)) * 2u;
#pragma unroll
    for (int r = 0; r < 16; ++r) {
#pragma unroll
      for (int d0 = 0; d0 < 4; ++d0) *(bf16*)(Ow + lo_ + (unsigned)((((r & 3) + 8 * (r >> 2)) * LDO + d0 * 32) * 2)) = (bf16)(cvtpk(o[d0][r] * rli[r], 0.f) & 0xffffu); } }
  asm volatile("s_waitcnt vmcnt(0) lgkmcnt(0)" ::: "memory"); __syncthreads();
#undef SLOAD
#undef SWRITE
#undef SWAIT
#undef RESCN
#undef RESC_APPLY
}
#undef ATT_KSWZ
#undef ATT_KEY
#undef ATT_PK
#undef ATT_SBAR
}
#define LAS __attribute__((address_space(3)))
typedef unsigned short u16;
typedef float f32x4 __attribute__((ext_vector_type(4)));
typedef short bf16x8 __attribute__((ext_vector_type(8)));
typedef unsigned u32x4 __attribute__((ext_vector_type(4)));
typedef unsigned u32x2 __attribute__((ext_vector_type(2)));
constexpr int DM = 2048, BATCH = 2, SEQ = 16384, T = BATCH * SEQ;
constexpr int IN0 = 4608, NLAT = 1088, NLATP = 1280, NQ = 3072, NKV = 4096, DFF = 8192;
constexpr float EPS = 1e-6f;
constexpr int NWAVES = 8, NTHREADS = 512;
constexpr int LDS_BYTES = 155648;
constexpr float LOG2_THETA = 13.287712379549449f;

constexpr size_t MiB = 1u << 20;
constexpr size_t WS_WIN = 0, WS_WOUT = 18 * MiB, WS_WDOWN = 26 * MiB, WS_WUQ = 31 * MiB, WS_WUKV = 34 * MiB, WS_WO = 38 * MiB;
constexpr size_t WS_WUP = 46 * MiB  , WS_WDN = 110 * MiB  ;
constexpr size_t WS_XN = 176 * MiB;
constexpr size_t WS_HB = 304 * MiB;
constexpr size_t WS_BIG = 432 * MiB;
constexpr size_t WS_PROJ = WS_BIG, WS_MIX = WS_BIG + 288 * MiB;
constexpr size_t WS_HID = WS_BIG;
constexpr size_t WS_LAT = WS_BIG;
constexpr size_t WS_Q = WS_BIG, WS_KV = WS_BIG + 192 * MiB, WS_CQN = WS_BIG + 448 * MiB, WS_CKVN = WS_BIG + 480 * MiB, WS_KROPE = WS_BIG + 512 * MiB;
constexpr size_t WS_AO = WS_XN;
constexpr size_t WS_CTL = WS_BIG + 516 * MiB, CTL_BAR = 65536, WS_SS = WS_CTL + CTL_BAR, CTL_BYTES = CTL_BAR + 3 * 131072;
constexpr size_t WS_END = WS_CTL + CTL_BYTES;

__device__ __forceinline__ float bflo(unsigned u) { return __uint_as_float(u << 16); }
__device__ __forceinline__ float bfhi(unsigned u) { return __uint_as_float(u & 0xffff0000u); }
__device__ __forceinline__ unsigned pk2(float lo, float hi) { unsigned r; asm volatile("v_cvt_pk_bf16_f32 %0, %1, %2" : "=v"(r) : "v"(lo), "v"(hi)); return r; }
__device__ __forceinline__ float wave_sum(float v) {
#pragma unroll
    for (int o = 1; o < 64; o <<= 1) v += __shfl_xor(v, o);
    return v;
}
__device__ __forceinline__ void rope_cs(float pos, float invf, float& c, float& s) {
    const float a = pos * invf;
    double rev = (double)a * 0.15915494309189535;
    rev -= __builtin_rint(rev);
    const float fr = (float)rev;
    c = __builtin_amdgcn_cosf(fr); s = __builtin_amdgcn_sinf(fr);
}

__device__ __forceinline__ void transpose_item(const float* __restrict__ W, const float* __restrict__ gain, float mul, int K, int N, u16* __restrict__ WT, LAS float* scr, int item, int lane) {
    const int nblk = N / 32, kb = item / nblk, nb = item % nblk, k0 = 64 * kb, n0 = 32 * nb;
#pragma unroll 8
    for (int i = 0; i < 32; ++i) { const int kk = 2 * i + (lane >> 5); float w = W[(size_t)(k0 + kk) * N + n0 + (lane & 31)]; if (gain) w *= gain[k0 + kk] * mul; scr[kk * 33 + (lane & 31)] = w; }
    asm volatile("s_waitcnt lgkmcnt(0)" ::: "memory");
    const int c = lane & 7;
#pragma unroll
    for (int j = 0; j < 4; ++j) { const int n = (lane >> 3) + 8 * j; const LAS float* s = scr + (8 * c) * 33 + n;
        u32x4 o; o.x = pk2(s[0 * 33], s[1 * 33]); o.y = pk2(s[2 * 33], s[3 * 33]); o.z = pk2(s[4 * 33], s[5 * 33]); o.w = pk2(s[6 * 33], s[7 * 33]);
        *(u32x4*)(WT + (size_t)(n0 + n) * K + k0 + 8 * c) = o; }
    asm volatile("s_waitcnt lgkmcnt(0)" ::: "memory");
}

__device__ __forceinline__ void norm_row_bf16(const float* __restrict__ xrow, u16* __restrict__ orow, int lane) {
    const f32x4* xr = (const f32x4*)xrow + lane;
    f32x4 v[8]; float s = 0.f;
#pragma unroll
    for (int j = 0; j < 8; ++j) { v[j] = xr[64 * j]; s += (v[j].x * v[j].x + v[j].y * v[j].y) + (v[j].z * v[j].z + v[j].w * v[j].w); }
    const float r = 1.0f / sqrtf(wave_sum(s) * (1.f / DM) + EPS);
    u32x2* o8 = (u32x2*)orow + lane;
#pragma unroll
    for (int j = 0; j < 8; ++j) { u32x2 w; w.x = pk2(v[j].x * r, v[j].y * r); w.y = pk2(v[j].z * r, v[j].w * r); o8[64 * j] = w; }
}
__device__ __forceinline__ void norm_row_b2b(const u16* __restrict__ hrow, u16* __restrict__ orow, int lane) {
    const u32x4* xr = (const u32x4*)hrow + lane;
    u32x4 w[4]; float s = 0.f;
#pragma unroll
    for (int j = 0; j < 4; ++j) { w[j] = xr[64 * j];
#pragma unroll
        for (int e = 0; e < 4; ++e) { const float a = bflo(w[j][e]), b = bfhi(w[j][e]); s += a * a + b * b; } }
    const float r = 1.0f / sqrtf(wave_sum(s) * (1.f / DM) + EPS);
    u32x4* o = (u32x4*)orow + lane;
#pragma unroll
    for (int j = 0; j < 4; ++j) { u32x4 v;
#pragma unroll
        for (int e = 0; e < 4; ++e) v[e] = pk2(bflo(w[j][e]) * r, bfhi(w[j][e]) * r);
        o[64 * j] = v; }
}
__device__ __forceinline__ void norm_row_final(const u16* __restrict__ hrow, float* __restrict__ orow, const float* __restrict__ g, int lane) {
    const u32x4* xr = (const u32x4*)hrow + lane;
    u32x4 w[4]; float s = 0.f;
#pragma unroll
    for (int j = 0; j < 4; ++j) { w[j] = xr[64 * j];
#pragma unroll
        for (int e = 0; e < 4; ++e) { const float a = bflo(w[j][e]), b = bfhi(w[j][e]); s += a * a + b * b; } }
    const float r = 1.0f / sqrtf(wave_sum(s) * (1.f / DM) + EPS);
#pragma unroll
    for (int j = 0; j < 4; ++j) { const int c = (64 * j + lane) * 8; const f32x4 g0 = *(const f32x4*)(g + c), g1 = *(const f32x4*)(g + c + 4);
        f32x4 o0 = {bflo(w[j][0]) * r * g0[0], bfhi(w[j][0]) * r * g0[1], bflo(w[j][1]) * r * g0[2], bfhi(w[j][1]) * r * g0[3]};
        f32x4 o1 = {bflo(w[j][2]) * r * g1[0], bfhi(w[j][2]) * r * g1[1], bflo(w[j][3]) * r * g1[2], bfhi(w[j][3]) * r * g1[3]};
        *(f32x4*)(orow + c) = o0; *(f32x4*)(orow + c + 4) = o1; }
}

__device__ __forceinline__ void ld8f(const u16* p, float* f) {
    const u32x4 w = *(const u32x4*)p;
    f[0] = bflo(w.x); f[1] = bfhi(w.x); f[2] = bflo(w.y); f[3] = bfhi(w.y); f[4] = bflo(w.z); f[5] = bfhi(w.z); f[6] = bflo(w.w); f[7] = bfhi(w.w);
}

__device__ __forceinline__ void ew0_token(int t, u16* __restrict__ PROJ, u16* __restrict__ MIX, const float* __restrict__ qg, const float* __restrict__ kg, const float* __restrict__ cw, int lane) {
    const int s = t & (SEQ - 1), row = s >> 6, col = s & 63;
    float c, sn; { const int j = lane & 31; const float invf = __builtin_amdgcn_exp2f(-(float)j * (LOG2_THETA / 32.f)); rope_cs((float)(lane < 32 ? row : col), invf, c, sn); }
    unsigned* pr = (unsigned*)(PROJ + (size_t)t * IN0);
    const float qg0 = qg[2 * lane], qg1 = qg[2 * lane + 1], kg0 = kg[2 * lane], kg1 = kg[2 * lane + 1];
#pragma unroll
    for (int h = 0; h < 10; ++h) {
        const unsigned u = pr[h * 64 + lane]; const float x1 = bflo(u), x2 = bfhi(u);
        const float ss = wave_sum(x1 * x1 + x2 * x2); const float r = 1.0f / sqrtf(ss * (1.f / 128.f) + EPS);
        const float y1 = x1 * r * (h < 8 ? qg0 * att::Cfg<128>::C : kg0), y2 = x2 * r * (h < 8 ? qg1 * att::Cfg<128>::C : kg1);
        pr[h * 64 + lane] = pk2(y1 * c - y2 * sn, y1 * sn + y2 * c);
    }
    const u16* p0 = PROJ + (size_t)t * IN0;
#pragma unroll
    for (int ch = 0; ch < 2; ++ch) {
        const int cc = ch * 512 + lane * 8;
        float gb[8], g0[8], u0[8], gm[8], um[8], gp[8], up[8];
        ld8f(p0 + 1536 + cc, gb); ld8f(p0 + 2560 + cc, g0); ld8f(p0 + 3584 + cc, u0);
        if (s > 0) { ld8f(p0 - IN0 + 2560 + cc, gm); ld8f(p0 - IN0 + 3584 + cc, um); } else {
#pragma unroll
            for (int e = 0; e < 8; ++e) { gm[e] = 0.f; um[e] = 0.f; } }
        if (s < SEQ - 1) { ld8f(p0 + IN0 + 2560 + cc, gp); ld8f(p0 + IN0 + 3584 + cc, up); } else {
#pragma unroll
            for (int e = 0; e < 8; ++e) { gp[e] = 0.f; up[e] = 0.f; } }
        float o[8];
#pragma unroll
        for (int e = 0; e < 8; ++e) o[e] = gb[e] * (cw[cc + e] * (gm[e] * um[e]) + cw[1024 + cc + e] * (g0[e] * u0[e]) + cw[2048 + cc + e] * (gp[e] * up[e]));
        u32x4 w; w.x = pk2(o[0], o[1]); w.y = pk2(o[2], o[3]); w.z = pk2(o[4], o[5]); w.w = pk2(o[6], o[7]);
        *(u32x4*)(MIX + (size_t)t * DM + 1024 + cc) = w;
    }
}
__device__ __forceinline__ void ew1_token(int t, const u16* __restrict__ LAT, u16* __restrict__ CQN, u16* __restrict__ CKVN, u16* __restrict__ KROPE, int lane) {
    const u16* p0 = LAT + (size_t)t * NLATP;
#pragma unroll
    for (int part = 0; part < 2; ++part) {
        float x[8]; ld8f(p0 + part * 512 + lane * 8, x);
        float ss = 0.f;
#pragma unroll
        for (int e = 0; e < 8; ++e) ss += x[e] * x[e];
        const float r = 1.0f / sqrtf(wave_sum(ss) * (1.f / 512.f) + EPS);
        u32x4 w; w.x = pk2(x[0] * r, x[1] * r); w.y = pk2(x[2] * r, x[3] * r); w.z = pk2(x[4] * r, x[5] * r); w.w = pk2(x[6] * r, x[7] * r);
        *(u32x4*)((part ? CKVN : CQN) + (size_t)t * 512 + lane * 8) = w;
    }
    if (lane < 32) {
        const int s = t & (SEQ - 1), row = s >> 6, col = s & 63; const int j = lane & 15;
        const float invf = __builtin_amdgcn_exp2f(-(float)j * (LOG2_THETA / 16.f)); float c, sn; rope_cs((float)(lane < 16 ? row : col), invf, c, sn);
        const unsigned u = *(const unsigned*)(p0 + 1024 + 2 * lane); const float x1 = bflo(u), x2 = bfhi(u);
        *(unsigned*)(KROPE + (size_t)t * 64 + 2 * lane) = pk2(x1 * c - x2 * sn, x1 * sn + x2 * c);
    }
}
__device__ __forceinline__ void ew2_token(int t, u16* __restrict__ Q, int lane) {
    const int s = t & (SEQ - 1), row = s >> 6, col = s & 63;
    const int h = lane >> 2, part = lane & 3; const float pos = (float)(part < 2 ? row : col);
    u16* p = Q + (size_t)t * NQ + h * 192 + 128 + part * 16;
    float x[16]; ld8f(p, x); ld8f(p + 8, x + 8);
    unsigned w[8];
#pragma unroll
    for (int i = 0; i < 8; ++i) { const int j = (part & 1) * 8 + i; const float invf = __builtin_amdgcn_exp2f(-(float)j * (LOG2_THETA / 16.f)); float c, sn; rope_cs(pos, invf, c, sn);
        w[i] = pk2(x[2 * i] * c - x[2 * i + 1] * sn, x[2 * i] * sn + x[2 * i + 1] * c); }
    *(u32x4*)p = (u32x4){w[0], w[1], w[2], w[3]}; *(u32x4*)(p + 8) = (u32x4){w[4], w[5], w[6], w[7]};
}

#define RLX_AGENT __ATOMIC_RELAXED, __HIP_MEMORY_SCOPE_AGENT
#define XB_TMO      128
#define XB_XCNT(j)  (256  + 64 * (j))
#define XB_XSUB(j)  (1280 + 64 * (j))
#define XB_XGEN(j)  (2304 + 64 * (j))
#define XB_TOP      3328
#define XB_TOPGEN   3392
#define XCD_BAR_WORDS 3456
#define XB_SPIN_CAP (1u << 22)

__device__ __forceinline__ unsigned xb_ld(unsigned* p)              { return __hip_atomic_load(p, __ATOMIC_RELAXED, __HIP_MEMORY_SCOPE_AGENT); }
__device__ __forceinline__ unsigned xb_add(unsigned* p, unsigned v) { return __hip_atomic_fetch_add(p, v, __ATOMIC_RELAXED, __HIP_MEMORY_SCOPE_AGENT); }
__device__ __forceinline__ unsigned xb_xcc_id() { return (unsigned)__builtin_amdgcn_s_getreg((3 << 11) | 20) & 0xFu; }
#define XB_SPIN(cond, bar) do { unsigned _sp = 0; while (cond) { __builtin_amdgcn_s_sleep(1); \
    if ((++_sp & 255u) == 0u) { if (xb_ld(&(bar)[XB_TMO])) break; if (_sp > XB_SPIN_CAP) { atomicAdd(&(bar)[XB_TMO], 1u); break; } } } } while (0)

struct XcdBarrier {
    unsigned* bar; unsigned x;
    volatile LAS unsigned* st;
};

__device__ __forceinline__ XcdBarrier xcd_barrier_post(unsigned* bar, volatile LAS unsigned* st) {
    XcdBarrier b; b.bar = bar; b.x = xb_xcc_id(); b.st = st;
    if (threadIdx.x == 0) (void)xb_add(&bar[XB_XCNT(b.x)], 1u);
    return b;
}
__device__ __forceinline__ void xcd_barrier_complete(unsigned* bar, unsigned x, unsigned& nloc, unsigned& nx) {
    const unsigned G = gridDim.x * gridDim.y * gridDim.z;
    unsigned sum, cnt, mine, sp = 0u;
    for (;;) {
        sum = 0u; cnt = 0u; mine = 0u;
#pragma unroll
        for (unsigned j = 0; j < 16; ++j) { const unsigned c = xb_ld(&bar[XB_XCNT(j)]); sum += c; cnt += (c > 0u) ? 1u : 0u; mine = (j == x) ? c : mine; }
        if (sum == G) break;
        __builtin_amdgcn_s_sleep(1);
        if ((++sp & 255u) == 0u) { if (xb_ld(&bar[XB_TMO])) break; if (sp > XB_SPIN_CAP) { atomicAdd(&bar[XB_TMO], 1u); break; } }
    }
    nloc = mine > 0u ? mine : 1u; nx = cnt > 0u ? cnt : 1u;
}

__device__ __forceinline__ void xcd_barrier(const XcdBarrier& b) {
    asm volatile("s_waitcnt vmcnt(0)" ::: "memory");
    __syncthreads();
    if (threadIdx.x == 0) {
        unsigned* bar = b.bar;
        __builtin_amdgcn_s_waitcnt(0);
        unsigned nloc = b.st[0], nx = b.st[1];
        if (nloc == 0u) { xcd_barrier_complete(bar, b.x, nloc, nx); b.st[0] = nloc; b.st[1] = nx; }
        const unsigned old = xb_add(&bar[XB_XSUB(b.x)], 1u);
        const unsigned gen = old / nloc;
        if (old + 1u == (gen + 1u) * nloc) {
            __builtin_amdgcn_fence(__ATOMIC_RELEASE, "agent");
            asm volatile("s_waitcnt vmcnt(0)" ::: "memory");
            const unsigned og = xb_add(&bar[XB_TOP], 1u);
            const unsigned tg = og / nx;
            if (og + 1u == (tg + 1u) * nx) xb_add(&bar[XB_TOPGEN], 1u);
            else XB_SPIN(xb_ld(&bar[XB_TOPGEN]) == tg, bar);
            __builtin_amdgcn_fence(__ATOMIC_ACQUIRE, "agent");
            xb_add(&bar[XB_XGEN(b.x)], 1u);
            asm volatile("s_waitcnt vmcnt(0)" ::: "memory");
        } else {
            XB_SPIN(xb_ld(&bar[XB_XGEN(b.x)]) == gen, bar);
            __builtin_amdgcn_fence(__ATOMIC_ACQUIRE, "agent");
            asm volatile("s_waitcnt vmcnt(0)" ::: "memory");
        }
    }
    __syncthreads();
}

struct Params { const float* in[18]; float* out; unsigned char* ws; int ph_lo, ph_hi; };
enum { I_X = 0, I_ENG, I_EWIN, I_EQG, I_EKG, I_ECW, I_EWOUT, I_ONG, I_OWDOWN, I_OQG, I_OKVG, I_OWUQ, I_OWUKV, I_OWO, I_MNG, I_MWUP, I_MWDN, I_FNG };
constexpr int NPHASE = 19;

template <int DQK> __device__ __forceinline__ bool attn_next(int i, int NU, int& unit) {
    const int G = gridDim.x, bx = blockIdx.x;
    if ((G & 7) == 0 && (NU & 7) == 0) { const int x = bx & 7, j = bx >> 3, per = G >> 3, upx = NU >> 3; const int k = i * per + j; if (k >= upx) return false; unit = x * upx + k; return true; }
    const int k = i * G + bx; if (k >= NU) return false; unit = k; return true;
}

__global__ void __launch_bounds__(NTHREADS, 2) fwd_mega(Params P) {
    extern __shared__ __attribute__((aligned(16))) unsigned char lds[];
    cg::grid_group grid = cg::this_grid();
    const int tid = threadIdx.x, lane = tid & 63, wave = __builtin_amdgcn_readfirstlane(tid >> 6);
    const int G = gridDim.x, gw = blockIdx.x * NWAVES + wave, NGW = G * NWAVES;
    unsigned char* ws = P.ws;
    u16* Win = (u16*)(ws + WS_WIN); u16* Wout = (u16*)(ws + WS_WOUT); u16* Wdown = (u16*)(ws + WS_WDOWN); u16* Wuq = (u16*)(ws + WS_WUQ); u16* Wukv = (u16*)(ws + WS_WUKV); u16* Wo = (u16*)(ws + WS_WO);
    u16* Wup = (u16*)(ws + WS_WUP); u16* Wdn = (u16*)(ws + WS_WDN);
    u16* XN = (u16*)(ws + WS_XN); u16* PROJ = (u16*)(ws + WS_PROJ); u16* MIX = (u16*)(ws + WS_MIX); u16* HID = (u16*)(ws + WS_HID);
    u16* LAT = (u16*)(ws + WS_LAT); u16* CQN = (u16*)(ws + WS_CQN); u16* CKVN = (u16*)(ws + WS_CKVN); u16* KROPE = (u16*)(ws + WS_KROPE);
    u16* Qm = (u16*)(ws + WS_Q); u16* KVm = (u16*)(ws + WS_KV); u16* AO = (u16*)(ws + WS_AO);
    u16* HB = (u16*)(ws + WS_HB); float* SS0 = (float*)(ws + WS_SS); float* SS1 = SS0 + T; float* SS2 = SS1 + T; const float* NOSS = nullptr; float* NOSSW = nullptr;
    LAS unsigned char* ldsl = (LAS unsigned char*)lds;
    const int lo = P.ph_lo, hi = P.ph_hi;
    volatile LAS unsigned* xst = (volatile LAS unsigned*)(ldsl + LDS_BYTES - 16);
    if (tid < 4) xst[tid] = 0u;
    __syncthreads();
    XcdBarrier xbar = xcd_barrier_post((unsigned*)(ws + WS_CTL), xst);
#define PH(k) if (lo <= (k) && (k) < hi) _Pragma("unroll") for (int rep_ = 0; rep_ <= (int)((REP_MASK >> (k)) & 1u); ++rep_)
#define SEAM(k) do { if (lo <= (k) && (k) + 1 < hi) { if ((k) == 0) grid.sync(); else xcd_barrier(xbar); } } while (0)
#define GEMM_BF16(ACT, Aptr, Bptr, Mv, Nv, Kv, Optr, ldc, ssptr) do { pg8::Gemm g{Aptr, Bptr, Mv, Nv, Kv}; pg8::StaticOrder S; S.init(Mv, Nv, G, (int)blockIdx.x); \
        pg8::EpiBf16<ACT> E{Optr, ldc, ssptr, 1.0f / (float)(Kv), EPS}; pg8::gemm_phase<pg8::EpiBf16<ACT>, pg8::StaticOrder, true, true>(ldsl, g, S, E); } while (0)
#define GEMM_RES(F32B, Aptr, Bptr, Mv, Nv, Kv, baseptr, ssptr) do { pg8::Gemm g{Aptr, Bptr, Mv, Nv, Kv}; pg8::StaticOrder S; S.init(Mv, Nv, G, (int)blockIdx.x); \
        pg8::EpiResB<F32B> E{baseptr, HB, Nv, ssptr}; pg8::gemm_phase<pg8::EpiResB<F32B>, pg8::StaticOrder, true, true>(ldsl, g, S, E); } while (0)
#define NORM_PHASE() do { for (int m = gw; m < T; m += NGW) norm_row_b2b(HB + (size_t)m * DM, XN + (size_t)m * DM, lane); } while (0)

    PH(0) {
        LAS float* scr = (LAS float*)(ldsl + wave * 16384);
        constexpr int I0 = (DM / 64) * (IN0 / 32), I1 = (DM / 64) * (DM / 32), I2 = (DM / 64) * (NLAT / 32), I3 = (512 / 64) * (NQ / 32), I4 = (512 / 64) * (NKV / 32), I5 = I1;
        constexpr int I6 = (DM / 64) * (DFF / 32), I7 = (DFF / 64) * (DM / 32);
        constexpr int NITEMS = I0 + I1 + I2 + I3 + I4 + I5 + 2 * I6 + 2 * I7;
        for (int it = gw; it < NITEMS; it += NGW) {
            int r = it;
            if (r < I0) { transpose_item(P.in[I_EWIN], P.in[I_ENG], 1.f, DM, IN0, Win, scr, r, lane); continue; } r -= I0;
            if (r < I1) { transpose_item(P.in[I_EWOUT], nullptr, 1.f, DM, DM, Wout, scr, r, lane); continue; } r -= I1;
            if (r < I2) { transpose_item(P.in[I_OWDOWN], P.in[I_ONG], 1.f, DM, NLAT, Wdown, scr, r, lane); continue; } r -= I2;
            if (r < I3) { transpose_item(P.in[I_OWUQ], P.in[I_OQG], att::Cfg<192>::C, 512, NQ, Wuq, scr, r, lane); continue; } r -= I3;
            if (r < I4) { transpose_item(P.in[I_OWUKV], P.in[I_OKVG], 1.f, 512, NKV, Wukv, scr, r, lane); continue; } r -= I4;
            if (r < I5) { transpose_item(P.in[I_OWO], nullptr, 1.f, DM, DM, Wo, scr, r, lane); continue; } r -= I5;
            if (r < I6) { transpose_item(P.in[I_MWUP], P.in[I_MNG], 1.f, DM, DFF, Wup, scr, r, lane); continue; } r -= I6;
            if (r < I6) { transpose_item(P.in[I_MWUP] + (size_t)DM * DFF, P.in[I_MNG] + DM, 1.f, DM, DFF, Wup + (size_t)DM * DFF, scr, r, lane); continue; } r -= I6;
            if (r < I7) { transpose_item(P.in[I_MWDN], nullptr, 1.f, DFF, DM, Wdn, scr, r, lane); continue; } r -= I7;
            transpose_item(P.in[I_MWDN] + (size_t)DM * DFF, nullptr, 1.f, DFF, DM, Wdn + (size_t)DM * DFF, scr, r, lane);
        }
        { const size_t n16 = (size_t)(NLATP - NLAT) * DM * 2 / 16; u32x4* z = (u32x4*)(Wdown + (size_t)NLAT * DM);
          for (size_t i = (size_t)blockIdx.x * NTHREADS + tid; i < n16; i += (size_t)G * NTHREADS) z[i] = (u32x4){0u, 0u, 0u, 0u}; }
        for (int m = gw; m < T; m += NGW) norm_row_bf16(P.in[I_X] + (size_t)m * DM, XN + (size_t)m * DM, lane);
    }
    SEAM(0);
    PH(1) { GEMM_BF16(0, XN, Win, T, IN0, DM, PROJ, IN0, NOSS); }
    SEAM(1);
    PH(2) { const int per = (T + NGW - 1) / NGW; const int t0 = gw * per; for (int t = t0; t < t0 + per && t < T; ++t) ew0_token(t, PROJ, MIX, P.in[I_EQG], P.in[I_EKG], P.in[I_ECW], lane); }
    SEAM(2);
    PH(3) {
        if (ATT_PRIO && wave >= 4) __builtin_amdgcn_s_setprio(1);
        constexpr int NU = BATCH * 8 * (SEQ / 256); int unit;
        for (int i = 0; attn_next<128>(i, NU, unit); ++i) {
            const int bh = unit / (SEQ / 256), qb = unit % (SEQ / 256), b = bh >> 3, hq = bh & 7, kvh = hq >> 2;
            const size_t tb = (size_t)b * SEQ;
#ifndef NO_GQA
            att::attn_unit<128, IN0, IN0, IN0, DM, GQA_SD>(PROJ + (tb + (size_t)qb * 256) * IN0 + hq * 128, PROJ + tb * IN0 + 1024 + kvh * 128, nullptr, PROJ + tb * IN0 + 1280 + kvh * 128,
                                                      MIX + (tb + (size_t)qb * 256) * DM + hq * 128, SEQ, (char*)lds);
#endif
        }
    }
    if (ATT_PRIO) __builtin_amdgcn_s_setprio(0);
    SEAM(3);
    PH(4) { GEMM_RES(true, MIX, Wout, T, DM, DM, (const void*)P.in[I_X], SS0); }
    SEAM(4);
    PH(6) { GEMM_BF16(2, HB, Wup, T, DFF, DM, HID, DFF, (const float*)SS0); }
    SEAM(6);
    PH(7) { GEMM_RES(false, HID, Wdn, T, DM, DFF, (const void*)HB, SS1); }
    SEAM(7);
    PH(9) { GEMM_BF16(0, HB, Wdown, T, NLATP, DM, LAT, NLATP, (const float*)SS1); }
    SEAM(9);
    PH(10) { for (int t = gw; t < T; t += NGW) ew1_token(t, LAT, CQN, CKVN, KROPE, lane); }
    SEAM(10);
    PH(11) { GEMM_BF16(0, CQN, Wuq, T, NQ, 512, Qm, NQ, NOSS); GEMM_BF16(0, CKVN, Wukv, T, NKV, 512, KVm, NKV, NOSS); }
    SEAM(11);
    PH(12) { for (int t = gw; t < T; t += NGW) ew2_token(t, Qm, lane); }
    SEAM(12);
    PH(13) {
        if (ATT_PRIO && wave >= 4) __builtin_amdgcn_s_setprio(1);
        constexpr int NU = BATCH * 16 * (SEQ / 256); int unit;
        for (int i = 0; attn_next<192>(i, NU, unit); ++i) {
            const int bh = unit / (SEQ / 256), qb = unit % (SEQ / 256), b = bh >> 4, h = bh & 15;
            const size_t tb = (size_t)b * SEQ;
#ifndef NO_MLA
            att::attn_unit<192, NQ, NKV, NKV, DM, MLA_SD>(Qm + (tb + (size_t)qb * 256) * NQ + h * 192, KVm + tb * NKV + h * 256, KROPE + tb * 64, KVm + tb * NKV + h * 256 + 128,
                                                          AO + (tb + (size_t)qb * 256) * DM + h * 128, SEQ, (char*)lds);
#endif
        }
    }
    if (ATT_PRIO) __builtin_amdgcn_s_setprio(0);
    SEAM(13);
    PH(14) { GEMM_RES(false, AO, Wo, T, DM, DM, (const void*)HB, SS2); }
    SEAM(14);
    PH(16) { GEMM_BF16(2, HB, Wup + (size_t)DM * DFF, T, DFF, DM, HID, DFF, (const float*)SS2); }
    SEAM(16);
    PH(17) { GEMM_RES(false, HID, Wdn + (size_t)DM * DFF, T, DM, DFF, (const void*)HB, NOSSW); }
    SEAM(17);
    PH(18) { for (int m = gw; m < T; m += NGW) norm_row_final(HB + (size_t)m * DM, P.out + (size_t)m * DM, P.in[I_FNG], lane); }
#undef PH
#undef SEAM
}

extern "C" void kernel_launch(void* const* d_in, const int* in_sizes, int n_in, void* d_out, int out_size, void* d_ws, size_t ws_size, hipStream_t stream) {
    static int grid = 0;
    if (grid == 0) {
        if (n_in != 18 || in_sizes[0] != T * DM || out_size != T * DM || ws_size < WS_END) {
            fprintf(stderr, "kernel_launch: shape mismatch (n_in %d in0 %d out %d ws %zu need %zu)\n", n_in, n_in > 0 ? in_sizes[0] : -1, out_size, ws_size, (size_t)WS_END); grid = -1; return; }
        int dev = 0, cus = 0, per_cu = 0;
        hipGetDevice(&dev); hipDeviceGetAttribute(&cus, hipDeviceAttributeMultiprocessorCount, dev);
        if (hipFuncSetAttribute((const void*)fwd_mega, hipFuncAttributeMaxDynamicSharedMemorySize, LDS_BYTES) != hipSuccess) { fprintf(stderr, "kernel_launch: hipFuncSetAttribute failed\n"); grid = -1; return; }
        if (hipOccupancyMaxActiveBlocksPerMultiprocessor(&per_cu, (const void*)fwd_mega, NTHREADS, LDS_BYTES) != hipSuccess || per_cu < 1) { fprintf(stderr, "kernel_launch: occupancy query says %d\n", per_cu); per_cu = 1; }
        (void)hipGetLastError();
        grid = cus * per_cu;
        fprintf(stderr, "kernel_launch: grid %d (cus %d x %d)\n", grid, cus, per_cu);
    }
    if (grid < 0) return;
    if (hipMemsetAsync((char*)d_ws + WS_CTL, 0, CTL_BYTES, stream) != hipSuccess) { fprintf(stderr, "kernel_launch: memset failed\n"); return; }
    Params p{};
    for (int i = 0; i < 18; ++i) p.in[i] = (const float*)d_in[i];
    p.out = (float*)d_out; p.ws = (unsigned char*)d_ws;
#if N_LAUNCH_SPLIT
    for (int k = 0; k < NPHASE; ++k) { p.ph_lo = k; p.ph_hi = k + 1; void* args[] = {&p};
        hipError_t e = hipLaunchCooperativeKernel((const void*)fwd_mega, dim3(grid), dim3(NTHREADS), args, LDS_BYTES, stream);
        if (e != hipSuccess) { fprintf(stderr, "cooperative launch failed: %s (grid %d)\n", hipGetErrorString(e), grid); break; } }
#else
    p.ph_lo = 0; p.ph_hi = NPHASE; void* args[] = {&p};
    hipError_t e = hipLaunchCooperativeKernel((const void*)fwd_mega, dim3(grid), dim3(NTHREADS), args, LDS_BYTES, stream);
    if (e != hipSuccess) fprintf(stderr, "cooperative launch failed: %s (grid %d)\n", hipGetErrorString(e), grid);
#endif
}
```

```cpp
#include <hip/hip_runtime.h>
#include <hip/hip_cooperative_groups.h>
#include <cstdio>
#include <cstdint>
namespace cg = cooperative_groups;
#ifndef GQA_SD
#define GQA_SD 1
#endif
#ifndef MLA_SD
#define MLA_SD 1
#endif
#ifndef MLA_QREG
#define MLA_QREG 8
#endif
#ifndef REP_MASK
#define REP_MASK 0u
#endif
#ifndef ATT_NVA128
#define ATT_NVA128 5
#endif
#ifndef ATT_NVA192
#define ATT_NVA192 3
#endif
#ifndef ATT_NVB
#define ATT_NVB 2
#endif
#ifndef ATT_PREA
#define ATT_PREA 4
#endif
#ifndef ATT_LEAD128
#define ATT_LEAD128 0
#endif
#ifndef ATT_NVL128
#define ATT_NVL128 7
#endif
#ifndef ATT_LEAD192
#define ATT_LEAD192 0
#endif
#ifndef ATT_NVL192
#define ATT_NVL192 8
#endif
#ifndef ATT_PREB
#define ATT_PREB 8
#endif
#ifndef ATT_PRIO
#define ATT_PRIO 0
#endif
#ifndef ATT_PRIOMODE
#define ATT_PRIOMODE 0
#endif
#ifndef ATT_TWAVE
#define ATT_TWAVE 0
#endif
#ifndef ATT_KEYMASK128
#define ATT_KEYMASK128 15
#endif
#ifndef ATT_MG192
#define ATT_MG192 2
#endif
#ifndef ATT_DS192
#define ATT_DS192 2
#endif
#ifndef ATT_UNIT
#define ATT_UNIT attn_unit_dma
#endif
#ifndef N_LAUNCH_SPLIT
#define N_LAUNCH_SPLIT 0
#endif
namespace pg8 {
#define PG8_LAS __attribute__((address_space(3)))
typedef unsigned short bf16_t;
typedef short bf16x8 __attribute__((ext_vector_type(8)));
typedef float f32x4 __attribute__((ext_vector_type(4)));
typedef unsigned u32x4 __attribute__((ext_vector_type(4)));
constexpr int BM = 256, BK = 64, HALF = 128, HTB = HALF * BK * 2  , STAGE_BYTES = 8 * HTB, NXCD = 8, WGM = 8;

__host__ __device__ __forceinline__ int lds_byte(int r, int c) { const int st = (r >> 4) * 2 + (c >> 5), rr = r & 15, cc = c & 31, ob = rr * 64 + cc * 2; return st * 1024 + (ob ^ (((ob >> 9) & 1) << 5)); }
__host__ __device__ __forceinline__ void stage_rc(int b, int& R, int& C) { const int st = b / 1024, sb = b % 1024, swz = sb ^ (((sb >> 9) & 1) << 5); R = (st >> 1) * 16 + swz / 64; C = (st & 1) * 32 + (swz % 64) / 2; }
__host__ __device__ __forceinline__ int perm32(int rho) { const int n = rho >> 4, i = rho & 15; return 8 * (i >> 2) + 4 * n + (i & 3); }

struct Unit { int pm, pn; };
struct Gemm { const bf16_t* A; const bf16_t* Bt; int M, N, K, lda; };

struct StaticOrder {
    int nM, nN, nwg, G, c;
    __host__ __device__ void init(int M, int N, int G_, int c_) { nM = M / BM; nN = N / BM; nwg = nM * nN; G = G_; c = c_; }
    __host__ __device__ bool next(int i, Unit& u) const {
        const long L = (long)i * G + c; if (L >= nwg) return false;
        int wgid = (int)L; { const int q = nwg / NXCD, r = nwg % NXCD, xcd = wgid % NXCD, off = wgid / NXCD; wgid = (xcd < r ? xcd * (q + 1) : r * (q + 1) + (xcd - r) * q) + off; }
        const int nig = WGM * nN, gid = wgid / nig, fm = gid * WGM, gsz = (nM - fm) < WGM ? (nM - fm) : WGM;
        u.pm = fm + ((wgid % nig) % gsz); u.pn = (wgid % nig) / gsz; return true;
    }
    __device__ __forceinline__ void a_ready(const Unit&) const {}
    __device__ __forceinline__ void done(const Unit&) const {}
};
__device__ __forceinline__ unsigned cvt_pk_bf16(float lo, float hi) { unsigned r; asm volatile("v_cvt_pk_bf16_f32 %0, %1, %2" : "=v"(r) : "v"(lo), "v"(hi)); return r; }
template <int ACT> struct EpiBf16 {
    static constexpr bool PERM = true, AFTER_DRAIN = false;
    bf16_t* O; int ldc; const float* ss; float inv_k, eps;
    float* sso0; float* sso1;
    __device__ __forceinline__ void operator()(const f32x4 (&acc)[2][2][4][2], const Unit& u, int wr, int wc, int fr, int fq) const {
        const int row0 = u.pm * BM + wr * 64 + fr; const int col0 = u.pn * BM + wc * 32 + 8 * fq;
#pragma unroll
        for (int ai = 0; ai < 2; ++ai)
#pragma unroll
            for (int m = 0; m < 4; ++m) { const int row = row0 + ai * HALF + m * 16; bf16_t* rowp = O + (size_t)row * ldc + col0;
                const float rs = ss ? (1.0f / sqrtf(ss[row] * inv_k + eps)) : 1.0f;
                float q = 0.f;
#pragma unroll
                for (int bj = 0; bj < 2; ++bj) { f32x4 v0 = acc[ai][bj][m][0] * rs, v1 = acc[ai][bj][m][1] * rs;
                    q += (v0[0] * v0[0] + v0[1] * v0[1]) + (v0[2] * v0[2] + v0[3] * v0[3]) + (v1[0] * v1[0] + v1[1] * v1[1]) + (v1[2] * v1[2] + v1[3] * v1[3]);
                    if (ACT == 2) {
#pragma unroll
                        for (int e = 0; e < 4; ++e) { float a = v0[e] > 0.f ? v0[e] : 0.f; v0[e] = a * a; float b = v1[e] > 0.f ? v1[e] : 0.f; v1[e] = b * b; } }
                    u32x4 w; w.x = cvt_pk_bf16(v0[0], v0[1]); w.y = cvt_pk_bf16(v0[2], v0[3]); w.z = cvt_pk_bf16(v1[0], v1[1]); w.w = cvt_pk_bf16(v1[2], v1[3]);
                    *(u32x4*)(rowp + bj * HALF) = w; }
                if (sso0) { float* so = (u.pn < 2) ? sso0 : ((u.pn < 4) ? sso1 : nullptr);
                    if (so) { q += __shfl_xor(q, 16); q += __shfl_xor(q, 32); if (fq == 0) atomicAdd(so + row, q); } } }
    }
};
template <bool BASE_F32> struct EpiResB {
    static constexpr bool PERM = true, AFTER_DRAIN = false;
    const void* base; bf16_t* out; int ldc; float* ss;
    __device__ __forceinline__ void operator()(const f32x4 (&acc)[2][2][4][2], const Unit& u, int wr, int wc, int fr, int fq) const {
        const int row0 = u.pm * BM + wr * 64 + fr; const int col0 = u.pn * BM + wc * 32 + 8 * fq;
#pragma unroll
        for (int ai = 0; ai < 2; ++ai)
#pragma unroll
            for (int m = 0; m < 4; ++m) { const size_t off = (size_t)(row0 + ai * HALF + m * 16) * ldc + col0; float q = 0.f;
#pragma unroll
                for (int bj = 0; bj < 2; ++bj) { const size_t o = off + bj * HALF; f32x4 b0, b1;
                    if constexpr (BASE_F32) { b0 = *(const f32x4*)((const float*)base + o); b1 = *(const f32x4*)((const float*)base + o + 4); }
                    else { const u32x4 w = *(const u32x4*)((const bf16_t*)base + o);
                        b0 = (f32x4){__uint_as_float(w.x << 16), __uint_as_float(w.x & 0xffff0000u), __uint_as_float(w.y << 16), __uint_as_float(w.y & 0xffff0000u)};
                        b1 = (f32x4){__uint_as_float(w.z << 16), __uint_as_float(w.z & 0xffff0000u), __uint_as_float(w.w << 16), __uint_as_float(w.w & 0xffff0000u)}; }
                    const f32x4 v0 = b0 + acc[ai][bj][m][0], v1 = b1 + acc[ai][bj][m][1];
                    q += (v0[0] * v0[0] + v0[1] * v0[1]) + (v0[2] * v0[2] + v0[3] * v0[3]) + (v1[0] * v1[0] + v1[1] * v1[1]) + (v1[2] * v1[2] + v1[3] * v1[3]);
                    u32x4 r; r.x = cvt_pk_bf16(v0[0], v0[1]); r.y = cvt_pk_bf16(v0[2], v0[3]); r.z = cvt_pk_bf16(v1[0], v1[1]); r.w = cvt_pk_bf16(v1[2], v1[3]);
                    *(u32x4*)(out + o) = r; }
                if (ss) { q += __shfl_xor(q, 16); q += __shfl_xor(q, 32); if (fq == 0) atomicAdd(ss + (row0 + ai * HALF + m * 16), q); }
                asm volatile("" ::: "memory"); }
    }
};
template <class Epi, class Sched, bool ALIGN_EPI = false, bool SP2 = false>
__device__ __forceinline__ void gemm_phase(PG8_LAS unsigned char* lds, const Gemm g, const Sched& S, const Epi& E) {
    const int tid = threadIdx.x, wid = __builtin_amdgcn_readfirstlane(tid >> 6), lane = tid & 63, wr = wid >> 2, wc = wid & 3, fr = lane & 15, fq = lane >> 4;
    const int K = g.K, nt = K / BK;
    unsigned voffA[2], voffB[2];
#pragma unroll
    for (int i = 0; i < 2; ++i) { int R, C; stage_rc(tid * 16 + i * 8192, R, C); const int Rb = Epi::PERM ? ((R & ~31) + perm32(R & 31)) : R;
        voffA[i] = (unsigned)(R * g.lda + C) * 2u; voffB[i] = (unsigned)(Rb * K + C) * 2u; }
    const size_t kstep = (size_t)(BK * 2);
    const size_t hstep = (size_t)HALF * K * 2;
    const size_t tstep = 2 * hstep;
    const size_t hstepA = (size_t)HALF * g.lda * 2, tstepA = 2 * hstepA;
    const unsigned ldsw = (unsigned)wid * 1024u;
    const int aoff = lds_byte(wr * 64 + fr, fq * 8), boff = lds_byte(wc * 32 + fr, fq * 8);
#define PG8_SA(b, h) (((b) * 2 + (h)) * HTB)
#define PG8_SB(b, h) ((4 + (b) * 2 + (h)) * HTB)
#define PG8_STAGE(bufoff, gbase, voff) do { _Pragma("unroll") for (int _i = 0; _i < 2; ++_i) \
        __builtin_amdgcn_global_load_lds((const unsigned*)((const char*)(gbase) + (voff)[_i]), (PG8_LAS unsigned*)(lds + (bufoff) + ldsw + _i * 8192), 16, 0, 0); } while (0)
#define PG8_LDA(dst, b, h) do { _Pragma("unroll") for (int m = 0; m < 4; ++m) _Pragma("unroll") for (int k = 0; k < 2; ++k) dst[m][k] = *(const PG8_LAS bf16x8*)(lds + PG8_SA(b, h) + aoff + m * 2048 + k * 1024); } while (0)
#define PG8_LDB(dst, b, h) do { _Pragma("unroll") for (int n = 0; n < 2; ++n) _Pragma("unroll") for (int k = 0; k < 2; ++k) dst[n][k] = *(const PG8_LAS bf16x8*)(lds + PG8_SB(b, h) + boff + n * 2048 + k * 1024); } while (0)
#define PG8_MMA(ai, bj, At, Bt) do { __builtin_amdgcn_s_setprio(1); _Pragma("unroll") for (int m = 0; m < 4; ++m) _Pragma("unroll") for (int n = 0; n < 2; ++n) _Pragma("unroll") for (int k = 0; k < 2; ++k) \
        acc[ai][bj][m][n] = __builtin_amdgcn_mfma_f32_16x16x32_bf16(Bt[n][k], At[m][k], acc[ai][bj][m][n], 0, 0, 0); __builtin_amdgcn_s_setprio(0); } while (0)
#define PG8_WAIT_V(n) asm volatile("s_waitcnt vmcnt(" #n ")" ::: "memory")
#define PG8_WAIT_L(n) asm volatile("s_waitcnt lgkmcnt(" #n ")" ::: "memory")
#define PG8_BAR __builtin_amdgcn_s_barrier()
#define PG8_SCHED __builtin_amdgcn_sched_barrier(0)
    Unit cur, nxt; int ui = 0;
    if (!S.next(0, cur)) return;
    f32x4 acc[2][2][4][2];
#pragma unroll
    for (int a = 0; a < 2; ++a)
#pragma unroll
        for (int b = 0; b < 2; ++b)
#pragma unroll
            for (int m = 0; m < 4; ++m)
#pragma unroll
                for (int n = 0; n < 2; ++n) acc[a][b][m][n] = (f32x4){0.f, 0.f, 0.f, 0.f};
    bf16x8 At[4][2], B0[2][2], B1[2][2];
    const char* cA = (const char*)g.A + (size_t)cur.pm * tstepA; const char* cB = (const char*)g.Bt + (size_t)cur.pn * tstep;
    S.a_ready(cur);
    if constexpr (SP2) {
        PG8_STAGE(PG8_SB(0, 0), cB, voffB); PG8_STAGE(PG8_SB(0, 1), cB + hstep, voffB); PG8_STAGE(PG8_SA(0, 0), cA, voffA); PG8_STAGE(PG8_SA(0, 1), cA + hstepA, voffA);
        if (wr == 1) PG8_BAR;
        PG8_WAIT_V(2); PG8_BAR;
        PG8_STAGE(PG8_SB(1, 0), cB + kstep, voffB); PG8_STAGE(PG8_SA(1, 0), cA + kstep, voffA); PG8_STAGE(PG8_SB(1, 1), cB + hstep + kstep, voffB);
        PG8_WAIT_V(6); PG8_BAR;
    } else {
        PG8_STAGE(PG8_SB(0, 0), cB, voffB); PG8_STAGE(PG8_SA(0, 0), cA, voffA); PG8_STAGE(PG8_SB(0, 1), cB + hstep, voffB); PG8_STAGE(PG8_SA(0, 1), cA + hstepA, voffA);
        if (wr == 1) PG8_BAR;
        PG8_WAIT_V(4); PG8_BAR;
        PG8_STAGE(PG8_SB(1, 0), cB + kstep, voffB); PG8_STAGE(PG8_SA(1, 0), cA + kstep, voffA); PG8_STAGE(PG8_SB(1, 1), cB + hstep + kstep, voffB);
        PG8_WAIT_V(6); PG8_BAR;
    }
    for (;;) {
        const bool has_next = S.next(ui + 1, nxt);
        const char* nA = has_next ? (const char*)g.A + (size_t)nxt.pm * tstepA : cA; const char* nB = has_next ? (const char*)g.Bt + (size_t)nxt.pn * tstep : cB;
        for (int t = 0; t < nt; t += 2) {
            const bool last = (t == nt - 2);
            const char* a1 = cA + (size_t)(t + 1) * kstep;
            const char* a2 = last ? nA : cA + (size_t)(t + 2) * kstep; const char* b2 = last ? nB : cB + (size_t)(t + 2) * kstep;
            const char* a3 = a2 + kstep; const char* b3 = b2 + kstep;
            if (last && has_next) S.a_ready(nxt);
            if constexpr (SP2) {
            PG8_LDB(B0, 0, 0); PG8_LDB(B1, 0, 1); PG8_SCHED; PG8_LDA(At, 0, 0); PG8_STAGE(PG8_SA(1, 1), a1 + hstepA, voffA);
            PG8_WAIT_V(8); PG8_WAIT_L(0); PG8_BAR; PG8_MMA(0, 0, At, B0); PG8_MMA(0, 1, At, B1); PG8_BAR; PG8_SCHED;
            PG8_LDA(At, 0, 1); PG8_STAGE(PG8_SB(0, 0), b2, voffB); PG8_STAGE(PG8_SB(0, 1), b2 + hstep, voffB); PG8_STAGE(PG8_SA(0, 0), a2, voffA);
            PG8_WAIT_V(8); PG8_WAIT_L(0); PG8_BAR; PG8_MMA(1, 0, At, B0); PG8_MMA(1, 1, At, B1); PG8_BAR; PG8_SCHED;
            PG8_LDB(B0, 1, 0); PG8_LDB(B1, 1, 1); PG8_SCHED; PG8_LDA(At, 1, 0); PG8_STAGE(PG8_SA(0, 1), a2 + hstepA, voffA);
            PG8_WAIT_V(8); PG8_WAIT_L(0); PG8_BAR; PG8_MMA(0, 0, At, B0); PG8_MMA(0, 1, At, B1); PG8_BAR; PG8_SCHED;
            PG8_LDA(At, 1, 1); PG8_STAGE(PG8_SB(1, 0), b3, voffB); PG8_STAGE(PG8_SB(1, 1), b3 + hstep, voffB); PG8_STAGE(PG8_SA(1, 0), a3, voffA);
            PG8_WAIT_V(8); PG8_WAIT_L(0); PG8_BAR; PG8_MMA(1, 0, At, B0); PG8_MMA(1, 1, At, B1); PG8_BAR; PG8_SCHED;
            } else {
            PG8_LDB(B0, 0, 0); PG8_SCHED; PG8_LDA(At, 0, 0); PG8_STAGE(PG8_SA(1, 1), a1 + hstepA, voffA);
            PG8_WAIT_L(8); PG8_BAR; PG8_WAIT_L(0); PG8_MMA(0, 0, At, B0); PG8_BAR; PG8_SCHED;
            PG8_LDB(B1, 0, 1); PG8_STAGE(PG8_SB(0, 0), b2, voffB);
            PG8_BAR; PG8_WAIT_L(0); PG8_MMA(0, 1, At, B1); PG8_BAR;
            PG8_LDA(At, 0, 1); PG8_STAGE(PG8_SA(0, 0), a2, voffA);
            PG8_BAR; PG8_WAIT_L(0); PG8_MMA(1, 0, At, B0); PG8_BAR; PG8_SCHED;
            PG8_STAGE(PG8_SB(0, 1), b2 + hstep, voffB);
            PG8_WAIT_V(6); PG8_BAR; PG8_MMA(1, 1, At, B1); PG8_BAR;
            PG8_LDB(B0, 1, 0); PG8_SCHED; PG8_LDA(At, 1, 0); PG8_STAGE(PG8_SA(0, 1), a2 + hstepA, voffA);
            PG8_WAIT_L(8); PG8_BAR; PG8_WAIT_L(0); PG8_MMA(0, 0, At, B0); PG8_BAR; PG8_SCHED;
            PG8_LDB(B1, 1, 1); PG8_STAGE(PG8_SB(1, 0), b3, voffB);
            PG8_BAR; PG8_WAIT_L(0); PG8_MMA(0, 1, At, B1); PG8_BAR;
            PG8_LDA(At, 1, 1); PG8_STAGE(PG8_SA(1, 0), a3, voffA);
            PG8_BAR; PG8_WAIT_L(0); PG8_MMA(1, 0, At, B0); PG8_BAR; PG8_SCHED;
            PG8_STAGE(PG8_SB(1, 1), b3 + hstep, voffB);
            PG8_WAIT_V(6); PG8_BAR; PG8_MMA(1, 1, At, B1); PG8_BAR;
            }
        }
        if constexpr (ALIGN_EPI) { if (wr == 0) PG8_BAR; }
        if constexpr (!Epi::AFTER_DRAIN) { E(acc, cur, wr, wc, fr, fq); S.done(cur); }
        if (!has_next) break;
#pragma unroll
        for (int a = 0; a < 2; ++a)
#pragma unroll
            for (int b = 0; b < 2; ++b)
#pragma unroll
                for (int m = 0; m < 4; ++m)
#pragma unroll
                    for (int n = 0; n < 2; ++n) acc[a][b][m][n] = (f32x4){0.f, 0.f, 0.f, 0.f};
        cur = nxt; cA = nA; cB = nB; ++ui;
        if constexpr (ALIGN_EPI) { if (wr == 1) PG8_BAR; }
    }
    PG8_WAIT_V(0);
    if constexpr (!ALIGN_EPI) { if (wr == 0) PG8_BAR; }
    PG8_BAR;
    if constexpr (Epi::AFTER_DRAIN) { E.fused(acc, cur, wr, wc, fr, fq, lds, wid, lane); S.done(cur); }
#undef PG8_SA
#undef PG8_SB
#undef PG8_STAGE
#undef PG8_LDA
#undef PG8_LDB
#undef PG8_MMA
#undef PG8_WAIT_V
#undef PG8_WAIT_L
#undef PG8_BAR
#undef PG8_SCHED
}
}
namespace att {
typedef unsigned short bf16;
using bf16x8 = __attribute__((ext_vector_type(8))) short;
using s16x4  = __attribute__((ext_vector_type(4))) short;
using f32x16 = __attribute__((ext_vector_type(16))) float;
using u32x4  = __attribute__((ext_vector_type(4))) unsigned;
constexpr int NW = 8, QBLK = 32, KVBLK = 64;
constexpr float THR = 8.f;
#define ATT_SBAR() __builtin_amdgcn_sched_barrier(0)
__device__ __forceinline__ int crow(int r, int hi) { return (r & 3) + 8 * (r >> 2) + 4 * hi; }
typedef float f32x2_t __attribute__((ext_vector_type(2))); typedef __bf16 bf16x2_t __attribute__((ext_vector_type(2)));
__device__ __forceinline__ unsigned cvtpk(float lo, float hi) { f32x2_t v = {lo, hi}; bf16x2_t b = __builtin_convertvector(v, bf16x2_t); return __builtin_bit_cast(unsigned, b); }
typedef short v4i16_t __attribute__((ext_vector_type(4)));
typedef __attribute__((address_space(3))) const char* lds_cptr;
__device__ __forceinline__ s16x4 vtr(lds_cptr p) { return __builtin_bit_cast(s16x4, __builtin_amdgcn_ds_read_tr16_b64_v4i16((__attribute__((address_space(3))) v4i16_t*)p)); }
__device__ __forceinline__ bf16x8 ld8(const bf16* p) { return *reinterpret_cast<const bf16x8*>(p); }

template <int DQK> struct Cfg {
  static constexpr float SCALE = (DQK == 128) ? 0.088388347648318440f : 0.072168783648703220f;
  static constexpr float C = SCALE * 1.4426950408889634f;
  static constexpr int KROWB = DQK * 2, SHM_K = KVBLK * KROWB, SHM_V = KVBLK * 128 * 2, ND0 = DQK / 16;
  static constexpr int QREG = (DQK > 128) ? MLA_QREG : 8;
  static constexpr int QXW = (ND0 - QREG) * 1024, SHM_QX = NW * QXW;
  static constexpr int SHM_TOTAL = 2 * SHM_V + 2 * SHM_K + NW * 64 * 4 + SHM_QX;
};

constexpr float TRIG = 65536.f;
__device__ __forceinline__ void firstSM(f32x16& p0, f32x16& p1, float& m_ref, f32x16& negm) {
  float pmax = p0[0];
#pragma unroll
  for (int r = 1; r < 16; ++r) pmax = fmaxf(pmax, p0[r]);
#pragma unroll
  for (int r = 0; r < 16; ++r) pmax = fmaxf(pmax, p1[r]);
  { auto rr = __builtin_amdgcn_permlane32_swap(__float_as_uint(pmax), __float_as_uint(pmax), false, false);
    pmax = fmaxf(__uint_as_float(rr[0]), __uint_as_float(rr[1])); }
  m_ref = pmax;
#pragma unroll
  for (int r = 0; r < 16; ++r) { p0[r] -= pmax; p1[r] -= pmax; negm[r] = -pmax; }
#pragma unroll
  for (int r = 0; r < 16; ++r) p0[r] = __builtin_amdgcn_exp2f(p0[r]);
  asm volatile("" : "+v"(p0), "+v"(p1), "+v"(negm));
}
__device__ __forceinline__ void firstSM0(f32x16& p0, f32x16& p1, float& m_ref, f32x16& negm) {
  float pmax = p0[0];
#pragma unroll
  for (int r = 1; r < 16; ++r) pmax = fmaxf(pmax, p0[r]);
#pragma unroll
  for (int r = 0; r < 16; ++r) pmax = fmaxf(pmax, p1[r]);
  { auto rr = __builtin_amdgcn_permlane32_swap(__float_as_uint(pmax), __float_as_uint(pmax), false, false);
    pmax = fmaxf(__uint_as_float(rr[0]), __uint_as_float(rr[1])); }
  m_ref = pmax;
#pragma unroll
  for (int r = 0; r < 16; ++r) { p0[r] -= pmax; p1[r] -= pmax; negm[r] = -pmax; }
  asm volatile("" : "+v"(p0), "+v"(p1), "+v"(negm));
}
__device__ __forceinline__ void partialSM(f32x16& p0, f32x16& p1) {
#pragma unroll
  for (int r = 0; r < 16; ++r) p0[r] = __builtin_amdgcn_exp2f(p0[r]);
  asm volatile("" : "+v"(p0), "+v"(p1));
}
__device__ __forceinline__ void finishSM(f32x16& p0, f32x16& p1, float& ps, float& l_reg, bf16x8& pa0, bf16x8& pa1, bf16x8& pa2, bf16x8& pa3) {
#pragma unroll
  for (int r = 0; r < 16; ++r) p1[r] = __builtin_amdgcn_exp2f(p1[r]);
  float s0 = 0, s1 = 0;
#pragma unroll
  for (int r = 0; r < 16; ++r) s0 += p0[r];
#pragma unroll
  for (int r = 0; r < 16; ++r) s1 += p1[r];
  ps = s0 + s1;
  { auto rr = __builtin_amdgcn_permlane32_swap(__float_as_uint(ps), __float_as_uint(ps), false, false);
    ps = __uint_as_float(rr[0]) + __uint_as_float(rr[1]); }
  l_reg += ps;
#define ATT_PK4(P, BASE, OUT) do { unsigned a0 = cvtpk(P[BASE + 0], P[BASE + 1]), a1 = cvtpk(P[BASE + 2], P[BASE + 3]);   \
    unsigned b0 = cvtpk(P[BASE + 4], P[BASE + 5]), b1 = cvtpk(P[BASE + 6], P[BASE + 7]);                              \
    auto r0 = __builtin_amdgcn_permlane32_swap(a0, b0, false, false); auto r1 = __builtin_amdgcn_permlane32_swap(a1, b1, false, false); \
    u32x4 w = {r0[0], r1[0], r0[1], r1[1]}; OUT = *reinterpret_cast<bf16x8*>(&w); } while (0)
  ATT_PK4(p0, 0, pa0); ATT_PK4(p0, 8, pa1); ATT_PK4(p1, 0, pa2); ATT_PK4(p1, 8, pa3);
#undef ATT_PK4
}
#define ATT_KEY(row) ((KROWB == 256) ? ((row) & ATT_KEYMASK128) : (((row) >> 1) & 7))
#define ATT_KSWZ(row, colB) ((row) * KROWB + ((colB) ^ (ATT_KEY(row) << 4)))
template <int DQK> __device__ __forceinline__ void qkt(f32x16& p0, f32x16& p1, const f32x16& negm, const char* Ks, const int* kb, const bf16x8* qr, const char* qx, int r32, int hi) {
  constexpr int KROWB = Cfg<DQK>::KROWB, ND0 = Cfg<DQK>::ND0, QREG = Cfg<DQK>::QREG;
  p0 = negm; p1 = negm;
  constexpr int NB = (KROWB == 256 && ATT_KEYMASK128 == 15) ? 8 : 4;
#pragma unroll
  for (int d0 = 0; d0 < ND0; ++d0) {
    bf16x8 b0 = *reinterpret_cast<const bf16x8*>(Ks + kb[d0 % NB] + (d0 / NB) * (NB * 32));
    bf16x8 b1 = *reinterpret_cast<const bf16x8*>(Ks + kb[d0 % NB] + (d0 / NB) * (NB * 32) + 32 * KROWB);
    bf16x8 q; if (d0 < QREG) q = qr[d0]; else q = *reinterpret_cast<const bf16x8*>(qx + (d0 - QREG) * 1024);
    p0 = __builtin_amdgcn_mfma_f32_32x32x16_bf16(b0, q, p0, 0, 0, 0);
    p1 = __builtin_amdgcn_mfma_f32_32x32x16_bf16(b1, q, p1, 0, 0, 0); }
}
__device__ __forceinline__ int v_st(int k, int c) { const int kk = (k & ~0xC) | ((k & 4) << 1) | ((k & 8) >> 1); return ((kk >> 3) * 4 + (c >> 5)) * 512 + ((kk & 7) * 32 + (c & 31)) * 2; }
__device__ __forceinline__ int v_rd_base(int lane) { return ((lane & 3) << 3) | (((lane >> 2) & 3) << 6) | (((lane >> 4) & 1) << 5) | (((lane >> 5) & 1) << 8); }
constexpr int v_rd_off(int d0, int ks, int half) { return d0 * 512 + ks * 4096 + half * 2048; }
template <int OFF> __device__ __forceinline__ s16x4 tr_read(int vb) {
  s16x4 r; asm volatile("ds_read_b64_tr_b16 %0, %1 offset:%2" : "=&v"(r) : "v"(vb), "i"(OFF) : "memory"); return r;
}
#define ATT_PK(L, H) (bf16x8){L[0], L[1], L[2], L[3], H[0], H[1], H[2], H[3]}
template <int D0> __device__ __forceinline__ void pv_one(f32x16& od, lds_cptr vp, bf16x8 pa0, bf16x8 pa1, bf16x8 pa2, bf16x8 pa3) {
  const s16x4 l0 = vtr(vp + v_rd_off(D0, 0, 0)), h0 = vtr(vp + v_rd_off(D0, 0, 1)), l1 = vtr(vp + v_rd_off(D0, 1, 0)), h1 = vtr(vp + v_rd_off(D0, 1, 1));
  const s16x4 l2 = vtr(vp + v_rd_off(D0, 2, 0)), h2 = vtr(vp + v_rd_off(D0, 2, 1)), l3 = vtr(vp + v_rd_off(D0, 3, 0)), h3 = vtr(vp + v_rd_off(D0, 3, 1));
  od = __builtin_amdgcn_mfma_f32_32x32x16_bf16(pa0, ATT_PK(l0, h0), od, 0, 0, 0);
  od = __builtin_amdgcn_mfma_f32_32x32x16_bf16(pa1, ATT_PK(l1, h1), od, 0, 0, 0);
  od = __builtin_amdgcn_mfma_f32_32x32x16_bf16(pa2, ATT_PK(l2, h2), od, 0, 0, 0);
  od = __builtin_amdgcn_mfma_f32_32x32x16_bf16(pa3, ATT_PK(l3, h3), od, 0, 0, 0);
}
__device__ __forceinline__ void pv_d0(f32x16* o, lds_cptr vp, bf16x8 pa0, bf16x8 pa1, bf16x8 pa2, bf16x8 pa3) {
  pv_one<0>(o[0], vp, pa0, pa1, pa2, pa3); pv_one<1>(o[1], vp, pa0, pa1, pa2, pa3); pv_one<2>(o[2], vp, pa0, pa1, pa2, pa3); pv_one<3>(o[3], vp, pa0, pa1, pa2, pa3);
}
template <int NGRP, int MG, int NVALU, int NDS, int NPRE, int NLEAD = 0, int NVALU2 = 0> __device__ __forceinline__ void sched_pipe() {
  __builtin_amdgcn_sched_group_barrier(0x100, NPRE, 0);
#pragma unroll
  for (int i = 0; i < NGRP; ++i) { __builtin_amdgcn_sched_group_barrier(0x008, MG, 0);
    if (i >= NLEAD) __builtin_amdgcn_sched_group_barrier(0x002, (NLEAD > 0) ? NVALU2 : NVALU, 0);
    __builtin_amdgcn_sched_group_barrier(0x100, NDS, 0); }
}

template <int DQK, int LDQ, int LDK, int LDV, int LDO, int SD>
__device__ __forceinline__ void attn_unit(const bf16* __restrict__ Qb, const bf16* __restrict__ Kh, const bf16* __restrict__ Kr, const bf16* __restrict__ Vh,
                                          bf16* __restrict__ Ob, int seq, char* lds, float* tmout = nullptr) {
  constexpr int KROWB = Cfg<DQK>::KROWB, SHM_K = Cfg<DQK>::SHM_K, SHM_V = Cfg<DQK>::SHM_V, ND0 = Cfg<DQK>::ND0;
  const int tid = threadIdx.x, wid = __builtin_amdgcn_readfirstlane(tid >> 6), lane = tid & 63, r32 = lane & 31, hi = lane >> 5;
  char* V_lds = lds; char* K_lds = lds + 2 * SHM_V;
  float* ws = (float*)(lds + 2 * SHM_V + 2 * SHM_K) + wid * 64; float* li_l = ws; float* al_l = ws + 32;
  float m_ref = 0.f, l_reg = 0; f32x16 o[4] = {}; f32x16 negm = {}; constexpr int QREG = Cfg<DQK>::QREG; bf16x8 qr[QREG];
  const bf16* Qw = Qb + (long)(wid * QBLK + r32) * LDQ + hi * 8;
  char* qx = lds + 2 * SHM_V + 2 * SHM_K + NW * 64 * 4 + wid * Cfg<DQK>::QXW + lane * 16;
#pragma unroll
  for (int d0 = 0; d0 < QREG; ++d0) qr[d0] = ld8(Qw + d0 * 16);
  if constexpr (QREG < ND0) {
#pragma unroll
    for (int d0 = QREG; d0 < ND0; ++d0) *(bf16x8*)(qx + (d0 - QREG) * 1024) = ld8(Qw + d0 * 16);
  }
  const int sr = tid >> 4, sc = (tid & 15) * 8, vst0 = v_st(sr, sc), vst1 = v_st(32 + sr, sc);
  const int krr = tid >> 3, krc = (tid & 7) * 8;
  const lds_cptr vb0 = (lds_cptr)V_lds + v_rd_base(lane);
  constexpr int NB = (KROWB == 256 && ATT_KEYMASK128 == 15) ? 8 : 4; int kb[NB];
#pragma unroll
  for (int dl = 0; dl < NB; ++dl) kb[dl] = r32 * KROWB + ((dl * 32 + hi * 16) ^ (ATT_KEY(r32) << 4));
  const unsigned boV = (unsigned)(sr * LDV + sc) * 2u, boK = (unsigned)(sr * LDK + sc) * 2u, boR = (unsigned)(krr * 64 + krc) * 2u;
  struct { bf16x8 vs0, vs1, ks0, ks1, kr; } sr_[SD];
#define SLOAD(i, k0) do { const char* vt_ = (const char*)(Vh + (long)(k0) * LDV); const char* kt_ = (const char*)(Kh + (long)(k0) * LDK); \
    sr_[i].vs0 = *(const bf16x8*)(vt_ + boV); sr_[i].vs1 = *(const bf16x8*)(vt_ + 32 * LDV * 2 + boV); \
    sr_[i].ks0 = *(const bf16x8*)(kt_ + boK); sr_[i].ks1 = *(const bf16x8*)(kt_ + 32 * LDK * 2 + boK); \
    if constexpr (DQK == 192) { const char* rt_ = (const char*)(Kr + (long)(k0) * 64); sr_[i].kr = *(const bf16x8*)(rt_ + boR); } } while (0)
#define SWRITE(b, i) do { *(bf16x8*)(V_lds + (b) * SHM_V + vst0) = sr_[i].vs0;          \
    *(bf16x8*)(V_lds + (b) * SHM_V + vst1) = sr_[i].vs1; int kc = sc * 2;               \
    *(bf16x8*)(K_lds + (b) * SHM_K + ATT_KSWZ(sr, kc)) = sr_[i].ks0;                       \
    *(bf16x8*)(K_lds + (b) * SHM_K + ATT_KSWZ(32 + sr, kc)) = sr_[i].ks1;                  \
    if constexpr (DQK == 192) *(bf16x8*)(K_lds + (b) * SHM_K + ATT_KSWZ(krr, 256 + krc * 2)) = sr_[i].kr; } while (0)
#define SWAIT() do { if constexpr (SD == 2) { if constexpr (DQK == 192) asm volatile("s_waitcnt vmcnt(5)" ::: "memory"); else asm volatile("s_waitcnt vmcnt(4)" ::: "memory"); } \
    else asm volatile("s_waitcnt vmcnt(0)" ::: "memory"); } while (0)
#define RESC_APPLY() do { l_reg *= alp; if (hi == 0) al_l[r32] = alp; asm volatile("s_waitcnt lgkmcnt(0)" ::: "memory"); \
    _Pragma("unroll") for (int d = 0; d < 4; ++d) _Pragma("unroll") for (int r = 0; r < 16; ++r) o[d][r] *= al_l[crow(r, hi)]; pend = false; } while (0)
#define RESCN(ps_) do { if (pend) { RESC_APPLY(); } else { const bool t_ = (ps_) > TRIG; const float d_ = t_ ? __builtin_amdgcn_logf(ps_) : 0.f; alp = __builtin_amdgcn_exp2f(-d_); m_ref += d_; pend = __any(t_); } \
    _Pragma("unroll") for (int r = 0; r < 16; ++r) negm[r] = -m_ref; } while (0)
  float alp = 1.f; bool pend = false;
  f32x16 pA0, pA1, pB0, pB1; float psA, psB; bf16x8 pa0, pa1, pa2, pa3; const int NT = seq / KVBLK;
  constexpr int SE = 0, SO = SD - 1;
  SLOAD(SE, 0); asm volatile("s_waitcnt vmcnt(0)" ::: "memory"); SWRITE(0, SE); __syncthreads();
  qkt<DQK>(pA0, pA1, negm, K_lds, kb, qr, qx, r32, hi); firstSM(pA0, pA1, m_ref, negm);
  SLOAD(SO, KVBLK); if constexpr (SD == 2) { if (2 < NT) SLOAD(SE, 2 * KVBLK); }
  SWAIT(); SWRITE(1, SO); __syncthreads();
#define SCHED_A() do { if constexpr (DQK == 128) sched_pipe<16, 1, ATT_NVA128, 1, ATT_PREA>(); else sched_pipe<24 / ATT_MG192, ATT_MG192, ATT_NVA192 * ATT_MG192, ATT_DS192, ATT_PREA>(); } while (0)
#define SCHED_B() sched_pipe<16, 1, ATT_NVB, 2, ATT_PREB>()
#if ATT_PRIOMODE == 2
#define PRIO_A() do { if (wid >= 4) __builtin_amdgcn_s_setprio(1); else __builtin_amdgcn_s_setprio(0); } while (0)
#define PRIO_B() do { if (wid >= 4) __builtin_amdgcn_s_setprio(0); else __builtin_amdgcn_s_setprio(1); } while (0)
#elif ATT_PRIOMODE == 3
#define PRIO_A() do { if (wid >= 4) __builtin_amdgcn_s_setprio(0); else __builtin_amdgcn_s_setprio(1); } while (0)
#define PRIO_B() do { if (wid >= 4) __builtin_amdgcn_s_setprio(1); else __builtin_amdgcn_s_setprio(0); } while (0)
#else
#define PRIO_A() ((void)0)
#define PRIO_B() ((void)0)
#endif
#ifdef ATT_TIMING
  unsigned long long tmA = 0, tmB = 0, tmW = 0, tmW1 = 0, tmS = 0, tmB2 = 0;
#define TMS() __builtin_readcyclecounter()
#else
#define TMS() 0ull
#endif
  for (int j = 1; j + 1 < NT; j += 2) {
    const unsigned long long t0_ = TMS();
    PRIO_A(); ATT_SBAR(); qkt<DQK>(pB0, pB1, negm, K_lds + SHM_K, kb, qr, qx, r32, hi);
    finishSM(pA0, pA1, psA, l_reg, pa0, pa1, pa2, pa3); SCHED_A(); ATT_SBAR();
    const unsigned long long t1_ = TMS();
    PRIO_B(); SLOAD(SO, (j + SD) * KVBLK); ATT_SBAR();
    pv_d0(o, vb0, pa0, pa1, pa2, pa3); partialSM(pB0, pB1); SCHED_B(); ATT_SBAR();
    const unsigned long long t2_ = TMS();
    __syncthreads(); const unsigned long long t3_ = TMS(); SWAIT(); const unsigned long long t3b_ = TMS(); SWRITE(0, SE);
    RESCN(psA); asm volatile("s_waitcnt lgkmcnt(0)" ::: "memory"); const unsigned long long t3c_ = TMS(); __syncthreads();
    const unsigned long long t4_ = TMS();
#ifdef ATT_TIMING
    tmA += t1_ - t0_; tmB += t2_ - t1_; tmW1 += t3_ - t2_; tmW += t4_ - t3_; tmS += t3b_ - t3_; tmB2 += t4_ - t3c_;
#endif
    PRIO_A(); ATT_SBAR(); qkt<DQK>(pA0, pA1, negm, K_lds, kb, qr, qx, r32, hi);
    finishSM(pB0, pB1, psB, l_reg, pa0, pa1, pa2, pa3); SCHED_A(); ATT_SBAR();
    PRIO_B(); if (SD == 1 || j + 3 < NT) SLOAD(SE, (j + 1 + SD) * KVBLK); ATT_SBAR();
    pv_d0(o, vb0 + SHM_V, pa0, pa1, pa2, pa3); partialSM(pA0, pA1); SCHED_B(); ATT_SBAR();
    __syncthreads(); SWAIT(); SWRITE(1, SO);
    RESCN(psB); __syncthreads();
  }
  ATT_SBAR(); qkt<DQK>(pB0, pB1, negm, K_lds + SHM_K, kb, qr, qx, r32, hi);
  finishSM(pA0, pA1, psA, l_reg, pa0, pa1, pa2, pa3); ATT_SBAR();
  pv_d0(o, vb0, pa0, pa1, pa2, pa3); partialSM(pB0, pB1);
  __syncthreads(); if (pend) { RESC_APPLY(); }
  finishSM(pB0, pB1, psB, l_reg, pa0, pa1, pa2, pa3); ATT_SBAR();
  pv_d0(o, vb0 + SHM_V, pa0, pa1, pa2, pa3);
#undef SCHED_A
#undef SCHED_B
  __builtin_amdgcn_s_setprio(0);
#ifdef ATT_TIMING
  if (tmout && blockIdx.x == 0 && tid == ATT_TWAVE * 64) { const float inv = 1.0f / (float)((NT - 2) / 2); tmout[0] = (float)tmA * inv; tmout[1] = (float)tmB * inv; tmout[2] = (float)tmW1 * inv; tmout[3] = (float)tmW * inv; tmout[4] = (float)tmS * inv; tmout[5] = (float)tmB2 * inv; }
#endif
  if (hi == 0) li_l[r32] = l_reg; asm volatile("s_waitcnt lgkmcnt(0)" ::: "memory");
  float rli[16];
#pragma unroll
  for (int r = 0; r < 16; ++r) rli[r] = __builtin_amdgcn_rcpf(li_l[crow(r, hi)]);
  { int r32e = r32, hie = hi; asm volatile("" : "+v"(r32e), "+v"(hie));
    char* Ow = (char*)(Ob + (long)(wid * QBLK) * LDO);
    const unsigned lo_ = (unsigned)(((r32e >> 5) + 4 * hie) * LDO + (r32e & 31)) * 2u;
#pragma unroll
    for (int r = 0; r < 16; ++r) {
#pragma unroll
      for (int d0 = 0; d0 < 4; ++d0) *(bf16*)(Ow + lo_ + (unsigned)((((r & 3) + 8 * (r >> 2)) * LDO + d0 * 32) * 2)) = (bf16)(cvtpk(o[d0][r] * rli[r], 0.f) & 0xffffu); } }
  asm volatile("s_waitcnt vmcnt(0) lgkmcnt(0)" ::: "memory"); __syncthreads();
#undef SLOAD
#undef SWRITE
#undef SWAIT
#undef RESCN
#undef RESC_APPLY
}
template <int DQK, int LDQ, int LDK, int LDV, int LDO>
__device__ __forceinline__ void attn_unit_dma(const bf16* __restrict__ Qb, const bf16* __restrict__ Kh, const bf16* __restrict__ Kr, const bf16* __restrict__ Vh,
                                              bf16* __restrict__ Ob, int seq, char* lds, int spos = 0) {
  constexpr int KROWB = Cfg<DQK>::KROWB, SHM_K = Cfg<DQK>::SHM_K, SHM_V = Cfg<DQK>::SHM_V, ND0 = Cfg<DQK>::ND0;
  typedef __attribute__((address_space(3))) unsigned lds_u32;
  const int tid = threadIdx.x, wid = __builtin_amdgcn_readfirstlane(tid >> 6), lane = tid & 63, r32 = lane & 31, hi = lane >> 5;
  char* V_lds = lds; char* K_lds = lds + 2 * SHM_V;
  float* ws = (float*)(lds + 2 * SHM_V + 2 * SHM_K) + wid * 64; float* li_l = ws; float* al_l = ws + 32;
  float m_ref = 0.f, l_reg = 0; f32x16 o[4] = {}; f32x16 negm = {}; constexpr int QREG = Cfg<DQK>::QREG; bf16x8 qr[QREG];
  const bf16* Qw = Qb + (long)(wid * QBLK + r32) * LDQ + hi * 8;
  char* qx = lds + 2 * SHM_V + 2 * SHM_K + NW * 64 * 4 + wid * Cfg<DQK>::QXW + lane * 16;
#pragma unroll
  for (int d0 = 0; d0 < QREG; ++d0) qr[d0] = ld8(Qw + d0 * 16);
  if constexpr (QREG < ND0) {
#pragma unroll
    for (int d0 = QREG; d0 < ND0; ++d0) { bf16x8 qv = ld8(Qw + d0 * 16);
      if (DQK == 192 && d0 >= 8) {
        int hiq = hi; asm volatile("" : "+v"(hiq));
        const int sq = spos + wid * QBLK + r32; const float pos = (float)((d0 < 10) ? (sq >> 6) : (sq & 63));
        u32x4 w = *reinterpret_cast<u32x4*>(&qv);
#pragma unroll
        for (int e = 0; e < 4; ++e) { const int j = ((d0 - 8) & 1) * 8 + hiq * 4 + e; const float invf = __builtin_amdgcn_exp2f(-(float)j * (13.287712379549449f / 16.f));
          const float ang = pos * invf; double rev = (double)ang * 0.15915494309189535; rev -= __builtin_rint(rev); const float fr = (float)rev;
          const float c = __builtin_amdgcn_cosf(fr), sn = __builtin_amdgcn_sinf(fr);
          const float x1 = __uint_as_float(w[e] << 16), x2 = __uint_as_float(w[e] & 0xffff0000u); w[e] = cvtpk(x1 * c - x2 * sn, x1 * sn + x2 * c); }
        qv = *reinterpret_cast<bf16x8*>(&w); }
      *(bf16x8*)(qx + (d0 - QREG) * 1024) = qv; }
  }
  const lds_cptr vb0 = (lds_cptr)V_lds + v_rd_base(lane);
  constexpr int NB = (KROWB == 256 && ATT_KEYMASK128 == 15) ? 8 : 4; int kb[NB];
#pragma unroll
  for (int dl = 0; dl < NB; ++dl) kb[dl] = r32 * KROWB + ((dl * 32 + hi * 16) ^ (ATT_KEY(r32) << 4));
  constexpr int NKI = SHM_K / 8192, SPR = KROWB / 16;
  unsigned voV[2]; const char* kp[NKI]; unsigned kst[NKI];
#pragma unroll
  for (int i = 0; i < 2; ++i) { const int s = i * 512 + wid * 64 + lane; const int kk = (((s >> 7) & 7) << 3) | ((s >> 2) & 7);
    const int k = (kk & ~0xC) | ((kk & 4) << 1) | ((kk & 8) >> 1), c = ((s >> 5) & 3) * 32 + (s & 3) * 8; voV[i] = (unsigned)(k * LDV + c) * 2u; }
#pragma unroll
  for (int i = 0; i < NKI; ++i) { const int s = i * 512 + wid * 64 + lane; const int row = s / SPR, cs = (s % SPR) * 16, colB = cs ^ (ATT_KEY(row) << 4);
    if (DQK == 192 && colB >= 256) { kp[i] = (const char*)Kr + (size_t)row * 128 + (colB - 256); kst[i] = 64u * 128u; }
    else { kp[i] = (const char*)Kh + (size_t)row * (LDK * 2) + colB; kst[i] = 64u * (unsigned)(LDK * 2); } }
  lds_u32* const ldsV = (lds_u32*)((__attribute__((address_space(3))) char*)V_lds + wid * 1024);
  lds_u32* const ldsK = (lds_u32*)((__attribute__((address_space(3))) char*)K_lds + wid * 1024);
#define DMA_V(t_, b_) do { const char* vt_ = (const char*)Vh + (size_t)(t_) * (64u * LDV * 2u); _Pragma("unroll") for (int i = 0; i < 2; ++i) \
    __builtin_amdgcn_global_load_lds((const unsigned*)(vt_ + voV[i]), (lds_u32*)((__attribute__((address_space(3))) char*)ldsV + (b_) * SHM_V + i * 8192), 16, 0, 0); } while (0)
#define DMA_K(t_, b_) do { _Pragma("unroll") for (int i = 0; i < NKI; ++i) \
    __builtin_amdgcn_global_load_lds((const unsigned*)(kp[i] + (size_t)(t_) * kst[i]), (lds_u32*)((__attribute__((address_space(3))) char*)ldsK + (b_) * SHM_K + i * 8192), 16, 0, 0); } while (0)
#define VMW0() asm volatile("s_waitcnt vmcnt(0)" ::: "memory")
#define RESC_APPLY() do { l_reg *= alp; if (hi == 0) al_l[r32] = alp; asm volatile("s_waitcnt lgkmcnt(0)" ::: "memory"); \
    _Pragma("unroll") for (int d = 0; d < 4; ++d) _Pragma("unroll") for (int r = 0; r < 16; ++r) o[d][r] *= al_l[crow(r, hi)]; pend = false; } while (0)
#define RESCN(ps_) do { if (pend) { RESC_APPLY(); } else { const bool t_ = (ps_) > TRIG; const float d_ = t_ ? __builtin_amdgcn_logf(ps_) : 0.f; alp = __builtin_amdgcn_exp2f(-d_); m_ref += d_; pend = __any(t_); } \
    _Pragma("unroll") for (int r = 0; r < 16; ++r) negm[r] = -m_ref; } while (0)
  float alp = 1.f; bool pend = false;
  f32x16 pA0, pA1, pB0, pB1; float psA, psB; bf16x8 pa0, pa1, pa2, pa3; const int NT = seq / KVBLK;
#define SCHED_A() do { if constexpr (DQK == 128) sched_pipe<16, 1, ATT_NVA128, 1, ATT_PREA, ATT_LEAD128, ATT_NVL128>(); else sched_pipe<24 / ATT_MG192, ATT_MG192, ATT_NVA192 * ATT_MG192, ATT_DS192, ATT_PREA, ATT_LEAD192, ATT_NVL192>(); } while (0)
#define SCHED_B() sched_pipe<16, 1, ATT_NVB, 2, ATT_PREB>()
#define STEP(C0, C1, P0, P1, psP, t_, KB, VB, haveK) do { DMA_V(t_, VB); if (haveK) DMA_K((t_) + 1, 1 - (KB)); ATT_SBAR(); \
    qkt<DQK>(C0, C1, negm, K_lds + (KB) * SHM_K, kb, qr, qx, r32, hi); finishSM(P0, P1, psP, l_reg, pa0, pa1, pa2, pa3); SCHED_A(); ATT_SBAR(); \
    pv_d0(o, vb0 + (1 - (VB)) * SHM_V, pa0, pa1, pa2, pa3); partialSM(C0, C1); SCHED_B(); ATT_SBAR(); \
    RESCN(psP); VMW0(); __syncthreads(); } while (0)
  DMA_K(0, 0); VMW0(); __syncthreads();
  DMA_V(0, 0); DMA_K(1, 1);
  qkt<DQK>(pA0, pA1, negm, K_lds, kb, qr, qx, r32, hi); firstSM(pA0, pA1, m_ref, negm);
  VMW0(); __syncthreads();
  for (int t = 1; t + 2 < NT; t += 2) {
    STEP(pB0, pB1, pA0, pA1, psA, t, 1, 1, true);
    STEP(pA0, pA1, pB0, pB1, psB, t + 1, 0, 0, true);
  }
  STEP(pB0, pB1, pA0, pA1, psA, NT - 1, 1, 1, false);
  finishSM(pB0, pB1, psB, l_reg, pa0, pa1, pa2, pa3); ATT_SBAR();
  pv_d0(o, vb0 + SHM_V, pa0, pa1, pa2, pa3);
#undef STEP
#undef SCHED_A
#undef SCHED_B
  if (hi == 0) li_l[r32] = l_reg; asm volatile("s_waitcnt lgkmcnt(0)" ::: "memory");
  float rli[16];
#pragma unroll
  for (int r = 0; r < 16; ++r) rli[r] = __builtin_amdgcn_rcpf(li_l[crow(r, hi)]);
  { int r32e = r32, hie = hi; asm volatile("" : "+v"(r32e), "+v"(hie));
    char* Ow = (char*)(Ob + (long)(wid * QBLK) * LDO);
    const unsigned lo_ = (unsigned)((4 * hie) * LDO + r32e) * 2u;
#pragma unroll
    for (int r = 0; r < 16; ++r) {
#pragma unroll
      for (int d0 = 0; d0 < 4; ++d0) *(bf16*)(Ow + lo_ + (unsigned)((((r & 3) + 8 * (r >> 2)) * LDO + d0 * 32) * 2)) = (bf16)(cvtpk(o[d0][r] * rli[r], 0.f) & 0xffffu); } }
  asm volatile("s_waitcnt vmcnt(0) lgkmcnt(0)" ::: "memory"); __syncthreads();
#undef DMA_V
#undef DMA_K
#undef VMW0
#undef RESCN
#undef RESC_APPLY
}
template <int DQK, int LDQ, int LDK, int LDV, int LDO>
__device__ __forceinline__ void attn_unit_dmas(const bf16* __restrict__ Qb, const bf16* __restrict__ Kh, const bf16* __restrict__ Kr, const bf16* __restrict__ Vh,
                                              bf16* __restrict__ Ob, int seq, char* lds, int spos = 0) {
  constexpr int KROWB = Cfg<DQK>::KROWB, SHM_K = Cfg<DQK>::SHM_K, SHM_V = Cfg<DQK>::SHM_V, ND0 = Cfg<DQK>::ND0;
  typedef __attribute__((address_space(3))) unsigned lds_u32;
  const int tid = threadIdx.x, wid = __builtin_amdgcn_readfirstlane(tid >> 6), lane = tid & 63, r32 = lane & 31, hi = lane >> 5;
  char* V_lds = lds; char* K_lds = lds + 3 * SHM_V;
  float* ws = (float*)(lds + 3 * SHM_V + 2 * SHM_K) + wid * 64; float* li_l = ws; float* al_l = ws + 32;
  float m_ref = 0.f, l_reg = 0; f32x16 o[4] = {}; f32x16 negm = {}; constexpr int QREG = Cfg<DQK>::QREG; bf16x8 qr[QREG];
  const bf16* Qw = Qb + (long)(wid * QBLK + r32) * LDQ + hi * 8;
  char* qx = lds + 3 * SHM_V + 2 * SHM_K + NW * 64 * 4 + wid * Cfg<DQK>::QXW + lane * 16;
#pragma unroll
  for (int d0 = 0; d0 < QREG; ++d0) qr[d0] = ld8(Qw + d0 * 16);
  if constexpr (QREG < ND0) {
#pragma unroll
    for (int d0 = QREG; d0 < ND0; ++d0) { bf16x8 qv = ld8(Qw + d0 * 16);
      if (DQK == 192 && d0 >= 8) {
        int hiq = hi; asm volatile("" : "+v"(hiq));
        const int sq = spos + wid * QBLK + r32; const float pos = (float)((d0 < 10) ? (sq >> 6) : (sq & 63));
        u32x4 w = *reinterpret_cast<u32x4*>(&qv);
#pragma unroll
        for (int e = 0; e < 4; ++e) { const int j = ((d0 - 8) & 1) * 8 + hiq * 4 + e; const float invf = __builtin_amdgcn_exp2f(-(float)j * (13.287712379549449f / 16.f));
          const float ang = pos * invf; double rev = (double)ang * 0.15915494309189535; rev -= __builtin_rint(rev); const float fr = (float)rev;
          const float c = __builtin_amdgcn_cosf(fr), sn = __builtin_amdgcn_sinf(fr);
          const float x1 = __uint_as_float(w[e] << 16), x2 = __uint_as_float(w[e] & 0xffff0000u); w[e] = cvtpk(x1 * c - x2 * sn, x1 * sn + x2 * c); }
        qv = *reinterpret_cast<bf16x8*>(&w); }
      *(bf16x8*)(qx + (d0 - QREG) * 1024) = qv; }
  }
  const lds_cptr vb0 = (lds_cptr)V_lds + v_rd_base(lane);
  constexpr int NB = (KROWB == 256 && ATT_KEYMASK128 == 15) ? 8 : 4; int kb[NB];
#pragma unroll
  for (int dl = 0; dl < NB; ++dl) kb[dl] = r32 * KROWB + ((dl * 32 + hi * 16) ^ (ATT_KEY(r32) << 4));
  constexpr int NKI = SHM_K / 8192, SPR = KROWB / 16;
  unsigned voV[2]; const char* kp[NKI]; unsigned kst[NKI];
#pragma unroll
  for (int i = 0; i < 2; ++i) { const int s = i * 512 + wid * 64 + lane; const int kk = (((s >> 7) & 7) << 3) | ((s >> 2) & 7);
    const int k = (kk & ~0xC) | ((kk & 4) << 1) | ((kk & 8) >> 1), c = ((s >> 5) & 3) * 32 + (s & 3) * 8; voV[i] = (unsigned)(k * LDV + c) * 2u; }
#pragma unroll
  for (int i = 0; i < NKI; ++i) { const int s = i * 512 + wid * 64 + lane; const int row = s / SPR, cs = (s % SPR) * 16, colB = cs ^ (ATT_KEY(row) << 4);
    if (DQK == 192 && colB >= 256) { kp[i] = (const char*)Kr + (size_t)row * 128 + (colB - 256); kst[i] = 64u * 128u; }
    else { kp[i] = (const char*)Kh + (size_t)row * (LDK * 2) + colB; kst[i] = 64u * (unsigned)(LDK * 2); } }
  lds_u32* const ldsV = (lds_u32*)((__attribute__((address_space(3))) char*)V_lds + wid * 1024);
  lds_u32* const ldsK = (lds_u32*)((__attribute__((address_space(3))) char*)K_lds + wid * 1024);
#define DMA_V(t_, b_) do { const char* vt_ = (const char*)Vh + (size_t)(t_) * (64u * LDV * 2u); _Pragma("unroll") for (int i = 0; i < 2; ++i) \
    __builtin_amdgcn_global_load_lds((const unsigned*)(vt_ + voV[i]), (lds_u32*)((__attribute__((address_space(3))) char*)ldsV + (b_) + i * 8192), 16, 0, 0); } while (0)
#define DMA_K(t_, b_) do { _Pragma("unroll") for (int i = 0; i < NKI; ++i) \
    __builtin_amdgcn_global_load_lds((const unsigned*)(kp[i] + (size_t)(t_) * kst[i]), (lds_u32*)((__attribute__((address_space(3))) char*)ldsK + (b_) * SHM_K + i * 8192), 16, 0, 0); } while (0)
#define VMW0() asm volatile("s_waitcnt vmcnt(0)" ::: "memory")
#define RESC_APPLY() do { l_reg *= alp; if (hi == 0) al_l[r32] = alp; asm volatile("s_waitcnt lgkmcnt(0)" ::: "memory"); \
    _Pragma("unroll") for (int d = 0; d < 4; ++d) _Pragma("unroll") for (int r = 0; r < 16; ++r) o[d][r] *= al_l[crow(r, hi)]; pend = false; } while (0)
#define RESCN(ps_) do { if (pend) { RESC_APPLY(); } else { const bool t_ = (ps_) > TRIG; const float d_ = t_ ? __builtin_amdgcn_logf(ps_) : 0.f; alp = __builtin_amdgcn_exp2f(-d_); m_ref += d_; pend = __any(t_); } \
    _Pragma("unroll") for (int r = 0; r < 16; ++r) negm[r] = -m_ref; } while (0)
  float alp = 1.f; bool pend = false;
  f32x16 pA0, pA1, pB0, pB1; float psA, psB; bf16x8 pa0, pa1, pa2, pa3; const int NT = seq / KVBLK;
#define SCHED_A() do { if constexpr (DQK == 128) sched_pipe<16, 1, ATT_NVA128, 1, ATT_PREA>(); else sched_pipe<24 / ATT_MG192, ATT_MG192, ATT_NVA192 * ATT_MG192, ATT_DS192, ATT_PREA>(); } while (0)
#define SCHED_B() sched_pipe<16, 1, ATT_NVB, 2, ATT_PREB>()
#define NEXTV(v_) (((v_) == 2 * SHM_V) ? 0 : (v_) + SHM_V)
#define STEPS(C0, C1, P0, P1, psP, psPrev, t_, KB, vo_t, vo_tm1, vo_tm2, haveK, havePV) do { DMA_V(t_, vo_t); if (haveK) DMA_K((t_) + 1, 1 - (KB)); ATT_SBAR(); \
    if (isY) { if (havePV) { pv_d0(o, vb0 + (vo_tm2), pa0, pa1, pa2, pa3); } partialSM(P0, P1); SCHED_B(); ATT_SBAR(); RESCN(psPrev); } \
    else { qkt<DQK>(C0, C1, negm, K_lds + (KB) * SHM_K, kb, qr, qx, r32, hi); finishSM(P0, P1, psP, l_reg, pa0, pa1, pa2, pa3); SCHED_A(); } \
    ATT_SBAR(); \
    if (isY) { qkt<DQK>(C0, C1, negm, K_lds + (KB) * SHM_K, kb, qr, qx, r32, hi); finishSM(P0, P1, psP, l_reg, pa0, pa1, pa2, pa3); SCHED_A(); } \
    else { pv_d0(o, vb0 + (vo_tm1), pa0, pa1, pa2, pa3); partialSM(C0, C1); SCHED_B(); ATT_SBAR(); RESCN(psP); } \
    ATT_SBAR(); VMW0(); __syncthreads(); } while (0)
  const bool isY = wid >= 4;
  DMA_K(0, 0); VMW0(); __syncthreads();
  DMA_V(0, 0); DMA_K(1, 1);
  qkt<DQK>(pA0, pA1, negm, K_lds, kb, qr, qx, r32, hi); firstSM0(pA0, pA1, m_ref, negm);
  if (!isY) partialSM(pA0, pA1);
  VMW0(); __syncthreads();
  psA = 0.f; psB = 0.f;
  int v2 = 0, v1 = 0, v0 = SHM_V;
  STEPS(pB0, pB1, pA0, pA1, psA, psB, 1, 1, v0, v1, v2, true, false); v2 = v1; v1 = v0; v0 = NEXTV(v0);
  for (int t = 2; t + 1 < NT; t += 2) {
    STEPS(pA0, pA1, pB0, pB1, psB, psA, t, 0, v0, v1, v2, true, true); v2 = v1; v1 = v0; v0 = NEXTV(v0);
    STEPS(pB0, pB1, pA0, pA1, psA, psB, t + 1, 1, v0, v1, v2, (t + 2 < NT), true); v2 = v1; v1 = v0; v0 = NEXTV(v0);
  }
  if (isY) { pv_d0(o, vb0 + v2, pa0, pa1, pa2, pa3); partialSM(pB0, pB1); ATT_SBAR(); if (pend) { RESC_APPLY(); } }
  finishSM(pB0, pB1, psB, l_reg, pa0, pa1, pa2, pa3); ATT_SBAR();
  pv_d0(o, vb0 + v1, pa0, pa1, pa2, pa3);
#undef STEPS
#undef NEXTV
#undef SCHED_A
#undef SCHED_B
  if (hi == 0) li_l[r32] = l_reg; asm volatile("s_waitcnt lgkmcnt(0)" ::: "memory");
  float rli[16];
#pragma unroll
  for (int r = 0; r < 16; ++r) rli[r] = __builtin_amdgcn_rcpf(li_l[crow(r, hi)]);
  { int r32e = r32, hie = hi; asm volatile("" : "+v"(r32e), "+v"(hie));
    char* Ow = (char*)(Ob + (long)(wid * QBLK) * LDO);
    const unsigned lo_ = (unsigned)((4 * hie) * LDO + r32e) * 2u;
#pragma unroll
    for (int r = 0; r < 16; ++r) {
#pragma unroll
      for (int d0 = 0; d0 < 4; ++d0) *(bf16*)(Ow + lo_ + (unsigned)((((r & 3) + 8 * (r >> 2)) * LDO + d0 * 32) * 2)) = (bf16)(cvtpk(o[d0][r] * rli[r], 0.f) & 0xffffu); } }
  asm volatile("s_waitcnt vmcnt(0) lgkmcnt(0)" ::: "memory"); __syncthreads();
#undef DMA_V
#undef DMA_K
#undef VMW0
#undef RESCN
#undef RESC_APPLY
}
#undef ATT_KSWZ
#undef ATT_KEY
#undef ATT_PK
#undef ATT_SBAR
}
#define LAS __attribute__((address_space(3)))
typedef unsigned short u16;
typedef float f32x4 __attribute__((ext_vector_type(4)));
typedef short bf16x8 __attribute__((ext_vector_type(8)));
typedef unsigned u32x4 __attribute__((ext_vector_type(4)));
typedef unsigned u32x2 __attribute__((ext_vector_type(2)));
constexpr int DM = 2048, BATCH = 2, SEQ = 16384, T = BATCH * SEQ;
constexpr int IN0 = 4608, NLAT = 1088, NLATP = 1280, NQ = 3072, NKV = 4096, DFF = 8192;
constexpr float EPS = 1e-6f;
constexpr int NWAVES = 8, NTHREADS = 512;
constexpr int LDS_BYTES = 155648;
constexpr float LOG2_THETA = 13.287712379549449f;

constexpr size_t MiB = 1u << 20;
constexpr size_t WS_WIN = 0, WS_WOUT = 18 * MiB, WS_WDOWN = 26 * MiB, WS_WUQ = 31 * MiB, WS_WUKV = 34 * MiB, WS_WO = 38 * MiB;
constexpr size_t WS_WUP = 46 * MiB  , WS_WDN = 110 * MiB  ;
constexpr size_t WS_XN = 176 * MiB;
constexpr size_t WS_HB = 304 * MiB;
constexpr size_t WS_BIG = 432 * MiB;
constexpr size_t WS_PROJ = WS_BIG, WS_MIX = WS_BIG + 288 * MiB;
constexpr size_t WS_HID = WS_BIG;
constexpr size_t WS_Q = WS_BIG, WS_KV = WS_BIG + 192 * MiB, WS_LAT = WS_BIG + 448 * MiB, WS_KROPE = WS_BIG + 528 * MiB;
constexpr size_t WS_CQN = WS_LAT, WS_CKVN = WS_LAT;
constexpr size_t WS_AO = WS_XN;
constexpr size_t WS_CTL = WS_BIG + 532 * MiB, CTL_BAR = 65536, WS_SS = WS_CTL + CTL_BAR, CTL_BYTES = CTL_BAR + 5 * 131072;
constexpr size_t WS_END = WS_CTL + CTL_BYTES;

__device__ __forceinline__ float bflo(unsigned u) { return __uint_as_float(u << 16); }
__device__ __forceinline__ float bfhi(unsigned u) { return __uint_as_float(u & 0xffff0000u); }
__device__ __forceinline__ unsigned pk2(float lo, float hi) { unsigned r; asm volatile("v_cvt_pk_bf16_f32 %0, %1, %2" : "=v"(r) : "v"(lo), "v"(hi)); return r; }
__device__ __forceinline__ float wave_sum(float v) {
#pragma unroll
    for (int o = 1; o < 64; o <<= 1) v += __shfl_xor(v, o);
    return v;
}
__device__ __forceinline__ void rope_cs(float pos, float invf, float& c, float& s) {
    const float a = pos * invf;
    double rev = (double)a * 0.15915494309189535;
    rev -= __builtin_rint(rev);
    const float fr = (float)rev;
    c = __builtin_amdgcn_cosf(fr); s = __builtin_amdgcn_sinf(fr);
}

__device__ __forceinline__ void transpose_item(const float* __restrict__ W, const float* __restrict__ gain, float mul, int K, int N, u16* __restrict__ WT, LAS float* scr, int item, int lane) {
    const int nblk = N / 32, kb = item / nblk, nb = item % nblk, k0 = 64 * kb, n0 = 32 * nb;
    float wv[32];
#pragma unroll
    for (int i = 0; i < 32; ++i) { const int kk = 2 * i + (lane >> 5); wv[i] = W[(size_t)(k0 + kk) * N + n0 + (lane & 31)]; }
    float gv = 1.f; if (gain) gv = gain[k0 + lane] * mul;
#pragma unroll
    for (int i = 0; i < 32; ++i) { const int kk = 2 * i + (lane >> 5); const float g = __shfl(gv, kk); scr[kk * 33 + (lane & 31)] = wv[i] * g; }
    asm volatile("s_waitcnt lgkmcnt(0)" ::: "memory");
    const int c = lane & 7;
#pragma unroll
    for (int j = 0; j < 4; ++j) { const int n = (lane >> 3) + 8 * j; const LAS float* s = scr + (8 * c) * 33 + n;
        u32x4 o; o.x = pk2(s[0 * 33], s[1 * 33]); o.y = pk2(s[2 * 33], s[3 * 33]); o.z = pk2(s[4 * 33], s[5 * 33]); o.w = pk2(s[6 * 33], s[7 * 33]);
        *(u32x4*)(WT + (size_t)(n0 + n) * K + k0 + 8 * c) = o; }
    asm volatile("s_waitcnt lgkmcnt(0)" ::: "memory");
}

__device__ __forceinline__ void norm_row_bf16(const float* __restrict__ xrow, u16* __restrict__ orow, int lane) {
    const f32x4* xr = (const f32x4*)xrow + lane;
    f32x4 v[8]; float s = 0.f;
#pragma unroll
    for (int j = 0; j < 8; ++j) { v[j] = xr[64 * j]; s += (v[j].x * v[j].x + v[j].y * v[j].y) + (v[j].z * v[j].z + v[j].w * v[j].w); }
    const float r = 1.0f / sqrtf(wave_sum(s) * (1.f / DM) + EPS);
    u32x2* o8 = (u32x2*)orow + lane;
#pragma unroll
    for (int j = 0; j < 8; ++j) { u32x2 w; w.x = pk2(v[j].x * r, v[j].y * r); w.y = pk2(v[j].z * r, v[j].w * r); o8[64 * j] = w; }
}
__device__ __forceinline__ void norm_row_b2b(const u16* __restrict__ hrow, u16* __restrict__ orow, int lane) {
    const u32x4* xr = (const u32x4*)hrow + lane;
    u32x4 w[4]; float s = 0.f;
#pragma unroll
    for (int j = 0; j < 4; ++j) { w[j] = xr[64 * j];
#pragma unroll
        for (int e = 0; e < 4; ++e) { const float a = bflo(w[j][e]), b = bfhi(w[j][e]); s += a * a + b * b; } }
    const float r = 1.0f / sqrtf(wave_sum(s) * (1.f / DM) + EPS);
    u32x4* o = (u32x4*)orow + lane;
#pragma unroll
    for (int j = 0; j < 4; ++j) { u32x4 v;
#pragma unroll
        for (int e = 0; e < 4; ++e) v[e] = pk2(bflo(w[j][e]) * r, bfhi(w[j][e]) * r);
        o[64 * j] = v; }
}
__device__ __forceinline__ void norm_row_final(const u16* __restrict__ hrow, float* __restrict__ orow, const float* __restrict__ g, int lane) {
    const u32x4* xr = (const u32x4*)hrow + lane;
    u32x4 w[4]; float s = 0.f;
#pragma unroll
    for (int j = 0; j < 4; ++j) { w[j] = xr[64 * j];
#pragma unroll
        for (int e = 0; e < 4; ++e) { const float a = bflo(w[j][e]), b = bfhi(w[j][e]); s += a * a + b * b; } }
    const float r = 1.0f / sqrtf(wave_sum(s) * (1.f / DM) + EPS);
#pragma unroll
    for (int j = 0; j < 4; ++j) { const int c = (64 * j + lane) * 8; const f32x4 g0 = *(const f32x4*)(g + c), g1 = *(const f32x4*)(g + c + 4);
        f32x4 o0 = {bflo(w[j][0]) * r * g0[0], bfhi(w[j][0]) * r * g0[1], bflo(w[j][1]) * r * g0[2], bfhi(w[j][1]) * r * g0[3]};
        f32x4 o1 = {bflo(w[j][2]) * r * g1[0], bfhi(w[j][2]) * r * g1[1], bflo(w[j][3]) * r * g1[2], bfhi(w[j][3]) * r * g1[3]};
        *(f32x4*)(orow + c) = o0; *(f32x4*)(orow + c + 4) = o1; }
}

__device__ __forceinline__ void ld8f(const u16* p, float* f) {
    const u32x4 w = *(const u32x4*)p;
    f[0] = bflo(w.x); f[1] = bfhi(w.x); f[2] = bflo(w.y); f[3] = bfhi(w.y); f[4] = bflo(w.z); f[5] = bfhi(w.z); f[6] = bflo(w.w); f[7] = bfhi(w.w);
}

__device__ __forceinline__ void ew0_token(int t, u16* __restrict__ PROJ, u16* __restrict__ MIX, const float* __restrict__ qg, const float* __restrict__ kg, const float* __restrict__ cw, int lane) {
    const int s = t & (SEQ - 1), row = s >> 6, col = s & 63;
    float c, sn; { const int j = lane & 31; const float invf = __builtin_amdgcn_exp2f(-(float)j * (LOG2_THETA / 32.f)); rope_cs((float)(lane < 32 ? row : col), invf, c, sn); }
    unsigned* pr = (unsigned*)(PROJ + (size_t)t * IN0);
    const float qg0 = qg[2 * lane], qg1 = qg[2 * lane + 1], kg0 = kg[2 * lane], kg1 = kg[2 * lane + 1];
#pragma unroll
    for (int h = 0; h < 10; ++h) {
        const unsigned u = pr[h * 64 + lane]; const float x1 = bflo(u), x2 = bfhi(u);
        const float ss = wave_sum(x1 * x1 + x2 * x2); const float r = 1.0f / sqrtf(ss * (1.f / 128.f) + EPS);
        const float y1 = x1 * r * (h < 8 ? qg0 * att::Cfg<128>::C : kg0), y2 = x2 * r * (h < 8 ? qg1 * att::Cfg<128>::C : kg1);
        pr[h * 64 + lane] = pk2(y1 * c - y2 * sn, y1 * sn + y2 * c);
    }
    const u16* p0 = PROJ + (size_t)t * IN0;
#pragma unroll
    for (int ch = 0; ch < 2; ++ch) {
        const int cc = ch * 512 + lane * 8;
        float gb[8], g0[8], u0[8], gm[8], um[8], gp[8], up[8];
        ld8f(p0 + 1536 + cc, gb); ld8f(p0 + 2560 + cc, g0); ld8f(p0 + 3584 + cc, u0);
        if (s > 0) { ld8f(p0 - IN0 + 2560 + cc, gm); ld8f(p0 - IN0 + 3584 + cc, um); } else {
#pragma unroll
            for (int e = 0; e < 8; ++e) { gm[e] = 0.f; um[e] = 0.f; } }
        if (s < SEQ - 1) { ld8f(p0 + IN0 + 2560 + cc, gp); ld8f(p0 + IN0 + 3584 + cc, up); } else {
#pragma unroll
            for (int e = 0; e < 8; ++e) { gp[e] = 0.f; up[e] = 0.f; } }
        float o[8];
#pragma unroll
        for (int e = 0; e < 8; ++e) o[e] = gb[e] * (cw[cc + e] * (gm[e] * um[e]) + cw[1024 + cc + e] * (g0[e] * u0[e]) + cw[2048 + cc + e] * (gp[e] * up[e]));
        u32x4 w; w.x = pk2(o[0], o[1]); w.y = pk2(o[2], o[3]); w.z = pk2(o[4], o[5]); w.w = pk2(o[6], o[7]);
        *(u32x4*)(MIX + (size_t)t * DM + 1024 + cc) = w;
    }
}
__device__ __forceinline__ void ew1_token(int t, const u16* __restrict__ LAT, u16* __restrict__ CQN, u16* __restrict__ CKVN, u16* __restrict__ KROPE, int lane) {
    const u16* p0 = LAT + (size_t)t * NLATP;
#pragma unroll
    for (int part = 0; part < 2; ++part) {
        float x[8]; ld8f(p0 + part * 512 + lane * 8, x);
        float ss = 0.f;
#pragma unroll
        for (int e = 0; e < 8; ++e) ss += x[e] * x[e];
        const float r = 1.0f / sqrtf(wave_sum(ss) * (1.f / 512.f) + EPS);
        u32x4 w; w.x = pk2(x[0] * r, x[1] * r); w.y = pk2(x[2] * r, x[3] * r); w.z = pk2(x[4] * r, x[5] * r); w.w = pk2(x[6] * r, x[7] * r);
        *(u32x4*)((part ? CKVN : CQN) + (size_t)t * 512 + lane * 8) = w;
    }
    if (lane < 32) {
        const int s = t & (SEQ - 1), row = s >> 6, col = s & 63; const int j = lane & 15;
        const float invf = __builtin_amdgcn_exp2f(-(float)j * (LOG2_THETA / 16.f)); float c, sn; rope_cs((float)(lane < 16 ? row : col), invf, c, sn);
        const unsigned u = *(const unsigned*)(p0 + 1024 + 2 * lane); const float x1 = bflo(u), x2 = bfhi(u);
        *(unsigned*)(KROPE + (size_t)t * 64 + 2 * lane) = pk2(x1 * c - x2 * sn, x1 * sn + x2 * c);
    }
}
__device__ __forceinline__ void ew2_token(int t, u16* __restrict__ Q, int lane) {
    const int s = t & (SEQ - 1), row = s >> 6, col = s & 63;
    const int h = lane >> 2, part = lane & 3; const float pos = (float)(part < 2 ? row : col);
    u16* p = Q + (size_t)t * NQ + h * 192 + 128 + part * 16;
    float x[16]; ld8f(p, x); ld8f(p + 8, x + 8);
    unsigned w[8];
#pragma unroll
    for (int i = 0; i < 8; ++i) { const int j = (part & 1) * 8 + i; const float invf = __builtin_amdgcn_exp2f(-(float)j * (LOG2_THETA / 16.f)); float c, sn; rope_cs(pos, invf, c, sn);
        w[i] = pk2(x[2 * i] * c - x[2 * i + 1] * sn, x[2 * i] * sn + x[2 * i + 1] * c); }
    *(u32x4*)p = (u32x4){w[0], w[1], w[2], w[3]}; *(u32x4*)(p + 8) = (u32x4){w[4], w[5], w[6], w[7]};
}

#define RLX_AGENT __ATOMIC_RELAXED, __HIP_MEMORY_SCOPE_AGENT
#define XB_TMO      128
#define XB_XCNT(j)  (256  + 64 * (j))
#define XB_XSUB(j)  (1280 + 64 * (j))
#define XB_XGEN(j)  (2304 + 64 * (j))
#define XB_TOP      3328
#define XB_TOPGEN   3392
#define XCD_BAR_WORDS 3456
#define XB_SPIN_CAP (1u << 22)

__device__ __forceinline__ unsigned xb_ld(unsigned* p)              { return __hip_atomic_load(p, __ATOMIC_RELAXED, __HIP_MEMORY_SCOPE_AGENT); }
__device__ __forceinline__ unsigned xb_add(unsigned* p, unsigned v) { return __hip_atomic_fetch_add(p, v, __ATOMIC_RELAXED, __HIP_MEMORY_SCOPE_AGENT); }
__device__ __forceinline__ unsigned xb_xcc_id() { return (unsigned)__builtin_amdgcn_s_getreg((3 << 11) | 20) & 0xFu; }
#define XB_SPIN(cond, bar) do { unsigned _sp = 0; while (cond) { __builtin_amdgcn_s_sleep(1); \
    if ((++_sp & 255u) == 0u) { if (xb_ld(&(bar)[XB_TMO])) break; if (_sp > XB_SPIN_CAP) { atomicAdd(&(bar)[XB_TMO], 1u); break; } } } } while (0)

struct XcdBarrier {
    unsigned* bar; unsigned x;
    volatile LAS unsigned* st;
};

__device__ __forceinline__ XcdBarrier xcd_barrier_post(unsigned* bar, volatile LAS unsigned* st) {
    XcdBarrier b; b.bar = bar; b.x = xb_xcc_id(); b.st = st;
    if (threadIdx.x == 0) (void)xb_add(&bar[XB_XCNT(b.x)], 1u);
    return b;
}
__device__ __forceinline__ void xcd_barrier_complete(unsigned* bar, unsigned x, unsigned& nloc, unsigned& nx) {
    const unsigned G = gridDim.x * gridDim.y * gridDim.z;
    unsigned sum, cnt, mine, sp = 0u;
    for (;;) {
        sum = 0u; cnt = 0u; mine = 0u;
#pragma unroll
        for (unsigned j = 0; j < 16; ++j) { const unsigned c = xb_ld(&bar[XB_XCNT(j)]); sum += c; cnt += (c > 0u) ? 1u : 0u; mine = (j == x) ? c : mine; }
        if (sum == G) break;
        __builtin_amdgcn_s_sleep(1);
        if ((++sp & 255u) == 0u) { if (xb_ld(&bar[XB_TMO])) break; if (sp > XB_SPIN_CAP) { atomicAdd(&bar[XB_TMO], 1u); break; } }
    }
    nloc = mine > 0u ? mine : 1u; nx = cnt > 0u ? cnt : 1u;
}

__device__ __forceinline__ void xcd_barrier(const XcdBarrier& b) {
    asm volatile("s_waitcnt vmcnt(0)" ::: "memory");
    __syncthreads();
    if (threadIdx.x == 0) {
        unsigned* bar = b.bar;
        __builtin_amdgcn_s_waitcnt(0);
        unsigned nloc = b.st[0], nx = b.st[1];
        if (nloc == 0u) { xcd_barrier_complete(bar, b.x, nloc, nx); b.st[0] = nloc; b.st[1] = nx; }
        const unsigned old = xb_add(&bar[XB_XSUB(b.x)], 1u);
        const unsigned gen = old / nloc;
        if (old + 1u == (gen + 1u) * nloc) {
            __builtin_amdgcn_fence(__ATOMIC_RELEASE, "agent");
            asm volatile("s_waitcnt vmcnt(0)" ::: "memory");
            const unsigned og = xb_add(&bar[XB_TOP], 1u);
            const unsigned tg = og / nx;
            if (og + 1u == (tg + 1u) * nx) xb_add(&bar[XB_TOPGEN], 1u);
            else XB_SPIN(xb_ld(&bar[XB_TOPGEN]) == tg, bar);
            __builtin_amdgcn_fence(__ATOMIC_ACQUIRE, "agent");
            xb_add(&bar[XB_XGEN(b.x)], 1u);
            asm volatile("s_waitcnt vmcnt(0)" ::: "memory");
        } else {
            XB_SPIN(xb_ld(&bar[XB_XGEN(b.x)]) == gen, bar);
            __builtin_amdgcn_fence(__ATOMIC_ACQUIRE, "agent");
            asm volatile("s_waitcnt vmcnt(0)" ::: "memory");
        }
    }
    __syncthreads();
}

struct Params { const float* in[18]; float* out; unsigned char* ws; int ph_lo, ph_hi; };
enum { I_X = 0, I_ENG, I_EWIN, I_EQG, I_EKG, I_ECW, I_EWOUT, I_ONG, I_OWDOWN, I_OQG, I_OKVG, I_OWUQ, I_OWUKV, I_OWO, I_MNG, I_MWUP, I_MWDN, I_FNG };
constexpr int NPHASE = 19;

template <int DQK> __device__ __forceinline__ bool attn_next(int i, int NU, int& unit) {
    const int G = gridDim.x, bx = blockIdx.x;
    if ((G & 7) == 0 && (NU & 7) == 0) { const int x = bx & 7, j = bx >> 3, per = G >> 3, upx = NU >> 3; const int k = i * per + j; if (k >= upx) return false; unit = x * upx + k; return true; }
    const int k = i * G + bx; if (k >= NU) return false; unit = k; return true;
}

__global__ void __launch_bounds__(NTHREADS, 2) fwd_mega(Params P) {
    extern __shared__ __attribute__((aligned(16))) unsigned char lds[];
    cg::grid_group grid = cg::this_grid();
    const int tid = threadIdx.x, lane = tid & 63, wave = __builtin_amdgcn_readfirstlane(tid >> 6);
    const int G = gridDim.x, gw = blockIdx.x * NWAVES + wave, NGW = G * NWAVES;
    unsigned char* ws = P.ws;
    u16* Win = (u16*)(ws + WS_WIN); u16* Wout = (u16*)(ws + WS_WOUT); u16* Wdown = (u16*)(ws + WS_WDOWN); u16* Wuq = (u16*)(ws + WS_WUQ); u16* Wukv = (u16*)(ws + WS_WUKV); u16* Wo = (u16*)(ws + WS_WO);
    u16* Wup = (u16*)(ws + WS_WUP); u16* Wdn = (u16*)(ws + WS_WDN);
    u16* XN = (u16*)(ws + WS_XN); u16* PROJ = (u16*)(ws + WS_PROJ); u16* MIX = (u16*)(ws + WS_MIX); u16* HID = (u16*)(ws + WS_HID);
    u16* LAT = (u16*)(ws + WS_LAT); u16* CQN = (u16*)(ws + WS_CQN); u16* CKVN = (u16*)(ws + WS_CKVN); u16* KROPE = (u16*)(ws + WS_KROPE);
    u16* Qm = (u16*)(ws + WS_Q); u16* KVm = (u16*)(ws + WS_KV); u16* AO = (u16*)(ws + WS_AO);
    u16* HB = (u16*)(ws + WS_HB); float* SS0 = (float*)(ws + WS_SS); float* SS1 = SS0 + T; float* SS2 = SS1 + T; float* SSQ = SS2 + T; float* SSKV = SSQ + T; const float* NOSS = nullptr; float* NOSSW = nullptr;
    LAS unsigned char* ldsl = (LAS unsigned char*)lds;
    const int lo = P.ph_lo, hi = P.ph_hi;
    volatile LAS unsigned* xst = (volatile LAS unsigned*)(ldsl + LDS_BYTES - 16);
    if (tid < 4) xst[tid] = 0u;
    __syncthreads();
    XcdBarrier xbar = xcd_barrier_post((unsigned*)(ws + WS_CTL), xst);
#define PH(k) if (lo <= (k) && (k) < hi) _Pragma("unroll") for (int rep_ = 0; rep_ <= (int)((REP_MASK >> (k)) & 1u); ++rep_)
#define SEAM(k) do { if (lo <= (k) && (k) + 1 < hi) { if ((k) == 0) grid.sync(); else xcd_barrier(xbar); } } while (0)
#define GEMM_BF16X(ACT, Aptr, ldav, Bptr, Mv, Nv, Kv, Optr, ldc, ssptr, sso0p, sso1p) do { pg8::Gemm g{Aptr, Bptr, Mv, Nv, Kv, ldav}; pg8::StaticOrder S; S.init(Mv, Nv, G, (int)blockIdx.x); \
        pg8::EpiBf16<ACT> E{Optr, ldc, ssptr, 1.0f / (float)(Kv), EPS, sso0p, sso1p}; pg8::gemm_phase<pg8::EpiBf16<ACT>, pg8::StaticOrder, true, true>(ldsl, g, S, E); } while (0)
#define GEMM_BF16(ACT, Aptr, Bptr, Mv, Nv, Kv, Optr, ldc, ssptr) GEMM_BF16X(ACT, Aptr, Kv, Bptr, Mv, Nv, Kv, Optr, ldc, ssptr, NOSSW, NOSSW)
#define GEMM_RES(F32B, Aptr, Bptr, Mv, Nv, Kv, baseptr, ssptr) do { pg8::Gemm g{Aptr, Bptr, Mv, Nv, Kv, Kv}; pg8::StaticOrder S; S.init(Mv, Nv, G, (int)blockIdx.x); \
        pg8::EpiResB<F32B> E{baseptr, HB, Nv, ssptr}; pg8::gemm_phase<pg8::EpiResB<F32B>, pg8::StaticOrder, true, true>(ldsl, g, S, E); } while (0)
#define NORM_PHASE() do { for (int m = gw; m < T; m += NGW) norm_row_b2b(HB + (size_t)m * DM, XN + (size_t)m * DM, lane); } while (0)

    PH(0) {
        LAS float* scr = (LAS float*)(ldsl + wave * 16384);
        constexpr int I0 = (DM / 64) * (IN0 / 32), I1 = (DM / 64) * (DM / 32), I2 = (DM / 64) * (NLAT / 32), I3 = (512 / 64) * (NQ / 32), I4 = (512 / 64) * (NKV / 32), I5 = I1;
        constexpr int I6 = (DM / 64) * (DFF / 32), I7 = (DFF / 64) * (DM / 32);
        constexpr int NITEMS = I0 + I1 + I2 + I3 + I4 + I5 + 2 * I6 + 2 * I7;
        for (int it = gw; it < NITEMS; it += NGW) {
            int r = it;
            if (r < I0) { transpose_item(P.in[I_EWIN], P.in[I_ENG], 1.f, DM, IN0, Win, scr, r, lane); continue; } r -= I0;
            if (r < I1) { transpose_item(P.in[I_EWOUT], nullptr, 1.f, DM, DM, Wout, scr, r, lane); continue; } r -= I1;
            if (r < I2) { transpose_item(P.in[I_OWDOWN], P.in[I_ONG], 1.f, DM, NLAT, Wdown, scr, r, lane); continue; } r -= I2;
            if (r < I3) { transpose_item(P.in[I_OWUQ], P.in[I_OQG], att::Cfg<192>::C, 512, NQ, Wuq, scr, r, lane); continue; } r -= I3;
            if (r < I4) { transpose_item(P.in[I_OWUKV], P.in[I_OKVG], 1.f, 512, NKV, Wukv, scr, r, lane); continue; } r -= I4;
            if (r < I5) { transpose_item(P.in[I_OWO], nullptr, 1.f, DM, DM, Wo, scr, r, lane); continue; } r -= I5;
            if (r < I6) { transpose_item(P.in[I_MWUP], P.in[I_MNG], 1.f, DM, DFF, Wup, scr, r, lane); continue; } r -= I6;
            if (r < I6) { transpose_item(P.in[I_MWUP] + (size_t)DM * DFF, P.in[I_MNG] + DM, 1.f, DM, DFF, Wup + (size_t)DM * DFF, scr, r, lane); continue; } r -= I6;
            if (r < I7) { transpose_item(P.in[I_MWDN], nullptr, 1.f, DFF, DM, Wdn, scr, r, lane); continue; } r -= I7;
            transpose_item(P.in[I_MWDN] + (size_t)DM * DFF, nullptr, 1.f, DFF, DM, Wdn + (size_t)DM * DFF, scr, r, lane);
        }
        { const size_t n16 = (size_t)(NLATP - NLAT) * DM * 2 / 16; u32x4* z = (u32x4*)(Wdown + (size_t)NLAT * DM);
          for (size_t i = (size_t)blockIdx.x * NTHREADS + tid; i < n16; i += (size_t)G * NTHREADS) z[i] = (u32x4){0u, 0u, 0u, 0u}; }
        for (int m = gw; m < T; m += NGW) norm_row_bf16(P.in[I_X] + (size_t)m * DM, XN + (size_t)m * DM, lane);
    }
    SEAM(0);
    PH(1) { GEMM_BF16(0, XN, Win, T, IN0, DM, PROJ, IN0, NOSS); }
    SEAM(1);
    PH(2) { const int per = (T + NGW - 1) / NGW; const int t0 = gw * per; for (int t = t0; t < t0 + per && t < T; ++t) ew0_token(t, PROJ, MIX, P.in[I_EQG], P.in[I_EKG], P.in[I_ECW], lane); }
    SEAM(2);
    PH(3) {
        if (ATT_PRIO && wave >= 4) __builtin_amdgcn_s_setprio(1);
        constexpr int NU = BATCH * 8 * (SEQ / 256); int unit;
        for (int i = 0; attn_next<128>(i, NU, unit); ++i) {
            const int bh = unit / (SEQ / 256), qb = unit % (SEQ / 256), b = bh >> 3, hq = bh & 7, kvh = hq >> 2;
            const size_t tb = (size_t)b * SEQ;
#ifndef NO_GQA
            att::ATT_UNIT<128, IN0, IN0, IN0, DM>(PROJ + (tb + (size_t)qb * 256) * IN0 + hq * 128, PROJ + tb * IN0 + 1024 + kvh * 128, nullptr, PROJ + tb * IN0 + 1280 + kvh * 128,
                                                      MIX + (tb + (size_t)qb * 256) * DM + hq * 128, SEQ, (char*)lds);
#endif
        }
    }
    if (ATT_PRIO) __builtin_amdgcn_s_setprio(0);
    SEAM(3);
    PH(4) { GEMM_RES(true, MIX, Wout, T, DM, DM, (const void*)P.in[I_X], SS0); }
    SEAM(4);
    PH(6) { GEMM_BF16(2, HB, Wup, T, DFF, DM, HID, DFF, (const float*)SS0); }
    SEAM(6);
    PH(7) { GEMM_RES(false, HID, Wdn, T, DM, DFF, (const void*)HB, SS1); }
    SEAM(7);
    PH(9) { GEMM_BF16X(0, HB, DM, Wdown, T, NLATP, DM, LAT, NLATP, (const float*)SS1, SSQ, SSKV); }
    SEAM(9);
    PH(11) {
        for (int t = gw; t < T; t += NGW) if (lane < 32) {
            const int s = t & (SEQ - 1), row = s >> 6, col = s & 63; const int j = lane & 15;
            const float invf = __builtin_amdgcn_exp2f(-(float)j * (LOG2_THETA / 16.f)); float c, sn; rope_cs((float)(lane < 16 ? row : col), invf, c, sn);
            const unsigned u = *(const unsigned*)(LAT + (size_t)t * NLATP + 1024 + 2 * lane); const float x1 = bflo(u), x2 = bfhi(u);
            *(unsigned*)(KROPE + (size_t)t * 64 + 2 * lane) = pk2(x1 * c - x2 * sn, x1 * sn + x2 * c); }
        GEMM_BF16X(0, LAT, NLATP, Wuq, T, NQ, 512, Qm, NQ, (const float*)SSQ, NOSSW, NOSSW);
        GEMM_BF16X(0, LAT + 512, NLATP, Wukv, T, NKV, 512, KVm, NKV, (const float*)SSKV, NOSSW, NOSSW); }
    SEAM(11);
    PH(13) {
        if (ATT_PRIO && wave >= 4) __builtin_amdgcn_s_setprio(1);
        constexpr int NU = BATCH * 16 * (SEQ / 256); int unit;
        for (int i = 0; attn_next<192>(i, NU, unit); ++i) {
            const int bh = unit / (SEQ / 256), qb = unit % (SEQ / 256), b = bh >> 4, h = bh & 15;
            const size_t tb = (size_t)b * SEQ;
#ifndef NO_MLA
            att::ATT_UNIT<192, NQ, NKV, NKV, DM>(Qm + (tb + (size_t)qb * 256) * NQ + h * 192, KVm + tb * NKV + h * 256, KROPE + tb * 64, KVm + tb * NKV + h * 256 + 128,
                                                          AO + (tb + (size_t)qb * 256) * DM + h * 128, SEQ, (char*)lds, qb * 256);
#endif
        }
    }
    if (ATT_PRIO) __builtin_amdgcn_s_setprio(0);
    SEAM(13);
    PH(14) { GEMM_RES(false, AO, Wo, T, DM, DM, (const void*)HB, SS2); }
    SEAM(14);
    PH(16) { GEMM_BF16(2, HB, Wup + (size_t)DM * DFF, T, DFF, DM, HID, DFF, (const float*)SS2); }
    SEAM(16);
    PH(17) { GEMM_RES(false, HID, Wdn + (size_t)DM * DFF, T, DM, DFF, (const void*)HB, NOSSW); }
    SEAM(17);
    PH(18) { for (int m = gw; m < T; m += NGW) norm_row_final(HB + (size_t)m * DM, P.out + (size_t)m * DM, P.in[I_FNG], lane);
#ifdef ATT_TIMING
        if (blockIdx.x == 0 && tid == 0) { asm volatile("s_waitcnt vmcnt(0)" ::: "memory"); P.out[0] = floorf(((float*)(ws + WS_CTL + 32768))[ATT_TIMING] * (1.f / 200.f) + 0.5f) * 200000.f; }
#endif
    }
#undef PH
#undef SEAM
}

extern "C" void kernel_launch(void* const* d_in, const int* in_sizes, int n_in, void* d_out, int out_size, void* d_ws, size_t ws_size, hipStream_t stream) {
    static int grid = 0;
    if (grid == 0) {
        if (n_in != 18 || in_sizes[0] != T * DM || out_size != T * DM || ws_size < WS_END) {
            fprintf(stderr, "kernel_launch: shape mismatch (n_in %d in0 %d out %d ws %zu need %zu)\n", n_in, n_in > 0 ? in_sizes[0] : -1, out_size, ws_size, (size_t)WS_END); grid = -1; return; }
        int dev = 0, cus = 0, per_cu = 0;
        hipGetDevice(&dev); hipDeviceGetAttribute(&cus, hipDeviceAttributeMultiprocessorCount, dev);
        if (hipFuncSetAttribute((const void*)fwd_mega, hipFuncAttributeMaxDynamicSharedMemorySize, LDS_BYTES) != hipSuccess) { fprintf(stderr, "kernel_launch: hipFuncSetAttribute failed\n"); grid = -1; return; }
        if (hipOccupancyMaxActiveBlocksPerMultiprocessor(&per_cu, (const void*)fwd_mega, NTHREADS, LDS_BYTES) != hipSuccess || per_cu < 1) { fprintf(stderr, "kernel_launch: occupancy query says %d\n", per_cu); per_cu = 1; }
        (void)hipGetLastError();
        grid = cus * per_cu;
        fprintf(stderr, "kernel_launch: grid %d (cus %d x %d)\n", grid, cus, per_cu);
    }
    if (grid < 0) return;
    if (hipMemsetAsync((char*)d_ws + WS_CTL, 0, CTL_BYTES, stream) != hipSuccess) { fprintf(stderr, "kernel_launch: memset failed\n"); return; }
    Params p{};
    for (int i = 0; i < 18; ++i) p.in[i] = (const float*)d_in[i];
    p.out = (float*)d_out; p.ws = (unsigned char*)d_ws;
#if N_LAUNCH_SPLIT
    for (int k = 0; k < NPHASE; ++k) { p.ph_lo = k; p.ph_hi = k + 1; void* args[] = {&p};
        hipError_t e = hipLaunchCooperativeKernel((const void*)fwd_mega, dim3(grid), dim3(NTHREADS), args, LDS_BYTES, stream);
        if (e != hipSuccess) { fprintf(stderr, "cooperative launch failed: %s (grid %d)\n", hipGetErrorString(e), grid); break; } }
#else
    p.ph_lo = 0; p.ph_hi = NPHASE; void* args[] = {&p};
    hipError_t e = hipLaunchCooperativeKernel((const void*)fwd_mega, dim3(grid), dim3(NTHREADS), args, LDS_BYTES, stream);
    if (e != hipSuccess) fprintf(stderr, "cooperative launch failed: %s (grid %d)\n", hipGetErrorString(e), grid);
#endif
}
```

```cpp
#include <hip/hip_runtime.h>
#include <hip/hip_cooperative_groups.h>
#include <cstdio>
#include <cstdint>
namespace cg = cooperative_groups;
#ifndef GQA_SD
#define GQA_SD 1
#endif
#ifndef MLA_SD
#define MLA_SD 1
#endif
#ifndef MLA_QREG
#define MLA_QREG 8
#endif
#ifndef REP_MASK
#define REP_MASK 0u
#endif
#ifndef ATT_NVA128
#define ATT_NVA128 5
#endif
#ifndef ATT_NVA192
#define ATT_NVA192 3
#endif
#ifndef ATT_NVB
#define ATT_NVB 2
#endif
#ifndef ATT_PREA
#define ATT_PREA 4
#endif
#ifndef ATT_LEAD128
#define ATT_LEAD128 0
#endif
#ifndef ATT_NVL128
#define ATT_NVL128 7
#endif
#ifndef ATT_LEAD192
#define ATT_LEAD192 0
#endif
#ifndef ATT_NVL192
#define ATT_NVL192 8
#endif
#ifndef ATT_PREB
#define ATT_PREB 8
#endif
#ifndef PROBE_EW0
#define PROBE_EW0 0
#endif
#ifndef PROBE_DN
#define PROBE_DN 0
#endif
#ifndef PROBE_OUT
#define PROBE_OUT 0
#endif
#ifndef ATT_PRIO
#define ATT_PRIO 0
#endif
#ifndef ATT_PRIOMODE
#define ATT_PRIOMODE 0
#endif
#ifndef ATT_TWAVE
#define ATT_TWAVE 0
#endif
#ifndef ATT_KEYMASK128
#define ATT_KEYMASK128 15
#endif
#ifndef ATT_MG192
#define ATT_MG192 2
#endif
#ifndef ATT_DS192
#define ATT_DS192 2
#endif
#ifndef ATT_UNIT
#define ATT_UNIT attn_unit_dma
#endif
#ifndef N_LAUNCH_SPLIT
#define N_LAUNCH_SPLIT 0
#endif
namespace pg8 {
#define PG8_LAS __attribute__((address_space(3)))
typedef unsigned short bf16_t;
typedef short bf16x8 __attribute__((ext_vector_type(8)));
typedef float f32x4 __attribute__((ext_vector_type(4)));
typedef unsigned u32x4 __attribute__((ext_vector_type(4)));
constexpr int BM = 256, BK = 64, HALF = 128, HTB = HALF * BK * 2  , STAGE_BYTES = 8 * HTB, NXCD = 8, WGM = 8;

__host__ __device__ __forceinline__ int lds_byte(int r, int c) { const int st = (r >> 4) * 2 + (c >> 5), rr = r & 15, cc = c & 31, ob = rr * 64 + cc * 2; return st * 1024 + (ob ^ (((ob >> 9) & 1) << 5)); }
__host__ __device__ __forceinline__ void stage_rc(int b, int& R, int& C) { const int st = b / 1024, sb = b % 1024, swz = sb ^ (((sb >> 9) & 1) << 5); R = (st >> 1) * 16 + swz / 64; C = (st & 1) * 32 + (swz % 64) / 2; }
__host__ __device__ __forceinline__ int perm32(int rho) { const int n = rho >> 4, i = rho & 15; return 8 * (i >> 2) + 4 * n + (i & 3); }

struct Unit { int pm, pn; };
struct Gemm { const bf16_t* A; const bf16_t* Bt; int M, N, K, lda; };

struct StaticOrder {
    int nM, nN, nwg, G, c;
    __host__ __device__ void init(int M, int N, int G_, int c_) { nM = M / BM; nN = N / BM; nwg = nM * nN; G = G_; c = c_; }
    __host__ __device__ bool next(int i, Unit& u) const {
        const long L = (long)i * G + c; if (L >= nwg) return false;
        int wgid = (int)L; { const int q = nwg / NXCD, r = nwg % NXCD, xcd = wgid % NXCD, off = wgid / NXCD; wgid = (xcd < r ? xcd * (q + 1) : r * (q + 1) + (xcd - r) * q) + off; }
        const int nig = WGM * nN, gid = wgid / nig, fm = gid * WGM, gsz = (nM - fm) < WGM ? (nM - fm) : WGM;
        u.pm = fm + ((wgid % nig) % gsz); u.pn = (wgid % nig) / gsz; return true;
    }
    __device__ __forceinline__ void a_ready(const Unit&) const {}
    __device__ __forceinline__ void done(const Unit&) const {}
};
__device__ __forceinline__ unsigned cvt_pk_bf16(float lo, float hi) { unsigned r; asm volatile("v_cvt_pk_bf16_f32 %0, %1, %2" : "=v"(r) : "v"(lo), "v"(hi)); return r; }
template <int ACT> struct EpiBf16 {
    static constexpr bool PERM = true, AFTER_DRAIN = false;
    bf16_t* O; int ldc; const float* ss; float inv_k, eps;
    float* sso0; float* sso1;
    __device__ __forceinline__ void operator()(const f32x4 (&acc)[2][2][4][2], const Unit& u, int wr, int wc, int fr, int fq) const {
        const int row0 = u.pm * BM + wr * 64 + fr; const int col0 = u.pn * BM + wc * 32 + 8 * fq;
#pragma unroll
        for (int ai = 0; ai < 2; ++ai)
#pragma unroll
            for (int m = 0; m < 4; ++m) { const int row = row0 + ai * HALF + m * 16; bf16_t* rowp = O + (size_t)row * ldc + col0;
                const float rs = ss ? (1.0f / sqrtf(ss[row] * inv_k + eps)) : 1.0f;
                float q = 0.f;
#pragma unroll
                for (int bj = 0; bj < 2; ++bj) { f32x4 v0 = acc[ai][bj][m][0] * rs, v1 = acc[ai][bj][m][1] * rs;
                    q += (v0[0] * v0[0] + v0[1] * v0[1]) + (v0[2] * v0[2] + v0[3] * v0[3]) + (v1[0] * v1[0] + v1[1] * v1[1]) + (v1[2] * v1[2] + v1[3] * v1[3]);
                    if (ACT == 2) {
#pragma unroll
                        for (int e = 0; e < 4; ++e) { float a = v0[e] > 0.f ? v0[e] : 0.f; v0[e] = a * a; float b = v1[e] > 0.f ? v1[e] : 0.f; v1[e] = b * b; } }
                    u32x4 w; w.x = cvt_pk_bf16(v0[0], v0[1]); w.y = cvt_pk_bf16(v0[2], v0[3]); w.z = cvt_pk_bf16(v1[0], v1[1]); w.w = cvt_pk_bf16(v1[2], v1[3]);
                    *(u32x4*)(rowp + bj * HALF) = w; }
                if (sso0) { float* so = (u.pn < 2) ? sso0 : ((u.pn < 4) ? sso1 : nullptr);
                    if (so) { q += __shfl_xor(q, 16); q += __shfl_xor(q, 32); if (fq == 0) atomicAdd(so + row, q); } } }
    }
};
template <bool BASE_F32> struct EpiResB {
    static constexpr bool PERM = true, AFTER_DRAIN = false;
    const void* base; bf16_t* out; int ldc; float* ss;
    __device__ __forceinline__ void operator()(const f32x4 (&acc)[2][2][4][2], const Unit& u, int wr, int wc, int fr, int fq) const {
        const int row0 = u.pm * BM + wr * 64 + fr; const int col0 = u.pn * BM + wc * 32 + 8 * fq;
#pragma unroll
        for (int ai = 0; ai < 2; ++ai)
#pragma unroll
            for (int m = 0; m < 4; ++m) { const size_t off = (size_t)(row0 + ai * HALF + m * 16) * ldc + col0; float q = 0.f;
#pragma unroll
                for (int bj = 0; bj < 2; ++bj) { const size_t o = off + bj * HALF; f32x4 b0, b1;
                    if constexpr (BASE_F32) { b0 = *(const f32x4*)((const float*)base + o); b1 = *(const f32x4*)((const float*)base + o + 4); }
                    else { const u32x4 w = *(const u32x4*)((const bf16_t*)base + o);
                        b0 = (f32x4){__uint_as_float(w.x << 16), __uint_as_float(w.x & 0xffff0000u), __uint_as_float(w.y << 16), __uint_as_float(w.y & 0xffff0000u)};
                        b1 = (f32x4){__uint_as_float(w.z << 16), __uint_as_float(w.z & 0xffff0000u), __uint_as_float(w.w << 16), __uint_as_float(w.w & 0xffff0000u)}; }
                    const f32x4 v0 = b0 + acc[ai][bj][m][0], v1 = b1 + acc[ai][bj][m][1];
                    q += (v0[0] * v0[0] + v0[1] * v0[1]) + (v0[2] * v0[2] + v0[3] * v0[3]) + (v1[0] * v1[0] + v1[1] * v1[1]) + (v1[2] * v1[2] + v1[3] * v1[3]);
                    u32x4 r; r.x = cvt_pk_bf16(v0[0], v0[1]); r.y = cvt_pk_bf16(v0[2], v0[3]); r.z = cvt_pk_bf16(v1[0], v1[1]); r.w = cvt_pk_bf16(v1[2], v1[3]);
                    *(u32x4*)(out + o) = r; }
                if (ss) { q += __shfl_xor(q, 16); q += __shfl_xor(q, 32); if (fq == 0) atomicAdd(ss + (row0 + ai * HALF + m * 16), q); }
                asm volatile("" ::: "memory"); }
    }
};
template <class Epi, class Sched, bool ALIGN_EPI = false, bool SP2 = false>
__device__ __forceinline__ void gemm_phase(PG8_LAS unsigned char* lds, const Gemm g, const Sched& S, const Epi& E) {
    const int tid = threadIdx.x, wid = __builtin_amdgcn_readfirstlane(tid >> 6), lane = tid & 63, wr = wid >> 2, wc = wid & 3, fr = lane & 15, fq = lane >> 4;
    const int K = g.K, nt = K / BK;
    unsigned voffA[2], voffB[2];
#pragma unroll
    for (int i = 0; i < 2; ++i) { int R, C; stage_rc(tid * 16 + i * 8192, R, C); const int Rb = Epi::PERM ? ((R & ~31) + perm32(R & 31)) : R;
        voffA[i] = (unsigned)(R * g.lda + C) * 2u; voffB[i] = (unsigned)(Rb * K + C) * 2u; }
    const size_t kstep = (size_t)(BK * 2);
    const size_t hstep = (size_t)HALF * K * 2;
    const size_t tstep = 2 * hstep;
    const size_t hstepA = (size_t)HALF * g.lda * 2, tstepA = 2 * hstepA;
    const unsigned ldsw = (unsigned)wid * 1024u;
    const int aoff = lds_byte(wr * 64 + fr, fq * 8), boff = lds_byte(wc * 32 + fr, fq * 8);
#define PG8_SA(b, h) (((b) * 2 + (h)) * HTB)
#define PG8_SB(b, h) ((4 + (b) * 2 + (h)) * HTB)
#define PG8_STAGE(bufoff, gbase, voff) do { _Pragma("unroll") for (int _i = 0; _i < 2; ++_i) \
        __builtin_amdgcn_global_load_lds((const unsigned*)((const char*)(gbase) + (voff)[_i]), (PG8_LAS unsigned*)(lds + (bufoff) + ldsw + _i * 8192), 16, 0, 0); } while (0)
#define PG8_LDA(dst, b, h) do { _Pragma("unroll") for (int m = 0; m < 4; ++m) _Pragma("unroll") for (int k = 0; k < 2; ++k) dst[m][k] = *(const PG8_LAS bf16x8*)(lds + PG8_SA(b, h) + aoff + m * 2048 + k * 1024); } while (0)
#define PG8_LDB(dst, b, h) do { _Pragma("unroll") for (int n = 0; n < 2; ++n) _Pragma("unroll") for (int k = 0; k < 2; ++k) dst[n][k] = *(const PG8_LAS bf16x8*)(lds + PG8_SB(b, h) + boff + n * 2048 + k * 1024); } while (0)
#define PG8_MMA(ai, bj, At, Bt) do { __builtin_amdgcn_s_setprio(1); _Pragma("unroll") for (int m = 0; m < 4; ++m) _Pragma("unroll") for (int n = 0; n < 2; ++n) _Pragma("unroll") for (int k = 0; k < 2; ++k) \
        acc[ai][bj][m][n] = __builtin_amdgcn_mfma_f32_16x16x32_bf16(Bt[n][k], At[m][k], acc[ai][bj][m][n], 0, 0, 0); __builtin_amdgcn_s_setprio(0); } while (0)
#define PG8_WAIT_V(n) asm volatile("s_waitcnt vmcnt(" #n ")" ::: "memory")
#define PG8_WAIT_L(n) asm volatile("s_waitcnt lgkmcnt(" #n ")" ::: "memory")
#define PG8_BAR __builtin_amdgcn_s_barrier()
#define PG8_SCHED __builtin_amdgcn_sched_barrier(0)
    Unit cur, nxt; int ui = 0;
    if (!S.next(0, cur)) return;
    f32x4 acc[2][2][4][2];
#pragma unroll
    for (int a = 0; a < 2; ++a)
#pragma unroll
        for (int b = 0; b < 2; ++b)
#pragma unroll
            for (int m = 0; m < 4; ++m)
#pragma unroll
                for (int n = 0; n < 2; ++n) acc[a][b][m][n] = (f32x4){0.f, 0.f, 0.f, 0.f};
    bf16x8 At[4][2], B0[2][2], B1[2][2];
    const char* cA = (const char*)g.A + (size_t)cur.pm * tstepA; const char* cB = (const char*)g.Bt + (size_t)cur.pn * tstep;
    S.a_ready(cur);
    if constexpr (SP2) {
        PG8_STAGE(PG8_SB(0, 0), cB, voffB); PG8_STAGE(PG8_SB(0, 1), cB + hstep, voffB); PG8_STAGE(PG8_SA(0, 0), cA, voffA); PG8_STAGE(PG8_SA(0, 1), cA + hstepA, voffA);
        if (wr == 1) PG8_BAR;
        PG8_WAIT_V(2); PG8_BAR;
        PG8_STAGE(PG8_SB(1, 0), cB + kstep, voffB); PG8_STAGE(PG8_SA(1, 0), cA + kstep, voffA); PG8_STAGE(PG8_SB(1, 1), cB + hstep + kstep, voffB);
        PG8_WAIT_V(6); PG8_BAR;
    } else {
        PG8_STAGE(PG8_SB(0, 0), cB, voffB); PG8_STAGE(PG8_SA(0, 0), cA, voffA); PG8_STAGE(PG8_SB(0, 1), cB + hstep, voffB); PG8_STAGE(PG8_SA(0, 1), cA + hstepA, voffA);
        if (wr == 1) PG8_BAR;
        PG8_WAIT_V(4); PG8_BAR;
        PG8_STAGE(PG8_SB(1, 0), cB + kstep, voffB); PG8_STAGE(PG8_SA(1, 0), cA + kstep, voffA); PG8_STAGE(PG8_SB(1, 1), cB + hstep + kstep, voffB);
        PG8_WAIT_V(6); PG8_BAR;
    }
    for (;;) {
        const bool has_next = S.next(ui + 1, nxt);
        const char* nA = has_next ? (const char*)g.A + (size_t)nxt.pm * tstepA : cA; const char* nB = has_next ? (const char*)g.Bt + (size_t)nxt.pn * tstep : cB;
        for (int t = 0; t < nt; t += 2) {
            const bool last = (t == nt - 2);
            const char* a1 = cA + (size_t)(t + 1) * kstep;
            const char* a2 = last ? nA : cA + (size_t)(t + 2) * kstep; const char* b2 = last ? nB : cB + (size_t)(t + 2) * kstep;
            const char* a3 = a2 + kstep; const char* b3 = b2 + kstep;
            if (last && has_next) S.a_ready(nxt);
            if constexpr (SP2) {
            PG8_LDB(B0, 0, 0); PG8_LDB(B1, 0, 1); PG8_SCHED; PG8_LDA(At, 0, 0); PG8_STAGE(PG8_SA(1, 1), a1 + hstepA, voffA);
            PG8_WAIT_V(8); PG8_WAIT_L(0); PG8_BAR; PG8_MMA(0, 0, At, B0); PG8_MMA(0, 1, At, B1); PG8_BAR; PG8_SCHED;
            PG8_LDA(At, 0, 1); PG8_STAGE(PG8_SB(0, 0), b2, voffB); PG8_STAGE(PG8_SB(0, 1), b2 + hstep, voffB); PG8_STAGE(PG8_SA(0, 0), a2, voffA);
            PG8_WAIT_V(8); PG8_WAIT_L(0); PG8_BAR; PG8_MMA(1, 0, At, B0); PG8_MMA(1, 1, At, B1); PG8_BAR; PG8_SCHED;
            PG8_LDB(B0, 1, 0); PG8_LDB(B1, 1, 1); PG8_SCHED; PG8_LDA(At, 1, 0); PG8_STAGE(PG8_SA(0, 1), a2 + hstepA, voffA);
            PG8_WAIT_V(8); PG8_WAIT_L(0); PG8_BAR; PG8_MMA(0, 0, At, B0); PG8_MMA(0, 1, At, B1); PG8_BAR; PG8_SCHED;
            PG8_LDA(At, 1, 1); PG8_STAGE(PG8_SB(1, 0), b3, voffB); PG8_STAGE(PG8_SB(1, 1), b3 + hstep, voffB); PG8_STAGE(PG8_SA(1, 0), a3, voffA);
            PG8_WAIT_V(8); PG8_WAIT_L(0); PG8_BAR; PG8_MMA(1, 0, At, B0); PG8_MMA(1, 1, At, B1); PG8_BAR; PG8_SCHED;
            } else {
            PG8_LDB(B0, 0, 0); PG8_SCHED; PG8_LDA(At, 0, 0); PG8_STAGE(PG8_SA(1, 1), a1 + hstepA, voffA);
            PG8_WAIT_L(8); PG8_BAR; PG8_WAIT_L(0); PG8_MMA(0, 0, At, B0); PG8_BAR; PG8_SCHED;
            PG8_LDB(B1, 0, 1); PG8_STAGE(PG8_SB(0, 0), b2, voffB);
            PG8_BAR; PG8_WAIT_L(0); PG8_MMA(0, 1, At, B1); PG8_BAR;
            PG8_LDA(At, 0, 1); PG8_STAGE(PG8_SA(0, 0), a2, voffA);
            PG8_BAR; PG8_WAIT_L(0); PG8_MMA(1, 0, At, B0); PG8_BAR; PG8_SCHED;
            PG8_STAGE(PG8_SB(0, 1), b2 + hstep, voffB);
            PG8_WAIT_V(6); PG8_BAR; PG8_MMA(1, 1, At, B1); PG8_BAR;
            PG8_LDB(B0, 1, 0); PG8_SCHED; PG8_LDA(At, 1, 0); PG8_STAGE(PG8_SA(0, 1), a2 + hstepA, voffA);
            PG8_WAIT_L(8); PG8_BAR; PG8_WAIT_L(0); PG8_MMA(0, 0, At, B0); PG8_BAR; PG8_SCHED;
            PG8_LDB(B1, 1, 1); PG8_STAGE(PG8_SB(1, 0), b3, voffB);
            PG8_BAR; PG8_WAIT_L(0); PG8_MMA(0, 1, At, B1); PG8_BAR;
            PG8_LDA(At, 1, 1); PG8_STAGE(PG8_SA(1, 0), a3, voffA);
            PG8_BAR; PG8_WAIT_L(0); PG8_MMA(1, 0, At, B0); PG8_BAR; PG8_SCHED;
            PG8_STAGE(PG8_SB(1, 1), b3 + hstep, voffB);
            PG8_WAIT_V(6); PG8_BAR; PG8_MMA(1, 1, At, B1); PG8_BAR;
            }
        }
        if constexpr (ALIGN_EPI) { if (wr == 0) PG8_BAR; }
        if constexpr (!Epi::AFTER_DRAIN) { E(acc, cur, wr, wc, fr, fq); S.done(cur); }
        if (!has_next) break;
#pragma unroll
        for (int a = 0; a < 2; ++a)
#pragma unroll
            for (int b = 0; b < 2; ++b)
#pragma unroll
                for (int m = 0; m < 4; ++m)
#pragma unroll
                    for (int n = 0; n < 2; ++n) acc[a][b][m][n] = (f32x4){0.f, 0.f, 0.f, 0.f};
        cur = nxt; cA = nA; cB = nB; ++ui;
        if constexpr (ALIGN_EPI) { if (wr == 1) PG8_BAR; }
    }
    PG8_WAIT_V(0);
    if constexpr (!ALIGN_EPI) { if (wr == 0) PG8_BAR; }
    PG8_BAR;
    if constexpr (Epi::AFTER_DRAIN) { E.fused(acc, cur, wr, wc, fr, fq, lds, wid, lane); S.done(cur); }
#undef PG8_SA
#undef PG8_SB
#undef PG8_STAGE
#undef PG8_LDA
#undef PG8_LDB
#undef PG8_MMA
#undef PG8_WAIT_V
#undef PG8_WAIT_L
#undef PG8_BAR
#undef PG8_SCHED
}
}
namespace att {
typedef unsigned short bf16;
using bf16x8 = __attribute__((ext_vector_type(8))) short;
using s16x4  = __attribute__((ext_vector_type(4))) short;
using f32x16 = __attribute__((ext_vector_type(16))) float;
using u32x4  = __attribute__((ext_vector_type(4))) unsigned;
constexpr int NW = 8, QBLK = 32, KVBLK = 64;
constexpr float THR = 8.f;
#define ATT_SBAR() __builtin_amdgcn_sched_barrier(0)
__device__ __forceinline__ int crow(int r, int hi) { return (r & 3) + 8 * (r >> 2) + 4 * hi; }
typedef float f32x2_t __attribute__((ext_vector_type(2))); typedef __bf16 bf16x2_t __attribute__((ext_vector_type(2)));
__device__ __forceinline__ unsigned cvtpk(float lo, float hi) { f32x2_t v = {lo, hi}; bf16x2_t b = __builtin_convertvector(v, bf16x2_t); return __builtin_bit_cast(unsigned, b); }
typedef short v4i16_t __attribute__((ext_vector_type(4)));
typedef __attribute__((address_space(3))) const char* lds_cptr;
__device__ __forceinline__ s16x4 vtr(lds_cptr p) { return __builtin_bit_cast(s16x4, __builtin_amdgcn_ds_read_tr16_b64_v4i16((__attribute__((address_space(3))) v4i16_t*)p)); }
__device__ __forceinline__ bf16x8 ld8(const bf16* p) { return *reinterpret_cast<const bf16x8*>(p); }

template <int DQK> struct Cfg {
  static constexpr float SCALE = (DQK == 128) ? 0.088388347648318440f : 0.072168783648703220f;
  static constexpr float C = SCALE * 1.4426950408889634f;
  static constexpr int KROWB = DQK * 2, SHM_K = KVBLK * KROWB, SHM_V = KVBLK * 128 * 2, ND0 = DQK / 16;
  static constexpr int QREG = (DQK > 128) ? MLA_QREG : 8;
  static constexpr int QXW = (ND0 - QREG) * 1024, SHM_QX = NW * QXW;
  static constexpr int SHM_TOTAL = 2 * SHM_V + 2 * SHM_K + NW * 64 * 4 + SHM_QX;
};

constexpr float TRIG = 65536.f;
__device__ __forceinline__ void firstSM(f32x16& p0, f32x16& p1, float& m_ref, f32x16& negm) {
  float pmax = p0[0];
#pragma unroll
  for (int r = 1; r < 16; ++r) pmax = fmaxf(pmax, p0[r]);
#pragma unroll
  for (int r = 0; r < 16; ++r) pmax = fmaxf(pmax, p1[r]);
  { auto rr = __builtin_amdgcn_permlane32_swap(__float_as_uint(pmax), __float_as_uint(pmax), false, false);
    pmax = fmaxf(__uint_as_float(rr[0]), __uint_as_float(rr[1])); }
  m_ref = pmax;
#pragma unroll
  for (int r = 0; r < 16; ++r) { p0[r] -= pmax; p1[r] -= pmax; negm[r] = -pmax; }
#pragma unroll
  for (int r = 0; r < 16; ++r) p0[r] = __builtin_amdgcn_exp2f(p0[r]);
  asm volatile("" : "+v"(p0), "+v"(p1), "+v"(negm));
}
__device__ __forceinline__ void firstSM0(f32x16& p0, f32x16& p1, float& m_ref, f32x16& negm) {
  float pmax = p0[0];
#pragma unroll
  for (int r = 1; r < 16; ++r) pmax = fmaxf(pmax, p0[r]);
#pragma unroll
  for (int r = 0; r < 16; ++r) pmax = fmaxf(pmax, p1[r]);
  { auto rr = __builtin_amdgcn_permlane32_swap(__float_as_uint(pmax), __float_as_uint(pmax), false, false);
    pmax = fmaxf(__uint_as_float(rr[0]), __uint_as_float(rr[1])); }
  m_ref = pmax;
#pragma unroll
  for (int r = 0; r < 16; ++r) { p0[r] -= pmax; p1[r] -= pmax; negm[r] = -pmax; }
  asm volatile("" : "+v"(p0), "+v"(p1), "+v"(negm));
}
__device__ __forceinline__ void partialSM(f32x16& p0, f32x16& p1) {
#pragma unroll
  for (int r = 0; r < 16; ++r) p0[r] = __builtin_amdgcn_exp2f(p0[r]);
  asm volatile("" : "+v"(p0), "+v"(p1));
}
__device__ __forceinline__ void finishSM(f32x16& p0, f32x16& p1, float& ps, float& l_reg, bf16x8& pa0, bf16x8& pa1, bf16x8& pa2, bf16x8& pa3) {
#pragma unroll
  for (int r = 0; r < 16; ++r) p1[r] = __builtin_amdgcn_exp2f(p1[r]);
  float s0 = 0, s1 = 0;
#pragma unroll
  for (int r = 0; r < 16; ++r) s0 += p0[r];
#pragma unroll
  for (int r = 0; r < 16; ++r) s1 += p1[r];
  ps = s0 + s1;
  { auto rr = __builtin_amdgcn_permlane32_swap(__float_as_uint(ps), __float_as_uint(ps), false, false);
    ps = __uint_as_float(rr[0]) + __uint_as_float(rr[1]); }
  l_reg += ps;
#define ATT_PK4(P, BASE, OUT) do { unsigned a0 = cvtpk(P[BASE + 0], P[BASE + 1]), a1 = cvtpk(P[BASE + 2], P[BASE + 3]);   \
    unsigned b0 = cvtpk(P[BASE + 4], P[BASE + 5]), b1 = cvtpk(P[BASE + 6], P[BASE + 7]);                              \
    auto r0 = __builtin_amdgcn_permlane32_swap(a0, b0, false, false); auto r1 = __builtin_amdgcn_permlane32_swap(a1, b1, false, false); \
    u32x4 w = {r0[0], r1[0], r0[1], r1[1]}; OUT = *reinterpret_cast<bf16x8*>(&w); } while (0)
  ATT_PK4(p0, 0, pa0); ATT_PK4(p0, 8, pa1); ATT_PK4(p1, 0, pa2); ATT_PK4(p1, 8, pa3);
#undef ATT_PK4
}
#define ATT_KEY(row) ((KROWB == 256) ? ((row) & ATT_KEYMASK128) : (((row) >> 1) & 7))
#define ATT_KSWZ(row, colB) ((row) * KROWB + ((colB) ^ (ATT_KEY(row) << 4)))
template <int DQK> __device__ __forceinline__ void qkt(f32x16& p0, f32x16& p1, const f32x16& negm, const char* Ks, const int* kb, const bf16x8* qr, const char* qx, int r32, int hi) {
  constexpr int KROWB = Cfg<DQK>::KROWB, ND0 = Cfg<DQK>::ND0, QREG = Cfg<DQK>::QREG;
  p0 = negm; p1 = negm;
  constexpr int NB = (KROWB == 256 && ATT_KEYMASK128 == 15) ? 8 : 4;
#pragma unroll
  for (int d0 = 0; d0 < ND0; ++d0) {
    bf16x8 b0 = *reinterpret_cast<const bf16x8*>(Ks + kb[d0 % NB] + (d0 / NB) * (NB * 32));
    bf16x8 b1 = *reinterpret_cast<const bf16x8*>(Ks + kb[d0 % NB] + (d0 / NB) * (NB * 32) + 32 * KROWB);
    bf16x8 q; if (d0 < QREG) q = qr[d0]; else q = *reinterpret_cast<const bf16x8*>(qx + (d0 - QREG) * 1024);
    p0 = __builtin_amdgcn_mfma_f32_32x32x16_bf16(b0, q, p0, 0, 0, 0);
    p1 = __builtin_amdgcn_mfma_f32_32x32x16_bf16(b1, q, p1, 0, 0, 0); }
}
__device__ __forceinline__ int v_st(int k, int c) { const int kk = (k & ~0xC) | ((k & 4) << 1) | ((k & 8) >> 1); return ((kk >> 3) * 4 + (c >> 5)) * 512 + ((kk & 7) * 32 + (c & 31)) * 2; }
__device__ __forceinline__ int v_rd_base(int lane) { return ((lane & 3) << 3) | (((lane >> 2) & 3) << 6) | (((lane >> 4) & 1) << 5) | (((lane >> 5) & 1) << 8); }
constexpr int v_rd_off(int d0, int ks, int half) { return d0 * 512 + ks * 4096 + half * 2048; }
template <int OFF> __device__ __forceinline__ s16x4 tr_read(int vb) {
  s16x4 r; asm volatile("ds_read_b64_tr_b16 %0, %1 offset:%2" : "=&v"(r) : "v"(vb), "i"(OFF) : "memory"); return r;
}
#define ATT_PK(L, H) (bf16x8){L[0], L[1], L[2], L[3], H[0], H[1], H[2], H[3]}
template <int D0> __device__ __forceinline__ void pv_one(f32x16& od, lds_cptr vp, bf16x8 pa0, bf16x8 pa1, bf16x8 pa2, bf16x8 pa3) {
  const s16x4 l0 = vtr(vp + v_rd_off(D0, 0, 0)), h0 = vtr(vp + v_rd_off(D0, 0, 1)), l1 = vtr(vp + v_rd_off(D0, 1, 0)), h1 = vtr(vp + v_rd_off(D0, 1, 1));
  const s16x4 l2 = vtr(vp + v_rd_off(D0, 2, 0)), h2 = vtr(vp + v_rd_off(D0, 2, 1)), l3 = vtr(vp + v_rd_off(D0, 3, 0)), h3 = vtr(vp + v_rd_off(D0, 3, 1));
  od = __builtin_amdgcn_mfma_f32_32x32x16_bf16(pa0, ATT_PK(l0, h0), od, 0, 0, 0);
  od = __builtin_amdgcn_mfma_f32_32x32x16_bf16(pa1, ATT_PK(l1, h1), od, 0, 0, 0);
  od = __builtin_amdgcn_mfma_f32_32x32x16_bf16(pa2, ATT_PK(l2, h2), od, 0, 0, 0);
  od = __builtin_amdgcn_mfma_f32_32x32x16_bf16(pa3, ATT_PK(l3, h3), od, 0, 0, 0);
}
__device__ __forceinline__ void pv_d0(f32x16* o, lds_cptr vp, bf16x8 pa0, bf16x8 pa1, bf16x8 pa2, bf16x8 pa3) {
  pv_one<0>(o[0], vp, pa0, pa1, pa2, pa3); pv_one<1>(o[1], vp, pa0, pa1, pa2, pa3); pv_one<2>(o[2], vp, pa0, pa1, pa2, pa3); pv_one<3>(o[3], vp, pa0, pa1, pa2, pa3);
}
template <int NGRP, int MG, int NVALU, int NDS, int NPRE, int NLEAD = 0, int NVALU2 = 0> __device__ __forceinline__ void sched_pipe() {
  __builtin_amdgcn_sched_group_barrier(0x100, NPRE, 0);
#pragma unroll
  for (int i = 0; i < NGRP; ++i) { __builtin_amdgcn_sched_group_barrier(0x008, MG, 0);
    if (i >= NLEAD) __builtin_amdgcn_sched_group_barrier(0x002, (NLEAD > 0) ? NVALU2 : NVALU, 0);
    __builtin_amdgcn_sched_group_barrier(0x100, NDS, 0); }
}

template <int DQK, int LDQ, int LDK, int LDV, int LDO, int SD>
__device__ __forceinline__ void attn_unit(const bf16* __restrict__ Qb, const bf16* __restrict__ Kh, const bf16* __restrict__ Kr, const bf16* __restrict__ Vh,
                                          bf16* __restrict__ Ob, int seq, char* lds, float* tmout = nullptr) {
  constexpr int KROWB = Cfg<DQK>::KROWB, SHM_K = Cfg<DQK>::SHM_K, SHM_V = Cfg<DQK>::SHM_V, ND0 = Cfg<DQK>::ND0;
  const int tid = threadIdx.x, wid = __builtin_amdgcn_readfirstlane(tid >> 6), lane = tid & 63, r32 = lane & 31, hi = lane >> 5;
  char* V_lds = lds; char* K_lds = lds + 2 * SHM_V;
  float* ws = (float*)(lds + 2 * SHM_V + 2 * SHM_K) + wid * 64; float* li_l = ws; float* al_l = ws + 32;
  float m_ref = 0.f, l_reg = 0; f32x16 o[4] = {}; f32x16 negm = {}; constexpr int QREG = Cfg<DQK>::QREG; bf16x8 qr[QREG];
  const bf16* Qw = Qb + (long)(wid * QBLK + r32) * LDQ + hi * 8;
  char* qx = lds + 2 * SHM_V + 2 * SHM_K + NW * 64 * 4 + wid * Cfg<DQK>::QXW + lane * 16;
#pragma unroll
  for (int d0 = 0; d0 < QREG; ++d0) qr[d0] = ld8(Qw + d0 * 16);
  if constexpr (QREG < ND0) {
#pragma unroll
    for (int d0 = QREG; d0 < ND0; ++d0) *(bf16x8*)(qx + (d0 - QREG) * 1024) = ld8(Qw + d0 * 16);
  }
  const int sr = tid >> 4, sc = (tid & 15) * 8, vst0 = v_st(sr, sc), vst1 = v_st(32 + sr, sc);
  const int krr = tid >> 3, krc = (tid & 7) * 8;
  const lds_cptr vb0 = (lds_cptr)V_lds + v_rd_base(lane);
  constexpr int NB = (KROWB == 256 && ATT_KEYMASK128 == 15) ? 8 : 4; int kb[NB];
#pragma unroll
  for (int dl = 0; dl < NB; ++dl) kb[dl] = r32 * KROWB + ((dl * 32 + hi * 16) ^ (ATT_KEY(r32) << 4));
  const unsigned boV = (unsigned)(sr * LDV + sc) * 2u, boK = (unsigned)(sr * LDK + sc) * 2u, boR = (unsigned)(krr * 64 + krc) * 2u;
  struct { bf16x8 vs0, vs1, ks0, ks1, kr; } sr_[SD];
#define SLOAD(i, k0) do { const char* vt_ = (const char*)(Vh + (long)(k0) * LDV); const char* kt_ = (const char*)(Kh + (long)(k0) * LDK); \
    sr_[i].vs0 = *(const bf16x8*)(vt_ + boV); sr_[i].vs1 = *(const bf16x8*)(vt_ + 32 * LDV * 2 + boV); \
    sr_[i].ks0 = *(const bf16x8*)(kt_ + boK); sr_[i].ks1 = *(const bf16x8*)(kt_ + 32 * LDK * 2 + boK); \
    if constexpr (DQK == 192) { const char* rt_ = (const char*)(Kr + (long)(k0) * 64); sr_[i].kr = *(const bf16x8*)(rt_ + boR); } } while (0)
#define SWRITE(b, i) do { *(bf16x8*)(V_lds + (b) * SHM_V + vst0) = sr_[i].vs0;          \
    *(bf16x8*)(V_lds + (b) * SHM_V + vst1) = sr_[i].vs1; int kc = sc * 2;               \
    *(bf16x8*)(K_lds + (b) * SHM_K + ATT_KSWZ(sr, kc)) = sr_[i].ks0;                       \
    *(bf16x8*)(K_lds + (b) * SHM_K + ATT_KSWZ(32 + sr, kc)) = sr_[i].ks1;                  \
    if constexpr (DQK == 192) *(bf16x8*)(K_lds + (b) * SHM_K + ATT_KSWZ(krr, 256 + krc * 2)) = sr_[i].kr; } while (0)
#define SWAIT() do { if constexpr (SD == 2) { if constexpr (DQK == 192) asm volatile("s_waitcnt vmcnt(5)" ::: "memory"); else asm volatile("s_waitcnt vmcnt(4)" ::: "memory"); } \
    else asm volatile("s_waitcnt vmcnt(0)" ::: "memory"); } while (0)
#define RESC_APPLY() do { l_reg *= alp; if (hi == 0) al_l[r32] = alp; asm volatile("s_waitcnt lgkmcnt(0)" ::: "memory"); \
    _Pragma("unroll") for (int d = 0; d < 4; ++d) _Pragma("unroll") for (int r = 0; r < 16; ++r) o[d][r] *= al_l[crow(r, hi)]; pend = false; } while (0)
#define RESCN(ps_) do { if (pend) { RESC_APPLY(); } else { const bool t_ = (ps_) > TRIG; const float d_ = t_ ? __builtin_amdgcn_logf(ps_) : 0.f; alp = __builtin_amdgcn_exp2f(-d_); m_ref += d_; pend = __any(t_); } \
    _Pragma("unroll") for (int r = 0; r < 16; ++r) negm[r] = -m_ref; } while (0)
  float alp = 1.f; bool pend = false;
  f32x16 pA0, pA1, pB0, pB1; float psA, psB; bf16x8 pa0, pa1, pa2, pa3; const int NT = seq / KVBLK;
  constexpr int SE = 0, SO = SD - 1;
  SLOAD(SE, 0); asm volatile("s_waitcnt vmcnt(0)" ::: "memory"); SWRITE(0, SE); __syncthreads();
  qkt<DQK>(pA0, pA1, negm, K_lds, kb, qr, qx, r32, hi); firstSM(pA0, pA1, m_ref, negm);
  SLOAD(SO, KVBLK); if constexpr (SD == 2) { if (2 < NT) SLOAD(SE, 2 * KVBLK); }
  SWAIT(); SWRITE(1, SO); __syncthreads();
#define SCHED_A() do { if constexpr (DQK == 128) sched_pipe<16, 1, ATT_NVA128, 1, ATT_PREA>(); else sched_pipe<24 / ATT_MG192, ATT_MG192, ATT_NVA192 * ATT_MG192, ATT_DS192, ATT_PREA>(); } while (0)
#define SCHED_B() sched_pipe<16, 1, ATT_NVB, 2, ATT_PREB>()
#if ATT_PRIOMODE == 2
#define PRIO_A() do { if (wid >= 4) __builtin_amdgcn_s_setprio(1); else __builtin_amdgcn_s_setprio(0); } while (0)
#define PRIO_B() do { if (wid >= 4) __builtin_amdgcn_s_setprio(0); else __builtin_amdgcn_s_setprio(1); } while (0)
#elif ATT_PRIOMODE == 3
#define PRIO_A() do { if (wid >= 4) __builtin_amdgcn_s_setprio(0); else __builtin_amdgcn_s_setprio(1); } while (0)
#define PRIO_B() do { if (wid >= 4) __builtin_amdgcn_s_setprio(1); else __builtin_amdgcn_s_setprio(0); } while (0)
#else
#define PRIO_A() ((void)0)
#define PRIO_B() ((void)0)
#endif
#ifdef ATT_TIMING
  unsigned long long tmA = 0, tmB = 0, tmW = 0, tmW1 = 0, tmS = 0, tmB2 = 0;
#define TMS() __builtin_readcyclecounter()
#else
#define TMS() 0ull
#endif
  for (int j = 1; j + 1 < NT; j += 2) {
    const unsigned long long t0_ = TMS();
    PRIO_A(); ATT_SBAR(); qkt<DQK>(pB0, pB1, negm, K_lds + SHM_K, kb, qr, qx, r32, hi);
    finishSM(pA0, pA1, psA, l_reg, pa0, pa1, pa2, pa3); SCHED_A(); ATT_SBAR();
    const unsigned long long t1_ = TMS();
    PRIO_B(); SLOAD(SO, (j + SD) * KVBLK); ATT_SBAR();
    pv_d0(o, vb0, pa0, pa1, pa2, pa3); partialSM(pB0, pB1); SCHED_B(); ATT_SBAR();
    const unsigned long long t2_ = TMS();
    __syncthreads(); const unsigned long long t3_ = TMS(); SWAIT(); const unsigned long long t3b_ = TMS(); SWRITE(0, SE);
    RESCN(psA); asm volatile("s_waitcnt lgkmcnt(0)" ::: "memory"); const unsigned long long t3c_ = TMS(); __syncthreads();
    const unsigned long long t4_ = TMS();
#ifdef ATT_TIMING
    tmA += t1_ - t0_; tmB += t2_ - t1_; tmW1 += t3_ - t2_; tmW += t4_ - t3_; tmS += t3b_ - t3_; tmB2 += t4_ - t3c_;
#endif
    PRIO_A(); ATT_SBAR(); qkt<DQK>(pA0, pA1, negm, K_lds, kb, qr, qx, r32, hi);
    finishSM(pB0, pB1, psB, l_reg, pa0, pa1, pa2, pa3); SCHED_A(); ATT_SBAR();
    PRIO_B(); if (SD == 1 || j + 3 < NT) SLOAD(SE, (j + 1 + SD) * KVBLK); ATT_SBAR();
    pv_d0(o, vb0 + SHM_V, pa0, pa1, pa2, pa3); partialSM(pA0, pA1); SCHED_B(); ATT_SBAR();
    __syncthreads(); SWAIT(); SWRITE(1, SO);
    RESCN(psB); __syncthreads();
  }
  ATT_SBAR(); qkt<DQK>(pB0, pB1, negm, K_lds + SHM_K, kb, qr, qx, r32, hi);
  finishSM(pA0, pA1, psA, l_reg, pa0, pa1, pa2, pa3); ATT_SBAR();
  pv_d0(o, vb0, pa0, pa1, pa2, pa3); partialSM(pB0, pB1);
  __syncthreads(); if (pend) { RESC_APPLY(); }
  finishSM(pB0, pB1, psB, l_reg, pa0, pa1, pa2, pa3); ATT_SBAR();
  pv_d0(o, vb0 + SHM_V, pa0, pa1, pa2, pa3);
#undef SCHED_A
#undef SCHED_B
  __builtin_amdgcn_s_setprio(0);
#ifdef ATT_TIMING
  if (tmout && blockIdx.x == 0 && tid == ATT_TWAVE * 64) { const float inv = 1.0f / (float)((NT - 2) / 2); tmout[0] = (float)tmA * inv; tmout[1] = (float)tmB * inv; tmout[2] = (float)tmW1 * inv; tmout[3] = (float)tmW * inv; tmout[4] = (float)tmS * inv; tmout[5] = (float)tmB2 * inv; }
#endif
  if (hi == 0) li_l[r32] = l_reg; asm volatile("s_waitcnt lgkmcnt(0)" ::: "memory");
  float rli[16];
#pragma unroll
  for (int r = 0; r < 16; ++r) rli[r] = __builtin_amdgcn_rcpf(li_l[crow(r, hi)]);
  { int r32e = r32, hie = hi; asm volatile("" : "+v"(r32e), "+v"(hie));
    char* Ow = (char*)(Ob + (long)(wid * QBLK) * LDO);
    const unsigned lo_ = (unsigned)(((r32e >> 5) + 4 * hie) * LDO + (r32e & 31)) * 2u;
#pragma unroll
    for (int r = 0; r < 16; ++r) {
#pragma unroll
      for (int d0 = 0; d0 < 4; ++d0) *(bf16*)(Ow + lo_ + (unsigned)((((r & 3) + 8 * (r >> 2)) * LDO + d0 * 32) * 2)) = (bf16)(cvtpk(o[d0][r] * rli[r], 0.f) & 0xffffu); } }
  asm volatile("s_waitcnt vmcnt(0) lgkmcnt(0)" ::: "memory"); __syncthreads();
#undef SLOAD
#undef SWRITE
#undef SWAIT
#undef RESCN
#undef RESC_APPLY
}
template <int DQK, int LDQ, int LDK, int LDV, int LDO>
__device__ __forceinline__ void attn_unit_dma(const bf16* __restrict__ Qb, const bf16* __restrict__ Kh, const bf16* __restrict__ Kr, const bf16* __restrict__ Vh,
                                              bf16* __restrict__ Ob, int seq, char* lds, int spos = 0) {
  constexpr int KROWB = Cfg<DQK>::KROWB, SHM_K = Cfg<DQK>::SHM_K, SHM_V = Cfg<DQK>::SHM_V, ND0 = Cfg<DQK>::ND0;
  typedef __attribute__((address_space(3))) unsigned lds_u32;
  const int tid = threadIdx.x, wid = __builtin_amdgcn_readfirstlane(tid >> 6), lane = tid & 63, r32 = lane & 31, hi = lane >> 5;
  char* V_lds = lds; char* K_lds = lds + 2 * SHM_V;
  float* ws = (float*)(lds + 2 * SHM_V + 2 * SHM_K) + wid * 64; float* li_l = ws; float* al_l = ws + 32;
  float m_ref = 0.f, l_reg = 0; f32x16 o[4] = {}; f32x16 negm = {}; constexpr int QREG = Cfg<DQK>::QREG; bf16x8 qr[QREG];
  const bf16* Qw = Qb + (long)(wid * QBLK + r32) * LDQ + hi * 8;
  char* qx = lds + 2 * SHM_V + 2 * SHM_K + NW * 64 * 4 + wid * Cfg<DQK>::QXW + lane * 16;
#pragma unroll
  for (int d0 = 0; d0 < QREG; ++d0) qr[d0] = ld8(Qw + d0 * 16);
  if constexpr (QREG < ND0) {
#pragma unroll
    for (int d0 = QREG; d0 < ND0; ++d0) { bf16x8 qv = ld8(Qw + d0 * 16);
      if (DQK == 192 && d0 >= 8) {
        int hiq = hi; asm volatile("" : "+v"(hiq));
        const int sq = spos + wid * QBLK + r32; const float pos = (float)((d0 < 10) ? (sq >> 6) : (sq & 63));
        u32x4 w = *reinterpret_cast<u32x4*>(&qv);
#pragma unroll
        for (int e = 0; e < 4; ++e) { const int j = ((d0 - 8) & 1) * 8 + hiq * 4 + e; const float invf = __builtin_amdgcn_exp2f(-(float)j * (13.287712379549449f / 16.f));
          const float ang = pos * invf; double rev = (double)ang * 0.15915494309189535; rev -= __builtin_rint(rev); const float fr = (float)rev;
          const float c = __builtin_amdgcn_cosf(fr), sn = __builtin_amdgcn_sinf(fr);
          const float x1 = __uint_as_float(w[e] << 16), x2 = __uint_as_float(w[e] & 0xffff0000u); w[e] = cvtpk(x1 * c - x2 * sn, x1 * sn + x2 * c); }
        qv = *reinterpret_cast<bf16x8*>(&w); }
      *(bf16x8*)(qx + (d0 - QREG) * 1024) = qv; }
  }
  const lds_cptr vb0 = (lds_cptr)V_lds + v_rd_base(lane);
  constexpr int NB = (KROWB == 256 && ATT_KEYMASK128 == 15) ? 8 : 4; int kb[NB];
#pragma unroll
  for (int dl = 0; dl < NB; ++dl) kb[dl] = r32 * KROWB + ((dl * 32 + hi * 16) ^ (ATT_KEY(r32) << 4));
  constexpr int NKI = SHM_K / 8192, SPR = KROWB / 16;
  unsigned voV[2]; const char* kp[NKI]; unsigned kst[NKI];
#pragma unroll
  for (int i = 0; i < 2; ++i) { const int s = i * 512 + wid * 64 + lane; const int kk = (((s >> 7) & 7) << 3) | ((s >> 2) & 7);
    const int k = (kk & ~0xC) | ((kk & 4) << 1) | ((kk & 8) >> 1), c = ((s >> 5) & 3) * 32 + (s & 3) * 8; voV[i] = (unsigned)(k * LDV + c) * 2u; }
#pragma unroll
  for (int i = 0; i < NKI; ++i) { const int s = i * 512 + wid * 64 + lane; const int row = s / SPR, cs = (s % SPR) * 16, colB = cs ^ (ATT_KEY(row) << 4);
    if (DQK == 192 && colB >= 256) { kp[i] = (const char*)Kr + (size_t)row * 128 + (colB - 256); kst[i] = 64u * 128u; }
    else { kp[i] = (const char*)Kh + (size_t)row * (LDK * 2) + colB; kst[i] = 64u * (unsigned)(LDK * 2); } }
  lds_u32* const ldsV = (lds_u32*)((__attribute__((address_space(3))) char*)V_lds + wid * 1024);
  lds_u32* const ldsK = (lds_u32*)((__attribute__((address_space(3))) char*)K_lds + wid * 1024);
#define DMA_V(t_, b_) do { const char* vt_ = (const char*)Vh + (size_t)(t_) * (64u * LDV * 2u); _Pragma("unroll") for (int i = 0; i < 2; ++i) \
    __builtin_amdgcn_global_load_lds((const unsigned*)(vt_ + voV[i]), (lds_u32*)((__attribute__((address_space(3))) char*)ldsV + (b_) * SHM_V + i * 8192), 16, 0, 0); } while (0)
#define DMA_K(t_, b_) do { _Pragma("unroll") for (int i = 0; i < NKI; ++i) \
    __builtin_amdgcn_global_load_lds((const unsigned*)(kp[i] + (size_t)(t_) * kst[i]), (lds_u32*)((__attribute__((address_space(3))) char*)ldsK + (b_) * SHM_K + i * 8192), 16, 0, 0); } while (0)
#define VMW0() asm volatile("s_waitcnt vmcnt(0)" ::: "memory")
#define RESC_APPLY() do { l_reg *= alp; if (hi == 0) al_l[r32] = alp; asm volatile("s_waitcnt lgkmcnt(0)" ::: "memory"); \
    _Pragma("unroll") for (int d = 0; d < 4; ++d) _Pragma("unroll") for (int r = 0; r < 16; ++r) o[d][r] *= al_l[crow(r, hi)]; pend = false; } while (0)
#define RESCN(ps_) do { if (pend) { RESC_APPLY(); } else { const bool t_ = (ps_) > TRIG; const float d_ = t_ ? __builtin_amdgcn_logf(ps_) : 0.f; alp = __builtin_amdgcn_exp2f(-d_); m_ref += d_; pend = __any(t_); } \
    _Pragma("unroll") for (int r = 0; r < 16; ++r) negm[r] = -m_ref; } while (0)
  float alp = 1.f; bool pend = false;
  f32x16 pA0, pA1, pB0, pB1; float psA, psB; bf16x8 pa0, pa1, pa2, pa3; const int NT = seq / KVBLK;
#define SCHED_A() do { if constexpr (DQK == 128) sched_pipe<16, 1, ATT_NVA128, 1, ATT_PREA, ATT_LEAD128, ATT_NVL128>(); else sched_pipe<24 / ATT_MG192, ATT_MG192, ATT_NVA192 * ATT_MG192, ATT_DS192, ATT_PREA, ATT_LEAD192, ATT_NVL192>(); } while (0)
#define SCHED_B() sched_pipe<16, 1, ATT_NVB, 2, ATT_PREB>()
#define STEP(C0, C1, P0, P1, psP, t_, KB, VB, haveK) do { DMA_V(t_, VB); if (haveK) DMA_K((t_) + 1, 1 - (KB)); ATT_SBAR(); \
    qkt<DQK>(C0, C1, negm, K_lds + (KB) * SHM_K, kb, qr, qx, r32, hi); finishSM(P0, P1, psP, l_reg, pa0, pa1, pa2, pa3); SCHED_A(); ATT_SBAR(); \
    pv_d0(o, vb0 + (1 - (VB)) * SHM_V, pa0, pa1, pa2, pa3); partialSM(C0, C1); SCHED_B(); ATT_SBAR(); \
    RESCN(psP); VMW0(); __syncthreads(); } while (0)
  DMA_K(0, 0); VMW0(); __syncthreads();
  DMA_V(0, 0); DMA_K(1, 1);
  qkt<DQK>(pA0, pA1, negm, K_lds, kb, qr, qx, r32, hi); firstSM(pA0, pA1, m_ref, negm);
  VMW0(); __syncthreads();
  for (int t = 1; t + 2 < NT; t += 2) {
    STEP(pB0, pB1, pA0, pA1, psA, t, 1, 1, true);
    STEP(pA0, pA1, pB0, pB1, psB, t + 1, 0, 0, true);
  }
  STEP(pB0, pB1, pA0, pA1, psA, NT - 1, 1, 1, false);
  finishSM(pB0, pB1, psB, l_reg, pa0, pa1, pa2, pa3); ATT_SBAR();
  pv_d0(o, vb0 + SHM_V, pa0, pa1, pa2, pa3);
#undef STEP
#undef SCHED_A
#undef SCHED_B
  if (hi == 0) li_l[r32] = l_reg; asm volatile("s_waitcnt lgkmcnt(0)" ::: "memory");
  float rli[16];
#pragma unroll
  for (int r = 0; r < 16; ++r) rli[r] = __builtin_amdgcn_rcpf(li_l[crow(r, hi)]);
  { int r32e = r32, hie = hi; asm volatile("" : "+v"(r32e), "+v"(hie));
    char* Ow = (char*)(Ob + (long)(wid * QBLK) * LDO);
    const unsigned lo_ = (unsigned)((4 * hie) * LDO + r32e) * 2u;
#pragma unroll
    for (int r = 0; r < 16; ++r) {
#pragma unroll
      for (int d0 = 0; d0 < 4; ++d0) *(bf16*)(Ow + lo_ + (unsigned)((((r & 3) + 8 * (r >> 2)) * LDO + d0 * 32) * 2)) = (bf16)(cvtpk(o[d0][r] * rli[r], 0.f) & 0xffffu); } }
  asm volatile("s_waitcnt vmcnt(0) lgkmcnt(0)" ::: "memory"); __syncthreads();
#undef DMA_V
#undef DMA_K
#undef VMW0
#undef RESCN
#undef RESC_APPLY
}
template <int DQK, int LDQ, int LDK, int LDV, int LDO>
__device__ __forceinline__ void attn_unit_dmas(const bf16* __restrict__ Qb, const bf16* __restrict__ Kh, const bf16* __restrict__ Kr, const bf16* __restrict__ Vh,
                                              bf16* __restrict__ Ob, int seq, char* lds, int spos = 0) {
  constexpr int KROWB = Cfg<DQK>::KROWB, SHM_K = Cfg<DQK>::SHM_K, SHM_V = Cfg<DQK>::SHM_V, ND0 = Cfg<DQK>::ND0;
  typedef __attribute__((address_space(3))) unsigned lds_u32;
  const int tid = threadIdx.x, wid = __builtin_amdgcn_readfirstlane(tid >> 6), lane = tid & 63, r32 = lane & 31, hi = lane >> 5;
  char* V_lds = lds; char* K_lds = lds + 3 * SHM_V;
  float* ws = (float*)(lds + 3 * SHM_V + 2 * SHM_K) + wid * 64; float* li_l = ws; float* al_l = ws + 32;
  float m_ref = 0.f, l_reg = 0; f32x16 o[4] = {}; f32x16 negm = {}; constexpr int QREG = Cfg<DQK>::QREG; bf16x8 qr[QREG];
  const bf16* Qw = Qb + (long)(wid * QBLK + r32) * LDQ + hi * 8;
  char* qx = lds + 3 * SHM_V + 2 * SHM_K + NW * 64 * 4 + wid * Cfg<DQK>::QXW + lane * 16;
#pragma unroll
  for (int d0 = 0; d0 < QREG; ++d0) qr[d0] = ld8(Qw + d0 * 16);
  if constexpr (QREG < ND0) {
#pragma unroll
    for (int d0 = QREG; d0 < ND0; ++d0) { bf16x8 qv = ld8(Qw + d0 * 16);
      if (DQK == 192 && d0 >= 8) {
        int hiq = hi; asm volatile("" : "+v"(hiq));
        const int sq = spos + wid * QBLK + r32; const float pos = (float)((d0 < 10) ? (sq >> 6) : (sq & 63));
        u32x4 w = *reinterpret_cast<u32x4*>(&qv);
#pragma unroll
        for (int e = 0; e < 4; ++e) { const int j = ((d0 - 8) & 1) * 8 + hiq * 4 + e; const float invf = __builtin_amdgcn_exp2f(-(float)j * (13.287712379549449f / 16.f));
          const float ang = pos * invf; double rev = (double)ang * 0.15915494309189535; rev -= __builtin_rint(rev); const float fr = (float)rev;
          const float c = __builtin_amdgcn_cosf(fr), sn = __builtin_amdgcn_sinf(fr);
          const float x1 = __uint_as_float(w[e] << 16), x2 = __uint_as_float(w[e] & 0xffff0000u); w[e] = cvtpk(x1 * c - x2 * sn, x1 * sn + x2 * c); }
        qv = *reinterpret_cast<bf16x8*>(&w); }
      *(bf16x8*)(qx + (d0 - QREG) * 1024) = qv; }
  }
  const lds_cptr vb0 = (lds_cptr)V_lds + v_rd_base(lane);
  constexpr int NB = (KROWB == 256 && ATT_KEYMASK128 == 15) ? 8 : 4; int kb[NB];
#pragma unroll
  for (int dl = 0; dl < NB; ++dl) kb[dl] = r32 * KROWB + ((dl * 32 + hi * 16) ^ (ATT_KEY(r32) << 4));
  constexpr int NKI = SHM_K / 8192, SPR = KROWB / 16;
  unsigned voV[2]; const char* kp[NKI]; unsigned kst[NKI];
#pragma unroll
  for (int i = 0; i < 2; ++i) { const int s = i * 512 + wid * 64 + lane; const int kk = (((s >> 7) & 7) << 3) | ((s >> 2) & 7);
    const int k = (kk & ~0xC) | ((kk & 4) << 1) | ((kk & 8) >> 1), c = ((s >> 5) & 3) * 32 + (s & 3) * 8; voV[i] = (unsigned)(k * LDV + c) * 2u; }
#pragma unroll
  for (int i = 0; i < NKI; ++i) { const int s = i * 512 + wid * 64 + lane; const int row = s / SPR, cs = (s % SPR) * 16, colB = cs ^ (ATT_KEY(row) << 4);
    if (DQK == 192 && colB >= 256) { kp[i] = (const char*)Kr + (size_t)row * 128 + (colB - 256); kst[i] = 64u * 128u; }
    else { kp[i] = (const char*)Kh + (size_t)row * (LDK * 2) + colB; kst[i] = 64u * (unsigned)(LDK * 2); } }
  lds_u32* const ldsV = (lds_u32*)((__attribute__((address_space(3))) char*)V_lds + wid * 1024);
  lds_u32* const ldsK = (lds_u32*)((__attribute__((address_space(3))) char*)K_lds + wid * 1024);
#define DMA_V(t_, b_) do { const char* vt_ = (const char*)Vh + (size_t)(t_) * (64u * LDV * 2u); _Pragma("unroll") for (int i = 0; i < 2; ++i) \
    __builtin_amdgcn_global_load_lds((const unsigned*)(vt_ + voV[i]), (lds_u32*)((__attribute__((address_space(3))) char*)ldsV + (b_) + i * 8192), 16, 0, 0); } while (0)
#define DMA_K(t_, b_) do { _Pragma("unroll") for (int i = 0; i < NKI; ++i) \
    __builtin_amdgcn_global_load_lds((const unsigned*)(kp[i] + (size_t)(t_) * kst[i]), (lds_u32*)((__attribute__((address_space(3))) char*)ldsK + (b_) * SHM_K + i * 8192), 16, 0, 0); } while (0)
#define VMW0() asm volatile("s_waitcnt vmcnt(0)" ::: "memory")
#define RESC_APPLY() do { l_reg *= alp; if (hi == 0) al_l[r32] = alp; asm volatile("s_waitcnt lgkmcnt(0)" ::: "memory"); \
    _Pragma("unroll") for (int d = 0; d < 4; ++d) _Pragma("unroll") for (int r = 0; r < 16; ++r) o[d][r] *= al_l[crow(r, hi)]; pend = false; } while (0)
#define RESCN(ps_) do { if (pend) { RESC_APPLY(); } else { const bool t_ = (ps_) > TRIG; const float d_ = t_ ? __builtin_amdgcn_logf(ps_) : 0.f; alp = __builtin_amdgcn_exp2f(-d_); m_ref += d_; pend = __any(t_); } \
    _Pragma("unroll") for (int r = 0; r < 16; ++r) negm[r] = -m_ref; } while (0)
  float alp = 1.f; bool pend = false;
  f32x16 pA0, pA1, pB0, pB1; float psA, psB; bf16x8 pa0, pa1, pa2, pa3; const int NT = seq / KVBLK;
#define SCHED_A() do { if constexpr (DQK == 128) sched_pipe<16, 1, ATT_NVA128, 1, ATT_PREA>(); else sched_pipe<24 / ATT_MG192, ATT_MG192, ATT_NVA192 * ATT_MG192, ATT_DS192, ATT_PREA>(); } while (0)
#define SCHED_B() sched_pipe<16, 1, ATT_NVB, 2, ATT_PREB>()
#define NEXTV(v_) (((v_) == 2 * SHM_V) ? 0 : (v_) + SHM_V)
#define STEPS(C0, C1, P0, P1, psP, psPrev, t_, KB, vo_t, vo_tm1, vo_tm2, haveK, havePV) do { DMA_V(t_, vo_t); if (haveK) DMA_K((t_) + 1, 1 - (KB)); ATT_SBAR(); \
    if (isY) { if (havePV) { pv_d0(o, vb0 + (vo_tm2), pa0, pa1, pa2, pa3); } partialSM(P0, P1); SCHED_B(); ATT_SBAR(); RESCN(psPrev); } \
    else { qkt<DQK>(C0, C1, negm, K_lds + (KB) * SHM_K, kb, qr, qx, r32, hi); finishSM(P0, P1, psP, l_reg, pa0, pa1, pa2, pa3); SCHED_A(); } \
    ATT_SBAR(); \
    if (isY) { qkt<DQK>(C0, C1, negm, K_lds + (KB) * SHM_K, kb, qr, qx, r32, hi); finishSM(P0, P1, psP, l_reg, pa0, pa1, pa2, pa3); SCHED_A(); } \
    else { pv_d0(o, vb0 + (vo_tm1), pa0, pa1, pa2, pa3); partialSM(C0, C1); SCHED_B(); ATT_SBAR(); RESCN(psP); } \
    ATT_SBAR(); VMW0(); __syncthreads(); } while (0)
  const bool isY = wid >= 4;
  DMA_K(0, 0); VMW0(); __syncthreads();
  DMA_V(0, 0); DMA_K(1, 1);
  qkt<DQK>(pA0, pA1, negm, K_lds, kb, qr, qx, r32, hi); firstSM0(pA0, pA1, m_ref, negm);
  if (!isY) partialSM(pA0, pA1);
  VMW0(); __syncthreads();
  psA = 0.f; psB = 0.f;
  int v2 = 0, v1 = 0, v0 = SHM_V;
  STEPS(pB0, pB1, pA0, pA1, psA, psB, 1, 1, v0, v1, v2, true, false); v2 = v1; v1 = v0; v0 = NEXTV(v0);
  for (int t = 2; t + 1 < NT; t += 2) {
    STEPS(pA0, pA1, pB0, pB1, psB, psA, t, 0, v0, v1, v2, true, true); v2 = v1; v1 = v0; v0 = NEXTV(v0);
    STEPS(pB0, pB1, pA0, pA1, psA, psB, t + 1, 1, v0, v1, v2, (t + 2 < NT), true); v2 = v1; v1 = v0; v0 = NEXTV(v0);
  }
  if (isY) { pv_d0(o, vb0 + v2, pa0, pa1, pa2, pa3); partialSM(pB0, pB1); ATT_SBAR(); if (pend) { RESC_APPLY(); } }
  finishSM(pB0, pB1, psB, l_reg, pa0, pa1, pa2, pa3); ATT_SBAR();
  pv_d0(o, vb0 + v1, pa0, pa1, pa2, pa3);
#undef STEPS
#undef NEXTV
#undef SCHED_A
#undef SCHED_B
  if (hi == 0) li_l[r32] = l_reg; asm volatile("s_waitcnt lgkmcnt(0)" ::: "memory");
  float rli[16];
#pragma unroll
  for (int r = 0; r < 16; ++r) rli[r] = __builtin_amdgcn_rcpf(li_l[crow(r, hi)]);
  { int r32e = r32, hie = hi; asm volatile("" : "+v"(r32e), "+v"(hie));
    char* Ow = (char*)(Ob + (long)(wid * QBLK) * LDO);
    const unsigned lo_ = (unsigned)((4 * hie) * LDO + r32e) * 2u;
#pragma unroll
    for (int r = 0; r < 16; ++r) {
#pragma unroll
      for (int d0 = 0; d0 < 4; ++d0) *(bf16*)(Ow + lo_ + (unsigned)((((r & 3) + 8 * (r >> 2)) * LDO + d0 * 32) * 2)) = (bf16)(cvtpk(o[d0][r] * rli[r], 0.f) & 0xffffu); } }
  asm volatile("s_waitcnt vmcnt(0) lgkmcnt(0)" ::: "memory"); __syncthreads();
#undef DMA_V
#undef DMA_K
#undef VMW0
#undef RESCN
#undef RESC_APPLY
}
#undef ATT_KSWZ
#undef ATT_KEY
#undef ATT_PK
#undef ATT_SBAR
}
#define LAS __attribute__((address_space(3)))
typedef unsigned short u16;
typedef float f32x4 __attribute__((ext_vector_type(4)));
typedef short bf16x8 __attribute__((ext_vector_type(8)));
typedef unsigned u32x4 __attribute__((ext_vector_type(4)));
typedef unsigned u32x2 __attribute__((ext_vector_type(2)));
constexpr int DM = 2048, BATCH = 2, SEQ = 16384, T = BATCH * SEQ;
constexpr int IN0 = 4608, NLAT = 1088, NLATP = 1280, NQ = 3072, NKV = 4096, DFF = 8192;
constexpr float EPS = 1e-6f;
constexpr int NWAVES = 8, NTHREADS = 512;
constexpr int LDS_BYTES = 155648;
constexpr float LOG2_THETA = 13.287712379549449f;

constexpr size_t MiB = 1u << 20;
constexpr size_t WS_WIN = 0, WS_WOUT = 18 * MiB, WS_WDOWN = 26 * MiB, WS_WUQ = 31 * MiB, WS_WUKV = 34 * MiB, WS_WO = 38 * MiB;
constexpr size_t WS_WUP = 46 * MiB  , WS_WDN = 110 * MiB  ;
constexpr size_t WS_XN = 176 * MiB;
constexpr size_t WS_HB = 304 * MiB;
constexpr size_t WS_BIG = 432 * MiB;
constexpr size_t WS_PROJ = WS_BIG, WS_MIX = WS_BIG + 288 * MiB;
constexpr size_t WS_HID = WS_BIG;
constexpr size_t WS_Q = WS_BIG, WS_KV = WS_BIG + 192 * MiB, WS_LAT = WS_BIG + 448 * MiB, WS_KROPE = WS_BIG + 528 * MiB;
constexpr size_t WS_CQN = WS_LAT, WS_CKVN = WS_LAT;
constexpr size_t WS_AO = WS_XN;
constexpr size_t WS_CTL = WS_BIG + 532 * MiB, CTL_BAR = 65536, WS_SS = WS_CTL + CTL_BAR, CTL_BYTES = CTL_BAR + 5 * 131072;
constexpr size_t WS_END = WS_CTL + CTL_BYTES;

__device__ __forceinline__ float bflo(unsigned u) { return __uint_as_float(u << 16); }
__device__ __forceinline__ float bfhi(unsigned u) { return __uint_as_float(u & 0xffff0000u); }
__device__ __forceinline__ unsigned pk2(float lo, float hi) { unsigned r; asm volatile("v_cvt_pk_bf16_f32 %0, %1, %2" : "=v"(r) : "v"(lo), "v"(hi)); return r; }
__device__ __forceinline__ float wave_sum(float v) {
#pragma unroll
    for (int o = 1; o < 64; o <<= 1) v += __shfl_xor(v, o);
    return v;
}
__device__ __forceinline__ void rope_cs(float pos, float invf, float& c, float& s) {
    const float a = pos * invf;
    double rev = (double)a * 0.15915494309189535;
    rev -= __builtin_rint(rev);
    const float fr = (float)rev;
    c = __builtin_amdgcn_cosf(fr); s = __builtin_amdgcn_sinf(fr);
}

__device__ __forceinline__ void transpose_item(const float* __restrict__ W, const float* __restrict__ gain, float mul, int K, int N, u16* __restrict__ WT, LAS float* scr, int item, int lane) {
    const int nblk = N / 32, kb = item / nblk, nb = item % nblk, k0 = 64 * kb, n0 = 32 * nb;
    float wv[32];
#pragma unroll
    for (int i = 0; i < 32; ++i) { const int kk = 2 * i + (lane >> 5); wv[i] = W[(size_t)(k0 + kk) * N + n0 + (lane & 31)]; }
    float gv = 1.f; if (gain) gv = gain[k0 + lane] * mul;
#pragma unroll
    for (int i = 0; i < 32; ++i) { const int kk = 2 * i + (lane >> 5); const float g = __shfl(gv, kk); scr[kk * 33 + (lane & 31)] = wv[i] * g; }
    asm volatile("s_waitcnt lgkmcnt(0)" ::: "memory");
    const int c = lane & 7;
#pragma unroll
    for (int j = 0; j < 4; ++j) { const int n = (lane >> 3) + 8 * j; const LAS float* s = scr + (8 * c) * 33 + n;
        u32x4 o; o.x = pk2(s[0 * 33], s[1 * 33]); o.y = pk2(s[2 * 33], s[3 * 33]); o.z = pk2(s[4 * 33], s[5 * 33]); o.w = pk2(s[6 * 33], s[7 * 33]);
        *(u32x4*)(WT + (size_t)(n0 + n) * K + k0 + 8 * c) = o; }
    asm volatile("s_waitcnt lgkmcnt(0)" ::: "memory");
}

__device__ __forceinline__ void norm_row_bf16(const float* __restrict__ xrow, u16* __restrict__ orow, int lane) {
    const f32x4* xr = (const f32x4*)xrow + lane;
    f32x4 v[8]; float s = 0.f;
#pragma unroll
    for (int j = 0; j < 8; ++j) { v[j] = xr[64 * j]; s += (v[j].x * v[j].x + v[j].y * v[j].y) + (v[j].z * v[j].z + v[j].w * v[j].w); }
    const float r = 1.0f / sqrtf(wave_sum(s) * (1.f / DM) + EPS);
    u32x2* o8 = (u32x2*)orow + lane;
#pragma unroll
    for (int j = 0; j < 8; ++j) { u32x2 w; w.x = pk2(v[j].x * r, v[j].y * r); w.y = pk2(v[j].z * r, v[j].w * r); o8[64 * j] = w; }
}
__device__ __forceinline__ void norm_row_b2b(const u16* __restrict__ hrow, u16* __restrict__ orow, int lane) {
    const u32x4* xr = (const u32x4*)hrow + lane;
    u32x4 w[4]; float s = 0.f;
#pragma unroll
    for (int j = 0; j < 4; ++j) { w[j] = xr[64 * j];
#pragma unroll
        for (int e = 0; e < 4; ++e) { const float a = bflo(w[j][e]), b = bfhi(w[j][e]); s += a * a + b * b; } }
    const float r = 1.0f / sqrtf(wave_sum(s) * (1.f / DM) + EPS);
    u32x4* o = (u32x4*)orow + lane;
#pragma unroll
    for (int j = 0; j < 4; ++j) { u32x4 v;
#pragma unroll
        for (int e = 0; e < 4; ++e) v[e] = pk2(bflo(w[j][e]) * r, bfhi(w[j][e]) * r);
        o[64 * j] = v; }
}
__device__ __forceinline__ void norm_row_final(const u16* __restrict__ hrow, float* __restrict__ orow, const float* __restrict__ g, int lane) {
    const u32x4* xr = (const u32x4*)hrow + lane;
    u32x4 w[4]; float s = 0.f;
#pragma unroll
    for (int j = 0; j < 4; ++j) { w[j] = xr[64 * j];
#pragma unroll
        for (int e = 0; e < 4; ++e) { const float a = bflo(w[j][e]), b = bfhi(w[j][e]); s += a * a + b * b; } }
    const float r = 1.0f / sqrtf(wave_sum(s) * (1.f / DM) + EPS);
#pragma unroll
    for (int j = 0; j < 4; ++j) { const int c = (64 * j + lane) * 8; const f32x4 g0 = *(const f32x4*)(g + c), g1 = *(const f32x4*)(g + c + 4);
        f32x4 o0 = {bflo(w[j][0]) * r * g0[0], bfhi(w[j][0]) * r * g0[1], bflo(w[j][1]) * r * g0[2], bfhi(w[j][1]) * r * g0[3]};
        f32x4 o1 = {bflo(w[j][2]) * r * g1[0], bfhi(w[j][2]) * r * g1[1], bflo(w[j][3]) * r * g1[2], bfhi(w[j][3]) * r * g1[3]};
        *(f32x4*)(orow + c) = o0; *(f32x4*)(orow + c + 4) = o1; }
}

__device__ __forceinline__ void ld8f(const u16* p, float* f) {
    const u32x4 w = *(const u32x4*)p;
    f[0] = bflo(w.x); f[1] = bfhi(w.x); f[2] = bflo(w.y); f[3] = bfhi(w.y); f[4] = bflo(w.z); f[5] = bfhi(w.z); f[6] = bflo(w.w); f[7] = bfhi(w.w);
}

__device__ __forceinline__ void ew0_token(int t, u16* __restrict__ PROJ, u16* __restrict__ MIX, const float* __restrict__ qg, const float* __restrict__ kg, const float* __restrict__ cw, int lane) {
    const int s = t & (SEQ - 1), row = s >> 6, col = s & 63;
    float c, sn; { const int j = lane & 31; const float invf = __builtin_amdgcn_exp2f(-(float)j * (LOG2_THETA / 32.f)); rope_cs((float)(lane < 32 ? row : col), invf, c, sn); }
    unsigned* pr = (unsigned*)(PROJ + (size_t)t * IN0);
    const float qg0 = qg[2 * lane], qg1 = qg[2 * lane + 1], kg0 = kg[2 * lane], kg1 = kg[2 * lane + 1];
#pragma unroll
    for (int h = 0; h < 10; ++h) {
        const unsigned u = pr[h * 64 + lane]; const float x1 = bflo(u), x2 = bfhi(u);
        const float ss = wave_sum(x1 * x1 + x2 * x2); const float r = 1.0f / sqrtf(ss * (1.f / 128.f) + EPS);
        const float y1 = x1 * r * (h < 8 ? qg0 * att::Cfg<128>::C : kg0), y2 = x2 * r * (h < 8 ? qg1 * att::Cfg<128>::C : kg1);
        pr[h * 64 + lane] = pk2(y1 * c - y2 * sn, y1 * sn + y2 * c);
    }
    const u16* p0 = PROJ + (size_t)t * IN0;
#pragma unroll
    for (int ch = 0; ch < 2; ++ch) {
        const int cc = ch * 512 + lane * 8;
        float gb[8], g0[8], u0[8], gm[8], um[8], gp[8], up[8];
        ld8f(p0 + 1536 + cc, gb); ld8f(p0 + 2560 + cc, g0); ld8f(p0 + 3584 + cc, u0);
        if (s > 0) { ld8f(p0 - IN0 + 2560 + cc, gm); ld8f(p0 - IN0 + 3584 + cc, um); } else {
#pragma unroll
            for (int e = 0; e < 8; ++e) { gm[e] = 0.f; um[e] = 0.f; } }
        if (s < SEQ - 1) { ld8f(p0 + IN0 + 2560 + cc, gp); ld8f(p0 + IN0 + 3584 + cc, up); } else {
#pragma unroll
            for (int e = 0; e < 8; ++e) { gp[e] = 0.f; up[e] = 0.f; } }
        float o[8];
#pragma unroll
        for (int e = 0; e < 8; ++e) o[e] = gb[e] * (cw[cc + e] * (gm[e] * um[e]) + cw[1024 + cc + e] * (g0[e] * u0[e]) + cw[2048 + cc + e] * (gp[e] * up[e]));
        u32x4 w; w.x = pk2(o[0], o[1]); w.y = pk2(o[2], o[3]); w.z = pk2(o[4], o[5]); w.w = pk2(o[6], o[7]);
        *(u32x4*)(MIX + (size_t)t * DM + 1024 + cc) = w;
    }
}
__device__ __forceinline__ void cv8f(const u32x4 w, float* f) {
    f[0] = bflo(w.x); f[1] = bfhi(w.x); f[2] = bflo(w.y); f[3] = bfhi(w.y); f[4] = bflo(w.z); f[5] = bfhi(w.z); f[6] = bflo(w.w); f[7] = bfhi(w.w);
}
__device__ __forceinline__ void ew0_pair(int t, u16* __restrict__ PROJ, u16* __restrict__ MIX, const float* __restrict__ qg, const float* __restrict__ kg, const float* __restrict__ cw, int lane) {
    const int s = t & (SEQ - 1), row = s >> 6, col = s & 63;
    unsigned* pr0 = (unsigned*)(PROJ + (size_t)t * IN0); unsigned* pr1 = pr0 + IN0 / 2;
    const u16* p0 = PROJ + (size_t)t * IN0;
    unsigned ua[10], ub[10];
#pragma unroll
    for (int h = 0; h < 10; ++h) { ua[h] = pr0[h * 64 + lane]; ub[h] = pr1[h * 64 + lane]; }
    u32x4 rgb[2][2], rg[2][4], ru[2][4];
    const bool hasm = s > 0, hasp = s + 1 < SEQ - 1; const u32x4 z4 = {0u, 0u, 0u, 0u};
#pragma unroll
    for (int ch = 0; ch < 2; ++ch) { const int cc = ch * 512 + lane * 8;
        rgb[ch][0] = *(const u32x4*)(p0 + 1536 + cc); rgb[ch][1] = *(const u32x4*)(p0 + IN0 + 1536 + cc);
        rg[ch][1] = *(const u32x4*)(p0 + 2560 + cc); ru[ch][1] = *(const u32x4*)(p0 + 3584 + cc);
        rg[ch][2] = *(const u32x4*)(p0 + IN0 + 2560 + cc); ru[ch][2] = *(const u32x4*)(p0 + IN0 + 3584 + cc);
        rg[ch][0] = hasm ? *(const u32x4*)(p0 - IN0 + 2560 + cc) : z4; ru[ch][0] = hasm ? *(const u32x4*)(p0 - IN0 + 3584 + cc) : z4;
        rg[ch][3] = hasp ? *(const u32x4*)(p0 + 2 * IN0 + 2560 + cc) : z4; ru[ch][3] = hasp ? *(const u32x4*)(p0 + 2 * IN0 + 3584 + cc) : z4; }
    float c0, s0, c1, s1; { const int j = lane & 31; const float invf = __builtin_amdgcn_exp2f(-(float)j * (LOG2_THETA / 32.f));
        rope_cs((float)(lane < 32 ? row : col), invf, c0, s0); rope_cs((float)(lane < 32 ? row : col + 1), invf, c1, s1); }
    const float qg0 = qg[2 * lane] * att::Cfg<128>::C, qg1 = qg[2 * lane + 1] * att::Cfg<128>::C, kg0 = kg[2 * lane], kg1 = kg[2 * lane + 1];
#pragma unroll
    for (int h = 0; h < 10; ++h) {
        const float a1 = bflo(ua[h]), a2 = bfhi(ua[h]), b1 = bflo(ub[h]), b2 = bfhi(ub[h]);
        const float ra = 1.0f / sqrtf(wave_sum(a1 * a1 + a2 * a2) * (1.f / 128.f) + EPS), rb = 1.0f / sqrtf(wave_sum(b1 * b1 + b2 * b2) * (1.f / 128.f) + EPS);
        const float g0 = (h < 8 ? qg0 : kg0), g1 = (h < 8 ? qg1 : kg1);
        const float ya1 = a1 * ra * g0, ya2 = a2 * ra * g1, yb1 = b1 * rb * g0, yb2 = b2 * rb * g1;
        pr0[h * 64 + lane] = pk2(ya1 * c0 - ya2 * s0, ya1 * s0 + ya2 * c0);
        pr1[h * 64 + lane] = pk2(yb1 * c1 - yb2 * s1, yb1 * s1 + yb2 * c1);
    }
#pragma unroll
    for (int ch = 0; ch < 2; ++ch) {
        const int cc = ch * 512 + lane * 8;
        float gbA[8], gbB[8], gm[8], um[8], g0[8], u0[8], g1[8], u1[8], g2[8], u2[8];
        cv8f(rgb[ch][0], gbA); cv8f(rgb[ch][1], gbB); cv8f(rg[ch][0], gm); cv8f(ru[ch][0], um); cv8f(rg[ch][1], g0); cv8f(ru[ch][1], u0);
        cv8f(rg[ch][2], g1); cv8f(ru[ch][2], u1); cv8f(rg[ch][3], g2); cv8f(ru[ch][3], u2);
        float oa[8], ob[8];
#pragma unroll
        for (int e = 0; e < 8; ++e) { const float w0 = cw[cc + e], w1 = cw[1024 + cc + e], w2 = cw[2048 + cc + e];
            const float xm = gm[e] * um[e], x0 = g0[e] * u0[e], x1 = g1[e] * u1[e], x2 = g2[e] * u2[e];
            oa[e] = gbA[e] * (w0 * xm + w1 * x0 + w2 * x1); ob[e] = gbB[e] * (w0 * x0 + w1 * x1 + w2 * x2); }
        u32x4 wa; wa.x = pk2(oa[0], oa[1]); wa.y = pk2(oa[2], oa[3]); wa.z = pk2(oa[4], oa[5]); wa.w = pk2(oa[6], oa[7]);
        u32x4 wb; wb.x = pk2(ob[0], ob[1]); wb.y = pk2(ob[2], ob[3]); wb.z = pk2(ob[4], ob[5]); wb.w = pk2(ob[6], ob[7]);
        *(u32x4*)(MIX + (size_t)t * DM + 1024 + cc) = wa; *(u32x4*)(MIX + (size_t)(t + 1) * DM + 1024 + cc) = wb;
    }
}
__device__ __forceinline__ void ew1_token(int t, const u16* __restrict__ LAT, u16* __restrict__ CQN, u16* __restrict__ CKVN, u16* __restrict__ KROPE, int lane) {
    const u16* p0 = LAT + (size_t)t * NLATP;
#pragma unroll
    for (int part = 0; part < 2; ++part) {
        float x[8]; ld8f(p0 + part * 512 + lane * 8, x);
        float ss = 0.f;
#pragma unroll
        for (int e = 0; e < 8; ++e) ss += x[e] * x[e];
        const float r = 1.0f / sqrtf(wave_sum(ss) * (1.f / 512.f) + EPS);
        u32x4 w; w.x = pk2(x[0] * r, x[1] * r); w.y = pk2(x[2] * r, x[3] * r); w.z = pk2(x[4] * r, x[5] * r); w.w = pk2(x[6] * r, x[7] * r);
        *(u32x4*)((part ? CKVN : CQN) + (size_t)t * 512 + lane * 8) = w;
    }
    if (lane < 32) {
        const int s = t & (SEQ - 1), row = s >> 6, col = s & 63; const int j = lane & 15;
        const float invf = __builtin_amdgcn_exp2f(-(float)j * (LOG2_THETA / 16.f)); float c, sn; rope_cs((float)(lane < 16 ? row : col), invf, c, sn);
        const unsigned u = *(const unsigned*)(p0 + 1024 + 2 * lane); const float x1 = bflo(u), x2 = bfhi(u);
        *(unsigned*)(KROPE + (size_t)t * 64 + 2 * lane) = pk2(x1 * c - x2 * sn, x1 * sn + x2 * c);
    }
}
__device__ __forceinline__ void ew2_token(int t, u16* __restrict__ Q, int lane) {
    const int s = t & (SEQ - 1), row = s >> 6, col = s & 63;
    const int h = lane >> 2, part = lane & 3; const float pos = (float)(part < 2 ? row : col);
    u16* p = Q + (size_t)t * NQ + h * 192 + 128 + part * 16;
    float x[16]; ld8f(p, x); ld8f(p + 8, x + 8);
    unsigned w[8];
#pragma unroll
    for (int i = 0; i < 8; ++i) { const int j = (part & 1) * 8 + i; const float invf = __builtin_amdgcn_exp2f(-(float)j * (LOG2_THETA / 16.f)); float c, sn; rope_cs(pos, invf, c, sn);
        w[i] = pk2(x[2 * i] * c - x[2 * i + 1] * sn, x[2 * i] * sn + x[2 * i + 1] * c); }
    *(u32x4*)p = (u32x4){w[0], w[1], w[2], w[3]}; *(u32x4*)(p + 8) = (u32x4){w[4], w[5], w[6], w[7]};
}

#define RLX_AGENT __ATOMIC_RELAXED, __HIP_MEMORY_SCOPE_AGENT
#define XB_TMO      128
#define XB_XCNT(j)  (256  + 64 * (j))
#define XB_XSUB(j)  (1280 + 64 * (j))
#define XB_XGEN(j)  (2304 + 64 * (j))
#define XB_TOP      3328
#define XB_TOPGEN   3392
#define XCD_BAR_WORDS 3456
#define XB_SPIN_CAP (1u << 22)

__device__ __forceinline__ unsigned xb_ld(unsigned* p)              { return __hip_atomic_load(p, __ATOMIC_RELAXED, __HIP_MEMORY_SCOPE_AGENT); }
__device__ __forceinline__ unsigned xb_add(unsigned* p, unsigned v) { return __hip_atomic_fetch_add(p, v, __ATOMIC_RELAXED, __HIP_MEMORY_SCOPE_AGENT); }
__device__ __forceinline__ unsigned xb_xcc_id() { return (unsigned)__builtin_amdgcn_s_getreg((3 << 11) | 20) & 0xFu; }
#define XB_SPIN(cond, bar) do { unsigned _sp = 0; while (cond) { __builtin_amdgcn_s_sleep(1); \
    if ((++_sp & 255u) == 0u) { if (xb_ld(&(bar)[XB_TMO])) break; if (_sp > XB_SPIN_CAP) { atomicAdd(&(bar)[XB_TMO], 1u); break; } } } } while (0)

struct XcdBarrier {
    unsigned* bar; unsigned x;
    volatile LAS unsigned* st;
};

__device__ __forceinline__ XcdBarrier xcd_barrier_post(unsigned* bar, volatile LAS unsigned* st) {
    XcdBarrier b; b.bar = bar; b.x = xb_xcc_id(); b.st = st;
    if (threadIdx.x == 0) (void)xb_add(&bar[XB_XCNT(b.x)], 1u);
    return b;
}
__device__ __forceinline__ void xcd_barrier_complete(unsigned* bar, unsigned x, unsigned& nloc, unsigned& nx) {
    const unsigned G = gridDim.x * gridDim.y * gridDim.z;
    unsigned sum, cnt, mine, sp = 0u;
    for (;;) {
        sum = 0u; cnt = 0u; mine = 0u;
#pragma unroll
        for (unsigned j = 0; j < 16; ++j) { const unsigned c = xb_ld(&bar[XB_XCNT(j)]); sum += c; cnt += (c > 0u) ? 1u : 0u; mine = (j == x) ? c : mine; }
        if (sum == G) break;
        __builtin_amdgcn_s_sleep(1);
        if ((++sp & 255u) == 0u) { if (xb_ld(&bar[XB_TMO])) break; if (sp > XB_SPIN_CAP) { atomicAdd(&bar[XB_TMO], 1u); break; } }
    }
    nloc = mine > 0u ? mine : 1u; nx = cnt > 0u ? cnt : 1u;
}

__device__ __forceinline__ void xcd_barrier(const XcdBarrier& b) {
    asm volatile("s_waitcnt vmcnt(0)" ::: "memory");
    __syncthreads();
    if (threadIdx.x == 0) {
        unsigned* bar = b.bar;
        __builtin_amdgcn_s_waitcnt(0);
        unsigned nloc = b.st[0], nx = b.st[1];
        if (nloc == 0u) { xcd_barrier_complete(bar, b.x, nloc, nx); b.st[0] = nloc; b.st[1] = nx; }
        const unsigned old = xb_add(&bar[XB_XSUB(b.x)], 1u);
        const unsigned gen = old / nloc;
        if (old + 1u == (gen + 1u) * nloc) {
            __builtin_amdgcn_fence(__ATOMIC_RELEASE, "agent");
            asm volatile("s_waitcnt vmcnt(0)" ::: "memory");
            const unsigned og = xb_add(&bar[XB_TOP], 1u);
            const unsigned tg = og / nx;
            if (og + 1u == (tg + 1u) * nx) xb_add(&bar[XB_TOPGEN], 1u);
            else XB_SPIN(xb_ld(&bar[XB_TOPGEN]) == tg, bar);
            __builtin_amdgcn_fence(__ATOMIC_ACQUIRE, "agent");
            xb_add(&bar[XB_XGEN(b.x)], 1u);
            asm volatile("s_waitcnt vmcnt(0)" ::: "memory");
        } else {
            XB_SPIN(xb_ld(&bar[XB_XGEN(b.x)]) == gen, bar);
            __builtin_amdgcn_fence(__ATOMIC_ACQUIRE, "agent");
            asm volatile("s_waitcnt vmcnt(0)" ::: "memory");
        }
    }
    __syncthreads();
}

struct Params { const float* in[18]; float* out; unsigned char* ws; int ph_lo, ph_hi; };
enum { I_X = 0, I_ENG, I_EWIN, I_EQG, I_EKG, I_ECW, I_EWOUT, I_ONG, I_OWDOWN, I_OQG, I_OKVG, I_OWUQ, I_OWUKV, I_OWO, I_MNG, I_MWUP, I_MWDN, I_FNG };
constexpr int NPHASE = 19;

template <int DQK> __device__ __forceinline__ bool attn_next(int i, int NU, int& unit) {
    const int G = gridDim.x, bx = blockIdx.x;
    if ((G & 7) == 0 && (NU & 7) == 0) { const int x = bx & 7, j = bx >> 3, per = G >> 3, upx = NU >> 3; const int k = i * per + j; if (k >= upx) return false; unit = x * upx + k; return true; }
    const int k = i * G + bx; if (k >= NU) return false; unit = k; return true;
}

__global__ void __launch_bounds__(NTHREADS, 2) fwd_mega(Params P) {
    extern __shared__ __attribute__((aligned(16))) unsigned char lds[];
    cg::grid_group grid = cg::this_grid();
    const int tid = threadIdx.x, lane = tid & 63, wave = __builtin_amdgcn_readfirstlane(tid >> 6);
    const int G = gridDim.x, gw = blockIdx.x * NWAVES + wave, NGW = G * NWAVES;
    unsigned char* ws = P.ws;
    u16* Win = (u16*)(ws + WS_WIN); u16* Wout = (u16*)(ws + WS_WOUT); u16* Wdown = (u16*)(ws + WS_WDOWN); u16* Wuq = (u16*)(ws + WS_WUQ); u16* Wukv = (u16*)(ws + WS_WUKV); u16* Wo = (u16*)(ws + WS_WO);
    u16* Wup = (u16*)(ws + WS_WUP); u16* Wdn = (u16*)(ws + WS_WDN);
    u16* XN = (u16*)(ws + WS_XN); u16* PROJ = (u16*)(ws + WS_PROJ); u16* MIX = (u16*)(ws + WS_MIX); u16* HID = (u16*)(ws + WS_HID);
    u16* LAT = (u16*)(ws + WS_LAT); u16* CQN = (u16*)(ws + WS_CQN); u16* CKVN = (u16*)(ws + WS_CKVN); u16* KROPE = (u16*)(ws + WS_KROPE);
    u16* Qm = (u16*)(ws + WS_Q); u16* KVm = (u16*)(ws + WS_KV); u16* AO = (u16*)(ws + WS_AO);
    u16* HB = (u16*)(ws + WS_HB); float* SS0 = (float*)(ws + WS_SS); float* SS1 = SS0 + T; float* SS2 = SS1 + T; float* SSQ = SS2 + T; float* SSKV = SSQ + T; const float* NOSS = nullptr; float* NOSSW = nullptr;
    LAS unsigned char* ldsl = (LAS unsigned char*)lds;
    const int lo = P.ph_lo, hi = P.ph_hi;
    volatile LAS unsigned* xst = (volatile LAS unsigned*)(ldsl + LDS_BYTES - 16);
    if (tid < 4) xst[tid] = 0u;
    __syncthreads();
    XcdBarrier xbar = xcd_barrier_post((unsigned*)(ws + WS_CTL), xst);
#define PH(k) if (lo <= (k) && (k) < hi) _Pragma("unroll") for (int rep_ = 0; rep_ <= (int)((REP_MASK >> (k)) & 1u); ++rep_)
#define SEAM(k) do { if (lo <= (k) && (k) + 1 < hi) { if ((k) == 0) grid.sync(); else xcd_barrier(xbar); } } while (0)
#define GEMM_BF16X(ACT, Aptr, ldav, Bptr, Mv, Nv, Kv, Optr, ldc, ssptr, sso0p, sso1p) do { pg8::Gemm g{Aptr, Bptr, Mv, Nv, Kv, ldav}; pg8::StaticOrder S; S.init(Mv, Nv, G, (int)blockIdx.x); \
        pg8::EpiBf16<ACT> E{Optr, ldc, ssptr, 1.0f / (float)(Kv), EPS, sso0p, sso1p}; pg8::gemm_phase<pg8::EpiBf16<ACT>, pg8::StaticOrder, true, true>(ldsl, g, S, E); } while (0)
#define GEMM_BF16(ACT, Aptr, Bptr, Mv, Nv, Kv, Optr, ldc, ssptr) GEMM_BF16X(ACT, Aptr, Kv, Bptr, Mv, Nv, Kv, Optr, ldc, ssptr, NOSSW, NOSSW)
#define GEMM_RES(F32B, Aptr, Bptr, Mv, Nv, Kv, baseptr, ssptr) do { pg8::Gemm g{Aptr, Bptr, Mv, Nv, Kv, Kv}; pg8::StaticOrder S; S.init(Mv, Nv, G, (int)blockIdx.x); \
        pg8::EpiResB<F32B> E{baseptr, HB, Nv, ssptr}; pg8::gemm_phase<pg8::EpiResB<F32B>, pg8::StaticOrder, true, true>(ldsl, g, S, E); } while (0)
#define NORM_PHASE() do { for (int m = gw; m < T; m += NGW) norm_row_b2b(HB + (size_t)m * DM, XN + (size_t)m * DM, lane); } while (0)

    PH(0) {
        LAS float* scr = (LAS float*)(ldsl + wave * 16384);
        constexpr int I0 = (DM / 64) * (IN0 / 32), I1 = (DM / 64) * (DM / 32), I2 = (DM / 64) * (NLAT / 32), I3 = (512 / 64) * (NQ / 32), I4 = (512 / 64) * (NKV / 32), I5 = I1;
        constexpr int I6 = (DM / 64) * (DFF / 32), I7 = (DFF / 64) * (DM / 32);
        constexpr int NITEMS = I0 + I1 + I2 + I3 + I4 + I5 + 2 * I6 + 2 * I7;
        for (int it = gw; it < NITEMS; it += NGW) {
            int r = it;
            if (r < I0) { transpose_item(P.in[I_EWIN], P.in[I_ENG], 1.f, DM, IN0, Win, scr, r, lane); continue; } r -= I0;
            if (r < I1) { transpose_item(P.in[I_EWOUT], nullptr, 1.f, DM, DM, Wout, scr, r, lane); continue; } r -= I1;
            if (r < I2) { transpose_item(P.in[I_OWDOWN], P.in[I_ONG], 1.f, DM, NLAT, Wdown, scr, r, lane); continue; } r -= I2;
            if (r < I3) { transpose_item(P.in[I_OWUQ], P.in[I_OQG], att::Cfg<192>::C, 512, NQ, Wuq, scr, r, lane); continue; } r -= I3;
            if (r < I4) { transpose_item(P.in[I_OWUKV], P.in[I_OKVG], 1.f, 512, NKV, Wukv, scr, r, lane); continue; } r -= I4;
            if (r < I5) { transpose_item(P.in[I_OWO], nullptr, 1.f, DM, DM, Wo, scr, r, lane); continue; } r -= I5;
            if (r < I6) { transpose_item(P.in[I_MWUP], P.in[I_MNG], 1.f, DM, DFF, Wup, scr, r, lane); continue; } r -= I6;
            if (r < I6) { transpose_item(P.in[I_MWUP] + (size_t)DM * DFF, P.in[I_MNG] + DM, 1.f, DM, DFF, Wup + (size_t)DM * DFF, scr, r, lane); continue; } r -= I6;
            if (r < I7) { transpose_item(P.in[I_MWDN], nullptr, 1.f, DFF, DM, Wdn, scr, r, lane); continue; } r -= I7;
            transpose_item(P.in[I_MWDN] + (size_t)DM * DFF, nullptr, 1.f, DFF, DM, Wdn + (size_t)DM * DFF, scr, r, lane);
        }
        { const size_t n16 = (size_t)(NLATP - NLAT) * DM * 2 / 16; u32x4* z = (u32x4*)(Wdown + (size_t)NLAT * DM);
          for (size_t i = (size_t)blockIdx.x * NTHREADS + tid; i < n16; i += (size_t)G * NTHREADS) z[i] = (u32x4){0u, 0u, 0u, 0u}; }
        for (int m = gw; m < T; m += NGW) norm_row_bf16(P.in[I_X] + (size_t)m * DM, XN + (size_t)m * DM, lane);
    }
    SEAM(0);
    PH(1) { GEMM_BF16(0, XN, Win, T, IN0, DM, PROJ, IN0, NOSS); }
    SEAM(1);
    PH(2) { const int per = ((T / 2 + NGW - 1) / NGW) * 2; const int t0 = gw * per; for (int t = t0; t < t0 + per && t < T; t += 2) ew0_pair(t, PROJ, MIX, P.in[I_EQG], P.in[I_EKG], P.in[I_ECW], lane); }
    SEAM(2);
    PH(3) {
        if (ATT_PRIO && wave >= 4) __builtin_amdgcn_s_setprio(1);
        constexpr int NU = BATCH * 8 * (SEQ / 256); int unit;
        for (int i = 0; attn_next<128>(i, NU, unit); ++i) {
            const int bh = unit / (SEQ / 256), qb = unit % (SEQ / 256), b = bh >> 3, hq = bh & 7, kvh = hq >> 2;
            const size_t tb = (size_t)b * SEQ;
#ifndef NO_GQA
            att::ATT_UNIT<128, IN0, IN0, IN0, DM>(PROJ + (tb + (size_t)qb * 256) * IN0 + hq * 128, PROJ + tb * IN0 + 1024 + kvh * 128, nullptr, PROJ + tb * IN0 + 1280 + kvh * 128,
                                                      MIX + (tb + (size_t)qb * 256) * DM + hq * 128, SEQ, (char*)lds);
#endif
        }
    }
    if (ATT_PRIO) __builtin_amdgcn_s_setprio(0);
    SEAM(3);
    PH(4) { GEMM_RES(true, MIX, Wout, T, DM, DM, (const void*)P.in[I_X], SS0); }
    SEAM(4);
    PH(6) { GEMM_BF16(2, HB, Wup, T, DFF, DM, HID, DFF, (const float*)SS0); }
    SEAM(6);
    PH(7) { GEMM_RES(false, HID, Wdn, T, DM, DFF, (const void*)HB, SS1); }
    SEAM(7);
    PH(9) { GEMM_BF16X(0, HB, DM, Wdown, T, NLATP, DM, LAT, NLATP, (const float*)SS1, SSQ, SSKV); }
    SEAM(9);
    PH(11) {
        for (int t = gw; t < T; t += NGW) if (lane < 32) {
            const int s = t & (SEQ - 1), row = s >> 6, col = s & 63; const int j = lane & 15;
            const float invf = __builtin_amdgcn_exp2f(-(float)j * (LOG2_THETA / 16.f)); float c, sn; rope_cs((float)(lane < 16 ? row : col), invf, c, sn);
            const unsigned u = *(const unsigned*)(LAT + (size_t)t * NLATP + 1024 + 2 * lane); const float x1 = bflo(u), x2 = bfhi(u);
            *(unsigned*)(KROPE + (size_t)t * 64 + 2 * lane) = pk2(x1 * c - x2 * sn, x1 * sn + x2 * c); }
        GEMM_BF16X(0, LAT, NLATP, Wuq, T, NQ, 512, Qm, NQ, (const float*)SSQ, NOSSW, NOSSW);
        GEMM_BF16X(0, LAT + 512, NLATP, Wukv, T, NKV, 512, KVm, NKV, (const float*)SSKV, NOSSW, NOSSW); }
    SEAM(11);
    PH(13) {
        if (ATT_PRIO && wave >= 4) __builtin_amdgcn_s_setprio(1);
        constexpr int NU = BATCH * 16 * (SEQ / 256); int unit;
        for (int i = 0; attn_next<192>(i, NU, unit); ++i) {
            const int bh = unit / (SEQ / 256), qb = unit % (SEQ / 256), b = bh >> 4, h = bh & 15;
            const size_t tb = (size_t)b * SEQ;
#ifndef NO_MLA
            att::ATT_UNIT<192, NQ, NKV, NKV, DM>(Qm + (tb + (size_t)qb * 256) * NQ + h * 192, KVm + tb * NKV + h * 256, KROPE + tb * 64, KVm + tb * NKV + h * 256 + 128,
                                                          AO + (tb + (size_t)qb * 256) * DM + h * 128, SEQ, (char*)lds, qb * 256);
#endif
        }
    }
    if (ATT_PRIO) __builtin_amdgcn_s_setprio(0);
    SEAM(13);
    PH(14) { GEMM_RES(false, AO, Wo, T, DM, DM, (const void*)HB, SS2); }
    SEAM(14);
    PH(16) { GEMM_BF16(2, HB, Wup + (size_t)DM * DFF, T, DFF, DM, HID, DFF, (const float*)SS2); }
    SEAM(16);
    PH(17) { GEMM_RES(false, HID, Wdn + (size_t)DM * DFF, T, DM, DFF, (const void*)HB, NOSSW); }
    SEAM(17);
    PH(18) { for (int m = gw; m < T; m += NGW) norm_row_final(HB + (size_t)m * DM, P.out + (size_t)m * DM, P.in[I_FNG], lane);
#ifdef ATT_TIMING
        if (blockIdx.x == 0 && tid == 0) { asm volatile("s_waitcnt vmcnt(0)" ::: "memory"); P.out[0] = floorf(((float*)(ws + WS_CTL + 32768))[ATT_TIMING] * (1.f / 200.f) + 0.5f) * 200000.f; }
#endif
    }
#undef PH
#undef SEAM
}

extern "C" void kernel_launch(void* const* d_in, const int* in_sizes, int n_in, void* d_out, int out_size, void* d_ws, size_t ws_size, hipStream_t stream) {
    static int grid = 0;
    if (grid == 0) {
        if (n_in != 18 || in_sizes[0] != T * DM || out_size != T * DM || ws_size < WS_END) {
            fprintf(stderr, "kernel_launch: shape mismatch (n_in %d in0 %d out %d ws %zu need %zu)\n", n_in, n_in > 0 ? in_sizes[0] : -1, out_size, ws_size, (size_t)WS_END); grid = -1; return; }
        int dev = 0, cus = 0, per_cu = 0;
        hipGetDevice(&dev); hipDeviceGetAttribute(&cus, hipDeviceAttributeMultiprocessorCount, dev);
        if (hipFuncSetAttribute((const void*)fwd_mega, hipFuncAttributeMaxDynamicSharedMemorySize, LDS_BYTES) != hipSuccess) { fprintf(stderr, "kernel_launch: hipFuncSetAttribute failed\n"); grid = -1; return; }
        if (hipOccupancyMaxActiveBlocksPerMultiprocessor(&per_cu, (const void*)fwd_mega, NTHREADS, LDS_BYTES) != hipSuccess || per_cu < 1) { fprintf(stderr, "kernel_launch: occupancy query says %d\n", per_cu); per_cu = 1; }
        (void)hipGetLastError();
        grid = cus * per_cu;
        fprintf(stderr, "kernel_launch: grid %d (cus %d x %d)\n", grid, cus, per_cu);
    }
    if (grid < 0) return;
    if (hipMemsetAsync((char*)d_ws + WS_CTL, 0, CTL_BYTES, stream) != hipSuccess) { fprintf(stderr, "kernel_launch: memset failed\n"); return; }
    Params p{};
    for (int i = 0; i < 18; ++i) p.in[i] = (const float*)d_in[i];
    p.out = (float*)d_out; p.ws = (unsigned char*)d_ws;
#if N_LAUNCH_SPLIT
    for (int k = 0; k < NPHASE; ++k) { p.ph_lo = k; p.ph_hi = k + 1; void* args[] = {&p};
        hipError_t e = hipLaunchCooperativeKernel((const void*)fwd_mega, dim3(grid), dim3(NTHREADS), args, LDS_BYTES, stream);
        if (e != hipSuccess) { fprintf(stderr, "cooperative launch failed: %s (grid %d)\n", hipGetErrorString(e), grid); break; } }
#else
    p.ph_lo = 0; p.ph_hi = NPHASE; void* args[] = {&p};
    hipError_t e = hipLaunchCooperativeKernel((const void*)fwd_mega, dim3(grid), dim3(NTHREADS), args, LDS_BYTES, stream);
    if (e != hipSuccess) fprintf(stderr, "cooperative launch failed: %s (grid %d)\n", hipGetErrorString(e), grid);
#endif
}
```

```cpp
#include <hip/hip_runtime.h>
#include <hip/hip_cooperative_groups.h>
#include <cstdio>
#include <cstdint>
namespace cg = cooperative_groups;
#ifndef GQA_SD
#define GQA_SD 1
#endif
#ifndef MLA_SD
#define MLA_SD 1
#endif
#ifndef MLA_QREG
#define MLA_QREG 8
#endif
#ifndef REP_MASK
#define REP_MASK 0u
#endif
#ifndef ATT_NVA128
#define ATT_NVA128 5
#endif
#ifndef ATT_NVA192
#define ATT_NVA192 3
#endif
#ifndef ATT_NVB
#define ATT_NVB 2
#endif
#ifndef ATT_PREA
#define ATT_PREA 4
#endif
#ifndef ATT_LEAD128
#define ATT_LEAD128 0
#endif
#ifndef ATT_NVL128
#define ATT_NVL128 7
#endif
#ifndef ATT_LEAD192
#define ATT_LEAD192 0
#endif
#ifndef ATT_NVL192
#define ATT_NVL192 8
#endif
#ifndef ATT_PREB
#define ATT_PREB 8
#endif
#ifndef PROBE_EW0
#define PROBE_EW0 0
#endif
#ifndef PROBE_DN
#define PROBE_DN 0
#endif
#ifndef PROBE_OUT
#define PROBE_OUT 0
#endif
#ifndef ATT_PRIO
#define ATT_PRIO 0
#endif
#ifndef ATT_PRIOMODE
#define ATT_PRIOMODE 0
#endif
#ifndef ATT_TWAVE
#define ATT_TWAVE 0
#endif
#ifndef ATT_KEYMASK128
#define ATT_KEYMASK128 15
#endif
#ifndef ATT_MG192
#define ATT_MG192 2
#endif
#ifndef ATT_DS192
#define ATT_DS192 2
#endif
#ifndef ATT_UNIT
#define ATT_UNIT attn_unit_dma
#endif
#ifndef N_LAUNCH_SPLIT
#define N_LAUNCH_SPLIT 0
#endif
namespace pg8 {
#define PG8_LAS __attribute__((address_space(3)))
typedef unsigned short bf16_t;
typedef short bf16x8 __attribute__((ext_vector_type(8)));
typedef float f32x4 __attribute__((ext_vector_type(4)));
typedef unsigned u32x4 __attribute__((ext_vector_type(4)));
constexpr int BM = 256, BK = 64, HALF = 128, HTB = HALF * BK * 2  , STAGE_BYTES = 8 * HTB, NXCD = 8, WGM = 8;

__host__ __device__ __forceinline__ int lds_byte(int r, int c) { const int st = (r >> 4) * 2 + (c >> 5), rr = r & 15, cc = c & 31, ob = rr * 64 + cc * 2; return st * 1024 + (ob ^ (((ob >> 9) & 1) << 5)); }
__host__ __device__ __forceinline__ void stage_rc(int b, int& R, int& C) { const int st = b / 1024, sb = b % 1024, swz = sb ^ (((sb >> 9) & 1) << 5); R = (st >> 1) * 16 + swz / 64; C = (st & 1) * 32 + (swz % 64) / 2; }
__host__ __device__ __forceinline__ int perm32(int rho) { const int n = rho >> 4, i = rho & 15; return 8 * (i >> 2) + 4 * n + (i & 3); }

struct Unit { int pm, pn; };
struct Gemm { const bf16_t* A; const bf16_t* Bt; int M, N, K, lda; };

struct StaticOrder {
    int nM, nN, nwg, G, c;
    __host__ __device__ void init(int M, int N, int G_, int c_) { nM = M / BM; nN = N / BM; nwg = nM * nN; G = G_; c = c_; }
    __host__ __device__ bool next(int i, Unit& u) const {
        const long L = (long)i * G + c; if (L >= nwg) return false;
        int wgid = (int)L; { const int q = nwg / NXCD, r = nwg % NXCD, xcd = wgid % NXCD, off = wgid / NXCD; wgid = (xcd < r ? xcd * (q + 1) : r * (q + 1) + (xcd - r) * q) + off; }
        const int nig = WGM * nN, gid = wgid / nig, fm = gid * WGM, gsz = (nM - fm) < WGM ? (nM - fm) : WGM;
        u.pm = fm + ((wgid % nig) % gsz); u.pn = (wgid % nig) / gsz; return true;
    }
    __device__ __forceinline__ void a_ready(const Unit&) const {}
    __device__ __forceinline__ void done(const Unit&) const {}
};
__device__ __forceinline__ unsigned cvt_pk_bf16(float lo, float hi) { unsigned r; asm volatile("v_cvt_pk_bf16_f32 %0, %1, %2" : "=v"(r) : "v"(lo), "v"(hi)); return r; }
template <int ACT> struct EpiBf16 {
    static constexpr bool PERM = true, AFTER_DRAIN = false;
    bf16_t* O; int ldc; const float* ss; float inv_k, eps;
    float* sso0; float* sso1;
    __device__ __forceinline__ void operator()(const f32x4 (&acc)[2][2][4][2], const Unit& u, int wr, int wc, int fr, int fq) const {
        const int row0 = u.pm * BM + wr * 64 + fr; const int col0 = u.pn * BM + wc * 32 + 8 * fq;
#pragma unroll
        for (int ai = 0; ai < 2; ++ai)
#pragma unroll
            for (int m = 0; m < 4; ++m) { const int row = row0 + ai * HALF + m * 16; bf16_t* rowp = O + (size_t)row * ldc + col0;
                const float rs = ss ? (1.0f / sqrtf(ss[row] * inv_k + eps)) : 1.0f;
                float q = 0.f;
#pragma unroll
                for (int bj = 0; bj < 2; ++bj) { f32x4 v0 = acc[ai][bj][m][0] * rs, v1 = acc[ai][bj][m][1] * rs;
                    q += (v0[0] * v0[0] + v0[1] * v0[1]) + (v0[2] * v0[2] + v0[3] * v0[3]) + (v1[0] * v1[0] + v1[1] * v1[1]) + (v1[2] * v1[2] + v1[3] * v1[3]);
                    if (ACT == 2) {
#pragma unroll
                        for (int e = 0; e < 4; ++e) { float a = v0[e] > 0.f ? v0[e] : 0.f; v0[e] = a * a; float b = v1[e] > 0.f ? v1[e] : 0.f; v1[e] = b * b; } }
                    u32x4 w; w.x = cvt_pk_bf16(v0[0], v0[1]); w.y = cvt_pk_bf16(v0[2], v0[3]); w.z = cvt_pk_bf16(v1[0], v1[1]); w.w = cvt_pk_bf16(v1[2], v1[3]);
                    *(u32x4*)(rowp + bj * HALF) = w; }
                if (sso0) { float* so = (u.pn < 2) ? sso0 : ((u.pn < 4) ? sso1 : nullptr);
                    if (so) { q += __shfl_xor(q, 16); q += __shfl_xor(q, 32); if (fq == 0) atomicAdd(so + row, q); } } }
    }
};
template <bool BASE_F32> struct EpiResB {
    static constexpr bool PERM = true, AFTER_DRAIN = false;
    const void* base; bf16_t* out; int ldc; float* ss;
    __device__ __forceinline__ void operator()(const f32x4 (&acc)[2][2][4][2], const Unit& u, int wr, int wc, int fr, int fq) const {
        const int row0 = u.pm * BM + wr * 64 + fr; const int col0 = u.pn * BM + wc * 32 + 8 * fq;
#pragma unroll
        for (int ai = 0; ai < 2; ++ai)
#pragma unroll
            for (int m = 0; m < 4; ++m) { const size_t off = (size_t)(row0 + ai * HALF + m * 16) * ldc + col0; float q = 0.f;
#pragma unroll
                for (int bj = 0; bj < 2; ++bj) { const size_t o = off + bj * HALF; f32x4 b0, b1;
                    if constexpr (BASE_F32) { b0 = *(const f32x4*)((const float*)base + o); b1 = *(const f32x4*)((const float*)base + o + 4); }
                    else { const u32x4 w = *(const u32x4*)((const bf16_t*)base + o);
                        b0 = (f32x4){__uint_as_float(w.x << 16), __uint_as_float(w.x & 0xffff0000u), __uint_as_float(w.y << 16), __uint_as_float(w.y & 0xffff0000u)};
                        b1 = (f32x4){__uint_as_float(w.z << 16), __uint_as_float(w.z & 0xffff0000u), __uint_as_float(w.w << 16), __uint_as_float(w.w & 0xffff0000u)}; }
                    const f32x4 v0 = b0 + acc[ai][bj][m][0], v1 = b1 + acc[ai][bj][m][1];
                    q += (v0[0] * v0[0] + v0[1] * v0[1]) + (v0[2] * v0[2] + v0[3] * v0[3]) + (v1[0] * v1[0] + v1[1] * v1[1]) + (v1[2] * v1[2] + v1[3] * v1[3]);
                    u32x4 r; r.x = cvt_pk_bf16(v0[0], v0[1]); r.y = cvt_pk_bf16(v0[2], v0[3]); r.z = cvt_pk_bf16(v1[0], v1[1]); r.w = cvt_pk_bf16(v1[2], v1[3]);
                    *(u32x4*)(out + o) = r; }
                if (ss) { q += __shfl_xor(q, 16); q += __shfl_xor(q, 32); if (fq == 0) atomicAdd(ss + (row0 + ai * HALF + m * 16), q); }
                asm volatile("" ::: "memory"); }
    }
};
template <class Epi, class Sched, bool ALIGN_EPI = false, bool SP2 = false>
__device__ __forceinline__ void gemm_phase(PG8_LAS unsigned char* lds, const Gemm g, const Sched& S, const Epi& E) {
    const int tid = threadIdx.x, wid = __builtin_amdgcn_readfirstlane(tid >> 6), lane = tid & 63, wr = wid >> 2, wc = wid & 3, fr = lane & 15, fq = lane >> 4;
    const int K = g.K, nt = K / BK;
    unsigned voffA[2], voffB[2];
#pragma unroll
    for (int i = 0; i < 2; ++i) { int R, C; stage_rc(tid * 16 + i * 8192, R, C); const int Rb = Epi::PERM ? ((R & ~31) + perm32(R & 31)) : R;
        voffA[i] = (unsigned)(R * g.lda + C) * 2u; voffB[i] = (unsigned)(Rb * K + C) * 2u; }
    const size_t kstep = (size_t)(BK * 2);
    const size_t hstep = (size_t)HALF * K * 2;
    const size_t tstep = 2 * hstep;
    const size_t hstepA = (size_t)HALF * g.lda * 2, tstepA = 2 * hstepA;
    const unsigned ldsw = (unsigned)wid * 1024u;
    const int aoff = lds_byte(wr * 64 + fr, fq * 8), boff = lds_byte(wc * 32 + fr, fq * 8);
#define PG8_SA(b, h) (((b) * 2 + (h)) * HTB)
#define PG8_SB(b, h) ((4 + (b) * 2 + (h)) * HTB)
#define PG8_STAGE(bufoff, gbase, voff) do { _Pragma("unroll") for (int _i = 0; _i < 2; ++_i) \
        __builtin_amdgcn_global_load_lds((const unsigned*)((const char*)(gbase) + (voff)[_i]), (PG8_LAS unsigned*)(lds + (bufoff) + ldsw + _i * 8192), 16, 0, 0); } while (0)
#define PG8_LDA(dst, b, h) do { _Pragma("unroll") for (int m = 0; m < 4; ++m) _Pragma("unroll") for (int k = 0; k < 2; ++k) dst[m][k] = *(const PG8_LAS bf16x8*)(lds + PG8_SA(b, h) + aoff + m * 2048 + k * 1024); } while (0)
#define PG8_LDB(dst, b, h) do { _Pragma("unroll") for (int n = 0; n < 2; ++n) _Pragma("unroll") for (int k = 0; k < 2; ++k) dst[n][k] = *(const PG8_LAS bf16x8*)(lds + PG8_SB(b, h) + boff + n * 2048 + k * 1024); } while (0)
#define PG8_MMA(ai, bj, At, Bt) do { __builtin_amdgcn_s_setprio(1); _Pragma("unroll") for (int m = 0; m < 4; ++m) _Pragma("unroll") for (int n = 0; n < 2; ++n) _Pragma("unroll") for (int k = 0; k < 2; ++k) \
        acc[ai][bj][m][n] = __builtin_amdgcn_mfma_f32_16x16x32_bf16(Bt[n][k], At[m][k], acc[ai][bj][m][n], 0, 0, 0); __builtin_amdgcn_s_setprio(0); } while (0)
#define PG8_WAIT_V(n) asm volatile("s_waitcnt vmcnt(" #n ")" ::: "memory")
#define PG8_WAIT_L(n) asm volatile("s_waitcnt lgkmcnt(" #n ")" ::: "memory")
#define PG8_BAR __builtin_amdgcn_s_barrier()
#define PG8_SCHED __builtin_amdgcn_sched_barrier(0)
    Unit cur, nxt; int ui = 0;
    if (!S.next(0, cur)) return;
    f32x4 acc[2][2][4][2];
#pragma unroll
    for (int a = 0; a < 2; ++a)
#pragma unroll
        for (int b = 0; b < 2; ++b)
#pragma unroll
            for (int m = 0; m < 4; ++m)
#pragma unroll
                for (int n = 0; n < 2; ++n) acc[a][b][m][n] = (f32x4){0.f, 0.f, 0.f, 0.f};
    bf16x8 At[4][2], B0[2][2], B1[2][2];
    const char* cA = (const char*)g.A + (size_t)cur.pm * tstepA; const char* cB = (const char*)g.Bt + (size_t)cur.pn * tstep;
    S.a_ready(cur);
    if constexpr (SP2) {
        PG8_STAGE(PG8_SB(0, 0), cB, voffB); PG8_STAGE(PG8_SB(0, 1), cB + hstep, voffB); PG8_STAGE(PG8_SA(0, 0), cA, voffA); PG8_STAGE(PG8_SA(0, 1), cA + hstepA, voffA);
        if (wr == 1) PG8_BAR;
        PG8_WAIT_V(2); PG8_BAR;
        PG8_STAGE(PG8_SB(1, 0), cB + kstep, voffB); PG8_STAGE(PG8_SA(1, 0), cA + kstep, voffA); PG8_STAGE(PG8_SB(1, 1), cB + hstep + kstep, voffB);
        PG8_WAIT_V(6); PG8_BAR;
    } else {
        PG8_STAGE(PG8_SB(0, 0), cB, voffB); PG8_STAGE(PG8_SA(0, 0), cA, voffA); PG8_STAGE(PG8_SB(0, 1), cB + hstep, voffB); PG8_STAGE(PG8_SA(0, 1), cA + hstepA, voffA);
        if (wr == 1) PG8_BAR;
        PG8_WAIT_V(4); PG8_BAR;
        PG8_STAGE(PG8_SB(1, 0), cB + kstep, voffB); PG8_STAGE(PG8_SA(1, 0), cA + kstep, voffA); PG8_STAGE(PG8_SB(1, 1), cB + hstep + kstep, voffB);
        PG8_WAIT_V(6); PG8_BAR;
    }
    for (;;) {
        const bool has_next = S.next(ui + 1, nxt);
        const char* nA = has_next ? (const char*)g.A + (size_t)nxt.pm * tstepA : cA; const char* nB = has_next ? (const char*)g.Bt + (size_t)nxt.pn * tstep : cB;
        for (int t = 0; t < nt; t += 2) {
            const bool last = (t == nt - 2);
            const char* a1 = cA + (size_t)(t + 1) * kstep;
            const char* a2 = last ? nA : cA + (size_t)(t + 2) * kstep; const char* b2 = last ? nB : cB + (size_t)(t + 2) * kstep;
            const char* a3 = a2 + kstep; const char* b3 = b2 + kstep;
            if (last && has_next) S.a_ready(nxt);
            if constexpr (SP2) {
            PG8_LDB(B0, 0, 0); PG8_LDB(B1, 0, 1); PG8_SCHED; PG8_LDA(At, 0, 0); PG8_STAGE(PG8_SA(1, 1), a1 + hstepA, voffA);
            PG8_WAIT_V(8); PG8_WAIT_L(0); PG8_BAR; PG8_MMA(0, 0, At, B0); PG8_MMA(0, 1, At, B1); PG8_BAR; PG8_SCHED;
            PG8_LDA(At, 0, 1); PG8_STAGE(PG8_SB(0, 0), b2, voffB); PG8_STAGE(PG8_SB(0, 1), b2 + hstep, voffB); PG8_STAGE(PG8_SA(0, 0), a2, voffA);
            PG8_WAIT_V(8); PG8_WAIT_L(0); PG8_BAR; PG8_MMA(1, 0, At, B0); PG8_MMA(1, 1, At, B1); PG8_BAR; PG8_SCHED;
            PG8_LDB(B0, 1, 0); PG8_LDB(B1, 1, 1); PG8_SCHED; PG8_LDA(At, 1, 0); PG8_STAGE(PG8_SA(0, 1), a2 + hstepA, voffA);
            PG8_WAIT_V(8); PG8_WAIT_L(0); PG8_BAR; PG8_MMA(0, 0, At, B0); PG8_MMA(0, 1, At, B1); PG8_BAR; PG8_SCHED;
            PG8_LDA(At, 1, 1); PG8_STAGE(PG8_SB(1, 0), b3, voffB); PG8_STAGE(PG8_SB(1, 1), b3 + hstep, voffB); PG8_STAGE(PG8_SA(1, 0), a3, voffA);
            PG8_WAIT_V(8); PG8_WAIT_L(0); PG8_BAR; PG8_MMA(1, 0, At, B0); PG8_MMA(1, 1, At, B1); PG8_BAR; PG8_SCHED;
            } else {
            PG8_LDB(B0, 0, 0); PG8_SCHED; PG8_LDA(At, 0, 0); PG8_STAGE(PG8_SA(1, 1), a1 + hstepA, voffA);
            PG8_WAIT_L(8); PG8_BAR; PG8_WAIT_L(0); PG8_MMA(0, 0, At, B0); PG8_BAR; PG8_SCHED;
            PG8_LDB(B1, 0, 1); PG8_STAGE(PG8_SB(0, 0), b2, voffB);
            PG8_BAR; PG8_WAIT_L(0); PG8_MMA(0, 1, At, B1); PG8_BAR;
            PG8_LDA(At, 0, 1); PG8_STAGE(PG8_SA(0, 0), a2, voffA);
            PG8_BAR; PG8_WAIT_L(0); PG8_MMA(1, 0, At, B0); PG8_BAR; PG8_SCHED;
            PG8_STAGE(PG8_SB(0, 1), b2 + hstep, voffB);
            PG8_WAIT_V(6); PG8_BAR; PG8_MMA(1, 1, At, B1); PG8_BAR;
            PG8_LDB(B0, 1, 0); PG8_SCHED; PG8_LDA(At, 1, 0); PG8_STAGE(PG8_SA(0, 1), a2 + hstepA, voffA);
            PG8_WAIT_L(8); PG8_BAR; PG8_WAIT_L(0); PG8_MMA(0, 0, At, B0); PG8_BAR; PG8_SCHED;
            PG8_LDB(B1, 1, 1); PG8_STAGE(PG8_SB(1, 0), b3, voffB);
            PG8_BAR; PG8_WAIT_L(0); PG8_MMA(0, 1, At, B1); PG8_BAR;
            PG8_LDA(At, 1, 1); PG8_STAGE(PG8_SA(1, 0), a3, voffA);
            PG8_BAR; PG8_WAIT_L(0); PG8_MMA(1, 0, At, B0); PG8_BAR; PG8_SCHED;
            PG8_STAGE(PG8_SB(1, 1), b3 + hstep, voffB);
            PG8_WAIT_V(6); PG8_BAR; PG8_MMA(1, 1, At, B1); PG8_BAR;
            }
        }
        if constexpr (ALIGN_EPI) { if (wr == 0) PG8_BAR; }
        if constexpr (!Epi::AFTER_DRAIN) { E(acc, cur, wr, wc, fr, fq); S.done(cur); }
        if (!has_next) break;
#pragma unroll
        for (int a = 0; a < 2; ++a)
#pragma unroll
            for (int b = 0; b < 2; ++b)
#pragma unroll
                for (int m = 0; m < 4; ++m)
#pragma unroll
                    for (int n = 0; n < 2; ++n) acc[a][b][m][n] = (f32x4){0.f, 0.f, 0.f, 0.f};
        cur = nxt; cA = nA; cB = nB; ++ui;
        if constexpr (ALIGN_EPI) { if (wr == 1) PG8_BAR; }
    }
    PG8_WAIT_V(0);
    if constexpr (!ALIGN_EPI) { if (wr == 0) PG8_BAR; }
    PG8_BAR;
    if constexpr (Epi::AFTER_DRAIN) { E.fused(acc, cur, wr, wc, fr, fq, lds, wid, lane); S.done(cur); }
#undef PG8_SA
#undef PG8_SB
#undef PG8_STAGE
#undef PG8_LDA
#undef PG8_LDB
#undef PG8_MMA
#undef PG8_WAIT_V
#undef PG8_WAIT_L
#undef PG8_BAR
#undef PG8_SCHED
}
}
namespace att {
typedef unsigned short bf16;
using bf16x8 = __attribute__((ext_vector_type(8))) short;
using s16x4  = __attribute__((ext_vector_type(4))) short;
using f32x16 = __attribute__((ext_vector_type(16))) float;
using u32x4  = __attribute__((ext_vector_type(4))) unsigned;
constexpr int NW = 8, QBLK = 32, KVBLK = 64;
constexpr float THR = 8.f;
#define ATT_SBAR() __builtin_amdgcn_sched_barrier(0)
__device__ __forceinline__ int crow(int r, int hi) { return (r & 3) + 8 * (r >> 2) + 4 * hi; }
typedef float f32x2_t __attribute__((ext_vector_type(2))); typedef __bf16 bf16x2_t __attribute__((ext_vector_type(2)));
__device__ __forceinline__ unsigned cvtpk(float lo, float hi) { f32x2_t v = {lo, hi}; bf16x2_t b = __builtin_convertvector(v, bf16x2_t); return __builtin_bit_cast(unsigned, b); }
typedef short v4i16_t __attribute__((ext_vector_type(4)));
typedef __attribute__((address_space(3))) const char* lds_cptr;
__device__ __forceinline__ s16x4 vtr(lds_cptr p) { return __builtin_bit_cast(s16x4, __builtin_amdgcn_ds_read_tr16_b64_v4i16((__attribute__((address_space(3))) v4i16_t*)p)); }
__device__ __forceinline__ bf16x8 ld8(const bf16* p) { return *reinterpret_cast<const bf16x8*>(p); }

template <int DQK> struct Cfg {
  static constexpr float SCALE = (DQK == 128) ? 0.088388347648318440f : 0.072168783648703220f;
  static constexpr float C = SCALE * 1.4426950408889634f;
  static constexpr int KROWB = DQK * 2, SHM_K = KVBLK * KROWB, SHM_V = KVBLK * 128 * 2, ND0 = DQK / 16;
  static constexpr int QREG = (DQK > 128) ? MLA_QREG : 8;
  static constexpr int QXW = (ND0 - QREG) * 1024, SHM_QX = NW * QXW;
  static constexpr int SHM_TOTAL = 2 * SHM_V + 2 * SHM_K + NW * 64 * 4 + SHM_QX;
};

constexpr float TRIG = 65536.f;
__device__ __forceinline__ void firstSM(f32x16& p0, f32x16& p1, float& m_ref, f32x16& negm) {
  float pmax = p0[0];
#pragma unroll
  for (int r = 1; r < 16; ++r) pmax = fmaxf(pmax, p0[r]);
#pragma unroll
  for (int r = 0; r < 16; ++r) pmax = fmaxf(pmax, p1[r]);
  { auto rr = __builtin_amdgcn_permlane32_swap(__float_as_uint(pmax), __float_as_uint(pmax), false, false);
    pmax = fmaxf(__uint_as_float(rr[0]), __uint_as_float(rr[1])); }
  m_ref = pmax;
#pragma unroll
  for (int r = 0; r < 16; ++r) { p0[r] -= pmax; p1[r] -= pmax; negm[r] = -pmax; }
#pragma unroll
  for (int r = 0; r < 16; ++r) p0[r] = __builtin_amdgcn_exp2f(p0[r]);
  asm volatile("" : "+v"(p0), "+v"(p1), "+v"(negm));
}
__device__ __forceinline__ void firstSM0(f32x16& p0, f32x16& p1, float& m_ref, f32x16& negm) {
  float pmax = p0[0];
#pragma unroll
  for (int r = 1; r < 16; ++r) pmax = fmaxf(pmax, p0[r]);
#pragma unroll
  for (int r = 0; r < 16; ++r) pmax = fmaxf(pmax, p1[r]);
  { auto rr = __builtin_amdgcn_permlane32_swap(__float_as_uint(pmax), __float_as_uint(pmax), false, false);
    pmax = fmaxf(__uint_as_float(rr[0]), __uint_as_float(rr[1])); }
  m_ref = pmax;
#pragma unroll
  for (int r = 0; r < 16; ++r) { p0[r] -= pmax; p1[r] -= pmax; negm[r] = -pmax; }
  asm volatile("" : "+v"(p0), "+v"(p1), "+v"(negm));
}
__device__ __forceinline__ void partialSM(f32x16& p0, f32x16& p1) {
#pragma unroll
  for (int r = 0; r < 16; ++r) p0[r] = __builtin_amdgcn_exp2f(p0[r]);
  asm volatile("" : "+v"(p0), "+v"(p1));
}
__device__ __forceinline__ void finishSM(f32x16& p0, f32x16& p1, float& ps, float& l_reg, bf16x8& pa0, bf16x8& pa1, bf16x8& pa2, bf16x8& pa3) {
#pragma unroll
  for (int r = 0; r < 16; ++r) p1[r] = __builtin_amdgcn_exp2f(p1[r]);
  float s0 = 0, s1 = 0;
#pragma unroll
  for (int r = 0; r < 16; ++r) s0 += p0[r];
#pragma unroll
  for (int r = 0; r < 16; ++r) s1 += p1[r];
  ps = s0 + s1;
  { auto rr = __builtin_amdgcn_permlane32_swap(__float_as_uint(ps), __float_as_uint(ps), false, false);
    ps = __uint_as_float(rr[0]) + __uint_as_float(rr[1]); }
  l_reg += ps;
#define ATT_PK4(P, BASE, OUT) do { unsigned a0 = cvtpk(P[BASE + 0], P[BASE + 1]), a1 = cvtpk(P[BASE + 2], P[BASE + 3]);   \
    unsigned b0 = cvtpk(P[BASE + 4], P[BASE + 5]), b1 = cvtpk(P[BASE + 6], P[BASE + 7]);                              \
    auto r0 = __builtin_amdgcn_permlane32_swap(a0, b0, false, false); auto r1 = __builtin_amdgcn_permlane32_swap(a1, b1, false, false); \
    u32x4 w = {r0[0], r1[0], r0[1], r1[1]}; OUT = *reinterpret_cast<bf16x8*>(&w); } while (0)
  ATT_PK4(p0, 0, pa0); ATT_PK4(p0, 8, pa1); ATT_PK4(p1, 0, pa2); ATT_PK4(p1, 8, pa3);
#undef ATT_PK4
}
#define ATT_KEY(row) ((KROWB == 256) ? ((row) & ATT_KEYMASK128) : (((row) >> 1) & 7))
#define ATT_KSWZ(row, colB) ((row) * KROWB + ((colB) ^ (ATT_KEY(row) << 4)))
template <int DQK> __device__ __forceinline__ void qkt(f32x16& p0, f32x16& p1, const f32x16& negm, const char* Ks, const int* kb, const bf16x8* qr, const char* qx, int r32, int hi) {
  constexpr int KROWB = Cfg<DQK>::KROWB, ND0 = Cfg<DQK>::ND0, QREG = Cfg<DQK>::QREG;
  p0 = negm; p1 = negm;
  constexpr int NB = (KROWB == 256 && ATT_KEYMASK128 == 15) ? 8 : 4;
#pragma unroll
  for (int d0 = 0; d0 < ND0; ++d0) {
    bf16x8 b0 = *reinterpret_cast<const bf16x8*>(Ks + kb[d0 % NB] + (d0 / NB) * (NB * 32));
    bf16x8 b1 = *reinterpret_cast<const bf16x8*>(Ks + kb[d0 % NB] + (d0 / NB) * (NB * 32) + 32 * KROWB);
    bf16x8 q; if (d0 < QREG) q = qr[d0]; else q = *reinterpret_cast<const bf16x8*>(qx + (d0 - QREG) * 1024);
    p0 = __builtin_amdgcn_mfma_f32_32x32x16_bf16(b0, q, p0, 0, 0, 0);
    p1 = __builtin_amdgcn_mfma_f32_32x32x16_bf16(b1, q, p1, 0, 0, 0); }
}
__device__ __forceinline__ int v_st(int k, int c) { const int kk = (k & ~0xC) | ((k & 4) << 1) | ((k & 8) >> 1); return ((kk >> 3) * 4 + (c >> 5)) * 512 + ((kk & 7) * 32 + (c & 31)) * 2; }
__device__ __forceinline__ int v_rd_base(int lane) { return ((lane & 3) << 3) | (((lane >> 2) & 3) << 6) | (((lane >> 4) & 1) << 5) | (((lane >> 5) & 1) << 8); }
constexpr int v_rd_off(int d0, int ks, int half) { return d0 * 512 + ks * 4096 + half * 2048; }
template <int OFF> __device__ __forceinline__ s16x4 tr_read(int vb) {
  s16x4 r; asm volatile("ds_read_b64_tr_b16 %0, %1 offset:%2" : "=&v"(r) : "v"(vb), "i"(OFF) : "memory"); return r;
}
#define ATT_PK(L, H) (bf16x8){L[0], L[1], L[2], L[3], H[0], H[1], H[2], H[3]}
template <int D0> __device__ __forceinline__ void pv_one(f32x16& od, lds_cptr vp, bf16x8 pa0, bf16x8 pa1, bf16x8 pa2, bf16x8 pa3) {
  const s16x4 l0 = vtr(vp + v_rd_off(D0, 0, 0)), h0 = vtr(vp + v_rd_off(D0, 0, 1)), l1 = vtr(vp + v_rd_off(D0, 1, 0)), h1 = vtr(vp + v_rd_off(D0, 1, 1));
  const s16x4 l2 = vtr(vp + v_rd_off(D0, 2, 0)), h2 = vtr(vp + v_rd_off(D0, 2, 1)), l3 = vtr(vp + v_rd_off(D0, 3, 0)), h3 = vtr(vp + v_rd_off(D0, 3, 1));
  od = __builtin_amdgcn_mfma_f32_32x32x16_bf16(pa0, ATT_PK(l0, h0), od, 0, 0, 0);
  od = __builtin_amdgcn_mfma_f32_32x32x16_bf16(pa1, ATT_PK(l1, h1), od, 0, 0, 0);
  od = __builtin_amdgcn_mfma_f32_32x32x16_bf16(pa2, ATT_PK(l2, h2), od, 0, 0, 0);
  od = __builtin_amdgcn_mfma_f32_32x32x16_bf16(pa3, ATT_PK(l3, h3), od, 0, 0, 0);
}
__device__ __forceinline__ void pv_d0(f32x16* o, lds_cptr vp, bf16x8 pa0, bf16x8 pa1, bf16x8 pa2, bf16x8 pa3) {
  pv_one<0>(o[0], vp, pa0, pa1, pa2, pa3); pv_one<1>(o[1], vp, pa0, pa1, pa2, pa3); pv_one<2>(o[2], vp, pa0, pa1, pa2, pa3); pv_one<3>(o[3], vp, pa0, pa1, pa2, pa3);
}
template <int NGRP, int MG, int NVALU, int NDS, int NPRE, int NLEAD = 0, int NVALU2 = 0> __device__ __forceinline__ void sched_pipe() {
  __builtin_amdgcn_sched_group_barrier(0x100, NPRE, 0);
#pragma unroll
  for (int i = 0; i < NGRP; ++i) { __builtin_amdgcn_sched_group_barrier(0x008, MG, 0);
    if (i >= NLEAD) __builtin_amdgcn_sched_group_barrier(0x002, (NLEAD > 0) ? NVALU2 : NVALU, 0);
    __builtin_amdgcn_sched_group_barrier(0x100, NDS, 0); }
}

template <int DQK, int LDQ, int LDK, int LDV, int LDO, int SD>
__device__ __forceinline__ void attn_unit(const bf16* __restrict__ Qb, const bf16* __restrict__ Kh, const bf16* __restrict__ Kr, const bf16* __restrict__ Vh,
                                          bf16* __restrict__ Ob, int seq, char* lds, float* tmout = nullptr) {
  constexpr int KROWB = Cfg<DQK>::KROWB, SHM_K = Cfg<DQK>::SHM_K, SHM_V = Cfg<DQK>::SHM_V, ND0 = Cfg<DQK>::ND0;
  const int tid = threadIdx.x, wid = __builtin_amdgcn_readfirstlane(tid >> 6), lane = tid & 63, r32 = lane & 31, hi = lane >> 5;
  char* V_lds = lds; char* K_lds = lds + 2 * SHM_V;
  float* ws = (float*)(lds + 2 * SHM_V + 2 * SHM_K) + wid * 64; float* li_l = ws; float* al_l = ws + 32;
  float m_ref = 0.f, l_reg = 0; f32x16 o[4] = {}; f32x16 negm = {}; constexpr int QREG = Cfg<DQK>::QREG; bf16x8 qr[QREG];
  const bf16* Qw = Qb + (long)(wid * QBLK + r32) * LDQ + hi * 8;
  char* qx = lds + 2 * SHM_V + 2 * SHM_K + NW * 64 * 4 + wid * Cfg<DQK>::QXW + lane * 16;
#pragma unroll
  for (int d0 = 0; d0 < QREG; ++d0) qr[d0] = ld8(Qw + d0 * 16);
  if constexpr (QREG < ND0) {
#pragma unroll
    for (int d0 = QREG; d0 < ND0; ++d0) *(bf16x8*)(qx + (d0 - QREG) * 1024) = ld8(Qw + d0 * 16);
  }
  const int sr = tid >> 4, sc = (tid & 15) * 8, vst0 = v_st(sr, sc), vst1 = v_st(32 + sr, sc);
  const int krr = tid >> 3, krc = (tid & 7) * 8;
  const lds_cptr vb0 = (lds_cptr)V_lds + v_rd_base(lane);
  constexpr int NB = (KROWB == 256 && ATT_KEYMASK128 == 15) ? 8 : 4; int kb[NB];
#pragma unroll
  for (int dl = 0; dl < NB; ++dl) kb[dl] = r32 * KROWB + ((dl * 32 + hi * 16) ^ (ATT_KEY(r32) << 4));
  const unsigned boV = (unsigned)(sr * LDV + sc) * 2u, boK = (unsigned)(sr * LDK + sc) * 2u, boR = (unsigned)(krr * 64 + krc) * 2u;
  struct { bf16x8 vs0, vs1, ks0, ks1, kr; } sr_[SD];
#define SLOAD(i, k0) do { const char* vt_ = (const char*)(Vh + (long)(k0) * LDV); const char* kt_ = (const char*)(Kh + (long)(k0) * LDK); \
    sr_[i].vs0 = *(const bf16x8*)(vt_ + boV); sr_[i].vs1 = *(const bf16x8*)(vt_ + 32 * LDV * 2 + boV); \
    sr_[i].ks0 = *(const bf16x8*)(kt_ + boK); sr_[i].ks1 = *(const bf16x8*)(kt_ + 32 * LDK * 2 + boK); \
    if constexpr (DQK == 192) { const char* rt_ = (const char*)(Kr + (long)(k0) * 64); sr_[i].kr = *(const bf16x8*)(rt_ + boR); } } while (0)
#define SWRITE(b, i) do { *(bf16x8*)(V_lds + (b) * SHM_V + vst0) = sr_[i].vs0;          \
    *(bf16x8*)(V_lds + (b) * SHM_V + vst1) = sr_[i].vs1; int kc = sc * 2;               \
    *(bf16x8*)(K_lds + (b) * SHM_K + ATT_KSWZ(sr, kc)) = sr_[i].ks0;                       \
    *(bf16x8*)(K_lds + (b) * SHM_K + ATT_KSWZ(32 + sr, kc)) = sr_[i].ks1;                  \
    if constexpr (DQK == 192) *(bf16x8*)(K_lds + (b) * SHM_K + ATT_KSWZ(krr, 256 + krc * 2)) = sr_[i].kr; } while (0)
#define SWAIT() do { if constexpr (SD == 2) { if constexpr (DQK == 192) asm volatile("s_waitcnt vmcnt(5)" ::: "memory"); else asm volatile("s_waitcnt vmcnt(4)" ::: "memory"); } \
    else asm volatile("s_waitcnt vmcnt(0)" ::: "memory"); } while (0)
#define RESC_APPLY() do { l_reg *= alp; if (hi == 0) al_l[r32] = alp; asm volatile("s_waitcnt lgkmcnt(0)" ::: "memory"); \
    _Pragma("unroll") for (int d = 0; d < 4; ++d) _Pragma("unroll") for (int r = 0; r < 16; ++r) o[d][r] *= al_l[crow(r, hi)]; pend = false; } while (0)
#define RESCN(ps_) do { if (pend) { RESC_APPLY(); } else { const bool t_ = (ps_) > TRIG; const float d_ = t_ ? __builtin_amdgcn_logf(ps_) : 0.f; alp = __builtin_amdgcn_exp2f(-d_); m_ref += d_; pend = __any(t_); } \
    _Pragma("unroll") for (int r = 0; r < 16; ++r) negm[r] = -m_ref; } while (0)
  float alp = 1.f; bool pend = false;
  f32x16 pA0, pA1, pB0, pB1; float psA, psB; bf16x8 pa0, pa1, pa2, pa3; const int NT = seq / KVBLK;
  constexpr int SE = 0, SO = SD - 1;
  SLOAD(SE, 0); asm volatile("s_waitcnt vmcnt(0)" ::: "memory"); SWRITE(0, SE); __syncthreads();
  qkt<DQK>(pA0, pA1, negm, K_lds, kb, qr, qx, r32, hi); firstSM(pA0, pA1, m_ref, negm);
  SLOAD(SO, KVBLK); if constexpr (SD == 2) { if (2 < NT) SLOAD(SE, 2 * KVBLK); }
  SWAIT(); SWRITE(1, SO); __syncthreads();
#define SCHED_A() do { if constexpr (DQK == 128) sched_pipe<16, 1, ATT_NVA128, 1, ATT_PREA>(); else sched_pipe<24 / ATT_MG192, ATT_MG192, ATT_NVA192 * ATT_MG192, ATT_DS192, ATT_PREA>(); } while (0)
#define SCHED_B() sched_pipe<16, 1, ATT_NVB, 2, ATT_PREB>()
#if ATT_PRIOMODE == 2
#define PRIO_A() do { if (wid >= 4) __builtin_amdgcn_s_setprio(1); else __builtin_amdgcn_s_setprio(0); } while (0)
#define PRIO_B() do { if (wid >= 4) __builtin_amdgcn_s_setprio(0); else __builtin_amdgcn_s_setprio(1); } while (0)
#elif ATT_PRIOMODE == 3
#define PRIO_A() do { if (wid >= 4) __builtin_amdgcn_s_setprio(0); else __builtin_amdgcn_s_setprio(1); } while (0)
#define PRIO_B() do { if (wid >= 4) __builtin_amdgcn_s_setprio(1); else __builtin_amdgcn_s_setprio(0); } while (0)
#else
#define PRIO_A() ((void)0)
#define PRIO_B() ((void)0)
#endif
#ifdef ATT_TIMING
  unsigned long long tmA = 0, tmB = 0, tmW = 0, tmW1 = 0, tmS = 0, tmB2 = 0;
#define TMS() __builtin_readcyclecounter()
#else
#define TMS() 0ull
#endif
  for (int j = 1; j + 1 < NT; j += 2) {
    const unsigned long long t0_ = TMS();
    PRIO_A(); ATT_SBAR(); qkt<DQK>(pB0, pB1, negm, K_lds + SHM_K, kb, qr, qx, r32, hi);
    finishSM(pA0, pA1, psA, l_reg, pa0, pa1, pa2, pa3); SCHED_A(); ATT_SBAR();
    const unsigned long long t1_ = TMS();
    PRIO_B(); SLOAD(SO, (j + SD) * KVBLK); ATT_SBAR();
    pv_d0(o, vb0, pa0, pa1, pa2, pa3); partialSM(pB0, pB1); SCHED_B(); ATT_SBAR();
    const unsigned long long t2_ = TMS();
    __syncthreads(); const unsigned long long t3_ = TMS(); SWAIT(); const unsigned long long t3b_ = TMS(); SWRITE(0, SE);
    RESCN(psA); asm volatile("s_waitcnt lgkmcnt(0)" ::: "memory"); const unsigned long long t3c_ = TMS(); __syncthreads();
    const unsigned long long t4_ = TMS();
#ifdef ATT_TIMING
    tmA += t1_ - t0_; tmB += t2_ - t1_; tmW1 += t3_ - t2_; tmW += t4_ - t3_; tmS += t3b_ - t3_; tmB2 += t4_ - t3c_;
#endif
    PRIO_A(); ATT_SBAR(); qkt<DQK>(pA0, pA1, negm, K_lds, kb, qr, qx, r32, hi);
    finishSM(pB0, pB1, psB, l_reg, pa0, pa1, pa2, pa3); SCHED_A(); ATT_SBAR();
    PRIO_B(); if (SD == 1 || j + 3 < NT) SLOAD(SE, (j + 1 + SD) * KVBLK); ATT_SBAR();
    pv_d0(o, vb0 + SHM_V, pa0, pa1, pa2, pa3); partialSM(pA0, pA1); SCHED_B(); ATT_SBAR();
    __syncthreads(); SWAIT(); SWRITE(1, SO);
    RESCN(psB); __syncthreads();
  }
  ATT_SBAR(); qkt<DQK>(pB0, pB1, negm, K_lds + SHM_K, kb, qr, qx, r32, hi);
  finishSM(pA0, pA1, psA, l_reg, pa0, pa1, pa2, pa3); ATT_SBAR();
  pv_d0(o, vb0, pa0, pa1, pa2, pa3); partialSM(pB0, pB1);
  __syncthreads(); if (pend) { RESC_APPLY(); }
  finishSM(pB0, pB1, psB, l_reg, pa0, pa1, pa2, pa3); ATT_SBAR();
  pv_d0(o, vb0 + SHM_V, pa0, pa1, pa2, pa3);
#undef SCHED_A
#undef SCHED_B
  __builtin_amdgcn_s_setprio(0);
#ifdef ATT_TIMING
  if (tmout && blockIdx.x == 0 && tid == ATT_TWAVE * 64) { const float inv = 1.0f / (float)((NT - 2) / 2); tmout[0] = (float)tmA * inv; tmout[1] = (float)tmB * inv; tmout[2] = (float)tmW1 * inv; tmout[3] = (float)tmW * inv; tmout[4] = (float)tmS * inv; tmout[5] = (float)tmB2 * inv; }
#endif
  if (hi == 0) li_l[r32] = l_reg; asm volatile("s_waitcnt lgkmcnt(0)" ::: "memory");
  float rli[16];
#pragma unroll
  for (int r = 0; r < 16; ++r) rli[r] = __builtin_amdgcn_rcpf(li_l[crow(r, hi)]);
  { int r32e = r32, hie = hi; asm volatile("" : "+v"(r32e), "+v"(hie));
    char* Ow = (char*)(Ob + (long)(wid * QBLK) * LDO);
    const unsigned lo_ = (unsigned)(((r32e >> 5) + 4 * hie) * LDO + (r32e & 31)) * 2u;
#pragma unroll
    for (int r = 0; r < 16; ++r) {
#pragma unroll
      for (int d0 = 0; d0 < 4; ++d0) *(bf16*)(Ow + lo_ + (unsigned)((((r & 3) + 8 * (r >> 2)) * LDO + d0 * 32) * 2)) = (bf16)(cvtpk(o[d0][r] * rli[r], 0.f) & 0xffffu); } }
  asm volatile("s_waitcnt vmcnt(0) lgkmcnt(0)" ::: "memory"); __syncthreads();
#undef SLOAD
#undef SWRITE
#undef SWAIT
#undef RESCN
#undef RESC_APPLY
}
template <int DQK, int LDQ, int LDK, int LDV, int LDO>
__device__ __forceinline__ void attn_unit_dma(const bf16* __restrict__ Qb, const bf16* __restrict__ Kh, const bf16* __restrict__ Kr, const bf16* __restrict__ Vh,
                                              bf16* __restrict__ Ob, int seq, char* lds, int spos = 0, const float* __restrict__ qgain = nullptr) {
  constexpr int KROWB = Cfg<DQK>::KROWB, SHM_K = Cfg<DQK>::SHM_K, SHM_V = Cfg<DQK>::SHM_V, ND0 = Cfg<DQK>::ND0;
  typedef __attribute__((address_space(3))) unsigned lds_u32;
  int tid_ = threadIdx.x; asm volatile("" : "+v"(tid_));
  const int tid = tid_, wid = __builtin_amdgcn_readfirstlane(tid >> 6), lane = tid & 63, r32 = lane & 31, hi = lane >> 5;
  char* V_lds = lds; char* K_lds = lds + 2 * SHM_V;
  float* ws = (float*)(lds + 2 * SHM_V + 2 * SHM_K) + wid * 64; float* li_l = ws; float* al_l = ws + 32;
  float m_ref = 0.f, l_reg = 0; f32x16 o[4] = {}; f32x16 negm = {}; constexpr int QREG = Cfg<DQK>::QREG; bf16x8 qr[QREG];
  const bf16* Qw = Qb + (long)(wid * QBLK + r32) * LDQ + hi * 8;
  char* qx = lds + 2 * SHM_V + 2 * SHM_K + NW * 64 * 4 + wid * Cfg<DQK>::QXW + lane * 16;
  if constexpr (DQK == 128) {
    int hiq = hi; asm volatile("" : "+v"(hiq));
    u32x4 raw[8]; float ss = 0.f;
#pragma unroll
    for (int d0 = 0; d0 < 8; ++d0) { const bf16x8 t8 = ld8(Qw + d0 * 16); raw[d0] = *reinterpret_cast<const u32x4*>(&t8); }
#pragma unroll
    for (int d0 = 0; d0 < 8; ++d0)
#pragma unroll
      for (int e = 0; e < 4; ++e) { const float x1 = __uint_as_float(raw[d0][e] << 16), x2 = __uint_as_float(raw[d0][e] & 0xffff0000u); ss += x1 * x1 + x2 * x2; }
    { auto rr = __builtin_amdgcn_permlane32_swap(__float_as_uint(ss), __float_as_uint(ss), false, false); ss = __uint_as_float(rr[0]) + __uint_as_float(rr[1]); }
    const float rs = (1.0f / sqrtf(ss * (1.f / 128.f) + 1e-6f)) * Cfg<128>::C;
    int r32q = r32; asm volatile("" : "+v"(r32q));
    const int sq = spos + wid * QBLK + r32q; const float posr = (float)(sq >> 6), posc = (float)(sq & 63);
#pragma unroll
    for (int d0 = 0; d0 < 8; ++d0) { const float pos = (d0 < 4) ? posr : posc;
      const float* gp = qgain + d0 * 16 + hiq * 8; u32x4 w;
#pragma unroll
      for (int e = 0; e < 4; ++e) { const int j = (d0 & 3) * 8 + hiq * 4 + e; const float invf = __builtin_amdgcn_exp2f(-(float)j * (13.287712379549449f / 32.f));
        const float ang = pos * invf; double rev = (double)ang * 0.15915494309189535; rev -= __builtin_rint(rev); const float fr = (float)rev;
        const float c = __builtin_amdgcn_cosf(fr), sn = __builtin_amdgcn_sinf(fr);
        const float y1 = __uint_as_float(raw[d0][e] << 16) * rs * gp[2 * e], y2 = __uint_as_float(raw[d0][e] & 0xffff0000u) * rs * gp[2 * e + 1];
        w[e] = cvtpk(y1 * c - y2 * sn, y1 * sn + y2 * c); }
      qr[d0] = *reinterpret_cast<bf16x8*>(&w); }
  } else {
#pragma unroll
  for (int d0 = 0; d0 < QREG; ++d0) qr[d0] = ld8(Qw + d0 * 16);
  }
  if constexpr (QREG < ND0) {
#pragma unroll
    for (int d0 = QREG; d0 < ND0; ++d0) { bf16x8 qv = ld8(Qw + d0 * 16);
      if (DQK == 192 && d0 >= 8) {
        int hiq = hi; asm volatile("" : "+v"(hiq));
        const int sq = spos + wid * QBLK + r32; const float pos = (float)((d0 < 10) ? (sq >> 6) : (sq & 63));
        u32x4 w = *reinterpret_cast<u32x4*>(&qv);
#pragma unroll
        for (int e = 0; e < 4; ++e) { const int j = ((d0 - 8) & 1) * 8 + hiq * 4 + e; const float invf = __builtin_amdgcn_exp2f(-(float)j * (13.287712379549449f / 16.f));
          const float ang = pos * invf; double rev = (double)ang * 0.15915494309189535; rev -= __builtin_rint(rev); const float fr = (float)rev;
          const float c = __builtin_amdgcn_cosf(fr), sn = __builtin_amdgcn_sinf(fr);
          const float x1 = __uint_as_float(w[e] << 16), x2 = __uint_as_float(w[e] & 0xffff0000u); w[e] = cvtpk(x1 * c - x2 * sn, x1 * sn + x2 * c); }
        qv = *reinterpret_cast<bf16x8*>(&w); }
      *(bf16x8*)(qx + (d0 - QREG) * 1024) = qv; }
  }
  const lds_cptr vb0 = (lds_cptr)V_lds + v_rd_base(lane);
  constexpr int NB = (KROWB == 256 && ATT_KEYMASK128 == 15) ? 8 : 4; int kb[NB];
#pragma unroll
  for (int dl = 0; dl < NB; ++dl) kb[dl] = r32 * KROWB + ((dl * 32 + hi * 16) ^ (ATT_KEY(r32) << 4));
  constexpr int NKI = SHM_K / 8192, SPR = KROWB / 16;
  unsigned voV[2]; const char* kp[NKI]; unsigned kst[NKI];
#pragma unroll
  for (int i = 0; i < 2; ++i) { const int s = i * 512 + wid * 64 + lane; const int kk = (((s >> 7) & 7) << 3) | ((s >> 2) & 7);
    const int k = (kk & ~0xC) | ((kk & 4) << 1) | ((kk & 8) >> 1), c = ((s >> 5) & 3) * 32 + (s & 3) * 8; voV[i] = (unsigned)(k * LDV + c) * 2u; }
#pragma unroll
  for (int i = 0; i < NKI; ++i) { const int s = i * 512 + wid * 64 + lane; const int row = s / SPR, cs = (s % SPR) * 16, colB = cs ^ (ATT_KEY(row) << 4);
    if (DQK == 192 && colB >= 256) { kp[i] = (const char*)Kr + (size_t)row * 128 + (colB - 256); kst[i] = 64u * 128u; }
    else { kp[i] = (const char*)Kh + (size_t)row * (LDK * 2) + colB; kst[i] = 64u * (unsigned)(LDK * 2); } }
  lds_u32* const ldsV = (lds_u32*)((__attribute__((address_space(3))) char*)V_lds + wid * 1024);
  lds_u32* const ldsK = (lds_u32*)((__attribute__((address_space(3))) char*)K_lds + wid * 1024);
#define DMA_V(t_, b_) do { const char* vt_ = (const char*)Vh + (size_t)(t_) * (64u * LDV * 2u); _Pragma("unroll") for (int i = 0; i < 2; ++i) \
    __builtin_amdgcn_global_load_lds((const unsigned*)(vt_ + voV[i]), (lds_u32*)((__attribute__((address_space(3))) char*)ldsV + (b_) * SHM_V + i * 8192), 16, 0, 0); } while (0)
#define DMA_K(t_, b_) do { _Pragma("unroll") for (int i = 0; i < NKI; ++i) \
    __builtin_amdgcn_global_load_lds((const unsigned*)(kp[i] + (size_t)(t_) * kst[i]), (lds_u32*)((__attribute__((address_space(3))) char*)ldsK + (b_) * SHM_K + i * 8192), 16, 0, 0); } while (0)
#define VMW0() asm volatile("s_waitcnt vmcnt(0)" ::: "memory")
#define RESC_APPLY() do { l_reg *= alp; if (hi == 0) al_l[r32] = alp; asm volatile("s_waitcnt lgkmcnt(0)" ::: "memory"); \
    _Pragma("unroll") for (int d = 0; d < 4; ++d) _Pragma("unroll") for (int r = 0; r < 16; ++r) o[d][r] *= al_l[crow(r, hi)]; pend = false; } while (0)
#define RESCN(ps_) do { if (pend) { RESC_APPLY(); } else { const bool t_ = (ps_) > TRIG; const float d_ = t_ ? __builtin_amdgcn_logf(ps_) : 0.f; alp = __builtin_amdgcn_exp2f(-d_); m_ref += d_; pend = __any(t_); } \
    _Pragma("unroll") for (int r = 0; r < 16; ++r) negm[r] = -m_ref; } while (0)
  float alp = 1.f; bool pend = false;
  f32x16 pA0, pA1, pB0, pB1; float psA, psB; bf16x8 pa0, pa1, pa2, pa3; const int NT = seq / KVBLK;
#define SCHED_A() do { if constexpr (DQK == 128) sched_pipe<16, 1, ATT_NVA128, 1, ATT_PREA, ATT_LEAD128, ATT_NVL128>(); else sched_pipe<24 / ATT_MG192, ATT_MG192, ATT_NVA192 * ATT_MG192, ATT_DS192, ATT_PREA, ATT_LEAD192, ATT_NVL192>(); } while (0)
#define SCHED_B() sched_pipe<16, 1, ATT_NVB, 2, ATT_PREB>()
#define STEP(C0, C1, P0, P1, psP, t_, KB, VB, haveK) do { DMA_V(t_, VB); if (haveK) DMA_K((t_) + 1, 1 - (KB)); ATT_SBAR(); \
    qkt<DQK>(C0, C1, negm, K_lds + (KB) * SHM_K, kb, qr, qx, r32, hi); finishSM(P0, P1, psP, l_reg, pa0, pa1, pa2, pa3); SCHED_A(); ATT_SBAR(); \
    pv_d0(o, vb0 + (1 - (VB)) * SHM_V, pa0, pa1, pa2, pa3); partialSM(C0, C1); SCHED_B(); ATT_SBAR(); \
    RESCN(psP); VMW0(); __syncthreads(); } while (0)
  DMA_K(0, 0); VMW0(); __syncthreads();
  DMA_V(0, 0); DMA_K(1, 1);
  qkt<DQK>(pA0, pA1, negm, K_lds, kb, qr, qx, r32, hi); firstSM(pA0, pA1, m_ref, negm);
  VMW0(); __syncthreads();
  for (int t = 1; t + 2 < NT; t += 2) {
    STEP(pB0, pB1, pA0, pA1, psA, t, 1, 1, true);
    STEP(pA0, pA1, pB0, pB1, psB, t + 1, 0, 0, true);
  }
  STEP(pB0, pB1, pA0, pA1, psA, NT - 1, 1, 1, false);
  finishSM(pB0, pB1, psB, l_reg, pa0, pa1, pa2, pa3); ATT_SBAR();
  pv_d0(o, vb0 + SHM_V, pa0, pa1, pa2, pa3);
#undef STEP
#undef SCHED_A
#undef SCHED_B
  if (hi == 0) li_l[r32] = l_reg; asm volatile("s_waitcnt lgkmcnt(0)" ::: "memory");
  float rli[16];
#pragma unroll
  for (int r = 0; r < 16; ++r) rli[r] = __builtin_amdgcn_rcpf(li_l[crow(r, hi)]);
  { int r32e = r32, hie = hi; asm volatile("" : "+v"(r32e), "+v"(hie));
    char* Ow = (char*)(Ob + (long)(wid * QBLK) * LDO);
    const unsigned lo_ = (unsigned)((4 * hie) * LDO + r32e) * 2u;
#pragma unroll
    for (int r = 0; r < 16; ++r) {
#pragma unroll
      for (int d0 = 0; d0 < 4; ++d0) *(bf16*)(Ow + lo_ + (unsigned)((((r & 3) + 8 * (r >> 2)) * LDO + d0 * 32) * 2)) = (bf16)(cvtpk(o[d0][r] * rli[r], 0.f) & 0xffffu); } }
  asm volatile("s_waitcnt vmcnt(0) lgkmcnt(0)" ::: "memory"); __syncthreads();
#undef DMA_V
#undef DMA_K
#undef VMW0
#undef RESCN
#undef RESC_APPLY
}
template <int DQK, int LDQ, int LDK, int LDV, int LDO>
__device__ __forceinline__ void attn_unit_dmas(const bf16* __restrict__ Qb, const bf16* __restrict__ Kh, const bf16* __restrict__ Kr, const bf16* __restrict__ Vh,
                                              bf16* __restrict__ Ob, int seq, char* lds, int spos = 0) {
  constexpr int KROWB = Cfg<DQK>::KROWB, SHM_K = Cfg<DQK>::SHM_K, SHM_V = Cfg<DQK>::SHM_V, ND0 = Cfg<DQK>::ND0;
  typedef __attribute__((address_space(3))) unsigned lds_u32;
  const int tid = threadIdx.x, wid = __builtin_amdgcn_readfirstlane(tid >> 6), lane = tid & 63, r32 = lane & 31, hi = lane >> 5;
  char* V_lds = lds; char* K_lds = lds + 3 * SHM_V;
  float* ws = (float*)(lds + 3 * SHM_V + 2 * SHM_K) + wid * 64; float* li_l = ws; float* al_l = ws + 32;
  float m_ref = 0.f, l_reg = 0; f32x16 o[4] = {}; f32x16 negm = {}; constexpr int QREG = Cfg<DQK>::QREG; bf16x8 qr[QREG];
  const bf16* Qw = Qb + (long)(wid * QBLK + r32) * LDQ + hi * 8;
  char* qx = lds + 3 * SHM_V + 2 * SHM_K + NW * 64 * 4 + wid * Cfg<DQK>::QXW + lane * 16;
#pragma unroll
  for (int d0 = 0; d0 < QREG; ++d0) qr[d0] = ld8(Qw + d0 * 16);
  if constexpr (QREG < ND0) {
#pragma unroll
    for (int d0 = QREG; d0 < ND0; ++d0) { bf16x8 qv = ld8(Qw + d0 * 16);
      if (DQK == 192 && d0 >= 8) {
        int hiq = hi; asm volatile("" : "+v"(hiq));
        const int sq = spos + wid * QBLK + r32; const float pos = (float)((d0 < 10) ? (sq >> 6) : (sq & 63));
        u32x4 w = *reinterpret_cast<u32x4*>(&qv);
#pragma unroll
        for (int e = 0; e < 4; ++e) { const int j = ((d0 - 8) & 1) * 8 + hiq * 4 + e; const float invf = __builtin_amdgcn_exp2f(-(float)j * (13.287712379549449f / 16.f));
          const float ang = pos * invf; double rev = (double)ang * 0.15915494309189535; rev -= __builtin_rint(rev); const float fr = (float)rev;
          const float c = __builtin_amdgcn_cosf(fr), sn = __builtin_amdgcn_sinf(fr);
          const float x1 = __uint_as_float(w[e] << 16), x2 = __uint_as_float(w[e] & 0xffff0000u); w[e] = cvtpk(x1 * c - x2 * sn, x1 * sn + x2 * c); }
        qv = *reinterpret_cast<bf16x8*>(&w); }
      *(bf16x8*)(qx + (d0 - QREG) * 1024) = qv; }
  }
  const lds_cptr vb0 = (lds_cptr)V_lds + v_rd_base(lane);
  constexpr int NB = (KROWB == 256 && ATT_KEYMASK128 == 15) ? 8 : 4; int kb[NB];
#pragma unroll
  for (int dl = 0; dl < NB; ++dl) kb[dl] = r32 * KROWB + ((dl * 32 + hi * 16) ^ (ATT_KEY(r32) << 4));
  constexpr int NKI = SHM_K / 8192, SPR = KROWB / 16;
  unsigned voV[2]; const char* kp[NKI]; unsigned kst[NKI];
#pragma unroll
  for (int i = 0; i < 2; ++i) { const int s = i * 512 + wid * 64 + lane; const int kk = (((s >> 7) & 7) << 3) | ((s >> 2) & 7);
    const int k = (kk & ~0xC) | ((kk & 4) << 1) | ((kk & 8) >> 1), c = ((s >> 5) & 3) * 32 + (s & 3) * 8; voV[i] = (unsigned)(k * LDV + c) * 2u; }
#pragma unroll
  for (int i = 0; i < NKI; ++i) { const int s = i * 512 + wid * 64 + lane; const int row = s / SPR, cs = (s % SPR) * 16, colB = cs ^ (ATT_KEY(row) << 4);
    if (DQK == 192 && colB >= 256) { kp[i] = (const char*)Kr + (size_t)row * 128 + (colB - 256); kst[i] = 64u * 128u; }
    else { kp[i] = (const char*)Kh + (size_t)row * (LDK * 2) + colB; kst[i] = 64u * (unsigned)(LDK * 2); } }
  lds_u32* const ldsV = (lds_u32*)((__attribute__((address_space(3))) char*)V_lds + wid * 1024);
  lds_u32* const ldsK = (lds_u32*)((__attribute__((address_space(3))) char*)K_lds + wid * 1024);
#define DMA_V(t_, b_) do { const char* vt_ = (const char*)Vh + (size_t)(t_) * (64u * LDV * 2u); _Pragma("unroll") for (int i = 0; i < 2; ++i) \
    __builtin_amdgcn_global_load_lds((const unsigned*)(vt_ + voV[i]), (lds_u32*)((__attribute__((address_space(3))) char*)ldsV + (b_) + i * 8192), 16, 0, 0); } while (0)
#define DMA_K(t_, b_) do { _Pragma("unroll") for (int i = 0; i < NKI; ++i) \
    __builtin_amdgcn_global_load_lds((const unsigned*)(kp[i] + (size_t)(t_) * kst[i]), (lds_u32*)((__attribute__((address_space(3))) char*)ldsK + (b_) * SHM_K + i * 8192), 16, 0, 0); } while (0)
#define VMW0() asm volatile("s_waitcnt vmcnt(0)" ::: "memory")
#define RESC_APPLY() do { l_reg *= alp; if (hi == 0) al_l[r32] = alp; asm volatile("s_waitcnt lgkmcnt(0)" ::: "memory"); \
    _Pragma("unroll") for (int d = 0; d < 4; ++d) _Pragma("unroll") for (int r = 0; r < 16; ++r) o[d][r] *= al_l[crow(r, hi)]; pend = false; } while (0)
#define RESCN(ps_) do { if (pend) { RESC_APPLY(); } else { const bool t_ = (ps_) > TRIG; const float d_ = t_ ? __builtin_amdgcn_logf(ps_) : 0.f; alp = __builtin_amdgcn_exp2f(-d_); m_ref += d_; pend = __any(t_); } \
    _Pragma("unroll") for (int r = 0; r < 16; ++r) negm[r] = -m_ref; } while (0)
  float alp = 1.f; bool pend = false;
  f32x16 pA0, pA1, pB0, pB1; float psA, psB; bf16x8 pa0, pa1, pa2, pa3; const int NT = seq / KVBLK;
#define SCHED_A() do { if constexpr (DQK == 128) sched_pipe<16, 1, ATT_NVA128, 1, ATT_PREA>(); else sched_pipe<24 / ATT_MG192, ATT_MG192, ATT_NVA192 * ATT_MG192, ATT_DS192, ATT_PREA>(); } while (0)
#define SCHED_B() sched_pipe<16, 1, ATT_NVB, 2, ATT_PREB>()
#define NEXTV(v_) (((v_) == 2 * SHM_V) ? 0 : (v_) + SHM_V)
#define STEPS(C0, C1, P0, P1, psP, psPrev, t_, KB, vo_t, vo_tm1, vo_tm2, haveK, havePV) do { DMA_V(t_, vo_t); if (haveK) DMA_K((t_) + 1, 1 - (KB)); ATT_SBAR(); \
    if (isY) { if (havePV) { pv_d0(o, vb0 + (vo_tm2), pa0, pa1, pa2, pa3); } partialSM(P0, P1); SCHED_B(); ATT_SBAR(); RESCN(psPrev); } \
    else { qkt<DQK>(C0, C1, negm, K_lds + (KB) * SHM_K, kb, qr, qx, r32, hi); finishSM(P0, P1, psP, l_reg, pa0, pa1, pa2, pa3); SCHED_A(); } \
    ATT_SBAR(); \
    if (isY) { qkt<DQK>(C0, C1, negm, K_lds + (KB) * SHM_K, kb, qr, qx, r32, hi); finishSM(P0, P1, psP, l_reg, pa0, pa1, pa2, pa3); SCHED_A(); } \
    else { pv_d0(o, vb0 + (vo_tm1), pa0, pa1, pa2, pa3); partialSM(C0, C1); SCHED_B(); ATT_SBAR(); RESCN(psP); } \
    ATT_SBAR(); VMW0(); __syncthreads(); } while (0)
  const bool isY = wid >= 4;
  DMA_K(0, 0); VMW0(); __syncthreads();
  DMA_V(0, 0); DMA_K(1, 1);
  qkt<DQK>(pA0, pA1, negm, K_lds, kb, qr, qx, r32, hi); firstSM0(pA0, pA1, m_ref, negm);
  if (!isY) partialSM(pA0, pA1);
  VMW0(); __syncthreads();
  psA = 0.f; psB = 0.f;
  int v2 = 0, v1 = 0, v0 = SHM_V;
  STEPS(pB0, pB1, pA0, pA1, psA, psB, 1, 1, v0, v1, v2, true, false); v2 = v1; v1 = v0; v0 = NEXTV(v0);
  for (int t = 2; t + 1 < NT; t += 2) {
    STEPS(pA0, pA1, pB0, pB1, psB, psA, t, 0, v0, v1, v2, true, true); v2 = v1; v1 = v0; v0 = NEXTV(v0);
    STEPS(pB0, pB1, pA0, pA1, psA, psB, t + 1, 1, v0, v1, v2, (t + 2 < NT), true); v2 = v1; v1 = v0; v0 = NEXTV(v0);
  }
  if (isY) { pv_d0(o, vb0 + v2, pa0, pa1, pa2, pa3); partialSM(pB0, pB1); ATT_SBAR(); if (pend) { RESC_APPLY(); } }
  finishSM(pB0, pB1, psB, l_reg, pa0, pa1, pa2, pa3); ATT_SBAR();
  pv_d0(o, vb0 + v1, pa0, pa1, pa2, pa3);
#undef STEPS
#undef NEXTV
#undef SCHED_A
#undef SCHED_B
  if (hi == 0) li_l[r32] = l_reg; asm volatile("s_waitcnt lgkmcnt(0)" ::: "memory");
  float rli[16];
#pragma unroll
  for (int r = 0; r < 16; ++r) rli[r] = __builtin_amdgcn_rcpf(li_l[crow(r, hi)]);
  { int r32e = r32, hie = hi; asm volatile("" : "+v"(r32e), "+v"(hie));
    char* Ow = (char*)(Ob + (long)(wid * QBLK) * LDO);
    const unsigned lo_ = (unsigned)((4 * hie) * LDO + r32e) * 2u;
#pragma unroll
    for (int r = 0; r < 16; ++r) {
#pragma unroll
      for (int d0 = 0; d0 < 4; ++d0) *(bf16*)(Ow + lo_ + (unsigned)((((r & 3) + 8 * (r >> 2)) * LDO + d0 * 32) * 2)) = (bf16)(cvtpk(o[d0][r] * rli[r], 0.f) & 0xffffu); } }
  asm volatile("s_waitcnt vmcnt(0) lgkmcnt(0)" ::: "memory"); __syncthreads();
#undef DMA_V
#undef DMA_K
#undef VMW0
#undef RESCN
#undef RESC_APPLY
}
#undef ATT_KSWZ
#undef ATT_KEY
#undef ATT_PK
#undef ATT_SBAR
}
#define LAS __attribute__((address_space(3)))
typedef unsigned short u16;
typedef float f32x4 __attribute__((ext_vector_type(4)));
typedef short bf16x8 __attribute__((ext_vector_type(8)));
typedef unsigned u32x4 __attribute__((ext_vector_type(4)));
typedef unsigned u32x2 __attribute__((ext_vector_type(2)));
constexpr int DM = 2048, BATCH = 2, SEQ = 16384, T = BATCH * SEQ;
constexpr int IN0 = 4608, NLAT = 1088, NLATP = 1280, NQ = 3072, NKV = 4096, DFF = 8192;
constexpr float EPS = 1e-6f;
constexpr int NWAVES = 8, NTHREADS = 512;
constexpr int LDS_BYTES = 155648;
constexpr float LOG2_THETA = 13.287712379549449f;

constexpr size_t MiB = 1u << 20;
constexpr size_t WS_WIN = 0, WS_WOUT = 18 * MiB, WS_WDOWN = 26 * MiB, WS_WUQ = 31 * MiB, WS_WUKV = 34 * MiB, WS_WO = 38 * MiB;
constexpr size_t WS_WUP = 46 * MiB  , WS_WDN = 110 * MiB  ;
constexpr size_t WS_XN = 176 * MiB;
constexpr size_t WS_HB = 304 * MiB;
constexpr size_t WS_BIG = 432 * MiB;
constexpr size_t WS_PROJ = WS_BIG, WS_MIX = WS_BIG + 288 * MiB;
constexpr size_t WS_HID = WS_BIG;
constexpr size_t WS_Q = WS_BIG, WS_KV = WS_BIG + 192 * MiB, WS_LAT = WS_BIG + 448 * MiB, WS_KROPE = WS_BIG + 528 * MiB;
constexpr size_t WS_CQN = WS_LAT, WS_CKVN = WS_LAT;
constexpr size_t WS_AO = WS_XN;
constexpr size_t WS_CTL = WS_BIG + 532 * MiB, CTL_BAR = 65536, WS_SS = WS_CTL + CTL_BAR, CTL_BYTES = CTL_BAR + 5 * 131072;
constexpr size_t WS_END = WS_CTL + CTL_BYTES;

__device__ __forceinline__ float bflo(unsigned u) { return __uint_as_float(u << 16); }
__device__ __forceinline__ float bfhi(unsigned u) { return __uint_as_float(u & 0xffff0000u); }
__device__ __forceinline__ unsigned pk2(float lo, float hi) { unsigned r; asm volatile("v_cvt_pk_bf16_f32 %0, %1, %2" : "=v"(r) : "v"(lo), "v"(hi)); return r; }
__device__ __forceinline__ float wave_sum(float v) {
#pragma unroll
    for (int o = 1; o < 64; o <<= 1) v += __shfl_xor(v, o);
    return v;
}
__device__ __forceinline__ void rope_cs(float pos, float invf, float& c, float& s) {
    const float a = pos * invf;
    double rev = (double)a * 0.15915494309189535;
    rev -= __builtin_rint(rev);
    const float fr = (float)rev;
    c = __builtin_amdgcn_cosf(fr); s = __builtin_amdgcn_sinf(fr);
}

__device__ __forceinline__ void transpose_item(const float* __restrict__ W, const float* __restrict__ gain, float mul, int K, int N, u16* __restrict__ WT, LAS float* scr, int item, int lane) {
    const int nblk = N / 32, kb = item / nblk, nb = item % nblk, k0 = 64 * kb, n0 = 32 * nb;
    float wv[32];
#pragma unroll
    for (int i = 0; i < 32; ++i) { const int kk = 2 * i + (lane >> 5); wv[i] = W[(size_t)(k0 + kk) * N + n0 + (lane & 31)]; }
    float gv = 1.f; if (gain) gv = gain[k0 + lane] * mul;
#pragma unroll
    for (int i = 0; i < 32; ++i) { const int kk = 2 * i + (lane >> 5); const float g = __shfl(gv, kk); scr[kk * 33 + (lane & 31)] = wv[i] * g; }
    asm volatile("s_waitcnt lgkmcnt(0)" ::: "memory");
    const int c = lane & 7;
#pragma unroll
    for (int j = 0; j < 4; ++j) { const int n = (lane >> 3) + 8 * j; const LAS float* s = scr + (8 * c) * 33 + n;
        u32x4 o; o.x = pk2(s[0 * 33], s[1 * 33]); o.y = pk2(s[2 * 33], s[3 * 33]); o.z = pk2(s[4 * 33], s[5 * 33]); o.w = pk2(s[6 * 33], s[7 * 33]);
        *(u32x4*)(WT + (size_t)(n0 + n) * K + k0 + 8 * c) = o; }
    asm volatile("s_waitcnt lgkmcnt(0)" ::: "memory");
}

__device__ __forceinline__ void norm_row_bf16(const float* __restrict__ xrow, u16* __restrict__ orow, int lane) {
    const f32x4* xr = (const f32x4*)xrow + lane;
    f32x4 v[8]; float s = 0.f;
#pragma unroll
    for (int j = 0; j < 8; ++j) { v[j] = xr[64 * j]; s += (v[j].x * v[j].x + v[j].y * v[j].y) + (v[j].z * v[j].z + v[j].w * v[j].w); }
    const float r = 1.0f / sqrtf(wave_sum(s) * (1.f / DM) + EPS);
    u32x2* o8 = (u32x2*)orow + lane;
#pragma unroll
    for (int j = 0; j < 8; ++j) { u32x2 w; w.x = pk2(v[j].x * r, v[j].y * r); w.y = pk2(v[j].z * r, v[j].w * r); o8[64 * j] = w; }
}
__device__ __forceinline__ void norm_row_b2b(const u16* __restrict__ hrow, u16* __restrict__ orow, int lane) {
    const u32x4* xr = (const u32x4*)hrow + lane;
    u32x4 w[4]; float s = 0.f;
#pragma unroll
    for (int j = 0; j < 4; ++j) { w[j] = xr[64 * j];
#pragma unroll
        for (int e = 0; e < 4; ++e) { const float a = bflo(w[j][e]), b = bfhi(w[j][e]); s += a * a + b * b; } }
    const float r = 1.0f / sqrtf(wave_sum(s) * (1.f / DM) + EPS);
    u32x4* o = (u32x4*)orow + lane;
#pragma unroll
    for (int j = 0; j < 4; ++j) { u32x4 v;
#pragma unroll
        for (int e = 0; e < 4; ++e) v[e] = pk2(bflo(w[j][e]) * r, bfhi(w[j][e]) * r);
        o[64 * j] = v; }
}
__device__ __forceinline__ void norm_row_final(const u16* __restrict__ hrow, float* __restrict__ orow, const float* __restrict__ g, int lane) {
    const u32x4* xr = (const u32x4*)hrow + lane;
    u32x4 w[4]; float s = 0.f;
#pragma unroll
    for (int j = 0; j < 4; ++j) { w[j] = xr[64 * j];
#pragma unroll
        for (int e = 0; e < 4; ++e) { const float a = bflo(w[j][e]), b = bfhi(w[j][e]); s += a * a + b * b; } }
    const float r = 1.0f / sqrtf(wave_sum(s) * (1.f / DM) + EPS);
#pragma unroll
    for (int j = 0; j < 4; ++j) { const int c = (64 * j + lane) * 8; const f32x4 g0 = *(const f32x4*)(g + c), g1 = *(const f32x4*)(g + c + 4);
        f32x4 o0 = {bflo(w[j][0]) * r * g0[0], bfhi(w[j][0]) * r * g0[1], bflo(w[j][1]) * r * g0[2], bfhi(w[j][1]) * r * g0[3]};
        f32x4 o1 = {bflo(w[j][2]) * r * g1[0], bfhi(w[j][2]) * r * g1[1], bflo(w[j][3]) * r * g1[2], bfhi(w[j][3]) * r * g1[3]};
        *(f32x4*)(orow + c) = o0; *(f32x4*)(orow + c + 4) = o1; }
}

__device__ __forceinline__ void ld8f(const u16* p, float* f) {
    const u32x4 w = *(const u32x4*)p;
    f[0] = bflo(w.x); f[1] = bfhi(w.x); f[2] = bflo(w.y); f[3] = bfhi(w.y); f[4] = bflo(w.z); f[5] = bfhi(w.z); f[6] = bflo(w.w); f[7] = bfhi(w.w);
}

__device__ __forceinline__ void ew0_token(int t, u16* __restrict__ PROJ, u16* __restrict__ MIX, const float* __restrict__ qg, const float* __restrict__ kg, const float* __restrict__ cw, int lane) {
    const int s = t & (SEQ - 1), row = s >> 6, col = s & 63;
    float c, sn; { const int j = lane & 31; const float invf = __builtin_amdgcn_exp2f(-(float)j * (LOG2_THETA / 32.f)); rope_cs((float)(lane < 32 ? row : col), invf, c, sn); }
    unsigned* pr = (unsigned*)(PROJ + (size_t)t * IN0);
    const float qg0 = qg[2 * lane], qg1 = qg[2 * lane + 1], kg0 = kg[2 * lane], kg1 = kg[2 * lane + 1];
#pragma unroll
    for (int h = 0; h < 10; ++h) {
        const unsigned u = pr[h * 64 + lane]; const float x1 = bflo(u), x2 = bfhi(u);
        const float ss = wave_sum(x1 * x1 + x2 * x2); const float r = 1.0f / sqrtf(ss * (1.f / 128.f) + EPS);
        const float y1 = x1 * r * (h < 8 ? qg0 * att::Cfg<128>::C : kg0), y2 = x2 * r * (h < 8 ? qg1 * att::Cfg<128>::C : kg1);
        pr[h * 64 + lane] = pk2(y1 * c - y2 * sn, y1 * sn + y2 * c);
    }
    const u16* p0 = PROJ + (size_t)t * IN0;
#pragma unroll
    for (int ch = 0; ch < 2; ++ch) {
        const int cc = ch * 512 + lane * 8;
        float gb[8], g0[8], u0[8], gm[8], um[8], gp[8], up[8];
        ld8f(p0 + 1536 + cc, gb); ld8f(p0 + 2560 + cc, g0); ld8f(p0 + 3584 + cc, u0);
        if (s > 0) { ld8f(p0 - IN0 + 2560 + cc, gm); ld8f(p0 - IN0 + 3584 + cc, um); } else {
#pragma unroll
            for (int e = 0; e < 8; ++e) { gm[e] = 0.f; um[e] = 0.f; } }
        if (s < SEQ - 1) { ld8f(p0 + IN0 + 2560 + cc, gp); ld8f(p0 + IN0 + 3584 + cc, up); } else {
#pragma unroll
            for (int e = 0; e < 8; ++e) { gp[e] = 0.f; up[e] = 0.f; } }
        float o[8];
#pragma unroll
        for (int e = 0; e < 8; ++e) o[e] = gb[e] * (cw[cc + e] * (gm[e] * um[e]) + cw[1024 + cc + e] * (g0[e] * u0[e]) + cw[2048 + cc + e] * (gp[e] * up[e]));
        u32x4 w; w.x = pk2(o[0], o[1]); w.y = pk2(o[2], o[3]); w.z = pk2(o[4], o[5]); w.w = pk2(o[6], o[7]);
        *(u32x4*)(MIX + (size_t)t * DM + 1024 + cc) = w;
    }
}
__device__ __forceinline__ void cv8f(const u32x4 w, float* f) {
    f[0] = bflo(w.x); f[1] = bfhi(w.x); f[2] = bflo(w.y); f[3] = bfhi(w.y); f[4] = bflo(w.z); f[5] = bfhi(w.z); f[6] = bflo(w.w); f[7] = bfhi(w.w);
}
__device__ __forceinline__ void ew0_pair(int t, u16* __restrict__ PROJ, u16* __restrict__ MIX, const float* __restrict__ qg, const float* __restrict__ kg, const float* __restrict__ cw, int lane) {
    const int s = t & (SEQ - 1), row = s >> 6, col = s & 63;
    unsigned* pr0 = (unsigned*)(PROJ + (size_t)t * IN0); unsigned* pr1 = pr0 + IN0 / 2;
    const u16* p0 = PROJ + (size_t)t * IN0;
    unsigned ua[10], ub[10];
#pragma unroll
    for (int h = 8; h < 10; ++h) { ua[h] = pr0[h * 64 + lane]; ub[h] = pr1[h * 64 + lane]; }
    u32x4 rgb[2][2], rg[2][4], ru[2][4];
    const bool hasm = s > 0, hasp = s + 1 < SEQ - 1; const u32x4 z4 = {0u, 0u, 0u, 0u};
#pragma unroll
    for (int ch = 0; ch < 2; ++ch) { const int cc = ch * 512 + lane * 8;
        rgb[ch][0] = *(const u32x4*)(p0 + 1536 + cc); rgb[ch][1] = *(const u32x4*)(p0 + IN0 + 1536 + cc);
        rg[ch][1] = *(const u32x4*)(p0 + 2560 + cc); ru[ch][1] = *(const u32x4*)(p0 + 3584 + cc);
        rg[ch][2] = *(const u32x4*)(p0 + IN0 + 2560 + cc); ru[ch][2] = *(const u32x4*)(p0 + IN0 + 3584 + cc);
        rg[ch][0] = hasm ? *(const u32x4*)(p0 - IN0 + 2560 + cc) : z4; ru[ch][0] = hasm ? *(const u32x4*)(p0 - IN0 + 3584 + cc) : z4;
        rg[ch][3] = hasp ? *(const u32x4*)(p0 + 2 * IN0 + 2560 + cc) : z4; ru[ch][3] = hasp ? *(const u32x4*)(p0 + 2 * IN0 + 3584 + cc) : z4; }
    float c0, s0, c1, s1; { const int j = lane & 31; const float invf = __builtin_amdgcn_exp2f(-(float)j * (LOG2_THETA / 32.f));
        rope_cs((float)(lane < 32 ? row : col), invf, c0, s0); rope_cs((float)(lane < 32 ? row : col + 1), invf, c1, s1); }
    const float qg0 = qg[2 * lane] * att::Cfg<128>::C, qg1 = qg[2 * lane + 1] * att::Cfg<128>::C, kg0 = kg[2 * lane], kg1 = kg[2 * lane + 1];
#pragma unroll
    for (int h = 8; h < 10; ++h) {
        const float a1 = bflo(ua[h]), a2 = bfhi(ua[h]), b1 = bflo(ub[h]), b2 = bfhi(ub[h]);
        const float ra = 1.0f / sqrtf(wave_sum(a1 * a1 + a2 * a2) * (1.f / 128.f) + EPS), rb = 1.0f / sqrtf(wave_sum(b1 * b1 + b2 * b2) * (1.f / 128.f) + EPS);
        const float g0 = (h < 8 ? qg0 : kg0), g1 = (h < 8 ? qg1 : kg1);
        const float ya1 = a1 * ra * g0, ya2 = a2 * ra * g1, yb1 = b1 * rb * g0, yb2 = b2 * rb * g1;
        pr0[h * 64 + lane] = pk2(ya1 * c0 - ya2 * s0, ya1 * s0 + ya2 * c0);
        pr1[h * 64 + lane] = pk2(yb1 * c1 - yb2 * s1, yb1 * s1 + yb2 * c1);
    }
#pragma unroll
    for (int ch = 0; ch < 2; ++ch) {
        const int cc = ch * 512 + lane * 8;
        float gbA[8], gbB[8], gm[8], um[8], g0[8], u0[8], g1[8], u1[8], g2[8], u2[8];
        cv8f(rgb[ch][0], gbA); cv8f(rgb[ch][1], gbB); cv8f(rg[ch][0], gm); cv8f(ru[ch][0], um); cv8f(rg[ch][1], g0); cv8f(ru[ch][1], u0);
        cv8f(rg[ch][2], g1); cv8f(ru[ch][2], u1); cv8f(rg[ch][3], g2); cv8f(ru[ch][3], u2);
        float oa[8], ob[8];
#pragma unroll
        for (int e = 0; e < 8; ++e) { const float w0 = cw[cc + e], w1 = cw[1024 + cc + e], w2 = cw[2048 + cc + e];
            const float xm = gm[e] * um[e], x0 = g0[e] * u0[e], x1 = g1[e] * u1[e], x2 = g2[e] * u2[e];
            oa[e] = gbA[e] * (w0 * xm + w1 * x0 + w2 * x1); ob[e] = gbB[e] * (w0 * x0 + w1 * x1 + w2 * x2); }
        u32x4 wa; wa.x = pk2(oa[0], oa[1]); wa.y = pk2(oa[2], oa[3]); wa.z = pk2(oa[4], oa[5]); wa.w = pk2(oa[6], oa[7]);
        u32x4 wb; wb.x = pk2(ob[0], ob[1]); wb.y = pk2(ob[2], ob[3]); wb.z = pk2(ob[4], ob[5]); wb.w = pk2(ob[6], ob[7]);
        *(u32x4*)(MIX + (size_t)t * DM + 1024 + cc) = wa; *(u32x4*)(MIX + (size_t)(t + 1) * DM + 1024 + cc) = wb;
    }
}
__device__ __forceinline__ void ew1_token(int t, const u16* __restrict__ LAT, u16* __restrict__ CQN, u16* __restrict__ CKVN, u16* __restrict__ KROPE, int lane) {
    const u16* p0 = LAT + (size_t)t * NLATP;
#pragma unroll
    for (int part = 0; part < 2; ++part) {
        float x[8]; ld8f(p0 + part * 512 + lane * 8, x);
        float ss = 0.f;
#pragma unroll
        for (int e = 0; e < 8; ++e) ss += x[e] * x[e];
        const float r = 1.0f / sqrtf(wave_sum(ss) * (1.f / 512.f) + EPS);
        u32x4 w; w.x = pk2(x[0] * r, x[1] * r); w.y = pk2(x[2] * r, x[3] * r); w.z = pk2(x[4] * r, x[5] * r); w.w = pk2(x[6] * r, x[7] * r);
        *(u32x4*)((part ? CKVN : CQN) + (size_t)t * 512 + lane * 8) = w;
    }
    if (lane < 32) {
        const int s = t & (SEQ - 1), row = s >> 6, col = s & 63; const int j = lane & 15;
        const float invf = __builtin_amdgcn_exp2f(-(float)j * (LOG2_THETA / 16.f)); float c, sn; rope_cs((float)(lane < 16 ? row : col), invf, c, sn);
        const unsigned u = *(const unsigned*)(p0 + 1024 + 2 * lane); const float x1 = bflo(u), x2 = bfhi(u);
        *(unsigned*)(KROPE + (size_t)t * 64 + 2 * lane) = pk2(x1 * c - x2 * sn, x1 * sn + x2 * c);
    }
}
__device__ __forceinline__ void ew2_token(int t, u16* __restrict__ Q, int lane) {
    const int s = t & (SEQ - 1), row = s >> 6, col = s & 63;
    const int h = lane >> 2, part = lane & 3; const float pos = (float)(part < 2 ? row : col);
    u16* p = Q + (size_t)t * NQ + h * 192 + 128 + part * 16;
    float x[16]; ld8f(p, x); ld8f(p + 8, x + 8);
    unsigned w[8];
#pragma unroll
    for (int i = 0; i < 8; ++i) { const int j = (part & 1) * 8 + i; const float invf = __builtin_amdgcn_exp2f(-(float)j * (LOG2_THETA / 16.f)); float c, sn; rope_cs(pos, invf, c, sn);
        w[i] = pk2(x[2 * i] * c - x[2 * i + 1] * sn, x[2 * i] * sn + x[2 * i + 1] * c); }
    *(u32x4*)p = (u32x4){w[0], w[1], w[2], w[3]}; *(u32x4*)(p + 8) = (u32x4){w[4], w[5], w[6], w[7]};
}

#define RLX_AGENT __ATOMIC_RELAXED, __HIP_MEMORY_SCOPE_AGENT
#define XB_TMO      128
#define XB_XCNT(j)  (256  + 64 * (j))
#define XB_XSUB(j)  (1280 + 64 * (j))
#define XB_XGEN(j)  (2304 + 64 * (j))
#define XB_TOP      3328
#define XB_TOPGEN   3392
#define XCD_BAR_WORDS 3456
#define XB_SPIN_CAP (1u << 22)

__device__ __forceinline__ unsigned xb_ld(unsigned* p)              { return __hip_atomic_load(p, __ATOMIC_RELAXED, __HIP_MEMORY_SCOPE_AGENT); }
__device__ __forceinline__ unsigned xb_add(unsigned* p, unsigned v) { return __hip_atomic_fetch_add(p, v, __ATOMIC_RELAXED, __HIP_MEMORY_SCOPE_AGENT); }
__device__ __forceinline__ unsigned xb_xcc_id() { return (unsigned)__builtin_amdgcn_s_getreg((3 << 11) | 20) & 0xFu; }
#define XB_SPIN(cond, bar) do { unsigned _sp = 0; while (cond) { __builtin_amdgcn_s_sleep(1); \
    if ((++_sp & 255u) == 0u) { if (xb_ld(&(bar)[XB_TMO])) break; if (_sp > XB_SPIN_CAP) { atomicAdd(&(bar)[XB_TMO], 1u); break; } } } } while (0)

struct XcdBarrier {
    unsigned* bar; unsigned x;
    volatile LAS unsigned* st;
};

__device__ __forceinline__ XcdBarrier xcd_barrier_post(unsigned* bar, volatile LAS unsigned* st) {
    XcdBarrier b; b.bar = bar; b.x = xb_xcc_id(); b.st = st;
    if (threadIdx.x == 0) (void)xb_add(&bar[XB_XCNT(b.x)], 1u);
    return b;
}
__device__ __forceinline__ void xcd_barrier_complete(unsigned* bar, unsigned x, unsigned& nloc, unsigned& nx) {
    const unsigned G = gridDim.x * gridDim.y * gridDim.z;
    unsigned sum, cnt, mine, sp = 0u;
    for (;;) {
        sum = 0u; cnt = 0u; mine = 0u;
#pragma unroll
        for (unsigned j = 0; j < 16; ++j) { const unsigned c = xb_ld(&bar[XB_XCNT(j)]); sum += c; cnt += (c > 0u) ? 1u : 0u; mine = (j == x) ? c : mine; }
        if (sum == G) break;
        __builtin_amdgcn_s_sleep(1);
        if ((++sp & 255u) == 0u) { if (xb_ld(&bar[XB_TMO])) break; if (sp > XB_SPIN_CAP) { atomicAdd(&bar[XB_TMO], 1u); break; } }
    }
    nloc = mine > 0u ? mine : 1u; nx = cnt > 0u ? cnt : 1u;
}

__device__ __forceinline__ void xcd_barrier(const XcdBarrier& b) {
    asm volatile("s_waitcnt vmcnt(0)" ::: "memory");
    __syncthreads();
    if (threadIdx.x == 0) {
        unsigned* bar = b.bar;
        __builtin_amdgcn_s_waitcnt(0);
        unsigned nloc = b.st[0], nx = b.st[1];
        if (nloc == 0u) { xcd_barrier_complete(bar, b.x, nloc, nx); b.st[0] = nloc; b.st[1] = nx; }
        const unsigned old = xb_add(&bar[XB_XSUB(b.x)], 1u);
        const unsigned gen = old / nloc;
        if (old + 1u == (gen + 1u) * nloc) {
            __builtin_amdgcn_fence(__ATOMIC_RELEASE, "agent");
            asm volatile("s_waitcnt vmcnt(0)" ::: "memory");
            const unsigned og = xb_add(&bar[XB_TOP], 1u);
            const unsigned tg = og / nx;
            if (og + 1u == (tg + 1u) * nx) xb_add(&bar[XB_TOPGEN], 1u);
            else XB_SPIN(xb_ld(&bar[XB_TOPGEN]) == tg, bar);
            __builtin_amdgcn_fence(__ATOMIC_ACQUIRE, "agent");
            xb_add(&bar[XB_XGEN(b.x)], 1u);
            asm volatile("s_waitcnt vmcnt(0)" ::: "memory");
        } else {
            XB_SPIN(xb_ld(&bar[XB_XGEN(b.x)]) == gen, bar);
            __builtin_amdgcn_fence(__ATOMIC_ACQUIRE, "agent");
            asm volatile("s_waitcnt vmcnt(0)" ::: "memory");
        }
    }
    __syncthreads();
}

struct Params { const float* in[18]; float* out; unsigned char* ws; int ph_lo, ph_hi; };
enum { I_X = 0, I_ENG, I_EWIN, I_EQG, I_EKG, I_ECW, I_EWOUT, I_ONG, I_OWDOWN, I_OQG, I_OKVG, I_OWUQ, I_OWUKV, I_OWO, I_MNG, I_MWUP, I_MWDN, I_FNG };
constexpr int NPHASE = 19;

template <int DQK> __device__ __forceinline__ bool attn_next(int i, int NU, int& unit) {
    const int G = gridDim.x, bx = blockIdx.x;
    if ((G & 7) == 0 && (NU & 7) == 0) { const int x = bx & 7, j = bx >> 3, per = G >> 3, upx = NU >> 3; const int k = i * per + j; if (k >= upx) return false; unit = x * upx + k; return true; }
    const int k = i * G + bx; if (k >= NU) return false; unit = k; return true;
}

__global__ void __launch_bounds__(NTHREADS, 2) fwd_mega(Params P) {
    extern __shared__ __attribute__((aligned(16))) unsigned char lds[];
    cg::grid_group grid = cg::this_grid();
    const int tid = threadIdx.x, lane = tid & 63, wave = __builtin_amdgcn_readfirstlane(tid >> 6);
    const int G = gridDim.x, gw = blockIdx.x * NWAVES + wave, NGW = G * NWAVES;
    unsigned char* ws = P.ws;
    u16* Win = (u16*)(ws + WS_WIN); u16* Wout = (u16*)(ws + WS_WOUT); u16* Wdown = (u16*)(ws + WS_WDOWN); u16* Wuq = (u16*)(ws + WS_WUQ); u16* Wukv = (u16*)(ws + WS_WUKV); u16* Wo = (u16*)(ws + WS_WO);
    u16* Wup = (u16*)(ws + WS_WUP); u16* Wdn = (u16*)(ws + WS_WDN);
    u16* XN = (u16*)(ws + WS_XN); u16* PROJ = (u16*)(ws + WS_PROJ); u16* MIX = (u16*)(ws + WS_MIX); u16* HID = (u16*)(ws + WS_HID);
    u16* LAT = (u16*)(ws + WS_LAT); u16* CQN = (u16*)(ws + WS_CQN); u16* CKVN = (u16*)(ws + WS_CKVN); u16* KROPE = (u16*)(ws + WS_KROPE);
    u16* Qm = (u16*)(ws + WS_Q); u16* KVm = (u16*)(ws + WS_KV); u16* AO = (u16*)(ws + WS_AO);
    u16* HB = (u16*)(ws + WS_HB); float* SS0 = (float*)(ws + WS_SS); float* SS1 = SS0 + T; float* SS2 = SS1 + T; float* SSQ = SS2 + T; float* SSKV = SSQ + T; const float* NOSS = nullptr; float* NOSSW = nullptr;
    LAS unsigned char* ldsl = (LAS unsigned char*)lds;
    const int lo = P.ph_lo, hi = P.ph_hi;
    volatile LAS unsigned* xst = (volatile LAS unsigned*)(ldsl + LDS_BYTES - 16);
    if (tid < 4) xst[tid] = 0u;
    __syncthreads();
    XcdBarrier xbar = xcd_barrier_post((unsigned*)(ws + WS_CTL), xst);
#define PH(k) if (lo <= (k) && (k) < hi) _Pragma("unroll") for (int rep_ = 0; rep_ <= (int)((REP_MASK >> (k)) & 1u); ++rep_)
#define SEAM(k) do { if (lo <= (k) && (k) + 1 < hi) { if ((k) == 0) grid.sync(); else xcd_barrier(xbar); } } while (0)
#define GEMM_BF16X(ACT, Aptr, ldav, Bptr, Mv, Nv, Kv, Optr, ldc, ssptr, sso0p, sso1p) do { pg8::Gemm g{Aptr, Bptr, Mv, Nv, Kv, ldav}; pg8::StaticOrder S; S.init(Mv, Nv, G, (int)blockIdx.x); \
        pg8::EpiBf16<ACT> E{Optr, ldc, ssptr, 1.0f / (float)(Kv), EPS, sso0p, sso1p}; pg8::gemm_phase<pg8::EpiBf16<ACT>, pg8::StaticOrder, true, true>(ldsl, g, S, E); } while (0)
#define GEMM_BF16(ACT, Aptr, Bptr, Mv, Nv, Kv, Optr, ldc, ssptr) GEMM_BF16X(ACT, Aptr, Kv, Bptr, Mv, Nv, Kv, Optr, ldc, ssptr, NOSSW, NOSSW)
#define GEMM_RES(F32B, Aptr, Bptr, Mv, Nv, Kv, baseptr, ssptr) do { pg8::Gemm g{Aptr, Bptr, Mv, Nv, Kv, Kv}; pg8::StaticOrder S; S.init(Mv, Nv, G, (int)blockIdx.x); \
        pg8::EpiResB<F32B> E{baseptr, HB, Nv, ssptr}; pg8::gemm_phase<pg8::EpiResB<F32B>, pg8::StaticOrder, true, true>(ldsl, g, S, E); } while (0)
#define NORM_PHASE() do { for (int m = gw; m < T; m += NGW) norm_row_b2b(HB + (size_t)m * DM, XN + (size_t)m * DM, lane); } while (0)

    PH(0) {
        LAS float* scr = (LAS float*)(ldsl + wave * 16384);
        constexpr int I0 = (DM / 64) * (IN0 / 32), I1 = (DM / 64) * (DM / 32), I2 = (DM / 64) * (NLAT / 32), I3 = (512 / 64) * (NQ / 32), I4 = (512 / 64) * (NKV / 32), I5 = I1;
        constexpr int I6 = (DM / 64) * (DFF / 32), I7 = (DFF / 64) * (DM / 32);
        constexpr int NITEMS = I0 + I1 + I2 + I3 + I4 + I5 + 2 * I6 + 2 * I7;
        for (int it = gw; it < NITEMS; it += NGW) {
            int r = it;
            if (r < I0) { transpose_item(P.in[I_EWIN], P.in[I_ENG], 1.f, DM, IN0, Win, scr, r, lane); continue; } r -= I0;
            if (r < I1) { transpose_item(P.in[I_EWOUT], nullptr, 1.f, DM, DM, Wout, scr, r, lane); continue; } r -= I1;
            if (r < I2) { transpose_item(P.in[I_OWDOWN], P.in[I_ONG], 1.f, DM, NLAT, Wdown, scr, r, lane); continue; } r -= I2;
            if (r < I3) { transpose_item(P.in[I_OWUQ], P.in[I_OQG], att::Cfg<192>::C, 512, NQ, Wuq, scr, r, lane); continue; } r -= I3;
            if (r < I4) { transpose_item(P.in[I_OWUKV], P.in[I_OKVG], 1.f, 512, NKV, Wukv, scr, r, lane); continue; } r -= I4;
            if (r < I5) { transpose_item(P.in[I_OWO], nullptr, 1.f, DM, DM, Wo, scr, r, lane); continue; } r -= I5;
            if (r < I6) { transpose_item(P.in[I_MWUP], P.in[I_MNG], 1.f, DM, DFF, Wup, scr, r, lane); continue; } r -= I6;
            if (r < I6) { transpose_item(P.in[I_MWUP] + (size_t)DM * DFF, P.in[I_MNG] + DM, 1.f, DM, DFF, Wup + (size_t)DM * DFF, scr, r, lane); continue; } r -= I6;
            if (r < I7) { transpose_item(P.in[I_MWDN], nullptr, 1.f, DFF, DM, Wdn, scr, r, lane); continue; } r -= I7;
            transpose_item(P.in[I_MWDN] + (size_t)DM * DFF, nullptr, 1.f, DFF, DM, Wdn + (size_t)DM * DFF, scr, r, lane);
        }
        { const size_t n16 = (size_t)(NLATP - NLAT) * DM * 2 / 16; u32x4* z = (u32x4*)(Wdown + (size_t)NLAT * DM);
          for (size_t i = (size_t)blockIdx.x * NTHREADS + tid; i < n16; i += (size_t)G * NTHREADS) z[i] = (u32x4){0u, 0u, 0u, 0u}; }
        for (int m = gw; m < T; m += NGW) norm_row_bf16(P.in[I_X] + (size_t)m * DM, XN + (size_t)m * DM, lane);
    }
    SEAM(0);
    PH(1) { GEMM_BF16(0, XN, Win, T, IN0, DM, PROJ, IN0, NOSS); }
    SEAM(1);
    PH(2) { const int per = ((T / 2 + NGW - 1) / NGW) * 2; const int t0 = gw * per; for (int t = t0; t < t0 + per && t < T; t += 2) ew0_pair(t, PROJ, MIX, P.in[I_EQG], P.in[I_EKG], P.in[I_ECW], lane); }
    SEAM(2);
    PH(3) {
        if (ATT_PRIO && wave >= 4) __builtin_amdgcn_s_setprio(1);
        constexpr int NU = BATCH * 8 * (SEQ / 256); int unit;
        for (int i = 0; attn_next<128>(i, NU, unit); ++i) {
            const int bh = unit / (SEQ / 256), qb = unit % (SEQ / 256), b = bh >> 3, hq = bh & 7, kvh = hq >> 2;
            const size_t tb = (size_t)b * SEQ;
#ifndef NO_GQA
            att::ATT_UNIT<128, IN0, IN0, IN0, DM>(PROJ + (tb + (size_t)qb * 256) * IN0 + hq * 128, PROJ + tb * IN0 + 1024 + kvh * 128, nullptr, PROJ + tb * IN0 + 1280 + kvh * 128,
                                                      MIX + (tb + (size_t)qb * 256) * DM + hq * 128, SEQ, (char*)lds, qb * 256, P.in[I_EQG]);
#endif
        }
    }
    if (ATT_PRIO) __builtin_amdgcn_s_setprio(0);
    SEAM(3);
    PH(4) { GEMM_RES(true, MIX, Wout, T, DM, DM, (const void*)P.in[I_X], SS0); }
    SEAM(4);
    PH(6) { GEMM_BF16(2, HB, Wup, T, DFF, DM, HID, DFF, (const float*)SS0); }
    SEAM(6);
    PH(7) { GEMM_RES(false, HID, Wdn, T, DM, DFF, (const void*)HB, SS1); }
    SEAM(7);
    PH(9) { GEMM_BF16X(0, HB, DM, Wdown, T, NLATP, DM, LAT, NLATP, (const float*)SS1, SSQ, SSKV); }
    SEAM(9);
    PH(11) {
        for (int t = gw; t < T; t += NGW) if (lane < 32) {
            const int s = t & (SEQ - 1), row = s >> 6, col = s & 63; const int j = lane & 15;
            const float invf = __builtin_amdgcn_exp2f(-(float)j * (LOG2_THETA / 16.f)); float c, sn; rope_cs((float)(lane < 16 ? row : col), invf, c, sn);
            const unsigned u = *(const unsigned*)(LAT + (size_t)t * NLATP + 1024 + 2 * lane); const float x1 = bflo(u), x2 = bfhi(u);
            *(unsigned*)(KROPE + (size_t)t * 64 + 2 * lane) = pk2(x1 * c - x2 * sn, x1 * sn + x2 * c); }
        GEMM_BF16X(0, LAT, NLATP, Wuq, T, NQ, 512, Qm, NQ, (const float*)SSQ, NOSSW, NOSSW);
        GEMM_BF16X(0, LAT + 512, NLATP, Wukv, T, NKV, 512, KVm, NKV, (const float*)SSKV, NOSSW, NOSSW); }
    SEAM(11);
    PH(13) {
        if (ATT_PRIO && wave >= 4) __builtin_amdgcn_s_setprio(1);
        constexpr int NU = BATCH * 16 * (SEQ / 256); int unit;
        for (int i = 0; attn_next<192>(i, NU, unit); ++i) {
            const int bh = unit / (SEQ / 256), qb = unit % (SEQ / 256), b = bh >> 4, h = bh & 15;
            const size_t tb = (size_t)b * SEQ;
#ifndef NO_MLA
            att::ATT_UNIT<192, NQ, NKV, NKV, DM>(Qm + (tb + (size_t)qb * 256) * NQ + h * 192, KVm + tb * NKV + h * 256, KROPE + tb * 64, KVm + tb * NKV + h * 256 + 128,
                                                          AO + (tb + (size_t)qb * 256) * DM + h * 128, SEQ, (char*)lds, qb * 256);
#endif
        }
    }
    if (ATT_PRIO) __builtin_amdgcn_s_setprio(0);
    SEAM(13);
    PH(14) { GEMM_RES(false, AO, Wo, T, DM, DM, (const void*)HB, SS2); }
    SEAM(14);
    PH(16) { GEMM_BF16(2, HB, Wup + (size_t)DM * DFF, T, DFF, DM, HID, DFF, (const float*)SS2); }
    SEAM(16);
    PH(17) { GEMM_RES(false, HID, Wdn + (size_t)DM * DFF, T, DM, DFF, (const void*)HB, NOSSW); }
    SEAM(17);
    PH(18) { for (int m = gw; m < T; m += NGW) norm_row_final(HB + (size_t)m * DM, P.out + (size_t)m * DM, P.in[I_FNG], lane);
#ifdef ATT_TIMING
        if (blockIdx.x == 0 && tid == 0) { asm volatile("s_waitcnt vmcnt(0)" ::: "memory"); P.out[0] = floorf(((float*)(ws + WS_CTL + 32768))[ATT_TIMING] * (1.f / 200.f) + 0.5f) * 200000.f; }
#endif
    }
#undef PH
#undef SEAM
}

extern "C" void kernel_launch(void* const* d_in, const int* in_sizes, int n_in, void* d_out, int out_size, void* d_ws, size_t ws_size, hipStream_t stream) {
    static int grid = 0;
    if (grid == 0) {
        if (n_in != 18 || in_sizes[0] != T * DM || out_size != T * DM || ws_size < WS_END) {
            fprintf(stderr, "kernel_launch: shape mismatch (n_in %d in0 %d out %d ws %zu need %zu)\n", n_in, n_in > 0 ? in_sizes[0] : -1, out_size, ws_size, (size_t)WS_END); grid = -1; return; }
        int dev = 0, cus = 0, per_cu = 0;
        hipGetDevice(&dev); hipDeviceGetAttribute(&cus, hipDeviceAttributeMultiprocessorCount, dev);
        if (hipFuncSetAttribute((const void*)fwd_mega, hipFuncAttributeMaxDynamicSharedMemorySize, LDS_BYTES) != hipSuccess) { fprintf(stderr, "kernel_launch: hipFuncSetAttribute failed\n"); grid = -1; return; }
        if (hipOccupancyMaxActiveBlocksPerMultiprocessor(&per_cu, (const void*)fwd_mega, NTHREADS, LDS_BYTES) != hipSuccess || per_cu < 1) { fprintf(stderr, "kernel_launch: occupancy query says %d\n", per_cu); per_cu = 1; }
        (void)hipGetLastError();
        grid = cus * per_cu;
        fprintf(stderr, "kernel_launch: grid %d (cus %d x %d)\n", grid, cus, per_cu);
    }
    if (grid < 0) return;
    if (hipMemsetAsync((char*)d_ws + WS_CTL, 0, CTL_BYTES, stream) != hipSuccess) { fprintf(stderr, "kernel_launch: memset failed\n"); return; }
    Params p{};
    for (int i = 0; i < 18; ++i) p.in[i] = (const float*)d_in[i];
    p.out = (float*)d_out; p.ws = (unsigned char*)d_ws;
#if N_LAUNCH_SPLIT
    for (int k = 0; k < NPHASE; ++k) { p.ph_lo = k; p.ph_hi = k + 1; void* args[] = {&p};
        hipError_t e = hipLaunchCooperativeKernel((const void*)fwd_mega, dim3(grid), dim3(NTHREADS), args, LDS_BYTES, stream);
        if (e != hipSuccess) { fprintf(stderr, "cooperative launch failed: %s (grid %d)\n", hipGetErrorString(e), grid); break; } }
#else
    p.ph_lo = 0; p.ph_hi = NPHASE; void* args[] = {&p};
    hipError_t e = hipLaunchCooperativeKernel((const void*)fwd_mega, dim3(grid), dim3(NTHREADS), args, LDS_BYTES, stream);
    if (e != hipSuccess) fprintf(stderr, "cooperative launch failed: %s (grid %d)\n", hipGetErrorString(e), grid);
#endif
}
```

```cpp
#include <hip/hip_runtime.h>
#include <hip/hip_cooperative_groups.h>
#include <cstdio>
#include <cstdint>
namespace cg = cooperative_groups;
#ifndef GQA_SD
#define GQA_SD 1
#endif
#ifndef MLA_SD
#define MLA_SD 1
#endif
#ifndef MLA_QREG
#define MLA_QREG 8
#endif
#ifndef REP_MASK
#define REP_MASK 0u
#endif
#ifndef ATT_NVA128
#define ATT_NVA128 5
#endif
#ifndef ATT_NVA192
#define ATT_NVA192 3
#endif
#ifndef ATT_NVB
#define ATT_NVB 2
#endif
#ifndef ATT_PREA
#define ATT_PREA 4
#endif
#ifndef ATT_LEAD128
#define ATT_LEAD128 0
#endif
#ifndef ATT_NVL128
#define ATT_NVL128 7
#endif
#ifndef ATT_LEAD192
#define ATT_LEAD192 0
#endif
#ifndef ATT_NVL192
#define ATT_NVL192 8
#endif
#ifndef ATT_PREB
#define ATT_PREB 8
#endif
#ifndef PROBE_EW0
#define PROBE_EW0 0
#endif
#ifndef PROBE_DN
#define PROBE_DN 0
#endif
#ifndef PROBE_OUT
#define PROBE_OUT 0
#endif
#ifndef ATT_PRIO
#define ATT_PRIO 0
#endif
#ifndef ATT_PRIOMODE
#define ATT_PRIOMODE 0
#endif
#ifndef ATT_TWAVE
#define ATT_TWAVE 0
#endif
#ifndef ATT_KEYMASK128
#define ATT_KEYMASK128 15
#endif
#ifndef ATT_MG192
#define ATT_MG192 2
#endif
#ifndef ATT_DS192
#define ATT_DS192 2
#endif
#ifndef ATT_UNIT
#define ATT_UNIT attn_unit_dma
#endif
#ifndef N_LAUNCH_SPLIT
#define N_LAUNCH_SPLIT 0
#endif
namespace pg8 {
#define PG8_LAS __attribute__((address_space(3)))
typedef unsigned short bf16_t;
typedef short bf16x8 __attribute__((ext_vector_type(8)));
typedef float f32x4 __attribute__((ext_vector_type(4)));
typedef unsigned u32x4 __attribute__((ext_vector_type(4)));
constexpr int BM = 256, BK = 64, HALF = 128, HTB = HALF * BK * 2  , STAGE_BYTES = 8 * HTB, NXCD = 8, WGM = 8;

__host__ __device__ __forceinline__ int lds_byte(int r, int c) { const int st = (r >> 4) * 2 + (c >> 5), rr = r & 15, cc = c & 31, ob = rr * 64 + cc * 2; return st * 1024 + (ob ^ (((ob >> 9) & 1) << 5)); }
__host__ __device__ __forceinline__ void stage_rc(int b, int& R, int& C) { const int st = b / 1024, sb = b % 1024, swz = sb ^ (((sb >> 9) & 1) << 5); R = (st >> 1) * 16 + swz / 64; C = (st & 1) * 32 + (swz % 64) / 2; }
__host__ __device__ __forceinline__ int perm32(int rho) { const int n = rho >> 4, i = rho & 15; return 8 * (i >> 2) + 4 * n + (i & 3); }

struct Unit { int pm, pn; };
struct Gemm { const bf16_t* A; const bf16_t* Bt; int M, N, K, lda; };

struct StaticOrder {
    int nM, nN, nwg, G, c;
    __host__ __device__ void init(int M, int N, int G_, int c_) { nM = M / BM; nN = N / BM; nwg = nM * nN; G = G_; c = c_; }
    __host__ __device__ bool next(int i, Unit& u) const {
        const long L = (long)i * G + c; if (L >= nwg) return false;
        int wgid = (int)L; { const int q = nwg / NXCD, r = nwg % NXCD, xcd = wgid % NXCD, off = wgid / NXCD; wgid = (xcd < r ? xcd * (q + 1) : r * (q + 1) + (xcd - r) * q) + off; }
        const int nig = WGM * nN, gid = wgid / nig, fm = gid * WGM, gsz = (nM - fm) < WGM ? (nM - fm) : WGM;
        u.pm = fm + ((wgid % nig) % gsz); u.pn = (wgid % nig) / gsz; return true;
    }
    __device__ __forceinline__ void a_ready(const Unit&) const {}
    __device__ __forceinline__ void done(const Unit&) const {}
};
__device__ __forceinline__ unsigned cvt_pk_bf16(float lo, float hi) { unsigned r; asm volatile("v_cvt_pk_bf16_f32 %0, %1, %2" : "=v"(r) : "v"(lo), "v"(hi)); return r; }
template <int ACT> struct EpiBf16 {
    static constexpr bool PERM = true, AFTER_DRAIN = false;
    bf16_t* O; int ldc; const float* ss; float inv_k, eps;
    float* sso0; float* sso1;
    __device__ __forceinline__ void operator()(const f32x4 (&acc)[2][2][4][2], const Unit& u, int wr, int wc, int fr, int fq) const {
        const int row0 = u.pm * BM + wr * 64 + fr; const int col0 = u.pn * BM + wc * 32 + 8 * fq;
#pragma unroll
        for (int ai = 0; ai < 2; ++ai)
#pragma unroll
            for (int m = 0; m < 4; ++m) { const int row = row0 + ai * HALF + m * 16; bf16_t* rowp = O + (size_t)row * ldc + col0;
                const float rs = ss ? (1.0f / sqrtf(ss[row] * inv_k + eps)) : 1.0f;
                float q = 0.f;
#pragma unroll
                for (int bj = 0; bj < 2; ++bj) { f32x4 v0 = acc[ai][bj][m][0] * rs, v1 = acc[ai][bj][m][1] * rs;
                    q += (v0[0] * v0[0] + v0[1] * v0[1]) + (v0[2] * v0[2] + v0[3] * v0[3]) + (v1[0] * v1[0] + v1[1] * v1[1]) + (v1[2] * v1[2] + v1[3] * v1[3]);
                    if (ACT == 2) {
#pragma unroll
                        for (int e = 0; e < 4; ++e) { float a = v0[e] > 0.f ? v0[e] : 0.f; v0[e] = a * a; float b = v1[e] > 0.f ? v1[e] : 0.f; v1[e] = b * b; } }
                    u32x4 w; w.x = cvt_pk_bf16(v0[0], v0[1]); w.y = cvt_pk_bf16(v0[2], v0[3]); w.z = cvt_pk_bf16(v1[0], v1[1]); w.w = cvt_pk_bf16(v1[2], v1[3]);
                    *(u32x4*)(rowp + bj * HALF) = w; }
                if (sso0) { float* so = (u.pn < 2) ? sso0 : ((u.pn < 4) ? sso1 : nullptr);
                    if (so) { q += __shfl_xor(q, 16); q += __shfl_xor(q, 32); if (fq == 0) atomicAdd(so + row, q); } } }
    }
};
template <bool BASE_F32> struct EpiResB {
    static constexpr bool PERM = true, AFTER_DRAIN = false;
    const void* base; bf16_t* out; int ldc; float* ss;
    __device__ __forceinline__ void operator()(const f32x4 (&acc)[2][2][4][2], const Unit& u, int wr, int wc, int fr, int fq) const {
        const int row0 = u.pm * BM + wr * 64 + fr; const int col0 = u.pn * BM + wc * 32 + 8 * fq;
#pragma unroll
        for (int ai = 0; ai < 2; ++ai)
#pragma unroll
            for (int m = 0; m < 4; ++m) { const size_t off = (size_t)(row0 + ai * HALF + m * 16) * ldc + col0; float q = 0.f;
#pragma unroll
                for (int bj = 0; bj < 2; ++bj) { const size_t o = off + bj * HALF; f32x4 b0, b1;
                    if constexpr (BASE_F32) { b0 = *(const f32x4*)((const float*)base + o); b1 = *(const f32x4*)((const float*)base + o + 4); }
                    else { const u32x4 w = *(const u32x4*)((const bf16_t*)base + o);
                        b0 = (f32x4){__uint_as_float(w.x << 16), __uint_as_float(w.x & 0xffff0000u), __uint_as_float(w.y << 16), __uint_as_float(w.y & 0xffff0000u)};
                        b1 = (f32x4){__uint_as_float(w.z << 16), __uint_as_float(w.z & 0xffff0000u), __uint_as_float(w.w << 16), __uint_as_float(w.w & 0xffff0000u)}; }
                    const f32x4 v0 = b0 + acc[ai][bj][m][0], v1 = b1 + acc[ai][bj][m][1];
                    q += (v0[0] * v0[0] + v0[1] * v0[1]) + (v0[2] * v0[2] + v0[3] * v0[3]) + (v1[0] * v1[0] + v1[1] * v1[1]) + (v1[2] * v1[2] + v1[3] * v1[3]);
                    u32x4 r; r.x = cvt_pk_bf16(v0[0], v0[1]); r.y = cvt_pk_bf16(v0[2], v0[3]); r.z = cvt_pk_bf16(v1[0], v1[1]); r.w = cvt_pk_bf16(v1[2], v1[3]);
                    *(u32x4*)(out + o) = r; }
                if (ss) { q += __shfl_xor(q, 16); q += __shfl_xor(q, 32); if (fq == 0) atomicAdd(ss + (row0 + ai * HALF + m * 16), q); }
                asm volatile("" ::: "memory"); }
    }
};
template <class Epi, class Sched, bool ALIGN_EPI = false, bool SP2 = false>
__device__ __forceinline__ void gemm_phase(PG8_LAS unsigned char* lds, const Gemm g, const Sched& S, const Epi& E) {
    const int tid = threadIdx.x, wid = __builtin_amdgcn_readfirstlane(tid >> 6), lane = tid & 63, wr = wid >> 2, wc = wid & 3, fr = lane & 15, fq = lane >> 4;
    const int K = g.K, nt = K / BK;
    unsigned voffA[2], voffB[2];
#pragma unroll
    for (int i = 0; i < 2; ++i) { int R, C; stage_rc(tid * 16 + i * 8192, R, C); const int Rb = Epi::PERM ? ((R & ~31) + perm32(R & 31)) : R;
        voffA[i] = (unsigned)(R * g.lda + C) * 2u; voffB[i] = (unsigned)(Rb * K + C) * 2u; }
    const size_t kstep = (size_t)(BK * 2);
    const size_t hstep = (size_t)HALF * K * 2;
    const size_t tstep = 2 * hstep;
    const size_t hstepA = (size_t)HALF * g.lda * 2, tstepA = 2 * hstepA;
    const unsigned ldsw = (unsigned)wid * 1024u;
    const int aoff = lds_byte(wr * 64 + fr, fq * 8), boff = lds_byte(wc * 32 + fr, fq * 8);
#define PG8_SA(b, h) (((b) * 2 + (h)) * HTB)
#define PG8_SB(b, h) ((4 + (b) * 2 + (h)) * HTB)
#define PG8_STAGE(bufoff, gbase, voff) do { _Pragma("unroll") for (int _i = 0; _i < 2; ++_i) \
        __builtin_amdgcn_global_load_lds((const unsigned*)((const char*)(gbase) + (voff)[_i]), (PG8_LAS unsigned*)(lds + (bufoff) + ldsw + _i * 8192), 16, 0, 0); } while (0)
#define PG8_LDA(dst, b, h) do { _Pragma("unroll") for (int m = 0; m < 4; ++m) _Pragma("unroll") for (int k = 0; k < 2; ++k) dst[m][k] = *(const PG8_LAS bf16x8*)(lds + PG8_SA(b, h) + aoff + m * 2048 + k * 1024); } while (0)
#define PG8_LDB(dst, b, h) do { _Pragma("unroll") for (int n = 0; n < 2; ++n) _Pragma("unroll") for (int k = 0; k < 2; ++k) dst[n][k] = *(const PG8_LAS bf16x8*)(lds + PG8_SB(b, h) + boff + n * 2048 + k * 1024); } while (0)
#define PG8_MMA(ai, bj, At, Bt) do { __builtin_amdgcn_s_setprio(1); _Pragma("unroll") for (int m = 0; m < 4; ++m) _Pragma("unroll") for (int n = 0; n < 2; ++n) _Pragma("unroll") for (int k = 0; k < 2; ++k) \
        acc[ai][bj][m][n] = __builtin_amdgcn_mfma_f32_16x16x32_bf16(Bt[n][k], At[m][k], acc[ai][bj][m][n], 0, 0, 0); __builtin_amdgcn_s_setprio(0); } while (0)
#define PG8_WAIT_V(n) asm volatile("s_waitcnt vmcnt(" #n ")" ::: "memory")
#define PG8_WAIT_L(n) asm volatile("s_waitcnt lgkmcnt(" #n ")" ::: "memory")
#define PG8_BAR __builtin_amdgcn_s_barrier()
#define PG8_SCHED __builtin_amdgcn_sched_barrier(0)
    Unit cur, nxt; int ui = 0;
    if (!S.next(0, cur)) return;
    f32x4 acc[2][2][4][2];
#pragma unroll
    for (int a = 0; a < 2; ++a)
#pragma unroll
        for (int b = 0; b < 2; ++b)
#pragma unroll
            for (int m = 0; m < 4; ++m)
#pragma unroll
                for (int n = 0; n < 2; ++n) acc[a][b][m][n] = (f32x4){0.f, 0.f, 0.f, 0.f};
    bf16x8 At[4][2], B0[2][2], B1[2][2];
    const char* cA = (const char*)g.A + (size_t)cur.pm * tstepA; const char* cB = (const char*)g.Bt + (size_t)cur.pn * tstep;
    S.a_ready(cur);
    if constexpr (SP2) {
        PG8_STAGE(PG8_SB(0, 0), cB, voffB); PG8_STAGE(PG8_SB(0, 1), cB + hstep, voffB); PG8_STAGE(PG8_SA(0, 0), cA, voffA); PG8_STAGE(PG8_SA(0, 1), cA + hstepA, voffA);
        if (wr == 1) PG8_BAR;
        PG8_WAIT_V(2); PG8_BAR;
        PG8_STAGE(PG8_SB(1, 0), cB + kstep, voffB); PG8_STAGE(PG8_SA(1, 0), cA + kstep, voffA); PG8_STAGE(PG8_SB(1, 1), cB + hstep + kstep, voffB);
        PG8_WAIT_V(6); PG8_BAR;
    } else {
        PG8_STAGE(PG8_SB(0, 0), cB, voffB); PG8_STAGE(PG8_SA(0, 0), cA, voffA); PG8_STAGE(PG8_SB(0, 1), cB + hstep, voffB); PG8_STAGE(PG8_SA(0, 1), cA + hstepA, voffA);
        if (wr == 1) PG8_BAR;
        PG8_WAIT_V(4); PG8_BAR;
        PG8_STAGE(PG8_SB(1, 0), cB + kstep, voffB); PG8_STAGE(PG8_SA(1, 0), cA + kstep, voffA); PG8_STAGE(PG8_SB(1, 1), cB + hstep + kstep, voffB);
        PG8_WAIT_V(6); PG8_BAR;
    }
    for (;;) {
        const bool has_next = S.next(ui + 1, nxt);
        const char* nA = has_next ? (const char*)g.A + (size_t)nxt.pm * tstepA : cA; const char* nB = has_next ? (const char*)g.Bt + (size_t)nxt.pn * tstep : cB;
        for (int t = 0; t < nt; t += 2) {
            const bool last = (t == nt - 2);
            const char* a1 = cA + (size_t)(t + 1) * kstep;
            const char* a2 = last ? nA : cA + (size_t)(t + 2) * kstep; const char* b2 = last ? nB : cB + (size_t)(t + 2) * kstep;
            const char* a3 = a2 + kstep; const char* b3 = b2 + kstep;
            if (last && has_next) S.a_ready(nxt);
            if constexpr (SP2) {
            PG8_LDB(B0, 0, 0); PG8_LDB(B1, 0, 1); PG8_SCHED; PG8_LDA(At, 0, 0); PG8_STAGE(PG8_SA(1, 1), a1 + hstepA, voffA);
            PG8_WAIT_V(8); PG8_WAIT_L(0); PG8_BAR; PG8_MMA(0, 0, At, B0); PG8_MMA(0, 1, At, B1); PG8_BAR; PG8_SCHED;
            PG8_LDA(At, 0, 1); PG8_STAGE(PG8_SB(0, 0), b2, voffB); PG8_STAGE(PG8_SB(0, 1), b2 + hstep, voffB); PG8_STAGE(PG8_SA(0, 0), a2, voffA);
            PG8_WAIT_V(8); PG8_WAIT_L(0); PG8_BAR; PG8_MMA(1, 0, At, B0); PG8_MMA(1, 1, At, B1); PG8_BAR; PG8_SCHED;
            PG8_LDB(B0, 1, 0); PG8_LDB(B1, 1, 1); PG8_SCHED; PG8_LDA(At, 1, 0); PG8_STAGE(PG8_SA(0, 1), a2 + hstepA, voffA);
            PG8_WAIT_V(8); PG8_WAIT_L(0); PG8_BAR; PG8_MMA(0, 0, At, B0); PG8_MMA(0, 1, At, B1); PG8_BAR; PG8_SCHED;
            PG8_LDA(At, 1, 1); PG8_STAGE(PG8_SB(1, 0), b3, voffB); PG8_STAGE(PG8_SB(1, 1), b3 + hstep, voffB); PG8_STAGE(PG8_SA(1, 0), a3, voffA);
            PG8_WAIT_V(8); PG8_WAIT_L(0); PG8_BAR; PG8_MMA(1, 0, At, B0); PG8_MMA(1, 1, At, B1); PG8_BAR; PG8_SCHED;
            } else {
            PG8_LDB(B0, 0, 0); PG8_SCHED; PG8_LDA(At, 0, 0); PG8_STAGE(PG8_SA(1, 1), a1 + hstepA, voffA);
            PG8_WAIT_L(8); PG8_BAR; PG8_WAIT_L(0); PG8_MMA(0, 0, At, B0); PG8_BAR; PG8_SCHED;
            PG8_LDB(B1, 0, 1); PG8_STAGE(PG8_SB(0, 0), b2, voffB);
            PG8_BAR; PG8_WAIT_L(0); PG8_MMA(0, 1, At, B1); PG8_BAR;
            PG8_LDA(At, 0, 1); PG8_STAGE(PG8_SA(0, 0), a2, voffA);
            PG8_BAR; PG8_WAIT_L(0); PG8_MMA(1, 0, At, B0); PG8_BAR; PG8_SCHED;
            PG8_STAGE(PG8_SB(0, 1), b2 + hstep, voffB);
            PG8_WAIT_V(6); PG8_BAR; PG8_MMA(1, 1, At, B1); PG8_BAR;
            PG8_LDB(B0, 1, 0); PG8_SCHED; PG8_LDA(At, 1, 0); PG8_STAGE(PG8_SA(0, 1), a2 + hstepA, voffA);
            PG8_WAIT_L(8); PG8_BAR; PG8_WAIT_L(0); PG8_MMA(0, 0, At, B0); PG8_BAR; PG8_SCHED;
            PG8_LDB(B1, 1, 1); PG8_STAGE(PG8_SB(1, 0), b3, voffB);
            PG8_BAR; PG8_WAIT_L(0); PG8_MMA(0, 1, At, B1); PG8_BAR;
            PG8_LDA(At, 1, 1); PG8_STAGE(PG8_SA(1, 0), a3, voffA);
            PG8_BAR; PG8_WAIT_L(0); PG8_MMA(1, 0, At, B0); PG8_BAR; PG8_SCHED;
            PG8_STAGE(PG8_SB(1, 1), b3 + hstep, voffB);
            PG8_WAIT_V(6); PG8_BAR; PG8_MMA(1, 1, At, B1); PG8_BAR;
            }
        }
        if constexpr (ALIGN_EPI) { if (wr == 0) PG8_BAR; }
        if constexpr (!Epi::AFTER_DRAIN) { E(acc, cur, wr, wc, fr, fq); S.done(cur); }
        if (!has_next) break;
#pragma unroll
        for (int a = 0; a < 2; ++a)
#pragma unroll
            for (int b = 0; b < 2; ++b)
#pragma unroll
                for (int m = 0; m < 4; ++m)
#pragma unroll
                    for (int n = 0; n < 2; ++n) acc[a][b][m][n] = (f32x4){0.f, 0.f, 0.f, 0.f};
        cur = nxt; cA = nA; cB = nB; ++ui;
        if constexpr (ALIGN_EPI) { if (wr == 1) PG8_BAR; }
    }
    PG8_WAIT_V(0);
    if constexpr (!ALIGN_EPI) { if (wr == 0) PG8_BAR; }
    PG8_BAR;
    if constexpr (Epi::AFTER_DRAIN) { E.fused(acc, cur, wr, wc, fr, fq, lds, wid, lane); S.done(cur); }
#undef PG8_SA
#undef PG8_SB
#undef PG8_STAGE
#undef PG8_LDA
#undef PG8_LDB
#undef PG8_MMA
#undef PG8_WAIT_V
#undef PG8_WAIT_L
#undef PG8_BAR
#undef PG8_SCHED
}
}
namespace att {
typedef unsigned short bf16;
using bf16x8 = __attribute__((ext_vector_type(8))) short;
using s16x4  = __attribute__((ext_vector_type(4))) short;
using f32x16 = __attribute__((ext_vector_type(16))) float;
using u32x4  = __attribute__((ext_vector_type(4))) unsigned;
constexpr int NW = 8, QBLK = 32, KVBLK = 64;
constexpr float THR = 8.f;
#define ATT_SBAR() __builtin_amdgcn_sched_barrier(0)
__device__ __forceinline__ int crow(int r, int hi) { return (r & 3) + 8 * (r >> 2) + 4 * hi; }
typedef float f32x2_t __attribute__((ext_vector_type(2))); typedef __bf16 bf16x2_t __attribute__((ext_vector_type(2)));
__device__ __forceinline__ unsigned cvtpk(float lo, float hi) { f32x2_t v = {lo, hi}; bf16x2_t b = __builtin_convertvector(v, bf16x2_t); return __builtin_bit_cast(unsigned, b); }
typedef short v4i16_t __attribute__((ext_vector_type(4)));
typedef __attribute__((address_space(3))) const char* lds_cptr;
__device__ __forceinline__ s16x4 vtr(lds_cptr p) { return __builtin_bit_cast(s16x4, __builtin_amdgcn_ds_read_tr16_b64_v4i16((__attribute__((address_space(3))) v4i16_t*)p)); }
__device__ __forceinline__ bf16x8 ld8(const bf16* p) { return *reinterpret_cast<const bf16x8*>(p); }

template <int DQK> struct Cfg {
  static constexpr float SCALE = (DQK == 128) ? 0.088388347648318440f : 0.072168783648703220f;
  static constexpr float C = SCALE * 1.4426950408889634f;
  static constexpr int KROWB = DQK * 2, SHM_K = KVBLK * KROWB, SHM_V = KVBLK * 128 * 2, ND0 = DQK / 16;
  static constexpr int QREG = (DQK > 128) ? MLA_QREG : 8;
  static constexpr int QXW = (ND0 - QREG) * 1024, SHM_QX = NW * QXW;
  static constexpr int SHM_TOTAL = 2 * SHM_V + 2 * SHM_K + NW * 64 * 4 + SHM_QX;
};

constexpr float TRIG = 65536.f;
__device__ __forceinline__ void firstSM(f32x16& p0, f32x16& p1, float& m_ref, f32x16& negm) {
  float pmax = p0[0];
#pragma unroll
  for (int r = 1; r < 16; ++r) pmax = fmaxf(pmax, p0[r]);
#pragma unroll
  for (int r = 0; r < 16; ++r) pmax = fmaxf(pmax, p1[r]);
  { auto rr = __builtin_amdgcn_permlane32_swap(__float_as_uint(pmax), __float_as_uint(pmax), false, false);
    pmax = fmaxf(__uint_as_float(rr[0]), __uint_as_float(rr[1])); }
  m_ref = pmax;
#pragma unroll
  for (int r = 0; r < 16; ++r) { p0[r] -= pmax; p1[r] -= pmax; negm[r] = -pmax; }
#pragma unroll
  for (int r = 0; r < 16; ++r) p0[r] = __builtin_amdgcn_exp2f(p0[r]);
  asm volatile("" : "+v"(p0), "+v"(p1), "+v"(negm));
}
__device__ __forceinline__ void firstSM0(f32x16& p0, f32x16& p1, float& m_ref, f32x16& negm) {
  float pmax = p0[0];
#pragma unroll
  for (int r = 1; r < 16; ++r) pmax = fmaxf(pmax, p0[r]);
#pragma unroll
  for (int r = 0; r < 16; ++r) pmax = fmaxf(pmax, p1[r]);
  { auto rr = __builtin_amdgcn_permlane32_swap(__float_as_uint(pmax), __float_as_uint(pmax), false, false);
    pmax = fmaxf(__uint_as_float(rr[0]), __uint_as_float(rr[1])); }
  m_ref = pmax;
#pragma unroll
  for (int r = 0; r < 16; ++r) { p0[r] -= pmax; p1[r] -= pmax; negm[r] = -pmax; }
  asm volatile("" : "+v"(p0), "+v"(p1), "+v"(negm));
}
__device__ __forceinline__ void partialSM(f32x16& p0, f32x16& p1) {
#pragma unroll
  for (int r = 0; r < 16; ++r) p0[r] = __builtin_amdgcn_exp2f(p0[r]);
  asm volatile("" : "+v"(p0), "+v"(p1));
}
__device__ __forceinline__ void finishSM(f32x16& p0, f32x16& p1, float& ps, float& l_reg, bf16x8& pa0, bf16x8& pa1, bf16x8& pa2, bf16x8& pa3) {
#pragma unroll
  for (int r = 0; r < 16; ++r) p1[r] = __builtin_amdgcn_exp2f(p1[r]);
  float s0 = 0, s1 = 0;
#pragma unroll
  for (int r = 0; r < 16; ++r) s0 += p0[r];
#pragma unroll
  for (int r = 0; r < 16; ++r) s1 += p1[r];
  ps = s0 + s1;
  { auto rr = __builtin_amdgcn_permlane32_swap(__float_as_uint(ps), __float_as_uint(ps), false, false);
    ps = __uint_as_float(rr[0]) + __uint_as_float(rr[1]); }
  l_reg += ps;
#define ATT_PK4(P, BASE, OUT) do { unsigned a0 = cvtpk(P[BASE + 0], P[BASE + 1]), a1 = cvtpk(P[BASE + 2], P[BASE + 3]);   \
    unsigned b0 = cvtpk(P[BASE + 4], P[BASE + 5]), b1 = cvtpk(P[BASE + 6], P[BASE + 7]);                              \
    auto r0 = __builtin_amdgcn_permlane32_swap(a0, b0, false, false); auto r1 = __builtin_amdgcn_permlane32_swap(a1, b1, false, false); \
    u32x4 w = {r0[0], r1[0], r0[1], r1[1]}; OUT = *reinterpret_cast<bf16x8*>(&w); } while (0)
  ATT_PK4(p0, 0, pa0); ATT_PK4(p0, 8, pa1); ATT_PK4(p1, 0, pa2); ATT_PK4(p1, 8, pa3);
#undef ATT_PK4
}
__device__ __forceinline__ void partialSM2(f32x16& p0, f32x16& p1, float& s0) {
#pragma unroll
  for (int r = 0; r < 16; ++r) p0[r] = __builtin_amdgcn_exp2f(p0[r]);
  float a = 0.f, b = 0.f;
#pragma unroll
  for (int r = 0; r < 16; r += 2) { a += p0[r]; b += p0[r + 1]; }
  s0 = a + b;
  asm volatile("" : "+v"(p0), "+v"(p1), "+v"(s0));
}
__device__ __forceinline__ void finishSM2(f32x16& p0, f32x16& p1, float s0, float& ps, float& l_reg, bf16x8& pa0, bf16x8& pa1, bf16x8& pa2, bf16x8& pa3) {
#pragma unroll
  for (int r = 0; r < 16; ++r) p1[r] = __builtin_amdgcn_exp2f(p1[r]);
  float s1 = 0;
#pragma unroll
  for (int r = 0; r < 16; ++r) s1 += p1[r];
  ps = s0 + s1;
  { auto rr = __builtin_amdgcn_permlane32_swap(__float_as_uint(ps), __float_as_uint(ps), false, false);
    ps = __uint_as_float(rr[0]) + __uint_as_float(rr[1]); }
  l_reg += ps;
#define ATT_PK4(P, BASE, OUT) do { unsigned a0 = cvtpk(P[BASE + 0], P[BASE + 1]), a1 = cvtpk(P[BASE + 2], P[BASE + 3]);   \
    unsigned b0 = cvtpk(P[BASE + 4], P[BASE + 5]), b1 = cvtpk(P[BASE + 6], P[BASE + 7]);                              \
    auto r0 = __builtin_amdgcn_permlane32_swap(a0, b0, false, false); auto r1 = __builtin_amdgcn_permlane32_swap(a1, b1, false, false); \
    u32x4 w = {r0[0], r1[0], r0[1], r1[1]}; OUT = *reinterpret_cast<bf16x8*>(&w); } while (0)
  ATT_PK4(p0, 0, pa0); ATT_PK4(p0, 8, pa1); ATT_PK4(p1, 0, pa2); ATT_PK4(p1, 8, pa3);
#undef ATT_PK4
}
#define ATT_KEY(row) ((KROWB == 256) ? ((row) & ATT_KEYMASK128) : (((row) >> 1) & 7))
#define ATT_KSWZ(row, colB) ((row) * KROWB + ((colB) ^ (ATT_KEY(row) << 4)))
template <int DQK> __device__ __forceinline__ void qkt(f32x16& p0, f32x16& p1, const f32x16& negm, const char* Ks, const int* kb, const bf16x8* qr, const char* qx, int r32, int hi) {
  constexpr int KROWB = Cfg<DQK>::KROWB, ND0 = Cfg<DQK>::ND0, QREG = Cfg<DQK>::QREG;
  p0 = negm; p1 = negm;
  constexpr int NB = (KROWB == 256 && ATT_KEYMASK128 == 15) ? 8 : 4;
#pragma unroll
  for (int d0 = 0; d0 < ND0; ++d0) {
    bf16x8 b0 = *reinterpret_cast<const bf16x8*>(Ks + kb[d0 % NB] + (d0 / NB) * (NB * 32));
    bf16x8 b1 = *reinterpret_cast<const bf16x8*>(Ks + kb[d0 % NB] + (d0 / NB) * (NB * 32) + 32 * KROWB);
    bf16x8 q; if (d0 < QREG) q = qr[d0]; else q = *reinterpret_cast<const bf16x8*>(qx + (d0 - QREG) * 1024);
    p0 = __builtin_amdgcn_mfma_f32_32x32x16_bf16(b0, q, p0, 0, 0, 0);
    p1 = __builtin_amdgcn_mfma_f32_32x32x16_bf16(b1, q, p1, 0, 0, 0); }
}
__device__ __forceinline__ int v_st(int k, int c) { const int kk = (k & ~0xC) | ((k & 4) << 1) | ((k & 8) >> 1); return ((kk >> 3) * 4 + (c >> 5)) * 512 + ((kk & 7) * 32 + (c & 31)) * 2; }
__device__ __forceinline__ int v_rd_base(int lane) { return ((lane & 3) << 3) | (((lane >> 2) & 3) << 6) | (((lane >> 4) & 1) << 5) | (((lane >> 5) & 1) << 8); }
constexpr int v_rd_off(int d0, int ks, int half) { return d0 * 512 + ks * 4096 + half * 2048; }
template <int OFF> __device__ __forceinline__ s16x4 tr_read(int vb) {
  s16x4 r; asm volatile("ds_read_b64_tr_b16 %0, %1 offset:%2" : "=&v"(r) : "v"(vb), "i"(OFF) : "memory"); return r;
}
#define ATT_PK(L, H) (bf16x8){L[0], L[1], L[2], L[3], H[0], H[1], H[2], H[3]}
template <int D0> __device__ __forceinline__ void pv_one(f32x16& od, lds_cptr vp, bf16x8 pa0, bf16x8 pa1, bf16x8 pa2, bf16x8 pa3) {
  const s16x4 l0 = vtr(vp + v_rd_off(D0, 0, 0)), h0 = vtr(vp + v_rd_off(D0, 0, 1)), l1 = vtr(vp + v_rd_off(D0, 1, 0)), h1 = vtr(vp + v_rd_off(D0, 1, 1));
  const s16x4 l2 = vtr(vp + v_rd_off(D0, 2, 0)), h2 = vtr(vp + v_rd_off(D0, 2, 1)), l3 = vtr(vp + v_rd_off(D0, 3, 0)), h3 = vtr(vp + v_rd_off(D0, 3, 1));
  od = __builtin_amdgcn_mfma_f32_32x32x16_bf16(pa0, ATT_PK(l0, h0), od, 0, 0, 0);
  od = __builtin_amdgcn_mfma_f32_32x32x16_bf16(pa1, ATT_PK(l1, h1), od, 0, 0, 0);
  od = __builtin_amdgcn_mfma_f32_32x32x16_bf16(pa2, ATT_PK(l2, h2), od, 0, 0, 0);
  od = __builtin_amdgcn_mfma_f32_32x32x16_bf16(pa3, ATT_PK(l3, h3), od, 0, 0, 0);
}
__device__ __forceinline__ void pv_d0(f32x16* o, lds_cptr vp, bf16x8 pa0, bf16x8 pa1, bf16x8 pa2, bf16x8 pa3) {
  pv_one<0>(o[0], vp, pa0, pa1, pa2, pa3); pv_one<1>(o[1], vp, pa0, pa1, pa2, pa3); pv_one<2>(o[2], vp, pa0, pa1, pa2, pa3); pv_one<3>(o[3], vp, pa0, pa1, pa2, pa3);
}
template <int NGRP, int MG, int NVALU, int NDS, int NPRE, int NLEAD = 0, int NVALU2 = 0> __device__ __forceinline__ void sched_pipe() {
  __builtin_amdgcn_sched_group_barrier(0x100, NPRE, 0);
#pragma unroll
  for (int i = 0; i < NGRP; ++i) { __builtin_amdgcn_sched_group_barrier(0x008, MG, 0);
    if (i >= NLEAD) __builtin_amdgcn_sched_group_barrier(0x002, (NLEAD > 0) ? NVALU2 : NVALU, 0);
    __builtin_amdgcn_sched_group_barrier(0x100, NDS, 0); }
}

template <int DQK, int LDQ, int LDK, int LDV, int LDO, int SD>
__device__ __forceinline__ void attn_unit(const bf16* __restrict__ Qb, const bf16* __restrict__ Kh, const bf16* __restrict__ Kr, const bf16* __restrict__ Vh,
                                          bf16* __restrict__ Ob, int seq, char* lds, float* tmout = nullptr) {
  constexpr int KROWB = Cfg<DQK>::KROWB, SHM_K = Cfg<DQK>::SHM_K, SHM_V = Cfg<DQK>::SHM_V, ND0 = Cfg<DQK>::ND0;
  const int tid = threadIdx.x, wid = __builtin_amdgcn_readfirstlane(tid >> 6), lane = tid & 63, r32 = lane & 31, hi = lane >> 5;
  char* V_lds = lds; char* K_lds = lds + 2 * SHM_V;
  float* ws = (float*)(lds + 2 * SHM_V + 2 * SHM_K) + wid * 64; float* li_l = ws; float* al_l = ws + 32;
  float m_ref = 0.f, l_reg = 0; f32x16 o[4] = {}; f32x16 negm = {}; constexpr int QREG = Cfg<DQK>::QREG; bf16x8 qr[QREG];
  const bf16* Qw = Qb + (long)(wid * QBLK + r32) * LDQ + hi * 8;
  char* qx = lds + 2 * SHM_V + 2 * SHM_K + NW * 64 * 4 + wid * Cfg<DQK>::QXW + lane * 16;
#pragma unroll
  for (int d0 = 0; d0 < QREG; ++d0) qr[d0] = ld8(Qw + d0 * 16);
  if constexpr (QREG < ND0) {
#pragma unroll
    for (int d0 = QREG; d0 < ND0; ++d0) *(bf16x8*)(qx + (d0 - QREG) * 1024) = ld8(Qw + d0 * 16);
  }
  const int sr = tid >> 4, sc = (tid & 15) * 8, vst0 = v_st(sr, sc), vst1 = v_st(32 + sr, sc);
  const int krr = tid >> 3, krc = (tid & 7) * 8;
  const lds_cptr vb0 = (lds_cptr)V_lds + v_rd_base(lane);
  constexpr int NB = (KROWB == 256 && ATT_KEYMASK128 == 15) ? 8 : 4; int kb[NB];
#pragma unroll
  for (int dl = 0; dl < NB; ++dl) kb[dl] = r32 * KROWB + ((dl * 32 + hi * 16) ^ (ATT_KEY(r32) << 4));
  const unsigned boV = (unsigned)(sr * LDV + sc) * 2u, boK = (unsigned)(sr * LDK + sc) * 2u, boR = (unsigned)(krr * 64 + krc) * 2u;
  struct { bf16x8 vs0, vs1, ks0, ks1, kr; } sr_[SD];
#define SLOAD(i, k0) do { const char* vt_ = (const char*)(Vh + (long)(k0) * LDV); const char* kt_ = (const char*)(Kh + (long)(k0) * LDK); \
    sr_[i].vs0 = *(const bf16x8*)(vt_ + boV); sr_[i].vs1 = *(const bf16x8*)(vt_ + 32 * LDV * 2 + boV); \
    sr_[i].ks0 = *(const bf16x8*)(kt_ + boK); sr_[i].ks1 = *(const bf16x8*)(kt_ + 32 * LDK * 2 + boK); \
    if constexpr (DQK == 192) { const char* rt_ = (const char*)(Kr + (long)(k0) * 64); sr_[i].kr = *(const bf16x8*)(rt_ + boR); } } while (0)
#define SWRITE(b, i) do { *(bf16x8*)(V_lds + (b) * SHM_V + vst0) = sr_[i].vs0;          \
    *(bf16x8*)(V_lds + (b) * SHM_V + vst1) = sr_[i].vs1; int kc = sc * 2;               \
    *(bf16x8*)(K_lds + (b) * SHM_K + ATT_KSWZ(sr, kc)) = sr_[i].ks0;                       \
    *(bf16x8*)(K_lds + (b) * SHM_K + ATT_KSWZ(32 + sr, kc)) = sr_[i].ks1;                  \
    if constexpr (DQK == 192) *(bf16x8*)(K_lds + (b) * SHM_K + ATT_KSWZ(krr, 256 + krc * 2)) = sr_[i].kr; } while (0)
#define SWAIT() do { if constexpr (SD == 2) { if constexpr (DQK == 192) asm volatile("s_waitcnt vmcnt(5)" ::: "memory"); else asm volatile("s_waitcnt vmcnt(4)" ::: "memory"); } \
    else asm volatile("s_waitcnt vmcnt(0)" ::: "memory"); } while (0)
#define RESC_APPLY() do { l_reg *= alp; if (hi == 0) al_l[r32] = alp; asm volatile("s_waitcnt lgkmcnt(0)" ::: "memory"); \
    _Pragma("unroll") for (int d = 0; d < 4; ++d) _Pragma("unroll") for (int r = 0; r < 16; ++r) o[d][r] *= al_l[crow(r, hi)]; pend = false; } while (0)
#define RESCN(ps_) do { if (pend) { RESC_APPLY(); } else { const bool t_ = (ps_) > TRIG; const float d_ = t_ ? __builtin_amdgcn_logf(ps_) : 0.f; alp = __builtin_amdgcn_exp2f(-d_); m_ref += d_; pend = __any(t_); } \
    _Pragma("unroll") for (int r = 0; r < 16; ++r) negm[r] = -m_ref; } while (0)
  float alp = 1.f; bool pend = false;
  f32x16 pA0, pA1, pB0, pB1; float psA, psB; bf16x8 pa0, pa1, pa2, pa3; const int NT = seq / KVBLK;
  constexpr int SE = 0, SO = SD - 1;
  SLOAD(SE, 0); asm volatile("s_waitcnt vmcnt(0)" ::: "memory"); SWRITE(0, SE); __syncthreads();
  qkt<DQK>(pA0, pA1, negm, K_lds, kb, qr, qx, r32, hi); firstSM(pA0, pA1, m_ref, negm);
  SLOAD(SO, KVBLK); if constexpr (SD == 2) { if (2 < NT) SLOAD(SE, 2 * KVBLK); }
  SWAIT(); SWRITE(1, SO); __syncthreads();
#define SCHED_A() do { if constexpr (DQK == 128) sched_pipe<16, 1, ATT_NVA128, 1, ATT_PREA>(); else sched_pipe<24 / ATT_MG192, ATT_MG192, ATT_NVA192 * ATT_MG192, ATT_DS192, ATT_PREA>(); } while (0)
#define SCHED_B() sched_pipe<16, 1, ATT_NVB, 2, ATT_PREB>()
#if ATT_PRIOMODE == 2
#define PRIO_A() do { if (wid >= 4) __builtin_amdgcn_s_setprio(1); else __builtin_amdgcn_s_setprio(0); } while (0)
#define PRIO_B() do { if (wid >= 4) __builtin_amdgcn_s_setprio(0); else __builtin_amdgcn_s_setprio(1); } while (0)
#elif ATT_PRIOMODE == 3
#define PRIO_A() do { if (wid >= 4) __builtin_amdgcn_s_setprio(0); else __builtin_amdgcn_s_setprio(1); } while (0)
#define PRIO_B() do { if (wid >= 4) __builtin_amdgcn_s_setprio(1); else __builtin_amdgcn_s_setprio(0); } while (0)
#else
#define PRIO_A() ((void)0)
#define PRIO_B() ((void)0)
#endif
#ifdef ATT_TIMING
  unsigned long long tmA = 0, tmB = 0, tmW = 0, tmW1 = 0, tmS = 0, tmB2 = 0;
#define TMS() __builtin_readcyclecounter()
#else
#define TMS() 0ull
#endif
  for (int j = 1; j + 1 < NT; j += 2) {
    const unsigned long long t0_ = TMS();
    PRIO_A(); ATT_SBAR(); qkt<DQK>(pB0, pB1, negm, K_lds + SHM_K, kb, qr, qx, r32, hi);
    finishSM(pA0, pA1, psA, l_reg, pa0, pa1, pa2, pa3); SCHED_A(); ATT_SBAR();
    const unsigned long long t1_ = TMS();
    PRIO_B(); SLOAD(SO, (j + SD) * KVBLK); ATT_SBAR();
    pv_d0(o, vb0, pa0, pa1, pa2, pa3); partialSM(pB0, pB1); SCHED_B(); ATT_SBAR();
    const unsigned long long t2_ = TMS();
    __syncthreads(); const unsigned long long t3_ = TMS(); SWAIT(); const unsigned long long t3b_ = TMS(); SWRITE(0, SE);
    RESCN(psA); asm volatile("s_waitcnt lgkmcnt(0)" ::: "memory"); const unsigned long long t3c_ = TMS(); __syncthreads();
    const unsigned long long t4_ = TMS();
#ifdef ATT_TIMING
    tmA += t1_ - t0_; tmB += t2_ - t1_; tmW1 += t3_ - t2_; tmW += t4_ - t3_; tmS += t3b_ - t3_; tmB2 += t4_ - t3c_;
#endif
    PRIO_A(); ATT_SBAR(); qkt<DQK>(pA0, pA1, negm, K_lds, kb, qr, qx, r32, hi);
    finishSM(pB0, pB1, psB, l_reg, pa0, pa1, pa2, pa3); SCHED_A(); ATT_SBAR();
    PRIO_B(); if (SD == 1 || j + 3 < NT) SLOAD(SE, (j + 1 + SD) * KVBLK); ATT_SBAR();
    pv_d0(o, vb0 + SHM_V, pa0, pa1, pa2, pa3); partialSM(pA0, pA1); SCHED_B(); ATT_SBAR();
    __syncthreads(); SWAIT(); SWRITE(1, SO);
    RESCN(psB); __syncthreads();
  }
  ATT_SBAR(); qkt<DQK>(pB0, pB1, negm, K_lds + SHM_K, kb, qr, qx, r32, hi);
  finishSM(pA0, pA1, psA, l_reg, pa0, pa1, pa2, pa3); ATT_SBAR();
  pv_d0(o, vb0, pa0, pa1, pa2, pa3); partialSM(pB0, pB1);
  __syncthreads(); if (pend) { RESC_APPLY(); }
  finishSM(pB0, pB1, psB, l_reg, pa0, pa1, pa2, pa3); ATT_SBAR();
  pv_d0(o, vb0 + SHM_V, pa0, pa1, pa2, pa3);
#undef SCHED_A
#undef SCHED_B
  __builtin_amdgcn_s_setprio(0);
#ifdef ATT_TIMING
  if (tmout && blockIdx.x == 0 && tid == ATT_TWAVE * 64) { const float inv = 1.0f / (float)((NT - 2) / 2); tmout[0] = (float)tmA * inv; tmout[1] = (float)tmB * inv; tmout[2] = (float)tmW1 * inv; tmout[3] = (float)tmW * inv; tmout[4] = (float)tmS * inv; tmout[5] = (float)tmB2 * inv; }
#endif
  if (hi == 0) li_l[r32] = l_reg; asm volatile("s_waitcnt lgkmcnt(0)" ::: "memory");
  float rli[16];
#pragma unroll
  for (int r = 0; r < 16; ++r) rli[r] = __builtin_amdgcn_rcpf(li_l[crow(r, hi)]);
  { int r32e = r32, hie = hi; asm volatile("" : "+v"(r32e), "+v"(hie));
    char* Ow = (char*)(Ob + (long)(wid * QBLK) * LDO);
    const unsigned lo_ = (unsigned)(((r32e >> 5) + 4 * hie) * LDO + (r32e & 31)) * 2u;
#pragma unroll
    for (int r = 0; r < 16; ++r) {
#pragma unroll
      for (int d0 = 0; d0 < 4; ++d0) *(bf16*)(Ow + lo_ + (unsigned)((((r & 3) + 8 * (r >> 2)) * LDO + d0 * 32) * 2)) = (bf16)(cvtpk(o[d0][r] * rli[r], 0.f) & 0xffffu); } }
  asm volatile("s_waitcnt vmcnt(0) lgkmcnt(0)" ::: "memory"); __syncthreads();
#undef SLOAD
#undef SWRITE
#undef SWAIT
#undef RESCN
#undef RESC_APPLY
}
template <int DQK, int LDQ, int LDK, int LDV, int LDO>
__device__ __forceinline__ void attn_unit_dma(const bf16* __restrict__ Qb, const bf16* __restrict__ Kh, const bf16* __restrict__ Kr, const bf16* __restrict__ Vh,
                                              bf16* __restrict__ Ob, int seq, char* lds, int spos = 0, const float* __restrict__ qgain = nullptr) {
  constexpr int KROWB = Cfg<DQK>::KROWB, SHM_K = Cfg<DQK>::SHM_K, SHM_V = Cfg<DQK>::SHM_V, ND0 = Cfg<DQK>::ND0;
  typedef __attribute__((address_space(3))) unsigned lds_u32;
  int tid_ = threadIdx.x; asm volatile("" : "+v"(tid_));
  const int tid = tid_, wid = __builtin_amdgcn_readfirstlane(tid >> 6), lane = tid & 63, r32 = lane & 31, hi = lane >> 5;
  char* V_lds = lds; char* K_lds = lds + 2 * SHM_V;
  float* ws = (float*)(lds + 2 * SHM_V + 2 * SHM_K) + wid * 64; float* li_l = ws; float* al_l = ws + 32;
  float m_ref = 0.f, l_reg = 0; f32x16 o[4] = {}; f32x16 negm = {}; constexpr int QREG = Cfg<DQK>::QREG; bf16x8 qr[QREG];
  const bf16* Qw = Qb + (long)(wid * QBLK + r32) * LDQ + hi * 8;
  char* qx = lds + 2 * SHM_V + 2 * SHM_K + NW * 64 * 4 + wid * Cfg<DQK>::QXW + lane * 16;
  if constexpr (DQK == 128) {
    int hiq = hi; asm volatile("" : "+v"(hiq));
    u32x4 raw[8]; float ss = 0.f;
#pragma unroll
    for (int d0 = 0; d0 < 8; ++d0) { const bf16x8 t8 = ld8(Qw + d0 * 16); raw[d0] = *reinterpret_cast<const u32x4*>(&t8); }
#pragma unroll
    for (int d0 = 0; d0 < 8; ++d0)
#pragma unroll
      for (int e = 0; e < 4; ++e) { const float x1 = __uint_as_float(raw[d0][e] << 16), x2 = __uint_as_float(raw[d0][e] & 0xffff0000u); ss += x1 * x1 + x2 * x2; }
    { auto rr = __builtin_amdgcn_permlane32_swap(__float_as_uint(ss), __float_as_uint(ss), false, false); ss = __uint_as_float(rr[0]) + __uint_as_float(rr[1]); }
    const float rs = (1.0f / sqrtf(ss * (1.f / 128.f) + 1e-6f)) * Cfg<128>::C;
    int r32q = r32; asm volatile("" : "+v"(r32q));
    const int sq = spos + wid * QBLK + r32q; const float posr = (float)(sq >> 6), posc = (float)(sq & 63);
#pragma unroll
    for (int d0 = 0; d0 < 8; ++d0) { const float pos = (d0 < 4) ? posr : posc;
      const float* gp = qgain + d0 * 16 + hiq * 8; u32x4 w;
#pragma unroll
      for (int e = 0; e < 4; ++e) { const int j = (d0 & 3) * 8 + hiq * 4 + e; const float invf = __builtin_amdgcn_exp2f(-(float)j * (13.287712379549449f / 32.f));
        const float ang = pos * invf; double rev = (double)ang * 0.15915494309189535; rev -= __builtin_rint(rev); const float fr = (float)rev;
        const float c = __builtin_amdgcn_cosf(fr), sn = __builtin_amdgcn_sinf(fr);
        const float y1 = __uint_as_float(raw[d0][e] << 16) * rs * gp[2 * e], y2 = __uint_as_float(raw[d0][e] & 0xffff0000u) * rs * gp[2 * e + 1];
        w[e] = cvtpk(y1 * c - y2 * sn, y1 * sn + y2 * c); }
      qr[d0] = *reinterpret_cast<bf16x8*>(&w); }
  } else {
#pragma unroll
  for (int d0 = 0; d0 < QREG; ++d0) qr[d0] = ld8(Qw + d0 * 16);
  }
  if constexpr (QREG < ND0) {
#pragma unroll
    for (int d0 = QREG; d0 < ND0; ++d0) { bf16x8 qv = ld8(Qw + d0 * 16);
      if (DQK == 192 && d0 >= 8) {
        int hiq = hi; asm volatile("" : "+v"(hiq));
        const int sq = spos + wid * QBLK + r32; const float pos = (float)((d0 < 10) ? (sq >> 6) : (sq & 63));
        u32x4 w = *reinterpret_cast<u32x4*>(&qv);
#pragma unroll
        for (int e = 0; e < 4; ++e) { const int j = ((d0 - 8) & 1) * 8 + hiq * 4 + e; const float invf = __builtin_amdgcn_exp2f(-(float)j * (13.287712379549449f / 16.f));
          const float ang = pos * invf; double rev = (double)ang * 0.15915494309189535; rev -= __builtin_rint(rev); const float fr = (float)rev;
          const float c = __builtin_amdgcn_cosf(fr), sn = __builtin_amdgcn_sinf(fr);
          const float x1 = __uint_as_float(w[e] << 16), x2 = __uint_as_float(w[e] & 0xffff0000u); w[e] = cvtpk(x1 * c - x2 * sn, x1 * sn + x2 * c); }
        qv = *reinterpret_cast<bf16x8*>(&w); }
      *(bf16x8*)(qx + (d0 - QREG) * 1024) = qv; }
  }
  const lds_cptr vb0 = (lds_cptr)V_lds + v_rd_base(lane);
  constexpr int NB = (KROWB == 256 && ATT_KEYMASK128 == 15) ? 8 : 4; int kb[NB];
#pragma unroll
  for (int dl = 0; dl < NB; ++dl) kb[dl] = r32 * KROWB + ((dl * 32 + hi * 16) ^ (ATT_KEY(r32) << 4));
  constexpr int NKI = SHM_K / 8192, SPR = KROWB / 16;
  unsigned voV[2]; const char* kp[NKI]; unsigned kst[NKI];
#pragma unroll
  for (int i = 0; i < 2; ++i) { const int s = i * 512 + wid * 64 + lane; const int kk = (((s >> 7) & 7) << 3) | ((s >> 2) & 7);
    const int k = (kk & ~0xC) | ((kk & 4) << 1) | ((kk & 8) >> 1), c = ((s >> 5) & 3) * 32 + (s & 3) * 8; voV[i] = (unsigned)(k * LDV + c) * 2u; }
#pragma unroll
  for (int i = 0; i < NKI; ++i) { const int s = i * 512 + wid * 64 + lane; const int row = s / SPR, cs = (s % SPR) * 16, colB = cs ^ (ATT_KEY(row) << 4);
    if (DQK == 192 && colB >= 256) { kp[i] = (const char*)Kr + (size_t)row * 128 + (colB - 256); kst[i] = 64u * 128u; }
    else { kp[i] = (const char*)Kh + (size_t)row * (LDK * 2) + colB; kst[i] = 64u * (unsigned)(LDK * 2); } }
  lds_u32* const ldsV = (lds_u32*)((__attribute__((address_space(3))) char*)V_lds + wid * 1024);
  lds_u32* const ldsK = (lds_u32*)((__attribute__((address_space(3))) char*)K_lds + wid * 1024);
#define DMA_V(t_, b_) do { const char* vt_ = (const char*)Vh + (size_t)(t_) * (64u * LDV * 2u); _Pragma("unroll") for (int i = 0; i < 2; ++i) \
    __builtin_amdgcn_global_load_lds((const unsigned*)(vt_ + voV[i]), (lds_u32*)((__attribute__((address_space(3))) char*)ldsV + (b_) * SHM_V + i * 8192), 16, 0, 0); } while (0)
#define DMA_K(t_, b_) do { _Pragma("unroll") for (int i = 0; i < NKI; ++i) \
    __builtin_amdgcn_global_load_lds((const unsigned*)(kp[i] + (size_t)(t_) * kst[i]), (lds_u32*)((__attribute__((address_space(3))) char*)ldsK + (b_) * SHM_K + i * 8192), 16, 0, 0); } while (0)
#define VMW0() asm volatile("s_waitcnt vmcnt(0)" ::: "memory")
#define RESC_APPLY() do { l_reg *= alp; if (hi == 0) al_l[r32] = alp; asm volatile("s_waitcnt lgkmcnt(0)" ::: "memory"); \
    _Pragma("unroll") for (int d = 0; d < 4; ++d) _Pragma("unroll") for (int r = 0; r < 16; ++r) o[d][r] *= al_l[crow(r, hi)]; pend = false; } while (0)
#define RESCN(ps_) do { if (pend) { RESC_APPLY(); } else { const bool t_ = (ps_) > TRIG; const float d_ = t_ ? __builtin_amdgcn_logf(ps_) : 0.f; alp = __builtin_amdgcn_exp2f(-d_); m_ref += d_; pend = __any(t_); } \
    _Pragma("unroll") for (int r = 0; r < 16; ++r) negm[r] = -m_ref; } while (0)
  float alp = 1.f; bool pend = false;
  f32x16 pA0, pA1, pB0, pB1; float psA, psB; bf16x8 pa0, pa1, pa2, pa3; const int NT = seq / KVBLK;
#define SCHED_A() do { if constexpr (DQK == 128) sched_pipe<16, 1, ATT_NVA128, 1, ATT_PREA, ATT_LEAD128, ATT_NVL128>(); else sched_pipe<24 / ATT_MG192, ATT_MG192, ATT_NVA192 * ATT_MG192, ATT_DS192, ATT_PREA, ATT_LEAD192, ATT_NVL192>(); } while (0)
#define SCHED_B() sched_pipe<16, 1, ATT_NVB, 2, ATT_PREB>()
#define STEP(C0, C1, s0C, P0, P1, s0P, psP, t_, KB, VB, haveK) do { DMA_V(t_, VB); if (haveK) DMA_K((t_) + 1, 1 - (KB)); ATT_SBAR(); \
    qkt<DQK>(C0, C1, negm, K_lds + (KB) * SHM_K, kb, qr, qx, r32, hi); finishSM2(P0, P1, s0P, psP, l_reg, pa0, pa1, pa2, pa3); SCHED_A(); ATT_SBAR(); \
    pv_d0(o, vb0 + (1 - (VB)) * SHM_V, pa0, pa1, pa2, pa3); partialSM2(C0, C1, s0C); SCHED_B(); ATT_SBAR(); \
    RESCN(psP); VMW0(); __syncthreads(); } while (0)
  float s0A = 0.f, s0B = 0.f;
  DMA_K(0, 0); VMW0(); __syncthreads();
  DMA_V(0, 0); DMA_K(1, 1);
  qkt<DQK>(pA0, pA1, negm, K_lds, kb, qr, qx, r32, hi); firstSM0(pA0, pA1, m_ref, negm); partialSM2(pA0, pA1, s0A);
  VMW0(); __syncthreads();
  for (int t = 1; t + 2 < NT; t += 2) {
    STEP(pB0, pB1, s0B, pA0, pA1, s0A, psA, t, 1, 1, true);
    STEP(pA0, pA1, s0A, pB0, pB1, s0B, psB, t + 1, 0, 0, true);
  }
  STEP(pB0, pB1, s0B, pA0, pA1, s0A, psA, NT - 1, 1, 1, false);
  finishSM2(pB0, pB1, s0B, psB, l_reg, pa0, pa1, pa2, pa3); ATT_SBAR();
  pv_d0(o, vb0 + SHM_V, pa0, pa1, pa2, pa3);
#undef STEP
#undef SCHED_A
#undef SCHED_B
  if (hi == 0) li_l[r32] = l_reg; asm volatile("s_waitcnt lgkmcnt(0)" ::: "memory");
  float rli[16];
#pragma unroll
  for (int r = 0; r < 16; ++r) rli[r] = __builtin_amdgcn_rcpf(li_l[crow(r, hi)]);
  { int r32e = r32, hie = hi; asm volatile("" : "+v"(r32e), "+v"(hie));
    char* Ow = (char*)(Ob + (long)(wid * QBLK) * LDO);
    const unsigned lo_ = (unsigned)((4 * hie) * LDO + r32e) * 2u;
#pragma unroll
    for (int r = 0; r < 16; ++r) {
#pragma unroll
      for (int d0 = 0; d0 < 4; ++d0) *(bf16*)(Ow + lo_ + (unsigned)((((r & 3) + 8 * (r >> 2)) * LDO + d0 * 32) * 2)) = (bf16)(cvtpk(o[d0][r] * rli[r], 0.f) & 0xffffu); } }
  asm volatile("s_waitcnt vmcnt(0) lgkmcnt(0)" ::: "memory"); __syncthreads();
#undef DMA_V
#undef DMA_K
#undef VMW0
#undef RESCN
#undef RESC_APPLY
}
template <int DQK, int LDQ, int LDK, int LDV, int LDO>
__device__ __forceinline__ void attn_unit_dmas(const bf16* __restrict__ Qb, const bf16* __restrict__ Kh, const bf16* __restrict__ Kr, const bf16* __restrict__ Vh,
                                              bf16* __restrict__ Ob, int seq, char* lds, int spos = 0) {
  constexpr int KROWB = Cfg<DQK>::KROWB, SHM_K = Cfg<DQK>::SHM_K, SHM_V = Cfg<DQK>::SHM_V, ND0 = Cfg<DQK>::ND0;
  typedef __attribute__((address_space(3))) unsigned lds_u32;
  const int tid = threadIdx.x, wid = __builtin_amdgcn_readfirstlane(tid >> 6), lane = tid & 63, r32 = lane & 31, hi = lane >> 5;
  char* V_lds = lds; char* K_lds = lds + 3 * SHM_V;
  float* ws = (float*)(lds + 3 * SHM_V + 2 * SHM_K) + wid * 64; float* li_l = ws; float* al_l = ws + 32;
  float m_ref = 0.f, l_reg = 0; f32x16 o[4] = {}; f32x16 negm = {}; constexpr int QREG = Cfg<DQK>::QREG; bf16x8 qr[QREG];
  const bf16* Qw = Qb + (long)(wid * QBLK + r32) * LDQ + hi * 8;
  char* qx = lds + 3 * SHM_V + 2 * SHM_K + NW * 64 * 4 + wid * Cfg<DQK>::QXW + lane * 16;
#pragma unroll
  for (int d0 = 0; d0 < QREG; ++d0) qr[d0] = ld8(Qw + d0 * 16);
  if constexpr (QREG < ND0) {
#pragma unroll
    for (int d0 = QREG; d0 < ND0; ++d0) { bf16x8 qv = ld8(Qw + d0 * 16);
      if (DQK == 192 && d0 >= 8) {
        int hiq = hi; asm volatile("" : "+v"(hiq));
        const int sq = spos + wid * QBLK + r32; const float pos = (float)((d0 < 10) ? (sq >> 6) : (sq & 63));
        u32x4 w = *reinterpret_cast<u32x4*>(&qv);
#pragma unroll
        for (int e = 0; e < 4; ++e) { const int j = ((d0 - 8) & 1) * 8 + hiq * 4 + e; const float invf = __builtin_amdgcn_exp2f(-(float)j * (13.287712379549449f / 16.f));
          const float ang = pos * invf; double rev = (double)ang * 0.15915494309189535; rev -= __builtin_rint(rev); const float fr = (float)rev;
          const float c = __builtin_amdgcn_cosf(fr), sn = __builtin_amdgcn_sinf(fr);
          const float x1 = __uint_as_float(w[e] << 16), x2 = __uint_as_float(w[e] & 0xffff0000u); w[e] = cvtpk(x1 * c - x2 * sn, x1 * sn + x2 * c); }
        qv = *reinterpret_cast<bf16x8*>(&w); }
      *(bf16x8*)(qx + (d0 - QREG) * 1024) = qv; }
  }
  const lds_cptr vb0 = (lds_cptr)V_lds + v_rd_base(lane);
  constexpr int NB = (KROWB == 256 && ATT_KEYMASK128 == 15) ? 8 : 4; int kb[NB];
#pragma unroll
  for (int dl = 0; dl < NB; ++dl) kb[dl] = r32 * KROWB + ((dl * 32 + hi * 16) ^ (ATT_KEY(r32) << 4));
  constexpr int NKI = SHM_K / 8192, SPR = KROWB / 16;
  unsigned voV[2]; const char* kp[NKI]; unsigned kst[NKI];
#pragma unroll
  for (int i = 0; i < 2; ++i) { const int s = i * 512 + wid * 64 + lane; const int kk = (((s >> 7) & 7) << 3) | ((s >> 2) & 7);
    const int k = (kk & ~0xC) | ((kk & 4) << 1) | ((kk & 8) >> 1), c = ((s >> 5) & 3) * 32 + (s & 3) * 8; voV[i] = (unsigned)(k * LDV + c) * 2u; }
#pragma unroll
  for (int i = 0; i < NKI; ++i) { const int s = i * 512 + wid * 64 + lane; const int row = s / SPR, cs = (s % SPR) * 16, colB = cs ^ (ATT_KEY(row) << 4);
    if (DQK == 192 && colB >= 256) { kp[i] = (const char*)Kr + (size_t)row * 128 + (colB - 256); kst[i] = 64u * 128u; }
    else { kp[i] = (const char*)Kh + (size_t)row * (LDK * 2) + colB; kst[i] = 64u * (unsigned)(LDK * 2); } }
  lds_u32* const ldsV = (lds_u32*)((__attribute__((address_space(3))) char*)V_lds + wid * 1024);
  lds_u32* const ldsK = (lds_u32*)((__attribute__((address_space(3))) char*)K_lds + wid * 1024);
#define DMA_V(t_, b_) do { const char* vt_ = (const char*)Vh + (size_t)(t_) * (64u * LDV * 2u); _Pragma("unroll") for (int i = 0; i < 2; ++i) \
    __builtin_amdgcn_global_load_lds((const unsigned*)(vt_ + voV[i]), (lds_u32*)((__attribute__((address_space(3))) char*)ldsV + (b_) + i * 8192), 16, 0, 0); } while (0)
#define DMA_K(t_, b_) do { _Pragma("unroll") for (int i = 0; i < NKI; ++i) \
    __builtin_amdgcn_global_load_lds((const unsigned*)(kp[i] + (size_t)(t_) * kst[i]), (lds_u32*)((__attribute__((address_space(3))) char*)ldsK + (b_) * SHM_K + i * 8192), 16, 0, 0); } while (0)
#define VMW0() asm volatile("s_waitcnt vmcnt(0)" ::: "memory")
#define RESC_APPLY() do { l_reg *= alp; if (hi == 0) al_l[r32] = alp; asm volatile("s_waitcnt lgkmcnt(0)" ::: "memory"); \
    _Pragma("unroll") for (int d = 0; d < 4; ++d) _Pragma("unroll") for (int r = 0; r < 16; ++r) o[d][r] *= al_l[crow(r, hi)]; pend = false; } while (0)
#define RESCN(ps_) do { if (pend) { RESC_APPLY(); } else { const bool t_ = (ps_) > TRIG; const float d_ = t_ ? __builtin_amdgcn_logf(ps_) : 0.f; alp = __builtin_amdgcn_exp2f(-d_); m_ref += d_; pend = __any(t_); } \
    _Pragma("unroll") for (int r = 0; r < 16; ++r) negm[r] = -m_ref; } while (0)
  float alp = 1.f; bool pend = false;
  f32x16 pA0, pA1, pB0, pB1; float psA, psB; bf16x8 pa0, pa1, pa2, pa3; const int NT = seq / KVBLK;
#define SCHED_A() do { if constexpr (DQK == 128) sched_pipe<16, 1, ATT_NVA128, 1, ATT_PREA>(); else sched_pipe<24 / ATT_MG192, ATT_MG192, ATT_NVA192 * ATT_MG192, ATT_DS192, ATT_PREA>(); } while (0)
#define SCHED_B() sched_pipe<16, 1, ATT_NVB, 2, ATT_PREB>()
#define NEXTV(v_) (((v_) == 2 * SHM_V) ? 0 : (v_) + SHM_V)
#define STEPS(C0, C1, P0, P1, psP, psPrev, t_, KB, vo_t, vo_tm1, vo_tm2, haveK, havePV) do { DMA_V(t_, vo_t); if (haveK) DMA_K((t_) + 1, 1 - (KB)); ATT_SBAR(); \
    if (isY) { if (havePV) { pv_d0(o, vb0 + (vo_tm2), pa0, pa1, pa2, pa3); } partialSM(P0, P1); SCHED_B(); ATT_SBAR(); RESCN(psPrev); } \
    else { qkt<DQK>(C0, C1, negm, K_lds + (KB) * SHM_K, kb, qr, qx, r32, hi); finishSM(P0, P1, psP, l_reg, pa0, pa1, pa2, pa3); SCHED_A(); } \
    ATT_SBAR(); \
    if (isY) { qkt<DQK>(C0, C1, negm, K_lds + (KB) * SHM_K, kb, qr, qx, r32, hi); finishSM(P0, P1, psP, l_reg, pa0, pa1, pa2, pa3); SCHED_A(); } \
    else { pv_d0(o, vb0 + (vo_tm1), pa0, pa1, pa2, pa3); partialSM(C0, C1); SCHED_B(); ATT_SBAR(); RESCN(psP); } \
    ATT_SBAR(); VMW0(); __syncthreads(); } while (0)
  const bool isY = wid >= 4;
  DMA_K(0, 0); VMW0(); __syncthreads();
  DMA_V(0, 0); DMA_K(1, 1);
  qkt<DQK>(pA0, pA1, negm, K_lds, kb, qr, qx, r32, hi); firstSM0(pA0, pA1, m_ref, negm);
  if (!isY) partialSM(pA0, pA1);
  VMW0(); __syncthreads();
  psA = 0.f; psB = 0.f;
  int v2 = 0, v1 = 0, v0 = SHM_V;
  STEPS(pB0, pB1, pA0, pA1, psA, psB, 1, 1, v0, v1, v2, true, false); v2 = v1; v1 = v0; v0 = NEXTV(v0);
  for (int t = 2; t + 1 < NT; t += 2) {
    STEPS(pA0, pA1, pB0, pB1, psB, psA, t, 0, v0, v1, v2, true, true); v2 = v1; v1 = v0; v0 = NEXTV(v0);
    STEPS(pB0, pB1, pA0, pA1, psA, psB, t + 1, 1, v0, v1, v2, (t + 2 < NT), true); v2 = v1; v1 = v0; v0 = NEXTV(v0);
  }
  if (isY) { pv_d0(o, vb0 + v2, pa0, pa1, pa2, pa3); partialSM(pB0, pB1); ATT_SBAR(); if (pend) { RESC_APPLY(); } }
  finishSM(pB0, pB1, psB, l_reg, pa0, pa1, pa2, pa3); ATT_SBAR();
  pv_d0(o, vb0 + v1, pa0, pa1, pa2, pa3);
#undef STEPS
#undef NEXTV
#undef SCHED_A
#undef SCHED_B
  if (hi == 0) li_l[r32] = l_reg; asm volatile("s_waitcnt lgkmcnt(0)" ::: "memory");
  float rli[16];
#pragma unroll
  for (int r = 0; r < 16; ++r) rli[r] = __builtin_amdgcn_rcpf(li_l[crow(r, hi)]);
  { int r32e = r32, hie = hi; asm volatile("" : "+v"(r32e), "+v"(hie));
    char* Ow = (char*)(Ob + (long)(wid * QBLK) * LDO);
    const unsigned lo_ = (unsigned)((4 * hie) * LDO + r32e) * 2u;
#pragma unroll
    for (int r = 0; r < 16; ++r) {
#pragma unroll
      for (int d0 = 0; d0 < 4; ++d0) *(bf16*)(Ow + lo_ + (unsigned)((((r & 3) + 8 * (r >> 2)) * LDO + d0 * 32) * 2)) = (bf16)(cvtpk(o[d0][r] * rli[r], 0.f) & 0xffffu); } }
  asm volatile("s_waitcnt vmcnt(0) lgkmcnt(0)" ::: "memory"); __syncthreads();
#undef DMA_V
#undef DMA_K
#undef VMW0
#undef RESCN
#undef RESC_APPLY
}
#undef ATT_KSWZ
#undef ATT_KEY
#undef ATT_PK
#undef ATT_SBAR
}
#define LAS __attribute__((address_space(3)))
typedef unsigned short u16;
typedef float f32x4 __attribute__((ext_vector_type(4)));
typedef short bf16x8 __attribute__((ext_vector_type(8)));
typedef unsigned u32x4 __attribute__((ext_vector_type(4)));
typedef unsigned u32x2 __attribute__((ext_vector_type(2)));
constexpr int DM = 2048, BATCH = 2, SEQ = 16384, T = BATCH * SEQ;
constexpr int IN0 = 4608, NLAT = 1088, NLATP = 1280, NQ = 3072, NKV = 4096, DFF = 8192;
constexpr float EPS = 1e-6f;
constexpr int NWAVES = 8, NTHREADS = 512;
constexpr int LDS_BYTES = 155648;
constexpr float LOG2_THETA = 13.287712379549449f;

constexpr size_t MiB = 1u << 20;
constexpr size_t WS_WIN = 0, WS_WOUT = 18 * MiB, WS_WDOWN = 26 * MiB, WS_WUQ = 31 * MiB, WS_WUKV = 34 * MiB, WS_WO = 38 * MiB;
constexpr size_t WS_WUP = 46 * MiB  , WS_WDN = 110 * MiB  ;
constexpr size_t WS_XN = 176 * MiB;
constexpr size_t WS_HB = 304 * MiB;
constexpr size_t WS_BIG = 432 * MiB;
constexpr size_t WS_PROJ = WS_BIG, WS_MIX = WS_BIG + 288 * MiB;
constexpr size_t WS_HID = WS_BIG;
constexpr size_t WS_Q = WS_BIG, WS_KV = WS_BIG + 192 * MiB, WS_LAT = WS_BIG + 448 * MiB, WS_KROPE = WS_BIG + 528 * MiB;
constexpr size_t WS_CQN = WS_LAT, WS_CKVN = WS_LAT;
constexpr size_t WS_AO = WS_XN;
constexpr size_t WS_CTL = WS_BIG + 532 * MiB, CTL_BAR = 65536, WS_SS = WS_CTL + CTL_BAR, CTL_BYTES = CTL_BAR + 5 * 131072;
constexpr size_t WS_END = WS_CTL + CTL_BYTES;

__device__ __forceinline__ float bflo(unsigned u) { return __uint_as_float(u << 16); }
__device__ __forceinline__ float bfhi(unsigned u) { return __uint_as_float(u & 0xffff0000u); }
__device__ __forceinline__ unsigned pk2(float lo, float hi) { unsigned r; asm volatile("v_cvt_pk_bf16_f32 %0, %1, %2" : "=v"(r) : "v"(lo), "v"(hi)); return r; }
__device__ __forceinline__ float wave_sum(float v) {
#pragma unroll
    for (int o = 1; o < 64; o <<= 1) v += __shfl_xor(v, o);
    return v;
}
__device__ __forceinline__ void rope_cs(float pos, float invf, float& c, float& s) {
    const float a = pos * invf;
    double rev = (double)a * 0.15915494309189535;
    rev -= __builtin_rint(rev);
    const float fr = (float)rev;
    c = __builtin_amdgcn_cosf(fr); s = __builtin_amdgcn_sinf(fr);
}

__device__ __forceinline__ void transpose_item(const float* __restrict__ W, const float* __restrict__ gain, float mul, int K, int N, u16* __restrict__ WT, LAS float* scr, int item, int lane) {
    const int nblk = N / 32, kb = item / nblk, nb = item % nblk, k0 = 64 * kb, n0 = 32 * nb;
    float wv[32];
#pragma unroll
    for (int i = 0; i < 32; ++i) { const int kk = 2 * i + (lane >> 5); wv[i] = W[(size_t)(k0 + kk) * N + n0 + (lane & 31)]; }
    float gv = 1.f; if (gain) gv = gain[k0 + lane] * mul;
#pragma unroll
    for (int i = 0; i < 32; ++i) { const int kk = 2 * i + (lane >> 5); const float g = __shfl(gv, kk); scr[kk * 33 + (lane & 31)] = wv[i] * g; }
    asm volatile("s_waitcnt lgkmcnt(0)" ::: "memory");
    const int c = lane & 7;
#pragma unroll
    for (int j = 0; j < 4; ++j) { const int n = (lane >> 3) + 8 * j; const LAS float* s = scr + (8 * c) * 33 + n;
        u32x4 o; o.x = pk2(s[0 * 33], s[1 * 33]); o.y = pk2(s[2 * 33], s[3 * 33]); o.z = pk2(s[4 * 33], s[5 * 33]); o.w = pk2(s[6 * 33], s[7 * 33]);
        *(u32x4*)(WT + (size_t)(n0 + n) * K + k0 + 8 * c) = o; }
    asm volatile("s_waitcnt lgkmcnt(0)" ::: "memory");
}

__device__ __forceinline__ void norm_row_bf16(const float* __restrict__ xrow, u16* __restrict__ orow, int lane) {
    const f32x4* xr = (const f32x4*)xrow + lane;
    f32x4 v[8]; float s = 0.f;
#pragma unroll
    for (int j = 0; j < 8; ++j) { v[j] = xr[64 * j]; s += (v[j].x * v[j].x + v[j].y * v[j].y) + (v[j].z * v[j].z + v[j].w * v[j].w); }
    const float r = 1.0f / sqrtf(wave_sum(s) * (1.f / DM) + EPS);
    u32x2* o8 = (u32x2*)orow + lane;
#pragma unroll
    for (int j = 0; j < 8; ++j) { u32x2 w; w.x = pk2(v[j].x * r, v[j].y * r); w.y = pk2(v[j].z * r, v[j].w * r); o8[64 * j] = w; }
}
__device__ __forceinline__ void norm_row_b2b(const u16* __restrict__ hrow, u16* __restrict__ orow, int lane) {
    const u32x4* xr = (const u32x4*)hrow + lane;
    u32x4 w[4]; float s = 0.f;
#pragma unroll
    for (int j = 0; j < 4; ++j) { w[j] = xr[64 * j];
#pragma unroll
        for (int e = 0; e < 4; ++e) { const float a = bflo(w[j][e]), b = bfhi(w[j][e]); s += a * a + b * b; } }
    const float r = 1.0f / sqrtf(wave_sum(s) * (1.f / DM) + EPS);
    u32x4* o = (u32x4*)orow + lane;
#pragma unroll
    for (int j = 0; j < 4; ++j) { u32x4 v;
#pragma unroll
        for (int e = 0; e < 4; ++e) v[e] = pk2(bflo(w[j][e]) * r, bfhi(w[j][e]) * r);
        o[64 * j] = v; }
}
__device__ __forceinline__ void norm_row_final(const u16* __restrict__ hrow, float* __restrict__ orow, const float* __restrict__ g, int lane) {
    const u32x4* xr = (const u32x4*)hrow + lane;
    u32x4 w[4]; float s = 0.f;
#pragma unroll
    for (int j = 0; j < 4; ++j) { w[j] = xr[64 * j];
#pragma unroll
        for (int e = 0; e < 4; ++e) { const float a = bflo(w[j][e]), b = bfhi(w[j][e]); s += a * a + b * b; } }
    const float r = 1.0f / sqrtf(wave_sum(s) * (1.f / DM) + EPS);
#pragma unroll
    for (int j = 0; j < 4; ++j) { const int c = (64 * j + lane) * 8; const f32x4 g0 = *(const f32x4*)(g + c), g1 = *(const f32x4*)(g + c + 4);
        f32x4 o0 = {bflo(w[j][0]) * r * g0[0], bfhi(w[j][0]) * r * g0[1], bflo(w[j][1]) * r * g0[2], bfhi(w[j][1]) * r * g0[3]};
        f32x4 o1 = {bflo(w[j][2]) * r * g1[0], bfhi(w[j][2]) * r * g1[1], bflo(w[j][3]) * r * g1[2], bfhi(w[j][3]) * r * g1[3]};
        *(f32x4*)(orow + c) = o0; *(f32x4*)(orow + c + 4) = o1; }
}

__device__ __forceinline__ void ld8f(const u16* p, float* f) {
    const u32x4 w = *(const u32x4*)p;
    f[0] = bflo(w.x); f[1] = bfhi(w.x); f[2] = bflo(w.y); f[3] = bfhi(w.y); f[4] = bflo(w.z); f[5] = bfhi(w.z); f[6] = bflo(w.w); f[7] = bfhi(w.w);
}

__device__ __forceinline__ void ew0_token(int t, u16* __restrict__ PROJ, u16* __restrict__ MIX, const float* __restrict__ qg, const float* __restrict__ kg, const float* __restrict__ cw, int lane) {
    const int s = t & (SEQ - 1), row = s >> 6, col = s & 63;
    float c, sn; { const int j = lane & 31; const float invf = __builtin_amdgcn_exp2f(-(float)j * (LOG2_THETA / 32.f)); rope_cs((float)(lane < 32 ? row : col), invf, c, sn); }
    unsigned* pr = (unsigned*)(PROJ + (size_t)t * IN0);
    const float qg0 = qg[2 * lane], qg1 = qg[2 * lane + 1], kg0 = kg[2 * lane], kg1 = kg[2 * lane + 1];
#pragma unroll
    for (int h = 0; h < 10; ++h) {
        const unsigned u = pr[h * 64 + lane]; const float x1 = bflo(u), x2 = bfhi(u);
        const float ss = wave_sum(x1 * x1 + x2 * x2); const float r = 1.0f / sqrtf(ss * (1.f / 128.f) + EPS);
        const float y1 = x1 * r * (h < 8 ? qg0 * att::Cfg<128>::C : kg0), y2 = x2 * r * (h < 8 ? qg1 * att::Cfg<128>::C : kg1);
        pr[h * 64 + lane] = pk2(y1 * c - y2 * sn, y1 * sn + y2 * c);
    }
    const u16* p0 = PROJ + (size_t)t * IN0;
#pragma unroll
    for (int ch = 0; ch < 2; ++ch) {
        const int cc = ch * 512 + lane * 8;
        float gb[8], g0[8], u0[8], gm[8], um[8], gp[8], up[8];
        ld8f(p0 + 1536 + cc, gb); ld8f(p0 + 2560 + cc, g0); ld8f(p0 + 3584 + cc, u0);
        if (s > 0) { ld8f(p0 - IN0 + 2560 + cc, gm); ld8f(p0 - IN0 + 3584 + cc, um); } else {
#pragma unroll
            for (int e = 0; e < 8; ++e) { gm[e] = 0.f; um[e] = 0.f; } }
        if (s < SEQ - 1) { ld8f(p0 + IN0 + 2560 + cc, gp); ld8f(p0 + IN0 + 3584 + cc, up); } else {
#pragma unroll
            for (int e = 0; e < 8; ++e) { gp[e] = 0.f; up[e] = 0.f; } }
        float o[8];
#pragma unroll
        for (int e = 0; e < 8; ++e) o[e] = gb[e] * (cw[cc + e] * (gm[e] * um[e]) + cw[1024 + cc + e] * (g0[e] * u0[e]) + cw[2048 + cc + e] * (gp[e] * up[e]));
        u32x4 w; w.x = pk2(o[0], o[1]); w.y = pk2(o[2], o[3]); w.z = pk2(o[4], o[5]); w.w = pk2(o[6], o[7]);
        *(u32x4*)(MIX + (size_t)t * DM + 1024 + cc) = w;
    }
}
__device__ __forceinline__ void cv8f(const u32x4 w, float* f) {
    f[0] = bflo(w.x); f[1] = bfhi(w.x); f[2] = bflo(w.y); f[3] = bfhi(w.y); f[4] = bflo(w.z); f[5] = bfhi(w.z); f[6] = bflo(w.w); f[7] = bfhi(w.w);
}
__device__ __forceinline__ void ew0_pair(int t, u16* __restrict__ PROJ, u16* __restrict__ MIX, const float* __restrict__ qg, const float* __restrict__ kg, const float* __restrict__ cw, int lane) {
    const int s = t & (SEQ - 1), row = s >> 6, col = s & 63;
    unsigned* pr0 = (unsigned*)(PROJ + (size_t)t * IN0); unsigned* pr1 = pr0 + IN0 / 2;
    const u16* p0 = PROJ + (size_t)t * IN0;
    unsigned ua[10], ub[10];
#pragma unroll
    for (int h = 8; h < 10; ++h) { ua[h] = pr0[h * 64 + lane]; ub[h] = pr1[h * 64 + lane]; }
    u32x4 rgb[2][2], rg[2][4], ru[2][4];
    const bool hasm = s > 0, hasp = s + 1 < SEQ - 1; const u32x4 z4 = {0u, 0u, 0u, 0u};
#pragma unroll
    for (int ch = 0; ch < 2; ++ch) { const int cc = ch * 512 + lane * 8;
        rgb[ch][0] = *(const u32x4*)(p0 + 1536 + cc); rgb[ch][1] = *(const u32x4*)(p0 + IN0 + 1536 + cc);
        rg[ch][1] = *(const u32x4*)(p0 + 2560 + cc); ru[ch][1] = *(const u32x4*)(p0 + 3584 + cc);
        rg[ch][2] = *(const u32x4*)(p0 + IN0 + 2560 + cc); ru[ch][2] = *(const u32x4*)(p0 + IN0 + 3584 + cc);
        rg[ch][0] = hasm ? *(const u32x4*)(p0 - IN0 + 2560 + cc) : z4; ru[ch][0] = hasm ? *(const u32x4*)(p0 - IN0 + 3584 + cc) : z4;
        rg[ch][3] = hasp ? *(const u32x4*)(p0 + 2 * IN0 + 2560 + cc) : z4; ru[ch][3] = hasp ? *(const u32x4*)(p0 + 2 * IN0 + 3584 + cc) : z4; }
    float c0, s0, c1, s1; { const int j = lane & 31; const float invf = __builtin_amdgcn_exp2f(-(float)j * (LOG2_THETA / 32.f));
        rope_cs((float)(lane < 32 ? row : col), invf, c0, s0); rope_cs((float)(lane < 32 ? row : col + 1), invf, c1, s1); }
    const float qg0 = qg[2 * lane] * att::Cfg<128>::C, qg1 = qg[2 * lane + 1] * att::Cfg<128>::C, kg0 = kg[2 * lane], kg1 = kg[2 * lane + 1];
#pragma unroll
    for (int h = 8; h < 10; ++h) {
        const float a1 = bflo(ua[h]), a2 = bfhi(ua[h]), b1 = bflo(ub[h]), b2 = bfhi(ub[h]);
        const float ra = 1.0f / sqrtf(wave_sum(a1 * a1 + a2 * a2) * (1.f / 128.f) + EPS), rb = 1.0f / sqrtf(wave_sum(b1 * b1 + b2 * b2) * (1.f / 128.f) + EPS);
        const float g0 = (h < 8 ? qg0 : kg0), g1 = (h < 8 ? qg1 : kg1);
        const float ya1 = a1 * ra * g0, ya2 = a2 * ra * g1, yb1 = b1 * rb * g0, yb2 = b2 * rb * g1;
        pr0[h * 64 + lane] = pk2(ya1 * c0 - ya2 * s0, ya1 * s0 + ya2 * c0);
        pr1[h * 64 + lane] = pk2(yb1 * c1 - yb2 * s1, yb1 * s1 + yb2 * c1);
    }
#pragma unroll
    for (int ch = 0; ch < 2; ++ch) {
        const int cc = ch * 512 + lane * 8;
        float gbA[8], gbB[8], gm[8], um[8], g0[8], u0[8], g1[8], u1[8], g2[8], u2[8];
        cv8f(rgb[ch][0], gbA); cv8f(rgb[ch][1], gbB); cv8f(rg[ch][0], gm); cv8f(ru[ch][0], um); cv8f(rg[ch][1], g0); cv8f(ru[ch][1], u0);
        cv8f(rg[ch][2], g1); cv8f(ru[ch][2], u1); cv8f(rg[ch][3], g2); cv8f(ru[ch][3], u2);
        float oa[8], ob[8];
#pragma unroll
        for (int e = 0; e < 8; ++e) { const float w0 = cw[cc + e], w1 = cw[1024 + cc + e], w2 = cw[2048 + cc + e];
            const float xm = gm[e] * um[e], x0 = g0[e] * u0[e], x1 = g1[e] * u1[e], x2 = g2[e] * u2[e];
            oa[e] = gbA[e] * (w0 * xm + w1 * x0 + w2 * x1); ob[e] = gbB[e] * (w0 * x0 + w1 * x1 + w2 * x2); }
        u32x4 wa; wa.x = pk2(oa[0], oa[1]); wa.y = pk2(oa[2], oa[3]); wa.z = pk2(oa[4], oa[5]); wa.w = pk2(oa[6], oa[7]);
        u32x4 wb; wb.x = pk2(ob[0], ob[1]); wb.y = pk2(ob[2], ob[3]); wb.z = pk2(ob[4], ob[5]); wb.w = pk2(ob[6], ob[7]);
        *(u32x4*)(MIX + (size_t)t * DM + 1024 + cc) = wa; *(u32x4*)(MIX + (size_t)(t + 1) * DM + 1024 + cc) = wb;
    }
}
__device__ __forceinline__ void ew1_token(int t, const u16* __restrict__ LAT, u16* __restrict__ CQN, u16* __restrict__ CKVN, u16* __restrict__ KROPE, int lane) {
    const u16* p0 = LAT + (size_t)t * NLATP;
#pragma unroll
    for (int part = 0; part < 2; ++part) {
        float x[8]; ld8f(p0 + part * 512 + lane * 8, x);
        float ss = 0.f;
#pragma unroll
        for (int e = 0; e < 8; ++e) ss += x[e] * x[e];
        const float r = 1.0f / sqrtf(wave_sum(ss) * (1.f / 512.f) + EPS);
        u32x4 w; w.x = pk2(x[0] * r, x[1] * r); w.y = pk2(x[2] * r, x[3] * r); w.z = pk2(x[4] * r, x[5] * r); w.w = pk2(x[6] * r, x[7] * r);
        *(u32x4*)((part ? CKVN : CQN) + (size_t)t * 512 + lane * 8) = w;
    }
    if (lane < 32) {
        const int s = t & (SEQ - 1), row = s >> 6, col = s & 63; const int j = lane & 15;
        const float invf = __builtin_amdgcn_exp2f(-(float)j * (LOG2_THETA / 16.f)); float c, sn; rope_cs((float)(lane < 16 ? row : col), invf, c, sn);
        const unsigned u = *(const unsigned*)(p0 + 1024 + 2 * lane); const float x1 = bflo(u), x2 = bfhi(u);
        *(unsigned*)(KROPE + (size_t)t * 64 + 2 * lane) = pk2(x1 * c - x2 * sn, x1 * sn + x2 * c);
    }
}
__device__ __forceinline__ void ew2_token(int t, u16* __restrict__ Q, int lane) {
    const int s = t & (SEQ - 1), row = s >> 6, col = s & 63;
    const int h = lane >> 2, part = lane & 3; const float pos = (float)(part < 2 ? row : col);
    u16* p = Q + (size_t)t * NQ + h * 192 + 128 + part * 16;
    float x[16]; ld8f(p, x); ld8f(p + 8, x + 8);
    unsigned w[8];
#pragma unroll
    for (int i = 0; i < 8; ++i) { const int j = (part & 1) * 8 + i; const float invf = __builtin_amdgcn_exp2f(-(float)j * (LOG2_THETA / 16.f)); float c, sn; rope_cs(pos, invf, c, sn);
        w[i] = pk2(x[2 * i] * c - x[2 * i + 1] * sn, x[2 * i] * sn + x[2 * i + 1] * c); }
    *(u32x4*)p = (u32x4){w[0], w[1], w[2], w[3]}; *(u32x4*)(p + 8) = (u32x4){w[4], w[5], w[6], w[7]};
}

#define RLX_AGENT __ATOMIC_RELAXED, __HIP_MEMORY_SCOPE_AGENT
#define XB_TMO      128
#define XB_XCNT(j)  (256  + 64 * (j))
#define XB_XSUB(j)  (1280 + 64 * (j))
#define XB_XGEN(j)  (2304 + 64 * (j))
#define XB_TOP      3328
#define XB_TOPGEN   3392
#define XCD_BAR_WORDS 3456
#define XB_SPIN_CAP (1u << 22)

__device__ __forceinline__ unsigned xb_ld(unsigned* p)              { return __hip_atomic_load(p, __ATOMIC_RELAXED, __HIP_MEMORY_SCOPE_AGENT); }
__device__ __forceinline__ unsigned xb_add(unsigned* p, unsigned v) { return __hip_atomic_fetch_add(p, v, __ATOMIC_RELAXED, __HIP_MEMORY_SCOPE_AGENT); }
__device__ __forceinline__ unsigned xb_xcc_id() { return (unsigned)__builtin_amdgcn_s_getreg((3 << 11) | 20) & 0xFu; }
#define XB_SPIN(cond, bar) do { unsigned _sp = 0; while (cond) { __builtin_amdgcn_s_sleep(1); \
    if ((++_sp & 255u) == 0u) { if (xb_ld(&(bar)[XB_TMO])) break; if (_sp > XB_SPIN_CAP) { atomicAdd(&(bar)[XB_TMO], 1u); break; } } } } while (0)

struct XcdBarrier {
    unsigned* bar; unsigned x;
    volatile LAS unsigned* st;
};

__device__ __forceinline__ XcdBarrier xcd_barrier_post(unsigned* bar, volatile LAS unsigned* st) {
    XcdBarrier b; b.bar = bar; b.x = xb_xcc_id(); b.st = st;
    if (threadIdx.x == 0) (void)xb_add(&bar[XB_XCNT(b.x)], 1u);
    return b;
}
__device__ __forceinline__ void xcd_barrier_complete(unsigned* bar, unsigned x, unsigned& nloc, unsigned& nx) {
    const unsigned G = gridDim.x * gridDim.y * gridDim.z;
    unsigned sum, cnt, mine, sp = 0u;
    for (;;) {
        sum = 0u; cnt = 0u; mine = 0u;
#pragma unroll
        for (unsigned j = 0; j < 16; ++j) { const unsigned c = xb_ld(&bar[XB_XCNT(j)]); sum += c; cnt += (c > 0u) ? 1u : 0u; mine = (j == x) ? c : mine; }
        if (sum == G) break;
        __builtin_amdgcn_s_sleep(1);
        if ((++sp & 255u) == 0u) { if (xb_ld(&bar[XB_TMO])) break; if (sp > XB_SPIN_CAP) { atomicAdd(&bar[XB_TMO], 1u); break; } }
    }
    nloc = mine > 0u ? mine : 1u; nx = cnt > 0u ? cnt : 1u;
}

__device__ __forceinline__ void xcd_barrier(const XcdBarrier& b) {
    asm volatile("s_waitcnt vmcnt(0)" ::: "memory");
    __syncthreads();
    if (threadIdx.x == 0) {
        unsigned* bar = b.bar;
        __builtin_amdgcn_s_waitcnt(0);
        unsigned nloc = b.st[0], nx = b.st[1];
        if (nloc == 0u) { xcd_barrier_complete(bar, b.x, nloc, nx); b.st[0] = nloc; b.st[1] = nx; }
        const unsigned old = xb_add(&bar[XB_XSUB(b.x)], 1u);
        const unsigned gen = old / nloc;
        if (old + 1u == (gen + 1u) * nloc) {
            __builtin_amdgcn_fence(__ATOMIC_RELEASE, "agent");
            asm volatile("s_waitcnt vmcnt(0)" ::: "memory");
            const unsigned og = xb_add(&bar[XB_TOP], 1u);
            const unsigned tg = og / nx;
            if (og + 1u == (tg + 1u) * nx) xb_add(&bar[XB_TOPGEN], 1u);
            else XB_SPIN(xb_ld(&bar[XB_TOPGEN]) == tg, bar);
            __builtin_amdgcn_fence(__ATOMIC_ACQUIRE, "agent");
            xb_add(&bar[XB_XGEN(b.x)], 1u);
            asm volatile("s_waitcnt vmcnt(0)" ::: "memory");
        } else {
            XB_SPIN(xb_ld(&bar[XB_XGEN(b.x)]) == gen, bar);
            __builtin_amdgcn_fence(__ATOMIC_ACQUIRE, "agent");
            asm volatile("s_waitcnt vmcnt(0)" ::: "memory");
        }
    }
    __syncthreads();
}

struct Params { const float* in[18]; float* out; unsigned char* ws; int ph_lo, ph_hi; };
enum { I_X = 0, I_ENG, I_EWIN, I_EQG, I_EKG, I_ECW, I_EWOUT, I_ONG, I_OWDOWN, I_OQG, I_OKVG, I_OWUQ, I_OWUKV, I_OWO, I_MNG, I_MWUP, I_MWDN, I_FNG };
constexpr int NPHASE = 19;

template <int DQK> __device__ __forceinline__ bool attn_next(int i, int NU, int& unit) {
    const int G = gridDim.x, bx = blockIdx.x;
    if ((G & 7) == 0 && (NU & 7) == 0) { const int x = bx & 7, j = bx >> 3, per = G >> 3, upx = NU >> 3; const int k = i * per + j; if (k >= upx) return false; unit = x * upx + k; return true; }
    const int k = i * G + bx; if (k >= NU) return false; unit = k; return true;
}

__global__ void __launch_bounds__(NTHREADS, 2) fwd_mega(Params P) {
    extern __shared__ __attribute__((aligned(16))) unsigned char lds[];
    cg::grid_group grid = cg::this_grid();
    const int tid = threadIdx.x, lane = tid & 63, wave = __builtin_amdgcn_readfirstlane(tid >> 6);
    const int G = gridDim.x, gw = blockIdx.x * NWAVES + wave, NGW = G * NWAVES;
    unsigned char* ws = P.ws;
    u16* Win = (u16*)(ws + WS_WIN); u16* Wout = (u16*)(ws + WS_WOUT); u16* Wdown = (u16*)(ws + WS_WDOWN); u16* Wuq = (u16*)(ws + WS_WUQ); u16* Wukv = (u16*)(ws + WS_WUKV); u16* Wo = (u16*)(ws + WS_WO);
    u16* Wup = (u16*)(ws + WS_WUP); u16* Wdn = (u16*)(ws + WS_WDN);
    u16* XN = (u16*)(ws + WS_XN); u16* PROJ = (u16*)(ws + WS_PROJ); u16* MIX = (u16*)(ws + WS_MIX); u16* HID = (u16*)(ws + WS_HID);
    u16* LAT = (u16*)(ws + WS_LAT); u16* CQN = (u16*)(ws + WS_CQN); u16* CKVN = (u16*)(ws + WS_CKVN); u16* KROPE = (u16*)(ws + WS_KROPE);
    u16* Qm = (u16*)(ws + WS_Q); u16* KVm = (u16*)(ws + WS_KV); u16* AO = (u16*)(ws + WS_AO);
    u16* HB = (u16*)(ws + WS_HB); float* SS0 = (float*)(ws + WS_SS); float* SS1 = SS0 + T; float* SS2 = SS1 + T; float* SSQ = SS2 + T; float* SSKV = SSQ + T; const float* NOSS = nullptr; float* NOSSW = nullptr;
    LAS unsigned char* ldsl = (LAS unsigned char*)lds;
    const int lo = P.ph_lo, hi = P.ph_hi;
    volatile LAS unsigned* xst = (volatile LAS unsigned*)(ldsl + LDS_BYTES - 16);
    if (tid < 4) xst[tid] = 0u;
    __syncthreads();
    XcdBarrier xbar = xcd_barrier_post((unsigned*)(ws + WS_CTL), xst);
#define PH(k) if (lo <= (k) && (k) < hi) _Pragma("unroll") for (int rep_ = 0; rep_ <= (int)((REP_MASK >> (k)) & 1u); ++rep_)
#define SEAM(k) do { if (lo <= (k) && (k) + 1 < hi) { if ((k) == 0) grid.sync(); else xcd_barrier(xbar); } } while (0)
#define GEMM_BF16X(ACT, Aptr, ldav, Bptr, Mv, Nv, Kv, Optr, ldc, ssptr, sso0p, sso1p) do { pg8::Gemm g{Aptr, Bptr, Mv, Nv, Kv, ldav}; pg8::StaticOrder S; S.init(Mv, Nv, G, (int)blockIdx.x); \
        pg8::EpiBf16<ACT> E{Optr, ldc, ssptr, 1.0f / (float)(Kv), EPS, sso0p, sso1p}; pg8::gemm_phase<pg8::EpiBf16<ACT>, pg8::StaticOrder, true, true>(ldsl, g, S, E); } while (0)
#define GEMM_BF16(ACT, Aptr, Bptr, Mv, Nv, Kv, Optr, ldc, ssptr) GEMM_BF16X(ACT, Aptr, Kv, Bptr, Mv, Nv, Kv, Optr, ldc, ssptr, NOSSW, NOSSW)
#define GEMM_RES(F32B, Aptr, Bptr, Mv, Nv, Kv, baseptr, ssptr) do { pg8::Gemm g{Aptr, Bptr, Mv, Nv, Kv, Kv}; pg8::StaticOrder S; S.init(Mv, Nv, G, (int)blockIdx.x); \
        pg8::EpiResB<F32B> E{baseptr, HB, Nv, ssptr}; pg8::gemm_phase<pg8::EpiResB<F32B>, pg8::StaticOrder, true, true>(ldsl, g, S, E); } while (0)
#define NORM_PHASE() do { for (int m = gw; m < T; m += NGW) norm_row_b2b(HB + (size_t)m * DM, XN + (size_t)m * DM, lane); } while (0)

    PH(0) {
        LAS float* scr = (LAS float*)(ldsl + wave * 16384);
        constexpr int I0 = (DM / 64) * (IN0 / 32), I1 = (DM / 64) * (DM / 32), I2 = (DM / 64) * (NLAT / 32), I3 = (512 / 64) * (NQ / 32), I4 = (512 / 64) * (NKV / 32), I5 = I1;
        constexpr int I6 = (DM / 64) * (DFF / 32), I7 = (DFF / 64) * (DM / 32);
        constexpr int NITEMS = I0 + I1 + I2 + I3 + I4 + I5 + 2 * I6 + 2 * I7;
        for (int it = gw; it < NITEMS; it += NGW) {
            int r = it;
            if (r < I0) { transpose_item(P.in[I_EWIN], P.in[I_ENG], 1.f, DM, IN0, Win, scr, r, lane); continue; } r -= I0;
            if (r < I1) { transpose_item(P.in[I_EWOUT], nullptr, 1.f, DM, DM, Wout, scr, r, lane); continue; } r -= I1;
            if (r < I2) { transpose_item(P.in[I_OWDOWN], P.in[I_ONG], 1.f, DM, NLAT, Wdown, scr, r, lane); continue; } r -= I2;
            if (r < I3) { transpose_item(P.in[I_OWUQ], P.in[I_OQG], att::Cfg<192>::C, 512, NQ, Wuq, scr, r, lane); continue; } r -= I3;
            if (r < I4) { transpose_item(P.in[I_OWUKV], P.in[I_OKVG], 1.f, 512, NKV, Wukv, scr, r, lane); continue; } r -= I4;
            if (r < I5) { transpose_item(P.in[I_OWO], nullptr, 1.f, DM, DM, Wo, scr, r, lane); continue; } r -= I5;
            if (r < I6) { transpose_item(P.in[I_MWUP], P.in[I_MNG], 1.f, DM, DFF, Wup, scr, r, lane); continue; } r -= I6;
            if (r < I6) { transpose_item(P.in[I_MWUP] + (size_t)DM * DFF, P.in[I_MNG] + DM, 1.f, DM, DFF, Wup + (size_t)DM * DFF, scr, r, lane); continue; } r -= I6;
            if (r < I7) { transpose_item(P.in[I_MWDN], nullptr, 1.f, DFF, DM, Wdn, scr, r, lane); continue; } r -= I7;
            transpose_item(P.in[I_MWDN] + (size_t)DM * DFF, nullptr, 1.f, DFF, DM, Wdn + (size_t)DM * DFF, scr, r, lane);
        }
        { const size_t n16 = (size_t)(NLATP - NLAT) * DM * 2 / 16; u32x4* z = (u32x4*)(Wdown + (size_t)NLAT * DM);
          for (size_t i = (size_t)blockIdx.x * NTHREADS + tid; i < n16; i += (size_t)G * NTHREADS) z[i] = (u32x4){0u, 0u, 0u, 0u}; }
        for (int m = gw; m < T; m += NGW) norm_row_bf16(P.in[I_X] + (size_t)m * DM, XN + (size_t)m * DM, lane);
    }
    SEAM(0);
    PH(1) { GEMM_BF16(0, XN, Win, T, IN0, DM, PROJ, IN0, NOSS); }
    SEAM(1);
    PH(2) { const int per = ((T / 2 + NGW - 1) / NGW) * 2; const int t0 = gw * per; for (int t = t0; t < t0 + per && t < T; t += 2) ew0_pair(t, PROJ, MIX, P.in[I_EQG], P.in[I_EKG], P.in[I_ECW], lane); }
    SEAM(2);
    PH(3) {
        if (ATT_PRIO && wave >= 4) __builtin_amdgcn_s_setprio(1);
        constexpr int NU = BATCH * 8 * (SEQ / 256); int unit;
        for (int i = 0; attn_next<128>(i, NU, unit); ++i) {
            const int bh = unit / (SEQ / 256), qb = unit % (SEQ / 256), b = bh >> 3, hq = bh & 7, kvh = hq >> 2;
            const size_t tb = (size_t)b * SEQ;
#ifndef NO_GQA
            att::ATT_UNIT<128, IN0, IN0, IN0, DM>(PROJ + (tb + (size_t)qb * 256) * IN0 + hq * 128, PROJ + tb * IN0 + 1024 + kvh * 128, nullptr, PROJ + tb * IN0 + 1280 + kvh * 128,
                                                      MIX + (tb + (size_t)qb * 256) * DM + hq * 128, SEQ, (char*)lds, qb * 256, P.in[I_EQG]);
#endif
        }
    }
    if (ATT_PRIO) __builtin_amdgcn_s_setprio(0);
    SEAM(3);
    PH(4) { GEMM_RES(true, MIX, Wout, T, DM, DM, (const void*)P.in[I_X], SS0); }
    SEAM(4);
    PH(6) { GEMM_BF16(2, HB, Wup, T, DFF, DM, HID, DFF, (const float*)SS0); }
    SEAM(6);
    PH(7) { GEMM_RES(false, HID, Wdn, T, DM, DFF, (const void*)HB, SS1); }
    SEAM(7);
    PH(9) { GEMM_BF16X(0, HB, DM, Wdown, T, NLATP, DM, LAT, NLATP, (const float*)SS1, SSQ, SSKV); }
    SEAM(9);
    PH(11) {
        for (int t = gw; t < T; t += NGW) if (lane < 32) {
            const int s = t & (SEQ - 1), row = s >> 6, col = s & 63; const int j = lane & 15;
            const float invf = __builtin_amdgcn_exp2f(-(float)j * (LOG2_THETA / 16.f)); float c, sn; rope_cs((float)(lane < 16 ? row : col), invf, c, sn);
            const unsigned u = *(const unsigned*)(LAT + (size_t)t * NLATP + 1024 + 2 * lane); const float x1 = bflo(u), x2 = bfhi(u);
            *(unsigned*)(KROPE + (size_t)t * 64 + 2 * lane) = pk2(x1 * c - x2 * sn, x1 * sn + x2 * c); }
        GEMM_BF16X(0, LAT, NLATP, Wuq, T, NQ, 512, Qm, NQ, (const float*)SSQ, NOSSW, NOSSW);
        GEMM_BF16X(0, LAT + 512, NLATP, Wukv, T, NKV, 512, KVm, NKV, (const float*)SSKV, NOSSW, NOSSW); }
    SEAM(11);
    PH(13) {
        if (ATT_PRIO && wave >= 4) __builtin_amdgcn_s_setprio(1);
        constexpr int NU = BATCH * 16 * (SEQ / 256); int unit;
        for (int i = 0; attn_next<192>(i, NU, unit); ++i) {
            const int bh = unit / (SEQ / 256), qb = unit % (SEQ / 256), b = bh >> 4, h = bh & 15;
            const size_t tb = (size_t)b * SEQ;
#ifndef NO_MLA
            att::ATT_UNIT<192, NQ, NKV, NKV, DM>(Qm + (tb + (size_t)qb * 256) * NQ + h * 192, KVm + tb * NKV + h * 256, KROPE + tb * 64, KVm + tb * NKV + h * 256 + 128,
                                                          AO + (tb + (size_t)qb * 256) * DM + h * 128, SEQ, (char*)lds, qb * 256);
#endif
        }
    }
    if (ATT_PRIO) __builtin_amdgcn_s_setprio(0);
    SEAM(13);
    PH(14) { GEMM_RES(false, AO, Wo, T, DM, DM, (const void*)HB, SS2); }
    SEAM(14);
    PH(16) { GEMM_BF16(2, HB, Wup + (size_t)DM * DFF, T, DFF, DM, HID, DFF, (const float*)SS2); }
    SEAM(16);
    PH(17) { GEMM_RES(false, HID, Wdn + (size_t)DM * DFF, T, DM, DFF, (const void*)HB, NOSSW); }
    SEAM(17);
    PH(18) { for (int m = gw; m < T; m += NGW) norm_row_final(HB + (size_t)m * DM, P.out + (size_t)m * DM, P.in[I_FNG], lane);
#ifdef ATT_TIMING
        if (blockIdx.x == 0 && tid == 0) { asm volatile("s_waitcnt vmcnt(0)" ::: "memory"); P.out[0] = floorf(((float*)(ws + WS_CTL + 32768))[ATT_TIMING] * (1.f / 200.f) + 0.5f) * 200000.f; }
#endif
    }
#undef PH
#undef SEAM
}

extern "C" void kernel_launch(void* const* d_in, const int* in_sizes, int n_in, void* d_out, int out_size, void* d_ws, size_t ws_size, hipStream_t stream) {
    static int grid = 0;
    if (grid == 0) {
        if (n_in != 18 || in_sizes[0] != T * DM || out_size != T * DM || ws_size < WS_END) {
            fprintf(stderr, "kernel_launch: shape mismatch (n_in %d in0 %d out %d ws %zu need %zu)\n", n_in, n_in > 0 ? in_sizes[0] : -1, out_size, ws_size, (size_t)WS_END); grid = -1; return; }
        int dev = 0, cus = 0, per_cu = 0;
        hipGetDevice(&dev); hipDeviceGetAttribute(&cus, hipDeviceAttributeMultiprocessorCount, dev);
        if (hipFuncSetAttribute((const void*)fwd_mega, hipFuncAttributeMaxDynamicSharedMemorySize, LDS_BYTES) != hipSuccess) { fprintf(stderr, "kernel_launch: hipFuncSetAttribute failed\n"); grid = -1; return; }
        if (hipOccupancyMaxActiveBlocksPerMultiprocessor(&per_cu, (const void*)fwd_mega, NTHREADS, LDS_BYTES) != hipSuccess || per_cu < 1) { fprintf(stderr, "kernel_launch: occupancy query says %d\n", per_cu); per_cu = 1; }
        (void)hipGetLastError();
        grid = cus * per_cu;
        fprintf(stderr, "kernel_launch: grid %d (cus %d x %d)\n", grid, cus, per_cu);
    }
    if (grid < 0) return;
    if (hipMemsetAsync((char*)d_ws + WS_CTL, 0, CTL_BYTES, stream) != hipSuccess) { fprintf(stderr, "kernel_launch: memset failed\n"); return; }
    Params p{};
    for (int i = 0; i < 18; ++i) p.in[i] = (const float*)d_in[i];
    p.out = (float*)d_out; p.ws = (unsigned char*)d_ws;
#if N_LAUNCH_SPLIT
    for (int k = 0; k < NPHASE; ++k) { p.ph_lo = k; p.ph_hi = k + 1; void* args[] = {&p};
        hipError_t e = hipLaunchCooperativeKernel((const void*)fwd_mega, dim3(grid), dim3(NTHREADS), args, LDS_BYTES, stream);
        if (e != hipSuccess) { fprintf(stderr, "cooperative launch failed: %s (grid %d)\n", hipGetErrorString(e), grid); break; } }
#else
    p.ph_lo = 0; p.ph_hi = NPHASE; void* args[] = {&p};
    hipError_t e = hipLaunchCooperativeKernel((const void*)fwd_mega, dim3(grid), dim3(NTHREADS), args, LDS_BYTES, stream);
    if (e != hipSuccess) fprintf(stderr, "cooperative launch failed: %s (grid %d)\n", hipGetErrorString(e), grid);
#endif
}
```

```cpp
#include <hip/hip_runtime.h>
#include <hip/hip_cooperative_groups.h>
#include <cstdio>
#include <cstdint>
namespace cg = cooperative_groups;
#ifndef GQA_SD
#define GQA_SD 1
#endif
#ifndef MLA_SD
#define MLA_SD 1
#endif
#ifndef MLA_QREG
#define MLA_QREG 8
#endif
#ifndef REP_MASK
#define REP_MASK 0u
#endif
#ifndef ATT_NVA128
#define ATT_NVA128 5
#endif
#ifndef ATT_NVA192
#define ATT_NVA192 3
#endif
#ifndef ATT_NVB
#define ATT_NVB 2
#endif
#ifndef ATT_PREA
#define ATT_PREA 4
#endif
#ifndef ATT_LEAD128
#define ATT_LEAD128 0
#endif
#ifndef ATT_NVL128
#define ATT_NVL128 7
#endif
#ifndef ATT_LEAD192
#define ATT_LEAD192 0
#endif
#ifndef ATT_NVL192
#define ATT_NVL192 8
#endif
#ifndef ATT_PREB
#define ATT_PREB 8
#endif
#ifndef PROBE_EW0
#define PROBE_EW0 0
#endif
#ifndef PROBE_DN
#define PROBE_DN 0
#endif
#ifndef PROBE_OUT
#define PROBE_OUT 0
#endif
#ifndef ATT_PRIO
#define ATT_PRIO 0
#endif
#ifndef ATT_PRIOMODE
#define ATT_PRIOMODE 0
#endif
#ifndef ATT_TWAVE
#define ATT_TWAVE 0
#endif
#ifndef ATT_KEYMASK128
#define ATT_KEYMASK128 15
#endif
#ifndef ATT_MG192
#define ATT_MG192 2
#endif
#ifndef ATT_DS192
#define ATT_DS192 2
#endif
#ifndef ATT_UNIT
#define ATT_UNIT attn_unit_dma
#endif
#ifndef N_LAUNCH_SPLIT
#define N_LAUNCH_SPLIT 0
#endif
namespace pg8 {
#define PG8_LAS __attribute__((address_space(3)))
typedef unsigned short bf16_t;
typedef short bf16x8 __attribute__((ext_vector_type(8)));
typedef float f32x4 __attribute__((ext_vector_type(4)));
typedef unsigned u32x4 __attribute__((ext_vector_type(4)));
constexpr int BM = 256, BK = 64, HALF = 128, HTB = HALF * BK * 2  , STAGE_BYTES = 8 * HTB, NXCD = 8, WGM = 8;

__host__ __device__ __forceinline__ int lds_byte(int r, int c) { const int st = (r >> 4) * 2 + (c >> 5), rr = r & 15, cc = c & 31, ob = rr * 64 + cc * 2; return st * 1024 + (ob ^ (((ob >> 9) & 1) << 5)); }
__host__ __device__ __forceinline__ void stage_rc(int b, int& R, int& C) { const int st = b / 1024, sb = b % 1024, swz = sb ^ (((sb >> 9) & 1) << 5); R = (st >> 1) * 16 + swz / 64; C = (st & 1) * 32 + (swz % 64) / 2; }
__host__ __device__ __forceinline__ int perm32(int rho) { const int n = rho >> 4, i = rho & 15; return 8 * (i >> 2) + 4 * n + (i & 3); }

struct Unit { int pm, pn; };
struct Gemm { const bf16_t* A; const bf16_t* Bt; int M, N, K, lda; };

struct StaticOrder {
    int nM, nN, nwg, G, c;
    __host__ __device__ void init(int M, int N, int G_, int c_) { nM = M / BM; nN = N / BM; nwg = nM * nN; G = G_; c = c_; }
    __host__ __device__ bool next(int i, Unit& u) const {
        const long L = (long)i * G + c; if (L >= nwg) return false;
        int wgid = (int)L; { const int q = nwg / NXCD, r = nwg % NXCD, xcd = wgid % NXCD, off = wgid / NXCD; wgid = (xcd < r ? xcd * (q + 1) : r * (q + 1) + (xcd - r) * q) + off; }
        const int nig = WGM * nN, gid = wgid / nig, fm = gid * WGM, gsz = (nM - fm) < WGM ? (nM - fm) : WGM;
        u.pm = fm + ((wgid % nig) % gsz); u.pn = (wgid % nig) / gsz; return true;
    }
    __device__ __forceinline__ void a_ready(const Unit&) const {}
    __device__ __forceinline__ void done(const Unit&) const {}
};
__device__ __forceinline__ unsigned cvt_pk_bf16(float lo, float hi) { unsigned r; asm volatile("v_cvt_pk_bf16_f32 %0, %1, %2" : "=v"(r) : "v"(lo), "v"(hi)); return r; }
template <int ACT> struct EpiBf16 {
    static constexpr bool PERM = true, AFTER_DRAIN = false;
    bf16_t* O; int ldc; const float* ss; float inv_k, eps;
    float* sso0; float* sso1;
    __device__ __forceinline__ void operator()(const f32x4 (&acc)[2][2][4][2], const Unit& u, int wr, int wc, int fr, int fq) const {
        const int row0 = u.pm * BM + wr * 64 + fr; const int col0 = u.pn * BM + wc * 32 + 8 * fq;
#pragma unroll
        for (int ai = 0; ai < 2; ++ai)
#pragma unroll
            for (int m = 0; m < 4; ++m) { const int row = row0 + ai * HALF + m * 16; bf16_t* rowp = O + (size_t)row * ldc + col0;
                const float rs = ss ? (1.0f / sqrtf(ss[row] * inv_k + eps)) : 1.0f;
                float q = 0.f;
#pragma unroll
                for (int bj = 0; bj < 2; ++bj) { f32x4 v0 = acc[ai][bj][m][0] * rs, v1 = acc[ai][bj][m][1] * rs;
                    q += (v0[0] * v0[0] + v0[1] * v0[1]) + (v0[2] * v0[2] + v0[3] * v0[3]) + (v1[0] * v1[0] + v1[1] * v1[1]) + (v1[2] * v1[2] + v1[3] * v1[3]);
                    if (ACT == 2) {
#pragma unroll
                        for (int e = 0; e < 4; ++e) { float a = v0[e] > 0.f ? v0[e] : 0.f; v0[e] = a * a; float b = v1[e] > 0.f ? v1[e] : 0.f; v1[e] = b * b; } }
                    u32x4 w; w.x = cvt_pk_bf16(v0[0], v0[1]); w.y = cvt_pk_bf16(v0[2], v0[3]); w.z = cvt_pk_bf16(v1[0], v1[1]); w.w = cvt_pk_bf16(v1[2], v1[3]);
                    *(u32x4*)(rowp + bj * HALF) = w; }
                if (sso0) { float* so = (u.pn < 2) ? sso0 : ((u.pn < 4) ? sso1 : nullptr);
                    if (so) { q += __shfl_xor(q, 16); q += __shfl_xor(q, 32); if (fq == 0) atomicAdd(so + row, q); } } }
    }
};
template <bool BASE_F32> struct EpiResB {
    static constexpr bool PERM = true, AFTER_DRAIN = false;
    const void* base; bf16_t* out; int ldc; float* ss;
    __device__ __forceinline__ void operator()(const f32x4 (&acc)[2][2][4][2], const Unit& u, int wr, int wc, int fr, int fq) const {
        const int row0 = u.pm * BM + wr * 64 + fr; const int col0 = u.pn * BM + wc * 32 + 8 * fq;
#pragma unroll
        for (int ai = 0; ai < 2; ++ai)
#pragma unroll
            for (int m = 0; m < 4; ++m) { const size_t off = (size_t)(row0 + ai * HALF + m * 16) * ldc + col0; float q = 0.f;
#pragma unroll
                for (int bj = 0; bj < 2; ++bj) { const size_t o = off + bj * HALF; f32x4 b0, b1;
                    if constexpr (BASE_F32) { b0 = *(const f32x4*)((const float*)base + o); b1 = *(const f32x4*)((const float*)base + o + 4); }
                    else { const u32x4 w = *(const u32x4*)((const bf16_t*)base + o);
                        b0 = (f32x4){__uint_as_float(w.x << 16), __uint_as_float(w.x & 0xffff0000u), __uint_as_float(w.y << 16), __uint_as_float(w.y & 0xffff0000u)};
                        b1 = (f32x4){__uint_as_float(w.z << 16), __uint_as_float(w.z & 0xffff0000u), __uint_as_float(w.w << 16), __uint_as_float(w.w & 0xffff0000u)}; }
                    const f32x4 v0 = b0 + acc[ai][bj][m][0], v1 = b1 + acc[ai][bj][m][1];
                    q += (v0[0] * v0[0] + v0[1] * v0[1]) + (v0[2] * v0[2] + v0[3] * v0[3]) + (v1[0] * v1[0] + v1[1] * v1[1]) + (v1[2] * v1[2] + v1[3] * v1[3]);
                    u32x4 r; r.x = cvt_pk_bf16(v0[0], v0[1]); r.y = cvt_pk_bf16(v0[2], v0[3]); r.z = cvt_pk_bf16(v1[0], v1[1]); r.w = cvt_pk_bf16(v1[2], v1[3]);
                    *(u32x4*)(out + o) = r; }
                if (ss) { q += __shfl_xor(q, 16); q += __shfl_xor(q, 32); if (fq == 0) atomicAdd(ss + (row0 + ai * HALF + m * 16), q); }
                asm volatile("" ::: "memory"); }
    }
};
template <class Epi, class Sched, bool ALIGN_EPI = false, bool SP2 = false>
__device__ __forceinline__ void gemm_phase(PG8_LAS unsigned char* lds, const Gemm g, const Sched& S, const Epi& E) {
    const int tid = threadIdx.x, wid = __builtin_amdgcn_readfirstlane(tid >> 6), lane = tid & 63, wr = wid >> 2, wc = wid & 3, fr = lane & 15, fq = lane >> 4;
    const int K = g.K, nt = K / BK;
    unsigned voffA[2], voffB[2];
#pragma unroll
    for (int i = 0; i < 2; ++i) { int R, C; stage_rc(tid * 16 + i * 8192, R, C); const int Rb = Epi::PERM ? ((R & ~31) + perm32(R & 31)) : R;
        voffA[i] = (unsigned)(R * g.lda + C) * 2u; voffB[i] = (unsigned)(Rb * K + C) * 2u; }
    const size_t kstep = (size_t)(BK * 2);
    const size_t hstep = (size_t)HALF * K * 2;
    const size_t tstep = 2 * hstep;
    const size_t hstepA = (size_t)HALF * g.lda * 2, tstepA = 2 * hstepA;
    const unsigned ldsw = (unsigned)wid * 1024u;
    const int aoff = lds_byte(wr * 64 + fr, fq * 8), boff = lds_byte(wc * 32 + fr, fq * 8);
#define PG8_SA(b, h) (((b) * 2 + (h)) * HTB)
#define PG8_SB(b, h) ((4 + (b) * 2 + (h)) * HTB)
#define PG8_STAGE(bufoff, gbase, voff) do { _Pragma("unroll") for (int _i = 0; _i < 2; ++_i) \
        __builtin_amdgcn_global_load_lds((const unsigned*)((const char*)(gbase) + (voff)[_i]), (PG8_LAS unsigned*)(lds + (bufoff) + ldsw + _i * 8192), 16, 0, 0); } while (0)
#define PG8_LDA(dst, b, h) do { _Pragma("unroll") for (int m = 0; m < 4; ++m) _Pragma("unroll") for (int k = 0; k < 2; ++k) dst[m][k] = *(const PG8_LAS bf16x8*)(lds + PG8_SA(b, h) + aoff + m * 2048 + k * 1024); } while (0)
#define PG8_LDB(dst, b, h) do { _Pragma("unroll") for (int n = 0; n < 2; ++n) _Pragma("unroll") for (int k = 0; k < 2; ++k) dst[n][k] = *(const PG8_LAS bf16x8*)(lds + PG8_SB(b, h) + boff + n * 2048 + k * 1024); } while (0)
#define PG8_MMA(ai, bj, At, Bt) do { __builtin_amdgcn_s_setprio(1); _Pragma("unroll") for (int m = 0; m < 4; ++m) _Pragma("unroll") for (int n = 0; n < 2; ++n) _Pragma("unroll") for (int k = 0; k < 2; ++k) \
        acc[ai][bj][m][n] = __builtin_amdgcn_mfma_f32_16x16x32_bf16(Bt[n][k], At[m][k], acc[ai][bj][m][n], 0, 0, 0); __builtin_amdgcn_s_setprio(0); } while (0)
#define PG8_WAIT_V(n) asm volatile("s_waitcnt vmcnt(" #n ")" ::: "memory")
#define PG8_WAIT_L(n) asm volatile("s_waitcnt lgkmcnt(" #n ")" ::: "memory")
#define PG8_BAR __builtin_amdgcn_s_barrier()
#define PG8_SCHED __builtin_amdgcn_sched_barrier(0)
    Unit cur, nxt; int ui = 0;
    if (!S.next(0, cur)) return;
    f32x4 acc[2][2][4][2];
#pragma unroll
    for (int a = 0; a < 2; ++a)
#pragma unroll
        for (int b = 0; b < 2; ++b)
#pragma unroll
            for (int m = 0; m < 4; ++m)
#pragma unroll
                for (int n = 0; n < 2; ++n) acc[a][b][m][n] = (f32x4){0.f, 0.f, 0.f, 0.f};
    bf16x8 At[4][2], B0[2][2], B1[2][2];
    const char* cA = (const char*)g.A + (size_t)cur.pm * tstepA; const char* cB = (const char*)g.Bt + (size_t)cur.pn * tstep;
    S.a_ready(cur);
    if constexpr (SP2) {
        PG8_STAGE(PG8_SB(0, 0), cB, voffB); PG8_STAGE(PG8_SB(0, 1), cB + hstep, voffB); PG8_STAGE(PG8_SA(0, 0), cA, voffA); PG8_STAGE(PG8_SA(0, 1), cA + hstepA, voffA);
        if (wr == 1) PG8_BAR;
        PG8_WAIT_V(2); PG8_BAR;
        PG8_STAGE(PG8_SB(1, 0), cB + kstep, voffB); PG8_STAGE(PG8_SA(1, 0), cA + kstep, voffA); PG8_STAGE(PG8_SB(1, 1), cB + hstep + kstep, voffB);
        PG8_WAIT_V(6); PG8_BAR;
    } else {
        PG8_STAGE(PG8_SB(0, 0), cB, voffB); PG8_STAGE(PG8_SA(0, 0), cA, voffA); PG8_STAGE(PG8_SB(0, 1), cB + hstep, voffB); PG8_STAGE(PG8_SA(0, 1), cA + hstepA, voffA);
        if (wr == 1) PG8_BAR;
        PG8_WAIT_V(4); PG8_BAR;
        PG8_STAGE(PG8_SB(1, 0), cB + kstep, voffB); PG8_STAGE(PG8_SA(1, 0), cA + kstep, voffA); PG8_STAGE(PG8_SB(1, 1), cB + hstep + kstep, voffB);
        PG8_WAIT_V(6); PG8_BAR;
    }
    for (;;) {
        const bool has_next = S.next(ui + 1, nxt);
        const char* nA = has_next ? (const char*)g.A + (size_t)nxt.pm * tstepA : cA; const char* nB = has_next ? (const char*)g.Bt + (size_t)nxt.pn * tstep : cB;
        for (int t = 0; t < nt; t += 2) {
            const bool last = (t == nt - 2);
            const char* a1 = cA + (size_t)(t + 1) * kstep;
            const char* a2 = last ? nA : cA + (size_t)(t + 2) * kstep; const char* b2 = last ? nB : cB + (size_t)(t + 2) * kstep;
            const char* a3 = a2 + kstep; const char* b3 = b2 + kstep;
            if (last && has_next) S.a_ready(nxt);
            if constexpr (SP2) {
            PG8_LDB(B0, 0, 0); PG8_LDB(B1, 0, 1); PG8_SCHED; PG8_LDA(At, 0, 0); PG8_STAGE(PG8_SA(1, 1), a1 + hstepA, voffA);
            PG8_WAIT_V(8); PG8_WAIT_L(0); PG8_BAR; PG8_MMA(0, 0, At, B0); PG8_MMA(0, 1, At, B1); PG8_BAR; PG8_SCHED;
            PG8_LDA(At, 0, 1); PG8_STAGE(PG8_SB(0, 0), b2, voffB); PG8_STAGE(PG8_SB(0, 1), b2 + hstep, voffB); PG8_STAGE(PG8_SA(0, 0), a2, voffA);
            PG8_WAIT_V(8); PG8_WAIT_L(0); PG8_BAR; PG8_MMA(1, 0, At, B0); PG8_MMA(1, 1, At, B1); PG8_BAR; PG8_SCHED;
            PG8_LDB(B0, 1, 0); PG8_LDB(B1, 1, 1); PG8_SCHED; PG8_LDA(At, 1, 0); PG8_STAGE(PG8_SA(0, 1), a2 + hstepA, voffA);
            PG8_WAIT_V(8); PG8_WAIT_L(0); PG8_BAR; PG8_MMA(0, 0, At, B0); PG8_MMA(0, 1, At, B1); PG8_BAR; PG8_SCHED;
            PG8_LDA(At, 1, 1); PG8_STAGE(PG8_SB(1, 0), b3, voffB); PG8_STAGE(PG8_SB(1, 1), b3 + hstep, voffB); PG8_STAGE(PG8_SA(1, 0), a3, voffA);
            PG8_WAIT_V(8); PG8_WAIT_L(0); PG8_BAR; PG8_MMA(1, 0, At, B0); PG8_MMA(1, 1, At, B1); PG8_BAR; PG8_SCHED;
            } else {
            PG8_LDB(B0, 0, 0); PG8_SCHED; PG8_LDA(At, 0, 0); PG8_STAGE(PG8_SA(1, 1), a1 + hstepA, voffA);
            PG8_WAIT_L(8); PG8_BAR; PG8_WAIT_L(0); PG8_MMA(0, 0, At, B0); PG8_BAR; PG8_SCHED;
            PG8_LDB(B1, 0, 1); PG8_STAGE(PG8_SB(0, 0), b2, voffB);
            PG8_BAR; PG8_WAIT_L(0); PG8_MMA(0, 1, At, B1); PG8_BAR;
            PG8_LDA(At, 0, 1); PG8_STAGE(PG8_SA(0, 0), a2, voffA);
            PG8_BAR; PG8_WAIT_L(0); PG8_MMA(1, 0, At, B0); PG8_BAR; PG8_SCHED;
            PG8_STAGE(PG8_SB(0, 1), b2 + hstep, voffB);
            PG8_WAIT_V(6); PG8_BAR; PG8_MMA(1, 1, At, B1); PG8_BAR;
            PG8_LDB(B0, 1, 0); PG8_SCHED; PG8_LDA(At, 1, 0); PG8_STAGE(PG8_SA(0, 1), a2 + hstepA, voffA);
            PG8_WAIT_L(8); PG8_BAR; PG8_WAIT_L(0); PG8_MMA(0, 0, At, B0); PG8_BAR; PG8_SCHED;
            PG8_LDB(B1, 1, 1); PG8_STAGE(PG8_SB(1, 0), b3, voffB);
            PG8_BAR; PG8_WAIT_L(0); PG8_MMA(0, 1, At, B1); PG8_BAR;
            PG8_LDA(At, 1, 1); PG8_STAGE(PG8_SA(1, 0), a3, voffA);
            PG8_BAR; PG8_WAIT_L(0); PG8_MMA(1, 0, At, B0); PG8_BAR; PG8_SCHED;
            PG8_STAGE(PG8_SB(1, 1), b3 + hstep, voffB);
            PG8_WAIT_V(6); PG8_BAR; PG8_MMA(1, 1, At, B1); PG8_BAR;
            }
        }
        if constexpr (ALIGN_EPI) { if (wr == 0) PG8_BAR; }
        if constexpr (!Epi::AFTER_DRAIN) { E(acc, cur, wr, wc, fr, fq); S.done(cur); }
        if (!has_next) break;
#pragma unroll
        for (int a = 0; a < 2; ++a)
#pragma unroll
            for (int b = 0; b < 2; ++b)
#pragma unroll
                for (int m = 0; m < 4; ++m)
#pragma unroll
                    for (int n = 0; n < 2; ++n) acc[a][b][m][n] = (f32x4){0.f, 0.f, 0.f, 0.f};
        cur = nxt; cA = nA; cB = nB; ++ui;
        if constexpr (ALIGN_EPI) { if (wr == 1) PG8_BAR; }
    }
    PG8_WAIT_V(0);
    if constexpr (!ALIGN_EPI) { if (wr == 0) PG8_BAR; }
    PG8_BAR;
    if constexpr (Epi::AFTER_DRAIN) { E.fused(acc, cur, wr, wc, fr, fq, lds, wid, lane); S.done(cur); }
#undef PG8_SA
#undef PG8_SB
#undef PG8_STAGE
#undef PG8_LDA
#undef PG8_LDB
#undef PG8_MMA
#undef PG8_WAIT_V
#undef PG8_WAIT_L
#undef PG8_BAR
#undef PG8_SCHED
}
}
namespace att {
typedef unsigned short bf16;
using bf16x8 = __attribute__((ext_vector_type(8))) short;
using s16x4  = __attribute__((ext_vector_type(4))) short;
using f32x16 = __attribute__((ext_vector_type(16))) float;
using u32x4  = __attribute__((ext_vector_type(4))) unsigned;
constexpr int NW = 8, QBLK = 32, KVBLK = 64;
constexpr float THR = 8.f;
#define ATT_SBAR() __builtin_amdgcn_sched_barrier(0)
__device__ __forceinline__ int crow(int r, int hi) { return (r & 3) + 8 * (r >> 2) + 4 * hi; }
typedef float f32x2_t __attribute__((ext_vector_type(2))); typedef __bf16 bf16x2_t __attribute__((ext_vector_type(2)));
__device__ __forceinline__ unsigned cvtpk(float lo, float hi) { f32x2_t v = {lo, hi}; bf16x2_t b = __builtin_convertvector(v, bf16x2_t); return __builtin_bit_cast(unsigned, b); }
typedef short v4i16_t __attribute__((ext_vector_type(4)));
typedef __attribute__((address_space(3))) const char* lds_cptr;
__device__ __forceinline__ s16x4 vtr(lds_cptr p) { return __builtin_bit_cast(s16x4, __builtin_amdgcn_ds_read_tr16_b64_v4i16((__attribute__((address_space(3))) v4i16_t*)p)); }
__device__ __forceinline__ bf16x8 ld8(const bf16* p) { return *reinterpret_cast<const bf16x8*>(p); }

template <int DQK> struct Cfg {
  static constexpr float SCALE = (DQK == 128) ? 0.088388347648318440f : 0.072168783648703220f;
  static constexpr float C = SCALE * 1.4426950408889634f;
  static constexpr int KROWB = DQK * 2, SHM_K = KVBLK * KROWB, SHM_V = KVBLK * 128 * 2, ND0 = DQK / 16;
  static constexpr int QREG = (DQK > 128) ? MLA_QREG : 8;
  static constexpr int QXW = (ND0 - QREG) * 1024, SHM_QX = NW * QXW;
  static constexpr int SHM_TOTAL = 2 * SHM_V + 2 * SHM_K + NW * 64 * 4 + SHM_QX;
};

constexpr float TRIG = 65536.f;
__device__ __forceinline__ void firstSM(f32x16& p0, f32x16& p1, float& m_ref, f32x16& negm) {
  float pmax = p0[0];
#pragma unroll
  for (int r = 1; r < 16; ++r) pmax = fmaxf(pmax, p0[r]);
#pragma unroll
  for (int r = 0; r < 16; ++r) pmax = fmaxf(pmax, p1[r]);
  { auto rr = __builtin_amdgcn_permlane32_swap(__float_as_uint(pmax), __float_as_uint(pmax), false, false);
    pmax = fmaxf(__uint_as_float(rr[0]), __uint_as_float(rr[1])); }
  m_ref = pmax;
#pragma unroll
  for (int r = 0; r < 16; ++r) { p0[r] -= pmax; p1[r] -= pmax; negm[r] = -pmax; }
#pragma unroll
  for (int r = 0; r < 16; ++r) p0[r] = __builtin_amdgcn_exp2f(p0[r]);
  asm volatile("" : "+v"(p0), "+v"(p1), "+v"(negm));
}
__device__ __forceinline__ void firstSM0(f32x16& p0, f32x16& p1, float& m_ref, f32x16& negm) {
  float pmax = p0[0];
#pragma unroll
  for (int r = 1; r < 16; ++r) pmax = fmaxf(pmax, p0[r]);
#pragma unroll
  for (int r = 0; r < 16; ++r) pmax = fmaxf(pmax, p1[r]);
  { auto rr = __builtin_amdgcn_permlane32_swap(__float_as_uint(pmax), __float_as_uint(pmax), false, false);
    pmax = fmaxf(__uint_as_float(rr[0]), __uint_as_float(rr[1])); }
  m_ref = pmax;
#pragma unroll
  for (int r = 0; r < 16; ++r) { p0[r] -= pmax; p1[r] -= pmax; negm[r] = -pmax; }
  asm volatile("" : "+v"(p0), "+v"(p1), "+v"(negm));
}
__device__ __forceinline__ void partialSM(f32x16& p0, f32x16& p1) {
#pragma unroll
  for (int r = 0; r < 16; ++r) p0[r] = __builtin_amdgcn_exp2f(p0[r]);
  asm volatile("" : "+v"(p0), "+v"(p1));
}
__device__ __forceinline__ void finishSM(f32x16& p0, f32x16& p1, float& ps, float& l_reg, bf16x8& pa0, bf16x8& pa1, bf16x8& pa2, bf16x8& pa3) {
#pragma unroll
  for (int r = 0; r < 16; ++r) p1[r] = __builtin_amdgcn_exp2f(p1[r]);
  float s0 = 0, s1 = 0;
#pragma unroll
  for (int r = 0; r < 16; ++r) s0 += p0[r];
#pragma unroll
  for (int r = 0; r < 16; ++r) s1 += p1[r];
  ps = s0 + s1;
  { auto rr = __builtin_amdgcn_permlane32_swap(__float_as_uint(ps), __float_as_uint(ps), false, false);
    ps = __uint_as_float(rr[0]) + __uint_as_float(rr[1]); }
  l_reg += ps;
#define ATT_PK4(P, BASE, OUT) do { unsigned a0 = cvtpk(P[BASE + 0], P[BASE + 1]), a1 = cvtpk(P[BASE + 2], P[BASE + 3]);   \
    unsigned b0 = cvtpk(P[BASE + 4], P[BASE + 5]), b1 = cvtpk(P[BASE + 6], P[BASE + 7]);                              \
    auto r0 = __builtin_amdgcn_permlane32_swap(a0, b0, false, false); auto r1 = __builtin_amdgcn_permlane32_swap(a1, b1, false, false); \
    u32x4 w = {r0[0], r1[0], r0[1], r1[1]}; OUT = *reinterpret_cast<bf16x8*>(&w); } while (0)
  ATT_PK4(p0, 0, pa0); ATT_PK4(p0, 8, pa1); ATT_PK4(p1, 0, pa2); ATT_PK4(p1, 8, pa3);
#undef ATT_PK4
}
__device__ __forceinline__ void partialSM2(f32x16& p0, f32x16& p1, float& s0) {
#pragma unroll
  for (int r = 0; r < 16; ++r) p0[r] = __builtin_amdgcn_exp2f(p0[r]);
  float a = 0.f, b = 0.f;
#pragma unroll
  for (int r = 0; r < 16; r += 2) { a += p0[r]; b += p0[r + 1]; }
  s0 = a + b;
  asm volatile("" : "+v"(p0), "+v"(p1), "+v"(s0));
}
__device__ __forceinline__ void finishSM2(f32x16& p0, f32x16& p1, float s0, float& ps, float& l_reg, bf16x8& pa0, bf16x8& pa1, bf16x8& pa2, bf16x8& pa3) {
#pragma unroll
  for (int r = 0; r < 16; ++r) p1[r] = __builtin_amdgcn_exp2f(p1[r]);
  float s1 = 0;
#pragma unroll
  for (int r = 0; r < 16; ++r) s1 += p1[r];
  ps = s0 + s1;
  { auto rr = __builtin_amdgcn_permlane32_swap(__float_as_uint(ps), __float_as_uint(ps), false, false);
    ps = __uint_as_float(rr[0]) + __uint_as_float(rr[1]); }
  l_reg += ps;
#define ATT_PK4(P, BASE, OUT) do { unsigned a0 = cvtpk(P[BASE + 0], P[BASE + 1]), a1 = cvtpk(P[BASE + 2], P[BASE + 3]);   \
    unsigned b0 = cvtpk(P[BASE + 4], P[BASE + 5]), b1 = cvtpk(P[BASE + 6], P[BASE + 7]);                              \
    auto r0 = __builtin_amdgcn_permlane32_swap(a0, b0, false, false); auto r1 = __builtin_amdgcn_permlane32_swap(a1, b1, false, false); \
    u32x4 w = {r0[0], r1[0], r0[1], r1[1]}; OUT = *reinterpret_cast<bf16x8*>(&w); } while (0)
  ATT_PK4(p0, 0, pa0); ATT_PK4(p0, 8, pa1); ATT_PK4(p1, 0, pa2); ATT_PK4(p1, 8, pa3);
#undef ATT_PK4
}
#define ATT_KEY(row) ((KROWB == 256) ? ((row) & ATT_KEYMASK128) : (((row) >> 1) & 7))
#define ATT_KSWZ(row, colB) ((row) * KROWB + ((colB) ^ (ATT_KEY(row) << 4)))
template <int DQK> __device__ __forceinline__ void qkt(f32x16& p0, f32x16& p1, const f32x16& negm, const char* Ks, const int* kb, const bf16x8* qr, const char* qx, int r32, int hi) {
  constexpr int KROWB = Cfg<DQK>::KROWB, ND0 = Cfg<DQK>::ND0, QREG = Cfg<DQK>::QREG;
  p0 = negm; p1 = negm;
  constexpr int NB = (KROWB == 256 && ATT_KEYMASK128 == 15) ? 8 : 4;
#pragma unroll
  for (int d0 = 0; d0 < ND0; ++d0) {
    bf16x8 b0 = *reinterpret_cast<const bf16x8*>(Ks + kb[d0 % NB] + (d0 / NB) * (NB * 32));
    bf16x8 b1 = *reinterpret_cast<const bf16x8*>(Ks + kb[d0 % NB] + (d0 / NB) * (NB * 32) + 32 * KROWB);
    bf16x8 q; if (d0 < QREG) q = qr[d0]; else q = *reinterpret_cast<const bf16x8*>(qx + (d0 - QREG) * 1024);
    p0 = __builtin_amdgcn_mfma_f32_32x32x16_bf16(b0, q, p0, 0, 0, 0);
    p1 = __builtin_amdgcn_mfma_f32_32x32x16_bf16(b1, q, p1, 0, 0, 0); }
}
__device__ __forceinline__ int v_st(int k, int c) { const int kk = (k & ~0xC) | ((k & 4) << 1) | ((k & 8) >> 1); return ((kk >> 3) * 4 + (c >> 5)) * 512 + ((kk & 7) * 32 + (c & 31)) * 2; }
__device__ __forceinline__ int v_rd_base(int lane) { return ((lane & 3) << 3) | (((lane >> 2) & 3) << 6) | (((lane >> 4) & 1) << 5) | (((lane >> 5) & 1) << 8); }
constexpr int v_rd_off(int d0, int ks, int half) { return d0 * 512 + ks * 4096 + half * 2048; }
template <int OFF> __device__ __forceinline__ s16x4 tr_read(int vb) {
  s16x4 r; asm volatile("ds_read_b64_tr_b16 %0, %1 offset:%2" : "=&v"(r) : "v"(vb), "i"(OFF) : "memory"); return r;
}
#define ATT_PK(L, H) (bf16x8){L[0], L[1], L[2], L[3], H[0], H[1], H[2], H[3]}
template <int D0> __device__ __forceinline__ void pv_one(f32x16& od, lds_cptr vp, bf16x8 pa0, bf16x8 pa1, bf16x8 pa2, bf16x8 pa3) {
  const s16x4 l0 = vtr(vp + v_rd_off(D0, 0, 0)), h0 = vtr(vp + v_rd_off(D0, 0, 1)), l1 = vtr(vp + v_rd_off(D0, 1, 0)), h1 = vtr(vp + v_rd_off(D0, 1, 1));
  const s16x4 l2 = vtr(vp + v_rd_off(D0, 2, 0)), h2 = vtr(vp + v_rd_off(D0, 2, 1)), l3 = vtr(vp + v_rd_off(D0, 3, 0)), h3 = vtr(vp + v_rd_off(D0, 3, 1));
  od = __builtin_amdgcn_mfma_f32_32x32x16_bf16(pa0, ATT_PK(l0, h0), od, 0, 0, 0);
  od = __builtin_amdgcn_mfma_f32_32x32x16_bf16(pa1, ATT_PK(l1, h1), od, 0, 0, 0);
  od = __builtin_amdgcn_mfma_f32_32x32x16_bf16(pa2, ATT_PK(l2, h2), od, 0, 0, 0);
  od = __builtin_amdgcn_mfma_f32_32x32x16_bf16(pa3, ATT_PK(l3, h3), od, 0, 0, 0);
}
__device__ __forceinline__ void pv_d0(f32x16* o, lds_cptr vp, bf16x8 pa0, bf16x8 pa1, bf16x8 pa2, bf16x8 pa3) {
  pv_one<0>(o[0], vp, pa0, pa1, pa2, pa3); pv_one<1>(o[1], vp, pa0, pa1, pa2, pa3); pv_one<2>(o[2], vp, pa0, pa1, pa2, pa3); pv_one<3>(o[3], vp, pa0, pa1, pa2, pa3);
}
template <int NGRP, int MG, int NVALU, int NDS, int NPRE, int NLEAD = 0, int NVALU2 = 0> __device__ __forceinline__ void sched_pipe() {
  __builtin_amdgcn_sched_group_barrier(0x100, NPRE, 0);
#pragma unroll
  for (int i = 0; i < NGRP; ++i) { __builtin_amdgcn_sched_group_barrier(0x008, MG, 0);
    if (i >= NLEAD) __builtin_amdgcn_sched_group_barrier(0x002, (NLEAD > 0) ? NVALU2 : NVALU, 0);
    __builtin_amdgcn_sched_group_barrier(0x100, NDS, 0); }
}

template <int DQK, int LDQ, int LDK, int LDV, int LDO, int SD>
__device__ __forceinline__ void attn_unit(const bf16* __restrict__ Qb, const bf16* __restrict__ Kh, const bf16* __restrict__ Kr, const bf16* __restrict__ Vh,
                                          bf16* __restrict__ Ob, int seq, char* lds, float* tmout = nullptr) {
  constexpr int KROWB = Cfg<DQK>::KROWB, SHM_K = Cfg<DQK>::SHM_K, SHM_V = Cfg<DQK>::SHM_V, ND0 = Cfg<DQK>::ND0;
  const int tid = threadIdx.x, wid = __builtin_amdgcn_readfirstlane(tid >> 6), lane = tid & 63, r32 = lane & 31, hi = lane >> 5;
  char* V_lds = lds; char* K_lds = lds + 2 * SHM_V;
  float* ws = (float*)(lds + 2 * SHM_V + 2 * SHM_K) + wid * 64; float* li_l = ws; float* al_l = ws + 32;
  float m_ref = 0.f, l_reg = 0; f32x16 o[4] = {}; f32x16 negm = {}; constexpr int QREG = Cfg<DQK>::QREG; bf16x8 qr[QREG];
  const bf16* Qw = Qb + (long)(wid * QBLK + r32) * LDQ + hi * 8;
  char* qx = lds + 2 * SHM_V + 2 * SHM_K + NW * 64 * 4 + wid * Cfg<DQK>::QXW + lane * 16;
#pragma unroll
  for (int d0 = 0; d0 < QREG; ++d0) qr[d0] = ld8(Qw + d0 * 16);
  if constexpr (QREG < ND0) {
#pragma unroll
    for (int d0 = QREG; d0 < ND0; ++d0) *(bf16x8*)(qx + (d0 - QREG) * 1024) = ld8(Qw + d0 * 16);
  }
  const int sr = tid >> 4, sc = (tid & 15) * 8, vst0 = v_st(sr, sc), vst1 = v_st(32 + sr, sc);
  const int krr = tid >> 3, krc = (tid & 7) * 8;
  const lds_cptr vb0 = (lds_cptr)V_lds + v_rd_base(lane);
  constexpr int NB = (KROWB == 256 && ATT_KEYMASK128 == 15) ? 8 : 4; int kb[NB];
#pragma unroll
  for (int dl = 0; dl < NB; ++dl) kb[dl] = r32 * KROWB + ((dl * 32 + hi * 16) ^ (ATT_KEY(r32) << 4));
  const unsigned boV = (unsigned)(sr * LDV + sc) * 2u, boK = (unsigned)(sr * LDK + sc) * 2u, boR = (unsigned)(krr * 64 + krc) * 2u;
  struct { bf16x8 vs0, vs1, ks0, ks1, kr; } sr_[SD];
#define SLOAD(i, k0) do { const char* vt_ = (const char*)(Vh + (long)(k0) * LDV); const char* kt_ = (const char*)(Kh + (long)(k0) * LDK); \
    sr_[i].vs0 = *(const bf16x8*)(vt_ + boV); sr_[i].vs1 = *(const bf16x8*)(vt_ + 32 * LDV * 2 + boV); \
    sr_[i].ks0 = *(const bf16x8*)(kt_ + boK); sr_[i].ks1 = *(const bf16x8*)(kt_ + 32 * LDK * 2 + boK); \
    if constexpr (DQK == 192) { const char* rt_ = (const char*)(Kr + (long)(k0) * 64); sr_[i].kr = *(const bf16x8*)(rt_ + boR); } } while (0)
#define SWRITE(b, i) do { *(bf16x8*)(V_lds + (b) * SHM_V + vst0) = sr_[i].vs0;          \
    *(bf16x8*)(V_lds + (b) * SHM_V + vst1) = sr_[i].vs1; int kc = sc * 2;               \
    *(bf16x8*)(K_lds + (b) * SHM_K + ATT_KSWZ(sr, kc)) = sr_[i].ks0;                       \
    *(bf16x8*)(K_lds + (b) * SHM_K + ATT_KSWZ(32 + sr, kc)) = sr_[i].ks1;                  \
    if constexpr (DQK == 192) *(bf16x8*)(K_lds + (b) * SHM_K + ATT_KSWZ(krr, 256 + krc * 2)) = sr_[i].kr; } while (0)
#define SWAIT() do { if constexpr (SD == 2) { if constexpr (DQK == 192) asm volatile("s_waitcnt vmcnt(5)" ::: "memory"); else asm volatile("s_waitcnt vmcnt(4)" ::: "memory"); } \
    else asm volatile("s_waitcnt vmcnt(0)" ::: "memory"); } while (0)
#define RESC_APPLY() do { l_reg *= alp; if (hi == 0) al_l[r32] = alp; asm volatile("s_waitcnt lgkmcnt(0)" ::: "memory"); \
    _Pragma("unroll") for (int d = 0; d < 4; ++d) _Pragma("unroll") for (int r = 0; r < 16; ++r) o[d][r] *= al_l[crow(r, hi)]; pend = false; } while (0)
#define RESCN(ps_) do { if (pend) { RESC_APPLY(); } else { const bool t_ = (ps_) > TRIG; const float d_ = t_ ? __builtin_amdgcn_logf(ps_) : 0.f; alp = __builtin_amdgcn_exp2f(-d_); m_ref += d_; pend = __any(t_); } \
    _Pragma("unroll") for (int r = 0; r < 16; ++r) negm[r] = -m_ref; } while (0)
  float alp = 1.f; bool pend = false;
  f32x16 pA0, pA1, pB0, pB1; float psA, psB; bf16x8 pa0, pa1, pa2, pa3; const int NT = seq / KVBLK;
  constexpr int SE = 0, SO = SD - 1;
  SLOAD(SE, 0); asm volatile("s_waitcnt vmcnt(0)" ::: "memory"); SWRITE(0, SE); __syncthreads();
  qkt<DQK>(pA0, pA1, negm, K_lds, kb, qr, qx, r32, hi); firstSM(pA0, pA1, m_ref, negm);
  SLOAD(SO, KVBLK); if constexpr (SD == 2) { if (2 < NT) SLOAD(SE, 2 * KVBLK); }
  SWAIT(); SWRITE(1, SO); __syncthreads();
#define SCHED_A() do { if constexpr (DQK == 128) sched_pipe<16, 1, ATT_NVA128, 1, ATT_PREA>(); else sched_pipe<24 / ATT_MG192, ATT_MG192, ATT_NVA192 * ATT_MG192, ATT_DS192, ATT_PREA>(); } while (0)
#define SCHED_B() sched_pipe<16, 1, ATT_NVB, 2, ATT_PREB>()
#if ATT_PRIOMODE == 2
#define PRIO_A() do { if (wid >= 4) __builtin_amdgcn_s_setprio(1); else __builtin_amdgcn_s_setprio(0); } while (0)
#define PRIO_B() do { if (wid >= 4) __builtin_amdgcn_s_setprio(0); else __builtin_amdgcn_s_setprio(1); } while (0)
#elif ATT_PRIOMODE == 3
#define PRIO_A() do { if (wid >= 4) __builtin_amdgcn_s_setprio(0); else __builtin_amdgcn_s_setprio(1); } while (0)
#define PRIO_B() do { if (wid >= 4) __builtin_amdgcn_s_setprio(1); else __builtin_amdgcn_s_setprio(0); } while (0)
#else
#define PRIO_A() ((void)0)
#define PRIO_B() ((void)0)
#endif
#ifdef ATT_TIMING
  unsigned long long tmA = 0, tmB = 0, tmW = 0, tmW1 = 0, tmS = 0, tmB2 = 0;
#define TMS() __builtin_readcyclecounter()
#else
#define TMS() 0ull
#endif
  for (int j = 1; j + 1 < NT; j += 2) {
    const unsigned long long t0_ = TMS();
    PRIO_A(); ATT_SBAR(); qkt<DQK>(pB0, pB1, negm, K_lds + SHM_K, kb, qr, qx, r32, hi);
    finishSM(pA0, pA1, psA, l_reg, pa0, pa1, pa2, pa3); SCHED_A(); ATT_SBAR();
    const unsigned long long t1_ = TMS();
    PRIO_B(); SLOAD(SO, (j + SD) * KVBLK); ATT_SBAR();
    pv_d0(o, vb0, pa0, pa1, pa2, pa3); partialSM(pB0, pB1); SCHED_B(); ATT_SBAR();
    const unsigned long long t2_ = TMS();
    __syncthreads(); const unsigned long long t3_ = TMS(); SWAIT(); const unsigned long long t3b_ = TMS(); SWRITE(0, SE);
    RESCN(psA); asm volatile("s_waitcnt lgkmcnt(0)" ::: "memory"); const unsigned long long t3c_ = TMS(); __syncthreads();
    const unsigned long long t4_ = TMS();
#ifdef ATT_TIMING
    tmA += t1_ - t0_; tmB += t2_ - t1_; tmW1 += t3_ - t2_; tmW += t4_ - t3_; tmS += t3b_ - t3_; tmB2 += t4_ - t3c_;
#endif
    PRIO_A(); ATT_SBAR(); qkt<DQK>(pA0, pA1, negm, K_lds, kb, qr, qx, r32, hi);
    finishSM(pB0, pB1, psB, l_reg, pa0, pa1, pa2, pa3); SCHED_A(); ATT_SBAR();
    PRIO_B(); if (SD == 1 || j + 3 < NT) SLOAD(SE, (j + 1 + SD) * KVBLK); ATT_SBAR();
    pv_d0(o, vb0 + SHM_V, pa0, pa1, pa2, pa3); partialSM(pA0, pA1); SCHED_B(); ATT_SBAR();
    __syncthreads(); SWAIT(); SWRITE(1, SO);
    RESCN(psB); __syncthreads();
  }
  ATT_SBAR(); qkt<DQK>(pB0, pB1, negm, K_lds + SHM_K, kb, qr, qx, r32, hi);
  finishSM(pA0, pA1, psA, l_reg, pa0, pa1, pa2, pa3); ATT_SBAR();
  pv_d0(o, vb0, pa0, pa1, pa2, pa3); partialSM(pB0, pB1);
  __syncthreads(); if (pend) { RESC_APPLY(); }
  finishSM(pB0, pB1, psB, l_reg, pa0, pa1, pa2, pa3); ATT_SBAR();
  pv_d0(o, vb0 + SHM_V, pa0, pa1, pa2, pa3);
#undef SCHED_A
#undef SCHED_B
  __builtin_amdgcn_s_setprio(0);
#ifdef ATT_TIMING
  if (tmout && blockIdx.x == 0 && tid == ATT_TWAVE * 64) { const float inv = 1.0f / (float)((NT - 2) / 2); tmout[0] = (float)tmA * inv; tmout[1] = (float)tmB * inv; tmout[2] = (float)tmW1 * inv; tmout[3] = (float)tmW * inv; tmout[4] = (float)tmS * inv; tmout[5] = (float)tmB2 * inv; }
#endif
  if (hi == 0) li_l[r32] = l_reg; asm volatile("s_waitcnt lgkmcnt(0)" ::: "memory");
  float rli[16];
#pragma unroll
  for (int r = 0; r < 16; ++r) rli[r] = __builtin_amdgcn_rcpf(li_l[crow(r, hi)]);
  { int r32e = r32, hie = hi; asm volatile("" : "+v"(r32e), "+v"(hie));
    char* Ow = (char*)(Ob + (long)(wid * QBLK) * LDO);
    const unsigned lo_ = (unsigned)(((r32e >> 5) + 4 * hie) * LDO + (r32e & 31)) * 2u;
#pragma unroll
    for (int r = 0; r < 16; ++r) {
#pragma unroll
      for (int d0 = 0; d0 < 4; ++d0) *(bf16*)(Ow + lo_ + (unsigned)((((r & 3) + 8 * (r >> 2)) * LDO + d0 * 32) * 2)) = (bf16)(cvtpk(o[d0][r] * rli[r], 0.f) & 0xffffu); } }
  asm volatile("s_waitcnt vmcnt(0) lgkmcnt(0)" ::: "memory"); __syncthreads();
#undef SLOAD
#undef SWRITE
#undef SWAIT
#undef RESCN
#undef RESC_APPLY
}
template <int DQK, int LDQ, int LDK, int LDV, int LDO>
__device__ __forceinline__ void attn_unit_dma(const bf16* __restrict__ Qb, const bf16* __restrict__ Kh, const bf16* __restrict__ Kr, const bf16* __restrict__ Vh,
                                              bf16* __restrict__ Ob, int seq, char* lds, int spos = 0, const float* __restrict__ qgain = nullptr) {
  constexpr int KROWB = Cfg<DQK>::KROWB, SHM_K = Cfg<DQK>::SHM_K, SHM_V = Cfg<DQK>::SHM_V, ND0 = Cfg<DQK>::ND0;
  typedef __attribute__((address_space(3))) unsigned lds_u32;
  int tid_ = threadIdx.x; asm volatile("" : "+v"(tid_));
  const int tid = tid_, wid = __builtin_amdgcn_readfirstlane(tid >> 6), lane = tid & 63, r32 = lane & 31, hi = lane >> 5;
  char* V_lds = lds; char* K_lds = lds + 2 * SHM_V;
  float* ws = (float*)(lds + 2 * SHM_V + 2 * SHM_K) + wid * 64; float* li_l = ws; float* al_l = ws + 32;
  float m_ref = 0.f, l_reg = 0; f32x16 o[4] = {}; f32x16 negm = {}; constexpr int QREG = Cfg<DQK>::QREG; bf16x8 qr[QREG];
  const bf16* Qw = Qb + (long)(wid * QBLK + r32) * LDQ + hi * 8;
  char* qx = lds + 2 * SHM_V + 2 * SHM_K + NW * 64 * 4 + wid * Cfg<DQK>::QXW + lane * 16;
  if constexpr (DQK == 128) {
    int hiq = hi; asm volatile("" : "+v"(hiq));
    u32x4 raw[8]; float ss = 0.f;
#pragma unroll
    for (int d0 = 0; d0 < 8; ++d0) { const bf16x8 t8 = ld8(Qw + d0 * 16); raw[d0] = *reinterpret_cast<const u32x4*>(&t8); }
#pragma unroll
    for (int d0 = 0; d0 < 8; ++d0)
#pragma unroll
      for (int e = 0; e < 4; ++e) { const float x1 = __uint_as_float(raw[d0][e] << 16), x2 = __uint_as_float(raw[d0][e] & 0xffff0000u); ss += x1 * x1 + x2 * x2; }
    { auto rr = __builtin_amdgcn_permlane32_swap(__float_as_uint(ss), __float_as_uint(ss), false, false); ss = __uint_as_float(rr[0]) + __uint_as_float(rr[1]); }
    const float rs = (1.0f / sqrtf(ss * (1.f / 128.f) + 1e-6f)) * Cfg<128>::C;
    int r32q = r32; asm volatile("" : "+v"(r32q));
    const int sq = spos + wid * QBLK + r32q; const float posr = (float)(sq >> 6), posc = (float)(sq & 63);
#pragma unroll
    for (int d0 = 0; d0 < 8; ++d0) { const float pos = (d0 < 4) ? posr : posc;
      const float* gp = qgain + d0 * 16 + hiq * 8; u32x4 w;
#pragma unroll
      for (int e = 0; e < 4; ++e) { const int j = (d0 & 3) * 8 + hiq * 4 + e; const float invf = __builtin_amdgcn_exp2f(-(float)j * (13.287712379549449f / 32.f));
        const float ang = pos * invf; double rev = (double)ang * 0.15915494309189535; rev -= __builtin_rint(rev); const float fr = (float)rev;
        const float c = __builtin_amdgcn_cosf(fr), sn = __builtin_amdgcn_sinf(fr);
        const float y1 = __uint_as_float(raw[d0][e] << 16) * rs * gp[2 * e], y2 = __uint_as_float(raw[d0][e] & 0xffff0000u) * rs * gp[2 * e + 1];
        w[e] = cvtpk(y1 * c - y2 * sn, y1 * sn + y2 * c); }
      qr[d0] = *reinterpret_cast<bf16x8*>(&w); }
  } else {
#pragma unroll
  for (int d0 = 0; d0 < QREG; ++d0) qr[d0] = ld8(Qw + d0 * 16);
  }
  if constexpr (QREG < ND0) {
#pragma unroll
    for (int d0 = QREG; d0 < ND0; ++d0) { bf16x8 qv = ld8(Qw + d0 * 16);
      if (DQK == 192 && d0 >= 8) {
        int hiq = hi; asm volatile("" : "+v"(hiq));
        const int sq = spos + wid * QBLK + r32; const float pos = (float)((d0 < 10) ? (sq >> 6) : (sq & 63));
        u32x4 w = *reinterpret_cast<u32x4*>(&qv);
#pragma unroll
        for (int e = 0; e < 4; ++e) { const int j = ((d0 - 8) & 1) * 8 + hiq * 4 + e; const float invf = __builtin_amdgcn_exp2f(-(float)j * (13.287712379549449f / 16.f));
          const float ang = pos * invf; double rev = (double)ang * 0.15915494309189535; rev -= __builtin_rint(rev); const float fr = (float)rev;
          const float c = __builtin_amdgcn_cosf(fr), sn = __builtin_amdgcn_sinf(fr);
          const float x1 = __uint_as_float(w[e] << 16), x2 = __uint_as_float(w[e] & 0xffff0000u); w[e] = cvtpk(x1 * c - x2 * sn, x1 * sn + x2 * c); }
        qv = *reinterpret_cast<bf16x8*>(&w); }
      *(bf16x8*)(qx + (d0 - QREG) * 1024) = qv; }
  }
  const lds_cptr vb0 = (lds_cptr)V_lds + v_rd_base(lane);
  constexpr int NB = (KROWB == 256 && ATT_KEYMASK128 == 15) ? 8 : 4; int kb[NB];
#pragma unroll
  for (int dl = 0; dl < NB; ++dl) kb[dl] = r32 * KROWB + ((dl * 32 + hi * 16) ^ (ATT_KEY(r32) << 4));
  constexpr int NKI = SHM_K / 8192, SPR = KROWB / 16;
  unsigned voV[2]; const char* kp[NKI]; unsigned kst[NKI];
#pragma unroll
  for (int i = 0; i < 2; ++i) { const int s = i * 512 + wid * 64 + lane; const int kk = (((s >> 7) & 7) << 3) | ((s >> 2) & 7);
    const int k = (kk & ~0xC) | ((kk & 4) << 1) | ((kk & 8) >> 1), c = ((s >> 5) & 3) * 32 + (s & 3) * 8; voV[i] = (unsigned)(k * LDV + c) * 2u; }
#pragma unroll
  for (int i = 0; i < NKI; ++i) { const int s = i * 512 + wid * 64 + lane; const int row = s / SPR, cs = (s % SPR) * 16, colB = cs ^ (ATT_KEY(row) << 4);
    if (DQK == 192 && colB >= 256) { kp[i] = (const char*)Kr + (size_t)row * 128 + (colB - 256); kst[i] = 64u * 128u; }
    else { kp[i] = (const char*)Kh + (size_t)row * (LDK * 2) + colB; kst[i] = 64u * (unsigned)(LDK * 2); } }
  lds_u32* const ldsV = (lds_u32*)((__attribute__((address_space(3))) char*)V_lds + wid * 1024);
  lds_u32* const ldsK = (lds_u32*)((__attribute__((address_space(3))) char*)K_lds + wid * 1024);
#define DMA_V(t_, b_) do { const char* vt_ = (const char*)Vh + (size_t)(t_) * (64u * LDV * 2u); _Pragma("unroll") for (int i = 0; i < 2; ++i) \
    __builtin_amdgcn_global_load_lds((const unsigned*)(vt_ + voV[i]), (lds_u32*)((__attribute__((address_space(3))) char*)ldsV + (b_) * SHM_V + i * 8192), 16, 0, 0); } while (0)
#define DMA_K(t_, b_) do { _Pragma("unroll") for (int i = 0; i < NKI; ++i) \
    __builtin_amdgcn_global_load_lds((const unsigned*)(kp[i] + (size_t)(t_) * kst[i]), (lds_u32*)((__attribute__((address_space(3))) char*)ldsK + (b_) * SHM_K + i * 8192), 16, 0, 0); } while (0)
#define VMW0() asm volatile("s_waitcnt vmcnt(0)" ::: "memory")
#define RESC_APPLY() do { l_reg *= alp; if (hi == 0) al_l[r32] = alp; asm volatile("s_waitcnt lgkmcnt(0)" ::: "memory"); \
    _Pragma("unroll") for (int d = 0; d < 4; ++d) _Pragma("unroll") for (int r = 0; r < 16; ++r) o[d][r] *= al_l[crow(r, hi)]; pend = false; } while (0)
#define RESCN(ps_) do { if (pend) { RESC_APPLY(); } else { const bool t_ = (ps_) > TRIG; const float d_ = t_ ? __builtin_amdgcn_logf(ps_) : 0.f; alp = __builtin_amdgcn_exp2f(-d_); m_ref += d_; pend = __any(t_); } \
    _Pragma("unroll") for (int r = 0; r < 16; ++r) negm[r] = -m_ref; } while (0)
  float alp = 1.f; bool pend = false;
  f32x16 pA0, pA1, pB0, pB1; float psA, psB; bf16x8 pa0, pa1, pa2, pa3; const int NT = seq / KVBLK;
#define SCHED_A() do { if constexpr (DQK == 128) sched_pipe<16, 1, ATT_NVA128, 1, ATT_PREA, ATT_LEAD128, ATT_NVL128>(); else sched_pipe<24 / ATT_MG192, ATT_MG192, ATT_NVA192 * ATT_MG192, ATT_DS192, ATT_PREA, ATT_LEAD192, ATT_NVL192>(); } while (0)
#define SCHED_B() sched_pipe<16, 1, ATT_NVB, 2, ATT_PREB>()
#define STEP(C0, C1, s0C, P0, P1, s0P, psP, t_, KB, VB, haveK) do { DMA_V(t_, VB); if (haveK) DMA_K((t_) + 1, 1 - (KB)); ATT_SBAR(); \
    qkt<DQK>(C0, C1, negm, K_lds + (KB) * SHM_K, kb, qr, qx, r32, hi); finishSM2(P0, P1, s0P, psP, l_reg, pa0, pa1, pa2, pa3); SCHED_A(); ATT_SBAR(); \
    pv_d0(o, vb0 + (1 - (VB)) * SHM_V, pa0, pa1, pa2, pa3); partialSM2(C0, C1, s0C); SCHED_B(); ATT_SBAR(); \
    RESCN(psP); VMW0(); __syncthreads(); } while (0)
  float s0A = 0.f, s0B = 0.f;
  DMA_K(0, 0); VMW0(); __syncthreads();
  DMA_V(0, 0); DMA_K(1, 1);
  qkt<DQK>(pA0, pA1, negm, K_lds, kb, qr, qx, r32, hi); firstSM0(pA0, pA1, m_ref, negm); partialSM2(pA0, pA1, s0A);
  VMW0(); __syncthreads();
  for (int t = 1; t + 2 < NT; t += 2) {
    STEP(pB0, pB1, s0B, pA0, pA1, s0A, psA, t, 1, 1, true);
    STEP(pA0, pA1, s0A, pB0, pB1, s0B, psB, t + 1, 0, 0, true);
  }
  STEP(pB0, pB1, s0B, pA0, pA1, s0A, psA, NT - 1, 1, 1, false);
  finishSM2(pB0, pB1, s0B, psB, l_reg, pa0, pa1, pa2, pa3); ATT_SBAR();
  pv_d0(o, vb0 + SHM_V, pa0, pa1, pa2, pa3);
#undef STEP
#undef SCHED_A
#undef SCHED_B
  if (hi == 0) li_l[r32] = l_reg; asm volatile("s_waitcnt lgkmcnt(0)" ::: "memory");
  float rli[16];
#pragma unroll
  for (int r = 0; r < 16; ++r) rli[r] = __builtin_amdgcn_rcpf(li_l[crow(r, hi)]);
  { int r32e = r32, hie = hi; asm volatile("" : "+v"(r32e), "+v"(hie));
    char* Ow = (char*)(Ob + (long)(wid * QBLK) * LDO);
    const unsigned lo_ = (unsigned)((4 * hie) * LDO + r32e) * 2u;
#pragma unroll
    for (int r = 0; r < 16; ++r) {
#pragma unroll
      for (int d0 = 0; d0 < 4; ++d0) *(bf16*)(Ow + lo_ + (unsigned)((((r & 3) + 8 * (r >> 2)) * LDO + d0 * 32) * 2)) = (bf16)(cvtpk(o[d0][r] * rli[r], 0.f) & 0xffffu); } }
  asm volatile("s_waitcnt vmcnt(0) lgkmcnt(0)" ::: "memory"); __syncthreads();
#undef DMA_V
#undef DMA_K
#undef VMW0
#undef RESCN
#undef RESC_APPLY
}
template <int DQK, int LDQ, int LDK, int LDV, int LDO>
__device__ __forceinline__ void attn_unit_dmas(const bf16* __restrict__ Qb, const bf16* __restrict__ Kh, const bf16* __restrict__ Kr, const bf16* __restrict__ Vh,
                                              bf16* __restrict__ Ob, int seq, char* lds, int spos = 0) {
  constexpr int KROWB = Cfg<DQK>::KROWB, SHM_K = Cfg<DQK>::SHM_K, SHM_V = Cfg<DQK>::SHM_V, ND0 = Cfg<DQK>::ND0;
  typedef __attribute__((address_space(3))) unsigned lds_u32;
  const int tid = threadIdx.x, wid = __builtin_amdgcn_readfirstlane(tid >> 6), lane = tid & 63, r32 = lane & 31, hi = lane >> 5;
  char* V_lds = lds; char* K_lds = lds + 3 * SHM_V;
  float* ws = (float*)(lds + 3 * SHM_V + 2 * SHM_K) + wid * 64; float* li_l = ws; float* al_l = ws + 32;
  float m_ref = 0.f, l_reg = 0; f32x16 o[4] = {}; f32x16 negm = {}; constexpr int QREG = Cfg<DQK>::QREG; bf16x8 qr[QREG];
  const bf16* Qw = Qb + (long)(wid * QBLK + r32) * LDQ + hi * 8;
  char* qx = lds + 3 * SHM_V + 2 * SHM_K + NW * 64 * 4 + wid * Cfg<DQK>::QXW + lane * 16;
#pragma unroll
  for (int d0 = 0; d0 < QREG; ++d0) qr[d0] = ld8(Qw + d0 * 16);
  if constexpr (QREG < ND0) {
#pragma unroll
    for (int d0 = QREG; d0 < ND0; ++d0) { bf16x8 qv = ld8(Qw + d0 * 16);
      if (DQK == 192 && d0 >= 8) {
        int hiq = hi; asm volatile("" : "+v"(hiq));
        const int sq = spos + wid * QBLK + r32; const float pos = (float)((d0 < 10) ? (sq >> 6) : (sq & 63));
        u32x4 w = *reinterpret_cast<u32x4*>(&qv);
#pragma unroll
        for (int e = 0; e < 4; ++e) { const int j = ((d0 - 8) & 1) * 8 + hiq * 4 + e; const float invf = __builtin_amdgcn_exp2f(-(float)j * (13.287712379549449f / 16.f));
          const float ang = pos * invf; double rev = (double)ang * 0.15915494309189535; rev -= __builtin_rint(rev); const float fr = (float)rev;
          const float c = __builtin_amdgcn_cosf(fr), sn = __builtin_amdgcn_sinf(fr);
          const float x1 = __uint_as_float(w[e] << 16), x2 = __uint_as_float(w[e] & 0xffff0000u); w[e] = cvtpk(x1 * c - x2 * sn, x1 * sn + x2 * c); }
        qv = *reinterpret_cast<bf16x8*>(&w); }
      *(bf16x8*)(qx + (d0 - QREG) * 1024) = qv; }
  }
  const lds_cptr vb0 = (lds_cptr)V_lds + v_rd_base(lane);
  constexpr int NB = (KROWB == 256 && ATT_KEYMASK128 == 15) ? 8 : 4; int kb[NB];
#pragma unroll
  for (int dl = 0; dl < NB; ++dl) kb[dl] = r32 * KROWB + ((dl * 32 + hi * 16) ^ (ATT_KEY(r32) << 4));
  constexpr int NKI = SHM_K / 8192, SPR = KROWB / 16;
  unsigned voV[2]; const char* kp[NKI]; unsigned kst[NKI];
#pragma unroll
  for (int i = 0; i < 2; ++i) { const int s = i * 512 + wid * 64 + lane; const int kk = (((s >> 7) & 7) << 3) | ((s >> 2) & 7);
    const int k = (kk & ~0xC) | ((kk & 4) << 1) | ((kk & 8) >> 1), c = ((s >> 5) & 3) * 32 + (s & 3) * 8; voV[i] = (unsigned)(k * LDV + c) * 2u; }
#pragma unroll
  for (int i = 0; i < NKI; ++i) { const int s = i * 512 + wid * 64 + lane; const int row = s / SPR, cs = (s % SPR) * 16, colB = cs ^ (ATT_KEY(row) << 4);
    if (DQK == 192 && colB >= 256) { kp[i] = (const char*)Kr + (size_t)row * 128 + (colB - 256); kst[i] = 64u * 128u; }
    else { kp[i] = (const char*)Kh + (size_t)row * (LDK * 2) + colB; kst[i] = 64u * (unsigned)(LDK * 2); } }
  lds_u32* const ldsV = (lds_u32*)((__attribute__((address_space(3))) char*)V_lds + wid * 1024);
  lds_u32* const ldsK = (lds_u32*)((__attribute__((address_space(3))) char*)K_lds + wid * 1024);
#define DMA_V(t_, b_) do { const char* vt_ = (const char*)Vh + (size_t)(t_) * (64u * LDV * 2u); _Pragma("unroll") for (int i = 0; i < 2; ++i) \
    __builtin_amdgcn_global_load_lds((const unsigned*)(vt_ + voV[i]), (lds_u32*)((__attribute__((address_space(3))) char*)ldsV + (b_) + i * 8192), 16, 0, 0); } while (0)
#define DMA_K(t_, b_) do { _Pragma("unroll") for (int i = 0; i < NKI; ++i) \
    __builtin_amdgcn_global_load_lds((const unsigned*)(kp[i] + (size_t)(t_) * kst[i]), (lds_u32*)((__attribute__((address_space(3))) char*)ldsK + (b_) * SHM_K + i * 8192), 16, 0, 0); } while (0)
#define VMW0() asm volatile("s_waitcnt vmcnt(0)" ::: "memory")
#define RESC_APPLY() do { l_reg *= alp; if (hi == 0) al_l[r32] = alp; asm volatile("s_waitcnt lgkmcnt(0)" ::: "memory"); \
    _Pragma("unroll") for (int d = 0; d < 4; ++d) _Pragma("unroll") for (int r = 0; r < 16; ++r) o[d][r] *= al_l[crow(r, hi)]; pend = false; } while (0)
#define RESCN(ps_) do { if (pend) { RESC_APPLY(); } else { const bool t_ = (ps_) > TRIG; const float d_ = t_ ? __builtin_amdgcn_logf(ps_) : 0.f; alp = __builtin_amdgcn_exp2f(-d_); m_ref += d_; pend = __any(t_); } \
    _Pragma("unroll") for (int r = 0; r < 16; ++r) negm[r] = -m_ref; } while (0)
  float alp = 1.f; bool pend = false;
  f32x16 pA0, pA1, pB0, pB1; float psA, psB; bf16x8 pa0, pa1, pa2, pa3; const int NT = seq / KVBLK;
#define SCHED_A() do { if constexpr (DQK == 128) sched_pipe<16, 1, ATT_NVA128, 1, ATT_PREA>(); else sched_pipe<24 / ATT_MG192, ATT_MG192, ATT_NVA192 * ATT_MG192, ATT_DS192, ATT_PREA>(); } while (0)
#define SCHED_B() sched_pipe<16, 1, ATT_NVB, 2, ATT_PREB>()
#define NEXTV(v_) (((v_) == 2 * SHM_V) ? 0 : (v_) + SHM_V)
#define STEPS(C0, C1, P0, P1, psP, psPrev, t_, KB, vo_t, vo_tm1, vo_tm2, haveK, havePV) do { DMA_V(t_, vo_t); if (haveK) DMA_K((t_) + 1, 1 - (KB)); ATT_SBAR(); \
    if (isY) { if (havePV) { pv_d0(o, vb0 + (vo_tm2), pa0, pa1, pa2, pa3); } partialSM(P0, P1); SCHED_B(); ATT_SBAR(); RESCN(psPrev); } \
    else { qkt<DQK>(C0, C1, negm, K_lds + (KB) * SHM_K, kb, qr, qx, r32, hi); finishSM(P0, P1, psP, l_reg, pa0, pa1, pa2, pa3); SCHED_A(); } \
    ATT_SBAR(); \
    if (isY) { qkt<DQK>(C0, C1, negm, K_lds + (KB) * SHM_K, kb, qr, qx, r32, hi); finishSM(P0, P1, psP, l_reg, pa0, pa1, pa2, pa3); SCHED_A(); } \
    else { pv_d0(o, vb0 + (vo_tm1), pa0, pa1, pa2, pa3); partialSM(C0, C1); SCHED_B(); ATT_SBAR(); RESCN(psP); } \
    ATT_SBAR(); VMW0(); __syncthreads(); } while (0)
  const bool isY = wid >= 4;
  DMA_K(0, 0); VMW0(); __syncthreads();
  DMA_V(0, 0); DMA_K(1, 1);
  qkt<DQK>(pA0, pA1, negm, K_lds, kb, qr, qx, r32, hi); firstSM0(pA0, pA1, m_ref, negm);
  if (!isY) partialSM(pA0, pA1);
  VMW0(); __syncthreads();
  psA = 0.f; psB = 0.f;
  int v2 = 0, v1 = 0, v0 = SHM_V;
  STEPS(pB0, pB1, pA0, pA1, psA, psB, 1, 1, v0, v1, v2, true, false); v2 = v1; v1 = v0; v0 = NEXTV(v0);
  for (int t = 2; t + 1 < NT; t += 2) {
    STEPS(pA0, pA1, pB0, pB1, psB, psA, t, 0, v0, v1, v2, true, true); v2 = v1; v1 = v0; v0 = NEXTV(v0);
    STEPS(pB0, pB1, pA0, pA1, psA, psB, t + 1, 1, v0, v1, v2, (t + 2 < NT), true); v2 = v1; v1 = v0; v0 = NEXTV(v0);
  }
  if (isY) { pv_d0(o, vb0 + v2, pa0, pa1, pa2, pa3); partialSM(pB0, pB1); ATT_SBAR(); if (pend) { RESC_APPLY(); } }
  finishSM(pB0, pB1, psB, l_reg, pa0, pa1, pa2, pa3); ATT_SBAR();
  pv_d0(o, vb0 + v1, pa0, pa1, pa2, pa3);
#undef STEPS
#undef NEXTV
#undef SCHED_A
#undef SCHED_B
  if (hi == 0) li_l[r32] = l_reg; asm volatile("s_waitcnt lgkmcnt(0)" ::: "memory");
  float rli[16];
#pragma unroll
  for (int r = 0; r < 16; ++r) rli[r] = __builtin_amdgcn_rcpf(li_l[crow(r, hi)]);
  { int r32e = r32, hie = hi; asm volatile("" : "+v"(r32e), "+v"(hie));
    char* Ow = (char*)(Ob + (long)(wid * QBLK) * LDO);
    const unsigned lo_ = (unsigned)((4 * hie) * LDO + r32e) * 2u;
#pragma unroll
    for (int r = 0; r < 16; ++r) {
#pragma unroll
      for (int d0 = 0; d0 < 4; ++d0) *(bf16*)(Ow + lo_ + (unsigned)((((r & 3) + 8 * (r >> 2)) * LDO + d0 * 32) * 2)) = (bf16)(cvtpk(o[d0][r] * rli[r], 0.f) & 0xffffu); } }
  asm volatile("s_waitcnt vmcnt(0) lgkmcnt(0)" ::: "memory"); __syncthreads();
#undef DMA_V
#undef DMA_K
#undef VMW0
#undef RESCN
#undef RESC_APPLY
}
#undef ATT_KSWZ
#undef ATT_KEY
#undef ATT_PK
#undef ATT_SBAR
}
#define LAS __attribute__((address_space(3)))
typedef unsigned short u16;
typedef float f32x4 __attribute__((ext_vector_type(4)));
typedef short bf16x8 __attribute__((ext_vector_type(8)));
typedef unsigned u32x4 __attribute__((ext_vector_type(4)));
typedef unsigned u32x2 __attribute__((ext_vector_type(2)));
constexpr int DM = 2048, BATCH = 2, SEQ = 16384, T = BATCH * SEQ;
constexpr int IN0 = 4608, NLAT = 1088, NLATP = 1280, NQ = 3072, NKV = 4096, DFF = 8192;
constexpr float EPS = 1e-6f;
constexpr int NWAVES = 8, NTHREADS = 512;
constexpr int LDS_BYTES = 155648;
constexpr float LOG2_THETA = 13.287712379549449f;

constexpr size_t MiB = 1u << 20;
constexpr size_t WS_WIN = 0, WS_WOUT = 18 * MiB, WS_WDOWN = 26 * MiB, WS_WUQ = 31 * MiB, WS_WUKV = 34 * MiB, WS_WO = 38 * MiB;
constexpr size_t WS_WUP = 46 * MiB  , WS_WDN = 110 * MiB  ;
constexpr size_t WS_XN = 176 * MiB;
constexpr size_t WS_HB = 304 * MiB;
constexpr size_t WS_BIG = 432 * MiB;
constexpr size_t WS_PROJ = WS_BIG, WS_MIX = WS_BIG + 288 * MiB;
constexpr size_t WS_HID = WS_BIG;
constexpr size_t WS_Q = WS_BIG, WS_KV = WS_BIG + 192 * MiB, WS_LAT = WS_BIG + 448 * MiB, WS_KROPE = WS_BIG + 528 * MiB;
constexpr size_t WS_CQN = WS_LAT, WS_CKVN = WS_LAT;
constexpr size_t WS_AO = WS_XN;
constexpr size_t WS_CTL = WS_BIG + 532 * MiB, CTL_BAR = 65536, WS_SS = WS_CTL + CTL_BAR, CTL_BYTES = CTL_BAR + 5 * 131072;
constexpr size_t WS_END = WS_CTL + CTL_BYTES;

__device__ __forceinline__ float bflo(unsigned u) { return __uint_as_float(u << 16); }
__device__ __forceinline__ float bfhi(unsigned u) { return __uint_as_float(u & 0xffff0000u); }
__device__ __forceinline__ unsigned pk2(float lo, float hi) { unsigned r; asm volatile("v_cvt_pk_bf16_f32 %0, %1, %2" : "=v"(r) : "v"(lo), "v"(hi)); return r; }
__device__ __forceinline__ float wave_sum(float v) {
#pragma unroll
    for (int o = 1; o < 64; o <<= 1) v += __shfl_xor(v, o);
    return v;
}
__device__ __forceinline__ void rope_cs(float pos, float invf, float& c, float& s) {
    const float a = pos * invf;
    double rev = (double)a * 0.15915494309189535;
    rev -= __builtin_rint(rev);
    const float fr = (float)rev;
    c = __builtin_amdgcn_cosf(fr); s = __builtin_amdgcn_sinf(fr);
}

__device__ __forceinline__ void transpose_item(const float* __restrict__ W, const float* __restrict__ gain, float mul, int K, int N, u16* __restrict__ WT, LAS float* scr, int item, int lane) {
    const int nblk = N / 32, kb = item / nblk, nb = item % nblk, k0 = 64 * kb, n0 = 32 * nb;
    float wv[32];
#pragma unroll
    for (int i = 0; i < 32; ++i) { const int kk = 2 * i + (lane >> 5); wv[i] = W[(size_t)(k0 + kk) * N + n0 + (lane & 31)]; }
    float gv = 1.f; if (gain) gv = gain[k0 + lane] * mul;
#pragma unroll
    for (int i = 0; i < 32; ++i) { const int kk = 2 * i + (lane >> 5); const float g = __shfl(gv, kk); scr[kk * 33 + (lane & 31)] = wv[i] * g; }
    asm volatile("s_waitcnt lgkmcnt(0)" ::: "memory");
    const int c = lane & 7;
#pragma unroll
    for (int j = 0; j < 4; ++j) { const int n = (lane >> 3) + 8 * j; const LAS float* s = scr + (8 * c) * 33 + n;
        u32x4 o; o.x = pk2(s[0 * 33], s[1 * 33]); o.y = pk2(s[2 * 33], s[3 * 33]); o.z = pk2(s[4 * 33], s[5 * 33]); o.w = pk2(s[6 * 33], s[7 * 33]);
        *(u32x4*)(WT + (size_t)(n0 + n) * K + k0 + 8 * c) = o; }
    asm volatile("s_waitcnt lgkmcnt(0)" ::: "memory");
}

__device__ __forceinline__ void norm_row_bf16(const float* __restrict__ xrow, u16* __restrict__ orow, int lane) {
    const f32x4* xr = (const f32x4*)xrow + lane;
    f32x4 v[8]; float s = 0.f;
#pragma unroll
    for (int j = 0; j < 8; ++j) { v[j] = xr[64 * j]; s += (v[j].x * v[j].x + v[j].y * v[j].y) + (v[j].z * v[j].z + v[j].w * v[j].w); }
    const float r = 1.0f / sqrtf(wave_sum(s) * (1.f / DM) + EPS);
    u32x2* o8 = (u32x2*)orow + lane;
#pragma unroll
    for (int j = 0; j < 8; ++j) { u32x2 w; w.x = pk2(v[j].x * r, v[j].y * r); w.y = pk2(v[j].z * r, v[j].w * r); o8[64 * j] = w; }
}
__device__ __forceinline__ void norm_row_b2b(const u16* __restrict__ hrow, u16* __restrict__ orow, int lane) {
    const u32x4* xr = (const u32x4*)hrow + lane;
    u32x4 w[4]; float s = 0.f;
#pragma unroll
    for (int j = 0; j < 4; ++j) { w[j] = xr[64 * j];
#pragma unroll
        for (int e = 0; e < 4; ++e) { const float a = bflo(w[j][e]), b = bfhi(w[j][e]); s += a * a + b * b; } }
    const float r = 1.0f / sqrtf(wave_sum(s) * (1.f / DM) + EPS);
    u32x4* o = (u32x4*)orow + lane;
#pragma unroll
    for (int j = 0; j < 4; ++j) { u32x4 v;
#pragma unroll
        for (int e = 0; e < 4; ++e) v[e] = pk2(bflo(w[j][e]) * r, bfhi(w[j][e]) * r);
        o[64 * j] = v; }
}
__device__ __forceinline__ void norm_row_final(const u16* __restrict__ hrow, float* __restrict__ orow, const float* __restrict__ g, int lane) {
    const u32x4* xr = (const u32x4*)hrow + lane;
    u32x4 w[4]; float s = 0.f;
#pragma unroll
    for (int j = 0; j < 4; ++j) { w[j] = xr[64 * j];
#pragma unroll
        for (int e = 0; e < 4; ++e) { const float a = bflo(w[j][e]), b = bfhi(w[j][e]); s += a * a + b * b; } }
    const float r = 1.0f / sqrtf(wave_sum(s) * (1.f / DM) + EPS);
#pragma unroll
    for (int j = 0; j < 4; ++j) { const int c = (64 * j + lane) * 8; const f32x4 g0 = *(const f32x4*)(g + c), g1 = *(const f32x4*)(g + c + 4);
        f32x4 o0 = {bflo(w[j][0]) * r * g0[0], bfhi(w[j][0]) * r * g0[1], bflo(w[j][1]) * r * g0[2], bfhi(w[j][1]) * r * g0[3]};
        f32x4 o1 = {bflo(w[j][2]) * r * g1[0], bfhi(w[j][2]) * r * g1[1], bflo(w[j][3]) * r * g1[2], bfhi(w[j][3]) * r * g1[3]};
        *(f32x4*)(orow + c) = o0; *(f32x4*)(orow + c + 4) = o1; }
}

__device__ __forceinline__ void ld8f(const u16* p, float* f) {
    const u32x4 w = *(const u32x4*)p;
    f[0] = bflo(w.x); f[1] = bfhi(w.x); f[2] = bflo(w.y); f[3] = bfhi(w.y); f[4] = bflo(w.z); f[5] = bfhi(w.z); f[6] = bflo(w.w); f[7] = bfhi(w.w);
}

__device__ __forceinline__ void ew0_token(int t, u16* __restrict__ PROJ, u16* __restrict__ MIX, const float* __restrict__ qg, const float* __restrict__ kg, const float* __restrict__ cw, int lane) {
    const int s = t & (SEQ - 1), row = s >> 6, col = s & 63;
    float c, sn; { const int j = lane & 31; const float invf = __builtin_amdgcn_exp2f(-(float)j * (LOG2_THETA / 32.f)); rope_cs((float)(lane < 32 ? row : col), invf, c, sn); }
    unsigned* pr = (unsigned*)(PROJ + (size_t)t * IN0);
    const float qg0 = qg[2 * lane], qg1 = qg[2 * lane + 1], kg0 = kg[2 * lane], kg1 = kg[2 * lane + 1];
#pragma unroll
    for (int h = 0; h < 10; ++h) {
        const unsigned u = pr[h * 64 + lane]; const float x1 = bflo(u), x2 = bfhi(u);
        const float ss = wave_sum(x1 * x1 + x2 * x2); const float r = 1.0f / sqrtf(ss * (1.f / 128.f) + EPS);
        const float y1 = x1 * r * (h < 8 ? qg0 * att::Cfg<128>::C : kg0), y2 = x2 * r * (h < 8 ? qg1 * att::Cfg<128>::C : kg1);
        pr[h * 64 + lane] = pk2(y1 * c - y2 * sn, y1 * sn + y2 * c);
    }
    const u16* p0 = PROJ + (size_t)t * IN0;
#pragma unroll
    for (int ch = 0; ch < 2; ++ch) {
        const int cc = ch * 512 + lane * 8;
        float gb[8], g0[8], u0[8], gm[8], um[8], gp[8], up[8];
        ld8f(p0 + 1536 + cc, gb); ld8f(p0 + 2560 + cc, g0); ld8f(p0 + 3584 + cc, u0);
        if (s > 0) { ld8f(p0 - IN0 + 2560 + cc, gm); ld8f(p0 - IN0 + 3584 + cc, um); } else {
#pragma unroll
            for (int e = 0; e < 8; ++e) { gm[e] = 0.f; um[e] = 0.f; } }
        if (s < SEQ - 1) { ld8f(p0 + IN0 + 2560 + cc, gp); ld8f(p0 + IN0 + 3584 + cc, up); } else {
#pragma unroll
            for (int e = 0; e < 8; ++e) { gp[e] = 0.f; up[e] = 0.f; } }
        float o[8];
#pragma unroll
        for (int e = 0; e < 8; ++e) o[e] = gb[e] * (cw[cc + e] * (gm[e] * um[e]) + cw[1024 + cc + e] * (g0[e] * u0[e]) + cw[2048 + cc + e] * (gp[e] * up[e]));
        u32x4 w; w.x = pk2(o[0], o[1]); w.y = pk2(o[2], o[3]); w.z = pk2(o[4], o[5]); w.w = pk2(o[6], o[7]);
        *(u32x4*)(MIX + (size_t)t * DM + 1024 + cc) = w;
    }
}
__device__ __forceinline__ void cv8f(const u32x4 w, float* f) {
    f[0] = bflo(w.x); f[1] = bfhi(w.x); f[2] = bflo(w.y); f[3] = bfhi(w.y); f[4] = bflo(w.z); f[5] = bfhi(w.z); f[6] = bflo(w.w); f[7] = bfhi(w.w);
}
__device__ __forceinline__ void ew0_pair(int t, u16* __restrict__ PROJ, u16* __restrict__ MIX, const float* __restrict__ qg, const float* __restrict__ kg, const float* __restrict__ cw, int lane) {
    const int s = t & (SEQ - 1), row = s >> 6, col = s & 63;
    unsigned* pr0 = (unsigned*)(PROJ + (size_t)t * IN0); unsigned* pr1 = pr0 + IN0 / 2;
    const u16* p0 = PROJ + (size_t)t * IN0;
    unsigned ua[10], ub[10];
#pragma unroll
    for (int h = 8; h < 10; ++h) { ua[h] = pr0[h * 64 + lane]; ub[h] = pr1[h * 64 + lane]; }
    u32x4 rgb[2][2], rg[2][4], ru[2][4];
    const bool hasm = s > 0, hasp = s + 1 < SEQ - 1; const u32x4 z4 = {0u, 0u, 0u, 0u};
#pragma unroll
    for (int ch = 0; ch < 2; ++ch) { const int cc = ch * 512 + lane * 8;
        rgb[ch][0] = *(const u32x4*)(p0 + 1536 + cc); rgb[ch][1] = *(const u32x4*)(p0 + IN0 + 1536 + cc);
        rg[ch][1] = *(const u32x4*)(p0 + 2560 + cc); ru[ch][1] = *(const u32x4*)(p0 + 3584 + cc);
        rg[ch][2] = *(const u32x4*)(p0 + IN0 + 2560 + cc); ru[ch][2] = *(const u32x4*)(p0 + IN0 + 3584 + cc);
        rg[ch][0] = hasm ? *(const u32x4*)(p0 - IN0 + 2560 + cc) : z4; ru[ch][0] = hasm ? *(const u32x4*)(p0 - IN0 + 3584 + cc) : z4;
        rg[ch][3] = hasp ? *(const u32x4*)(p0 + 2 * IN0 + 2560 + cc) : z4; ru[ch][3] = hasp ? *(const u32x4*)(p0 + 2 * IN0 + 3584 + cc) : z4; }
    float c0, s0, c1, s1; { const int j = lane & 31; const float invf = __builtin_amdgcn_exp2f(-(float)j * (LOG2_THETA / 32.f));
        rope_cs((float)(lane < 32 ? row : col), invf, c0, s0); rope_cs((float)(lane < 32 ? row : col + 1), invf, c1, s1); }
    const float qg0 = qg[2 * lane] * att::Cfg<128>::C, qg1 = qg[2 * lane + 1] * att::Cfg<128>::C, kg0 = kg[2 * lane], kg1 = kg[2 * lane + 1];
#pragma unroll
    for (int h = 8; h < 10; ++h) {
        const float a1 = bflo(ua[h]), a2 = bfhi(ua[h]), b1 = bflo(ub[h]), b2 = bfhi(ub[h]);
        const float ra = 1.0f / sqrtf(wave_sum(a1 * a1 + a2 * a2) * (1.f / 128.f) + EPS), rb = 1.0f / sqrtf(wave_sum(b1 * b1 + b2 * b2) * (1.f / 128.f) + EPS);
        const float g0 = (h < 8 ? qg0 : kg0), g1 = (h < 8 ? qg1 : kg1);
        const float ya1 = a1 * ra * g0, ya2 = a2 * ra * g1, yb1 = b1 * rb * g0, yb2 = b2 * rb * g1;
        pr0[h * 64 + lane] = pk2(ya1 * c0 - ya2 * s0, ya1 * s0 + ya2 * c0);
        pr1[h * 64 + lane] = pk2(yb1 * c1 - yb2 * s1, yb1 * s1 + yb2 * c1);
    }
#pragma unroll
    for (int ch = 0; ch < 2; ++ch) {
        const int cc = ch * 512 + lane * 8;
        float gbA[8], gbB[8], gm[8], um[8], g0[8], u0[8], g1[8], u1[8], g2[8], u2[8];
        cv8f(rgb[ch][0], gbA); cv8f(rgb[ch][1], gbB); cv8f(rg[ch][0], gm); cv8f(ru[ch][0], um); cv8f(rg[ch][1], g0); cv8f(ru[ch][1], u0);
        cv8f(rg[ch][2], g1); cv8f(ru[ch][2], u1); cv8f(rg[ch][3], g2); cv8f(ru[ch][3], u2);
        float oa[8], ob[8];
#pragma unroll
        for (int e = 0; e < 8; ++e) { const float w0 = cw[cc + e], w1 = cw[1024 + cc + e], w2 = cw[2048 + cc + e];
            const float xm = gm[e] * um[e], x0 = g0[e] * u0[e], x1 = g1[e] * u1[e], x2 = g2[e] * u2[e];
            oa[e] = gbA[e] * (w0 * xm + w1 * x0 + w2 * x1); ob[e] = gbB[e] * (w0 * x0 + w1 * x1 + w2 * x2); }
        u32x4 wa; wa.x = pk2(oa[0], oa[1]); wa.y = pk2(oa[2], oa[3]); wa.z = pk2(oa[4], oa[5]); wa.w = pk2(oa[6], oa[7]);
        u32x4 wb; wb.x = pk2(ob[0], ob[1]); wb.y = pk2(ob[2], ob[3]); wb.z = pk2(ob[4], ob[5]); wb.w = pk2(ob[6], ob[7]);
        *(u32x4*)(MIX + (size_t)t * DM + 1024 + cc) = wa; *(u32x4*)(MIX + (size_t)(t + 1) * DM + 1024 + cc) = wb;
    }
}
__device__ __forceinline__ void ew1_token(int t, const u16* __restrict__ LAT, u16* __restrict__ CQN, u16* __restrict__ CKVN, u16* __restrict__ KROPE, int lane) {
    const u16* p0 = LAT + (size_t)t * NLATP;
#pragma unroll
    for (int part = 0; part < 2; ++part) {
        float x[8]; ld8f(p0 + part * 512 + lane * 8, x);
        float ss = 0.f;
#pragma unroll
        for (int e = 0; e < 8; ++e) ss += x[e] * x[e];
        const float r = 1.0f / sqrtf(wave_sum(ss) * (1.f / 512.f) + EPS);
        u32x4 w; w.x = pk2(x[0] * r, x[1] * r); w.y = pk2(x[2] * r, x[3] * r); w.z = pk2(x[4] * r, x[5] * r); w.w = pk2(x[6] * r, x[7] * r);
        *(u32x4*)((part ? CKVN : CQN) + (size_t)t * 512 + lane * 8) = w;
    }
    if (lane < 32) {
        const int s = t & (SEQ - 1), row = s >> 6, col = s & 63; const int j = lane & 15;
        const float invf = __builtin_amdgcn_exp2f(-(float)j * (LOG2_THETA / 16.f)); float c, sn; rope_cs((float)(lane < 16 ? row : col), invf, c, sn);
        const unsigned u = *(const unsigned*)(p0 + 1024 + 2 * lane); const float x1 = bflo(u), x2 = bfhi(u);
        *(unsigned*)(KROPE + (size_t)t * 64 + 2 * lane) = pk2(x1 * c - x2 * sn, x1 * sn + x2 * c);
    }
}
__device__ __forceinline__ void ew2_token(int t, u16* __restrict__ Q, int lane) {
    const int s = t & (SEQ - 1), row = s >> 6, col = s & 63;
    const int h = lane >> 2, part = lane & 3; const float pos = (float)(part < 2 ? row : col);
    u16* p = Q + (size_t)t * NQ + h * 192 + 128 + part * 16;
    float x[16]; ld8f(p, x); ld8f(p + 8, x + 8);
    unsigned w[8];
#pragma unroll
    for (int i = 0; i < 8; ++i) { const int j = (part & 1) * 8 + i; const float invf = __builtin_amdgcn_exp2f(-(float)j * (LOG2_THETA / 16.f)); float c, sn; rope_cs(pos, invf, c, sn);
        w[i] = pk2(x[2 * i] * c - x[2 * i + 1] * sn, x[2 * i] * sn + x[2 * i + 1] * c); }
    *(u32x4*)p = (u32x4){w[0], w[1], w[2], w[3]}; *(u32x4*)(p + 8) = (u32x4){w[4], w[5], w[6], w[7]};
}

#define RLX_AGENT __ATOMIC_RELAXED, __HIP_MEMORY_SCOPE_AGENT
#define XB_TMO      128
#define XB_XCNT(j)  (256  + 64 * (j))
#define XB_XSUB(j)  (1280 + 64 * (j))
#define XB_XGEN(j)  (2304 + 64 * (j))
#define XB_TOP      3328
#define XB_TOPGEN   3392
#define XCD_BAR_WORDS 3456
#define XB_SPIN_CAP (1u << 22)

__device__ __forceinline__ unsigned xb_ld(unsigned* p)              { return __hip_atomic_load(p, __ATOMIC_RELAXED, __HIP_MEMORY_SCOPE_AGENT); }
__device__ __forceinline__ unsigned xb_add(unsigned* p, unsigned v) { return __hip_atomic_fetch_add(p, v, __ATOMIC_RELAXED, __HIP_MEMORY_SCOPE_AGENT); }
__device__ __forceinline__ unsigned xb_xcc_id() { return (unsigned)__builtin_amdgcn_s_getreg((3 << 11) | 20) & 0xFu; }
#define XB_SPIN(cond, bar) do { unsigned _sp = 0; while (cond) { __builtin_amdgcn_s_sleep(1); \
    if ((++_sp & 255u) == 0u) { if (xb_ld(&(bar)[XB_TMO])) break; if (_sp > XB_SPIN_CAP) { atomicAdd(&(bar)[XB_TMO], 1u); break; } } } } while (0)

struct XcdBarrier {
    unsigned* bar; unsigned x;
    volatile LAS unsigned* st;
};

__device__ __forceinline__ XcdBarrier xcd_barrier_post(unsigned* bar, volatile LAS unsigned* st) {
    XcdBarrier b; b.bar = bar; b.x = xb_xcc_id(); b.st = st;
    if (threadIdx.x == 0) (void)xb_add(&bar[XB_XCNT(b.x)], 1u);
    return b;
}
__device__ __forceinline__ void xcd_barrier_complete(unsigned* bar, unsigned x, unsigned& nloc, unsigned& nx) {
    const unsigned G = gridDim.x * gridDim.y * gridDim.z;
    unsigned sum, cnt, mine, sp = 0u;
    for (;;) {
        sum = 0u; cnt = 0u; mine = 0u;
#pragma unroll
        for (unsigned j = 0; j < 16; ++j) { const unsigned c = xb_ld(&bar[XB_XCNT(j)]); sum += c; cnt += (c > 0u) ? 1u : 0u; mine = (j == x) ? c : mine; }
        if (sum == G) break;
        __builtin_amdgcn_s_sleep(1);
        if ((++sp & 255u) == 0u) { if (xb_ld(&bar[XB_TMO])) break; if (sp > XB_SPIN_CAP) { atomicAdd(&bar[XB_TMO], 1u); break; } }
    }
    nloc = mine > 0u ? mine : 1u; nx = cnt > 0u ? cnt : 1u;
}

__device__ __forceinline__ void xcd_barrier(const XcdBarrier& b) {
    asm volatile("s_waitcnt vmcnt(0)" ::: "memory");
    __syncthreads();
    if (threadIdx.x == 0) {
        unsigned* bar = b.bar;
        __builtin_amdgcn_s_waitcnt(0);
        unsigned nloc = b.st[0], nx = b.st[1];
        if (nloc == 0u) { xcd_barrier_complete(bar, b.x, nloc, nx); b.st[0] = nloc; b.st[1] = nx; }
        const unsigned old = xb_add(&bar[XB_XSUB(b.x)], 1u);
        const unsigned gen = old / nloc;
        if (old + 1u == (gen + 1u) * nloc) {
            __builtin_amdgcn_fence(__ATOMIC_RELEASE, "agent");
            asm volatile("s_waitcnt vmcnt(0)" ::: "memory");
            const unsigned og = xb_add(&bar[XB_TOP], 1u);
            const unsigned tg = og / nx;
            if (og + 1u == (tg + 1u) * nx) xb_add(&bar[XB_TOPGEN], 1u);
            else XB_SPIN(xb_ld(&bar[XB_TOPGEN]) == tg, bar);
            __builtin_amdgcn_fence(__ATOMIC_ACQUIRE, "agent");
            xb_add(&bar[XB_XGEN(b.x)], 1u);
            asm volatile("s_waitcnt vmcnt(0)" ::: "memory");
        } else {
            XB_SPIN(xb_ld(&bar[XB_XGEN(b.x)]) == gen, bar);
            __builtin_amdgcn_fence(__ATOMIC_ACQUIRE, "agent");
            asm volatile("s_waitcnt vmcnt(0)" ::: "memory");
        }
    }
    __syncthreads();
}

struct Params { const float* in[18]; float* out; unsigned char* ws; int ph_lo, ph_hi; };
enum { I_X = 0, I_ENG, I_EWIN, I_EQG, I_EKG, I_ECW, I_EWOUT, I_ONG, I_OWDOWN, I_OQG, I_OKVG, I_OWUQ, I_OWUKV, I_OWO, I_MNG, I_MWUP, I_MWDN, I_FNG };
constexpr int NPHASE = 19;

template <int DQK> __device__ __forceinline__ bool attn_next(int i, int NU, int& unit) {
    const int G = gridDim.x, bx = blockIdx.x;
    if ((G & 7) == 0 && (NU & 7) == 0) { const int x = bx & 7, j = bx >> 3, per = G >> 3, upx = NU >> 3; const int k = i * per + j; if (k >= upx) return false; unit = x * upx + k; return true; }
    const int k = i * G + bx; if (k >= NU) return false; unit = k; return true;
}

__global__ void __launch_bounds__(NTHREADS, 2) fwd_mega(Params P) {
    extern __shared__ __attribute__((aligned(16))) unsigned char lds[];
    cg::grid_group grid = cg::this_grid();
    const int tid = threadIdx.x, lane = tid & 63, wave = __builtin_amdgcn_readfirstlane(tid >> 6);
    const int G = gridDim.x, gw = blockIdx.x * NWAVES + wave, NGW = G * NWAVES;
    unsigned char* ws = P.ws;
    u16* Win = (u16*)(ws + WS_WIN); u16* Wout = (u16*)(ws + WS_WOUT); u16* Wdown = (u16*)(ws + WS_WDOWN); u16* Wuq = (u16*)(ws + WS_WUQ); u16* Wukv = (u16*)(ws + WS_WUKV); u16* Wo = (u16*)(ws + WS_WO);
    u16* Wup = (u16*)(ws + WS_WUP); u16* Wdn = (u16*)(ws + WS_WDN);
    u16* XN = (u16*)(ws + WS_XN); u16* PROJ = (u16*)(ws + WS_PROJ); u16* MIX = (u16*)(ws + WS_MIX); u16* HID = (u16*)(ws + WS_HID);
    u16* LAT = (u16*)(ws + WS_LAT); u16* CQN = (u16*)(ws + WS_CQN); u16* CKVN = (u16*)(ws + WS_CKVN); u16* KROPE = (u16*)(ws + WS_KROPE);
    u16* Qm = (u16*)(ws + WS_Q); u16* KVm = (u16*)(ws + WS_KV); u16* AO = (u16*)(ws + WS_AO);
    u16* HB = (u16*)(ws + WS_HB); float* SS0 = (float*)(ws + WS_SS); float* SS1 = SS0 + T; float* SS2 = SS1 + T; float* SSQ = SS2 + T; float* SSKV = SSQ + T; const float* NOSS = nullptr; float* NOSSW = nullptr;
    LAS unsigned char* ldsl = (LAS unsigned char*)lds;
    const int lo = P.ph_lo, hi = P.ph_hi;
    volatile LAS unsigned* xst = (volatile LAS unsigned*)(ldsl + LDS_BYTES - 16);
    if (tid < 4) xst[tid] = 0u;
    __syncthreads();
    XcdBarrier xbar = xcd_barrier_post((unsigned*)(ws + WS_CTL), xst);
#define PH(k) if (lo <= (k) && (k) < hi) _Pragma("unroll") for (int rep_ = 0; rep_ <= (int)((REP_MASK >> (k)) & 1u); ++rep_)
#define SEAM(k) do { if (lo <= (k) && (k) + 1 < hi) { if ((k) == 0) grid.sync(); else xcd_barrier(xbar); } } while (0)
#define GEMM_BF16X(ACT, Aptr, ldav, Bptr, Mv, Nv, Kv, Optr, ldc, ssptr, sso0p, sso1p) do { pg8::Gemm g{Aptr, Bptr, Mv, Nv, Kv, ldav}; pg8::StaticOrder S; S.init(Mv, Nv, G, (int)blockIdx.x); \
        pg8::EpiBf16<ACT> E{Optr, ldc, ssptr, 1.0f / (float)(Kv), EPS, sso0p, sso1p}; pg8::gemm_phase<pg8::EpiBf16<ACT>, pg8::StaticOrder, true, true>(ldsl, g, S, E); } while (0)
#define GEMM_BF16(ACT, Aptr, Bptr, Mv, Nv, Kv, Optr, ldc, ssptr) GEMM_BF16X(ACT, Aptr, Kv, Bptr, Mv, Nv, Kv, Optr, ldc, ssptr, NOSSW, NOSSW)
#define GEMM_RES(F32B, Aptr, Bptr, Mv, Nv, Kv, baseptr, ssptr) do { pg8::Gemm g{Aptr, Bptr, Mv, Nv, Kv, Kv}; pg8::StaticOrder S; S.init(Mv, Nv, G, (int)blockIdx.x); \
        pg8::EpiResB<F32B> E{baseptr, HB, Nv, ssptr}; pg8::gemm_phase<pg8::EpiResB<F32B>, pg8::StaticOrder, true, true>(ldsl, g, S, E); } while (0)
#define NORM_PHASE() do { for (int m = gw; m < T; m += NGW) norm_row_b2b(HB + (size_t)m * DM, XN + (size_t)m * DM, lane); } while (0)

    PH(0) {
        LAS float* scr = (LAS float*)(ldsl + wave * 16384);
        constexpr int I0 = (DM / 64) * (IN0 / 32), I1 = (DM / 64) * (DM / 32), I2 = (DM / 64) * (NLAT / 32), I3 = (512 / 64) * (NQ / 32), I4 = (512 / 64) * (NKV / 32), I5 = I1;
        constexpr int I6 = (DM / 64) * (DFF / 32), I7 = (DFF / 64) * (DM / 32);
        constexpr int NITEMS = I0 + I1 + I2 + I3 + I4 + I5 + 2 * I6 + 2 * I7;
        for (int it = gw; it < NITEMS; it += NGW) {
            int r = it;
            if (r < I0) { transpose_item(P.in[I_EWIN], P.in[I_ENG], 1.f, DM, IN0, Win, scr, r, lane); continue; } r -= I0;
            if (r < I1) { transpose_item(P.in[I_EWOUT], nullptr, 1.f, DM, DM, Wout, scr, r, lane); continue; } r -= I1;
            if (r < I2) { transpose_item(P.in[I_OWDOWN], P.in[I_ONG], 1.f, DM, NLAT, Wdown, scr, r, lane); continue; } r -= I2;
            if (r < I3) { transpose_item(P.in[I_OWUQ], P.in[I_OQG], att::Cfg<192>::C, 512, NQ, Wuq, scr, r, lane); continue; } r -= I3;
            if (r < I4) { transpose_item(P.in[I_OWUKV], P.in[I_OKVG], 1.f, 512, NKV, Wukv, scr, r, lane); continue; } r -= I4;
            if (r < I5) { transpose_item(P.in[I_OWO], nullptr, 1.f, DM, DM, Wo, scr, r, lane); continue; } r -= I5;
            if (r < I6) { transpose_item(P.in[I_MWUP], P.in[I_MNG], 1.f, DM, DFF, Wup, scr, r, lane); continue; } r -= I6;
            if (r < I6) { transpose_item(P.in[I_MWUP] + (size_t)DM * DFF, P.in[I_MNG] + DM, 1.f, DM, DFF, Wup + (size_t)DM * DFF, scr, r, lane); continue; } r -= I6;
            if (r < I7) { transpose_item(P.in[I_MWDN], nullptr, 1.f, DFF, DM, Wdn, scr, r, lane); continue; } r -= I7;
            transpose_item(P.in[I_MWDN] + (size_t)DM * DFF, nullptr, 1.f, DFF, DM, Wdn + (size_t)DM * DFF, scr, r, lane);
        }
        { const size_t n16 = (size_t)(NLATP - NLAT) * DM * 2 / 16; u32x4* z = (u32x4*)(Wdown + (size_t)NLAT * DM);
          for (size_t i = (size_t)blockIdx.x * NTHREADS + tid; i < n16; i += (size_t)G * NTHREADS) z[i] = (u32x4){0u, 0u, 0u, 0u}; }
        for (int m = gw; m < T; m += NGW) norm_row_bf16(P.in[I_X] + (size_t)m * DM, XN + (size_t)m * DM, lane);
    }
    SEAM(0);
    PH(1) { GEMM_BF16(0, XN, Win, T, IN0, DM, PROJ, IN0, NOSS); }
    SEAM(1);
    PH(2) { const int per = ((T / 2 + NGW - 1) / NGW) * 2; const int t0 = gw * per; for (int t = t0; t < t0 + per && t < T; t += 2) ew0_pair(t, PROJ, MIX, P.in[I_EQG], P.in[I_EKG], P.in[I_ECW], lane); }
    SEAM(2);
    PH(3) {
        if (ATT_PRIO && wave >= 4) __builtin_amdgcn_s_setprio(1);
        constexpr int NU = BATCH * 8 * (SEQ / 256); int unit;
        for (int i = 0; attn_next<128>(i, NU, unit); ++i) {
            const int bh = unit / (SEQ / 256), qb = unit % (SEQ / 256), b = bh >> 3, hq = bh & 7, kvh = hq >> 2;
            const size_t tb = (size_t)b * SEQ;
#ifndef NO_GQA
            att::ATT_UNIT<128, IN0, IN0, IN0, DM>(PROJ + (tb + (size_t)qb * 256) * IN0 + hq * 128, PROJ + tb * IN0 + 1024 + kvh * 128, nullptr, PROJ + tb * IN0 + 1280 + kvh * 128,
                                                      MIX + (tb + (size_t)qb * 256) * DM + hq * 128, SEQ, (char*)lds, qb * 256, P.in[I_EQG]);
#endif
        }
    }
    if (ATT_PRIO) __builtin_amdgcn_s_setprio(0);
    SEAM(3);
    PH(4) { GEMM_RES(true, MIX, Wout, T, DM, DM, (const void*)P.in[I_X], SS0); }
    SEAM(4);
    PH(6) { GEMM_BF16(2, HB, Wup, T, DFF, DM, HID, DFF, (const float*)SS0); }
    SEAM(6);
    PH(7) { GEMM_RES(false, HID, Wdn, T, DM, DFF, (const void*)HB, SS1); }
    SEAM(7);
    PH(9) { GEMM_BF16X(0, HB, DM, Wdown, T, NLATP, DM, LAT, NLATP, (const float*)SS1, SSQ, SSKV); }
    SEAM(9);
    PH(11) {
        for (int tb_ = gw; tb_ < T; tb_ += 8 * NGW) {
            unsigned uu[8];
#pragma unroll
            for (int i = 0; i < 8; ++i) { const int t = tb_ + i * NGW; uu[i] = (t < T && lane < 32) ? *(const unsigned*)(LAT + (size_t)t * NLATP + 1024 + 2 * lane) : 0u; }
            const int j = lane & 15; const float invf = __builtin_amdgcn_exp2f(-(float)j * (LOG2_THETA / 16.f));
#pragma unroll
            for (int i = 0; i < 8; ++i) { const int t = tb_ + i * NGW; if (t < T && lane < 32) {
                const int s = t & (SEQ - 1), row = s >> 6, col = s & 63; float c, sn; rope_cs((float)(lane < 16 ? row : col), invf, c, sn);
                const float x1 = bflo(uu[i]), x2 = bfhi(uu[i]);
                *(unsigned*)(KROPE + (size_t)t * 64 + 2 * lane) = pk2(x1 * c - x2 * sn, x1 * sn + x2 * c); } } }
        GEMM_BF16X(0, LAT, NLATP, Wuq, T, NQ, 512, Qm, NQ, (const float*)SSQ, NOSSW, NOSSW);
        GEMM_BF16X(0, LAT + 512, NLATP, Wukv, T, NKV, 512, KVm, NKV, (const float*)SSKV, NOSSW, NOSSW); }
    SEAM(11);
    PH(13) {
        if (ATT_PRIO && wave >= 4) __builtin_amdgcn_s_setprio(1);
        constexpr int NU = BATCH * 16 * (SEQ / 256); int unit;
        for (int i = 0; attn_next<192>(i, NU, unit); ++i) {
            const int bh = unit / (SEQ / 256), qb = unit % (SEQ / 256), b = bh >> 4, h = bh & 15;
            const size_t tb = (size_t)b * SEQ;
#ifndef NO_MLA
            att::ATT_UNIT<192, NQ, NKV, NKV, DM>(Qm + (tb + (size_t)qb * 256) * NQ + h * 192, KVm + tb * NKV + h * 256, KROPE + tb * 64, KVm + tb * NKV + h * 256 + 128,
                                                          AO + (tb + (size_t)qb * 256) * DM + h * 128, SEQ, (char*)lds, qb * 256);
#endif
        }
    }
    if (ATT_PRIO) __builtin_amdgcn_s_setprio(0);
    SEAM(13);
    PH(14) { GEMM_RES(false, AO, Wo, T, DM, DM, (const void*)HB, SS2); }
    SEAM(14);
    PH(16) { GEMM_BF16(2, HB, Wup + (size_t)DM * DFF, T, DFF, DM, HID, DFF, (const float*)SS2); }
    SEAM(16);
    PH(17) { GEMM_RES(false, HID, Wdn + (size_t)DM * DFF, T, DM, DFF, (const void*)HB, NOSSW); }
    SEAM(17);
    PH(18) { for (int m = gw; m < T; m += NGW) norm_row_final(HB + (size_t)m * DM, P.out + (size_t)m * DM, P.in[I_FNG], lane);
#ifdef ATT_TIMING
        if (blockIdx.x == 0 && tid == 0) { asm volatile("s_waitcnt vmcnt(0)" ::: "memory"); P.out[0] = floorf(((float*)(ws + WS_CTL + 32768))[ATT_TIMING] * (1.f / 200.f) + 0.5f) * 200000.f; }
#endif
    }
#undef PH
#undef SEAM
}

extern "C" void kernel_launch(void* const* d_in, const int* in_sizes, int n_in, void* d_out, int out_size, void* d_ws, size_t ws_size, hipStream_t stream) {
    static int grid = 0;
    if (grid == 0) {
        if (n_in != 18 || in_sizes[0] != T * DM || out_size != T * DM || ws_size < WS_END) {
            fprintf(stderr, "kernel_launch: shape mismatch (n_in %d in0 %d out %d ws %zu need %zu)\n", n_in, n_in > 0 ? in_sizes[0] : -1, out_size, ws_size, (size_t)WS_END); grid = -1; return; }
        int dev = 0, cus = 0, per_cu = 0;
        hipGetDevice(&dev); hipDeviceGetAttribute(&cus, hipDeviceAttributeMultiprocessorCount, dev);
        if (hipFuncSetAttribute((const void*)fwd_mega, hipFuncAttributeMaxDynamicSharedMemorySize, LDS_BYTES) != hipSuccess) { fprintf(stderr, "kernel_launch: hipFuncSetAttribute failed\n"); grid = -1; return; }
        if (hipOccupancyMaxActiveBlocksPerMultiprocessor(&per_cu, (const void*)fwd_mega, NTHREADS, LDS_BYTES) != hipSuccess || per_cu < 1) { fprintf(stderr, "kernel_launch: occupancy query says %d\n", per_cu); per_cu = 1; }
        (void)hipGetLastError();
        grid = cus * per_cu;
        fprintf(stderr, "kernel_launch: grid %d (cus %d x %d)\n", grid, cus, per_cu);
    }
    if (grid < 0) return;
    if (hipMemsetAsync((char*)d_ws + WS_CTL, 0, CTL_BYTES, stream) != hipSuccess) { fprintf(stderr, "kernel_launch: memset failed\n"); return; }
    Params p{};
    for (int i = 0; i < 18; ++i) p.in[i] = (const float*)d_in[i];
    p.out = (float*)d_out; p.ws = (unsigned char*)d_ws;
#if N_LAUNCH_SPLIT
    for (int k = 0; k < NPHASE; ++k) { p.ph_lo = k; p.ph_hi = k + 1; void* args[] = {&p};
        hipError_t e = hipLaunchCooperativeKernel((const void*)fwd_mega, dim3(grid), dim3(NTHREADS), args, LDS_BYTES, stream);
        if (e != hipSuccess) { fprintf(stderr, "cooperative launch failed: %s (grid %d)\n", hipGetErrorString(e), grid); break; } }
#else
    p.ph_lo = 0; p.ph_hi = NPHASE; void* args[] = {&p};
    hipError_t e = hipLaunchCooperativeKernel((const void*)fwd_mega, dim3(grid), dim3(NTHREADS), args, LDS_BYTES, stream);
    if (e != hipSuccess) fprintf(stderr, "cooperative launch failed: %s (grid %d)\n", hipGetErrorString(e), grid);
#endif
}
```

```cpp
#include <hip/hip_runtime.h>
#include <hip/hip_cooperative_groups.h>
#include <cstdio>
#include <cstdint>
namespace cg = cooperative_groups;
#ifndef GQA_SD
#define GQA_SD 1
#endif
#ifndef MLA_SD
#define MLA_SD 1
#endif
#ifndef MLA_QREG
#define MLA_QREG 8
#endif
#ifndef REP_MASK
#define REP_MASK 0u
#endif
#ifndef ATT_NVA128
#define ATT_NVA128 5
#endif
#ifndef ATT_NVA192
#define ATT_NVA192 3
#endif
#ifndef ATT_NVB
#define ATT_NVB 2
#endif
#ifndef ATT_PREA
#define ATT_PREA 4
#endif
#ifndef ATT_LEAD128
#define ATT_LEAD128 0
#endif
#ifndef ATT_NVL128
#define ATT_NVL128 7
#endif
#ifndef ATT_LEAD192
#define ATT_LEAD192 0
#endif
#ifndef ATT_NVL192
#define ATT_NVL192 8
#endif
#ifndef ATT_PREB
#define ATT_PREB 8
#endif
#ifndef PROBE_EW0
#define PROBE_EW0 0
#endif
#ifndef PROBE_DN
#define PROBE_DN 0
#endif
#ifndef PROBE_OUT
#define PROBE_OUT 0
#endif
#ifndef ATT_PRIO
#define ATT_PRIO 0
#endif
#ifndef ATT_PRIOMODE
#define ATT_PRIOMODE 0
#endif
#ifndef ATT_TWAVE
#define ATT_TWAVE 0
#endif
#ifndef ATT_KEYMASK128
#define ATT_KEYMASK128 15
#endif
#ifndef ATT_MG192
#define ATT_MG192 2
#endif
#ifndef ATT_DS192
#define ATT_DS192 2
#endif
#ifndef ATT_UNIT
#define ATT_UNIT attn_unit_dma
#endif
#ifndef N_LAUNCH_SPLIT
#define N_LAUNCH_SPLIT 0
#endif
namespace pg8 {
#define PG8_LAS __attribute__((address_space(3)))
typedef unsigned short bf16_t;
typedef short bf16x8 __attribute__((ext_vector_type(8)));
typedef float f32x4 __attribute__((ext_vector_type(4)));
typedef unsigned u32x4 __attribute__((ext_vector_type(4)));
constexpr int BM = 256, BK = 64, HALF = 128, HTB = HALF * BK * 2  , STAGE_BYTES = 8 * HTB, NXCD = 8, WGM = 8;

__host__ __device__ __forceinline__ int lds_byte(int r, int c) { const int st = (r >> 4) * 2 + (c >> 5), rr = r & 15, cc = c & 31, ob = rr * 64 + cc * 2; return st * 1024 + (ob ^ (((ob >> 9) & 1) << 5)); }
__host__ __device__ __forceinline__ void stage_rc(int b, int& R, int& C) { const int st = b / 1024, sb = b % 1024, swz = sb ^ (((sb >> 9) & 1) << 5); R = (st >> 1) * 16 + swz / 64; C = (st & 1) * 32 + (swz % 64) / 2; }
__host__ __device__ __forceinline__ int perm32(int rho) { const int n = rho >> 4, i = rho & 15; return 8 * (i >> 2) + 4 * n + (i & 3); }

struct Unit { int pm, pn; };
struct Gemm { const bf16_t* A; const bf16_t* Bt; int M, N, K, lda; };

struct StaticOrder {
    int nM, nN, nwg, G, c;
    __host__ __device__ void init(int M, int N, int G_, int c_) { nM = M / BM; nN = N / BM; nwg = nM * nN; G = G_; c = c_; }
    __host__ __device__ bool next(int i, Unit& u) const {
        const long L = (long)i * G + c; if (L >= nwg) return false;
        int wgid = (int)L; { const int q = nwg / NXCD, r = nwg % NXCD, xcd = wgid % NXCD, off = wgid / NXCD; wgid = (xcd < r ? xcd * (q + 1) : r * (q + 1) + (xcd - r) * q) + off; }
        const int nig = WGM * nN, gid = wgid / nig, fm = gid * WGM, gsz = (nM - fm) < WGM ? (nM - fm) : WGM;
        u.pm = fm + ((wgid % nig) % gsz); u.pn = (wgid % nig) / gsz; return true;
    }
    __device__ __forceinline__ void a_ready(const Unit&) const {}
    __device__ __forceinline__ void done(const Unit&) const {}
};
__device__ __forceinline__ unsigned cvt_pk_bf16(float lo, float hi) { unsigned r; asm volatile("v_cvt_pk_bf16_f32 %0, %1, %2" : "=v"(r) : "v"(lo), "v"(hi)); return r; }
template <int ACT> struct EpiBf16 {
    static constexpr bool PERM = true, AFTER_DRAIN = false;
    bf16_t* O; int ldc; const float* ss; float inv_k, eps;
    float* sso0; float* sso1;
    __device__ __forceinline__ void operator()(const f32x4 (&acc)[2][2][4][2], const Unit& u, int wr, int wc, int fr, int fq) const {
        const int row0 = u.pm * BM + wr * 64 + fr; const int col0 = u.pn * BM + wc * 32 + 8 * fq;
#pragma unroll
        for (int ai = 0; ai < 2; ++ai)
#pragma unroll
            for (int m = 0; m < 4; ++m) { const int row = row0 + ai * HALF + m * 16; bf16_t* rowp = O + (size_t)row * ldc + col0;
                const float rs = ss ? (1.0f / sqrtf(ss[row] * inv_k + eps)) : 1.0f;
                float q = 0.f;
#pragma unroll
                for (int bj = 0; bj < 2; ++bj) { f32x4 v0 = acc[ai][bj][m][0] * rs, v1 = acc[ai][bj][m][1] * rs;
                    q += (v0[0] * v0[0] + v0[1] * v0[1]) + (v0[2] * v0[2] + v0[3] * v0[3]) + (v1[0] * v1[0] + v1[1] * v1[1]) + (v1[2] * v1[2] + v1[3] * v1[3]);
                    if (ACT == 2) {
#pragma unroll
                        for (int e = 0; e < 4; ++e) { float a = v0[e] > 0.f ? v0[e] : 0.f; v0[e] = a * a; float b = v1[e] > 0.f ? v1[e] : 0.f; v1[e] = b * b; } }
                    u32x4 w; w.x = cvt_pk_bf16(v0[0], v0[1]); w.y = cvt_pk_bf16(v0[2], v0[3]); w.z = cvt_pk_bf16(v1[0], v1[1]); w.w = cvt_pk_bf16(v1[2], v1[3]);
                    *(u32x4*)(rowp + bj * HALF) = w; }
                if (sso0) { float* so = (u.pn < 2) ? sso0 : ((u.pn < 4) ? sso1 : nullptr);
                    if (so) { q += __shfl_xor(q, 16); q += __shfl_xor(q, 32); if (fq == 0) atomicAdd(so + row, q); } } }
    }
};
template <bool BASE_F32> struct EpiResB {
    static constexpr bool PERM = true, AFTER_DRAIN = false;
    const void* base; bf16_t* out; int ldc; float* ss;
    __device__ __forceinline__ void operator()(const f32x4 (&acc)[2][2][4][2], const Unit& u, int wr, int wc, int fr, int fq) const {
        const int row0 = u.pm * BM + wr * 64 + fr; const int col0 = u.pn * BM + wc * 32 + 8 * fq;
#pragma unroll
        for (int ai = 0; ai < 2; ++ai)
#pragma unroll
            for (int m = 0; m < 4; ++m) { const size_t off = (size_t)(row0 + ai * HALF + m * 16) * ldc + col0; float q = 0.f;
#pragma unroll
                for (int bj = 0; bj < 2; ++bj) { const size_t o = off + bj * HALF; f32x4 b0, b1;
                    if constexpr (BASE_F32) { b0 = *(const f32x4*)((const float*)base + o); b1 = *(const f32x4*)((const float*)base + o + 4); }
                    else { const u32x4 w = *(const u32x4*)((const bf16_t*)base + o);
                        b0 = (f32x4){__uint_as_float(w.x << 16), __uint_as_float(w.x & 0xffff0000u), __uint_as_float(w.y << 16), __uint_as_float(w.y & 0xffff0000u)};
                        b1 = (f32x4){__uint_as_float(w.z << 16), __uint_as_float(w.z & 0xffff0000u), __uint_as_float(w.w << 16), __uint_as_float(w.w & 0xffff0000u)}; }
                    const f32x4 v0 = b0 + acc[ai][bj][m][0], v1 = b1 + acc[ai][bj][m][1];
                    q += (v0[0] * v0[0] + v0[1] * v0[1]) + (v0[2] * v0[2] + v0[3] * v0[3]) + (v1[0] * v1[0] + v1[1] * v1[1]) + (v1[2] * v1[2] + v1[3] * v1[3]);
                    u32x4 r; r.x = cvt_pk_bf16(v0[0], v0[1]); r.y = cvt_pk_bf16(v0[2], v0[3]); r.z = cvt_pk_bf16(v1[0], v1[1]); r.w = cvt_pk_bf16(v1[2], v1[3]);
                    *(u32x4*)(out + o) = r; }
                if (ss) { q += __shfl_xor(q, 16); q += __shfl_xor(q, 32); if (fq == 0) atomicAdd(ss + (row0 + ai * HALF + m * 16), q); }
                asm volatile("" ::: "memory"); }
    }
};
template <class Epi, class Sched, bool ALIGN_EPI = false, bool SP2 = false>
__device__ __forceinline__ void gemm_phase(PG8_LAS unsigned char* lds, const Gemm g, const Sched& S, const Epi& E) {
    const int tid = threadIdx.x, wid = __builtin_amdgcn_readfirstlane(tid >> 6), lane = tid & 63, wr = wid >> 2, wc = wid & 3, fr = lane & 15, fq = lane >> 4;
    const int K = g.K, nt = K / BK;
    unsigned voffA[2], voffB[2];
#pragma unroll
    for (int i = 0; i < 2; ++i) { int R, C; stage_rc(tid * 16 + i * 8192, R, C); const int Rb = Epi::PERM ? ((R & ~31) + perm32(R & 31)) : R;
        voffA[i] = (unsigned)(R * g.lda + C) * 2u; voffB[i] = (unsigned)(Rb * K + C) * 2u; }
    const size_t kstep = (size_t)(BK * 2);
    const size_t hstep = (size_t)HALF * K * 2;
    const size_t tstep = 2 * hstep;
    const size_t hstepA = (size_t)HALF * g.lda * 2, tstepA = 2 * hstepA;
    const unsigned ldsw = (unsigned)wid * 1024u;
    const int aoff = lds_byte(wr * 64 + fr, fq * 8), boff = lds_byte(wc * 32 + fr, fq * 8);
#define PG8_SA(b, h) (((b) * 2 + (h)) * HTB)
#define PG8_SB(b, h) ((4 + (b) * 2 + (h)) * HTB)
#define PG8_STAGE(bufoff, gbase, voff) do { _Pragma("unroll") for (int _i = 0; _i < 2; ++_i) \
        __builtin_amdgcn_global_load_lds((const unsigned*)((const char*)(gbase) + (voff)[_i]), (PG8_LAS unsigned*)(lds + (bufoff) + ldsw + _i * 8192), 16, 0, 0); } while (0)
#define PG8_LDA(dst, b, h) do { _Pragma("unroll") for (int m = 0; m < 4; ++m) _Pragma("unroll") for (int k = 0; k < 2; ++k) dst[m][k] = *(const PG8_LAS bf16x8*)(lds + PG8_SA(b, h) + aoff + m * 2048 + k * 1024); } while (0)
#define PG8_LDB(dst, b, h) do { _Pragma("unroll") for (int n = 0; n < 2; ++n) _Pragma("unroll") for (int k = 0; k < 2; ++k) dst[n][k] = *(const PG8_LAS bf16x8*)(lds + PG8_SB(b, h) + boff + n * 2048 + k * 1024); } while (0)
#define PG8_MMA(ai, bj, At, Bt) do { __builtin_amdgcn_s_setprio(1); _Pragma("unroll") for (int m = 0; m < 4; ++m) _Pragma("unroll") for (int n = 0; n < 2; ++n) _Pragma("unroll") for (int k = 0; k < 2; ++k) \
        acc[ai][bj][m][n] = __builtin_amdgcn_mfma_f32_16x16x32_bf16(Bt[n][k], At[m][k], acc[ai][bj][m][n], 0, 0, 0); __builtin_amdgcn_s_setprio(0); } while (0)
#define PG8_WAIT_V(n) asm volatile("s_waitcnt vmcnt(" #n ")" ::: "memory")
#define PG8_WAIT_L(n) asm volatile("s_waitcnt lgkmcnt(" #n ")" ::: "memory")
#define PG8_BAR __builtin_amdgcn_s_barrier()
#define PG8_SCHED __builtin_amdgcn_sched_barrier(0)
    Unit cur, nxt; int ui = 0;
    if (!S.next(0, cur)) return;
    f32x4 acc[2][2][4][2];
#pragma unroll
    for (int a = 0; a < 2; ++a)
#pragma unroll
        for (int b = 0; b < 2; ++b)
#pragma unroll
            for (int m = 0; m < 4; ++m)
#pragma unroll
                for (int n = 0; n < 2; ++n) acc[a][b][m][n] = (f32x4){0.f, 0.f, 0.f, 0.f};
    bf16x8 At[4][2], B0[2][2], B1[2][2];
    const char* cA = (const char*)g.A + (size_t)cur.pm * tstepA; const char* cB = (const char*)g.Bt + (size_t)cur.pn * tstep;
    S.a_ready(cur);
    if constexpr (SP2) {
        PG8_STAGE(PG8_SB(0, 0), cB, voffB); PG8_STAGE(PG8_SB(0, 1), cB + hstep, voffB); PG8_STAGE(PG8_SA(0, 0), cA, voffA); PG8_STAGE(PG8_SA(0, 1), cA + hstepA, voffA);
        if (wr == 1) PG8_BAR;
        PG8_WAIT_V(2); PG8_BAR;
        PG8_STAGE(PG8_SB(1, 0), cB + kstep, voffB); PG8_STAGE(PG8_SA(1, 0), cA + kstep, voffA); PG8_STAGE(PG8_SB(1, 1), cB + hstep + kstep, voffB);
        PG8_WAIT_V(6); PG8_BAR;
    } else {
        PG8_STAGE(PG8_SB(0, 0), cB, voffB); PG8_STAGE(PG8_SA(0, 0), cA, voffA); PG8_STAGE(PG8_SB(0, 1), cB + hstep, voffB); PG8_STAGE(PG8_SA(0, 1), cA + hstepA, voffA);
        if (wr == 1) PG8_BAR;
        PG8_WAIT_V(4); PG8_BAR;
        PG8_STAGE(PG8_SB(1, 0), cB + kstep, voffB); PG8_STAGE(PG8_SA(1, 0), cA + kstep, voffA); PG8_STAGE(PG8_SB(1, 1), cB + hstep + kstep, voffB);
        PG8_WAIT_V(6); PG8_BAR;
    }
    for (;;) {
        const bool has_next = S.next(ui + 1, nxt);
        const char* nA = has_next ? (const char*)g.A + (size_t)nxt.pm * tstepA : cA; const char* nB = has_next ? (const char*)g.Bt + (size_t)nxt.pn * tstep : cB;
        for (int t = 0; t < nt; t += 2) {
            const bool last = (t == nt - 2);
            const char* a1 = cA + (size_t)(t + 1) * kstep;
            const char* a2 = last ? nA : cA + (size_t)(t + 2) * kstep; const char* b2 = last ? nB : cB + (size_t)(t + 2) * kstep;
            const char* a3 = a2 + kstep; const char* b3 = b2 + kstep;
            if (last && has_next) S.a_ready(nxt);
            if constexpr (SP2) {
            PG8_LDB(B0, 0, 0); PG8_LDB(B1, 0, 1); PG8_SCHED; PG8_LDA(At, 0, 0); PG8_STAGE(PG8_SA(1, 1), a1 + hstepA, voffA);
            PG8_WAIT_V(8); PG8_WAIT_L(0); PG8_BAR; PG8_MMA(0, 0, At, B0); PG8_MMA(0, 1, At, B1); PG8_BAR; PG8_SCHED;
            PG8_LDA(At, 0, 1); PG8_STAGE(PG8_SB(0, 0), b2, voffB); PG8_STAGE(PG8_SB(0, 1), b2 + hstep, voffB); PG8_STAGE(PG8_SA(0, 0), a2, voffA);
            PG8_WAIT_V(8); PG8_WAIT_L(0); PG8_BAR; PG8_MMA(1, 0, At, B0); PG8_MMA(1, 1, At, B1); PG8_BAR; PG8_SCHED;
            PG8_LDB(B0, 1, 0); PG8_LDB(B1, 1, 1); PG8_SCHED; PG8_LDA(At, 1, 0); PG8_STAGE(PG8_SA(0, 1), a2 + hstepA, voffA);
            PG8_WAIT_V(8); PG8_WAIT_L(0); PG8_BAR; PG8_MMA(0, 0, At, B0); PG8_MMA(0, 1, At, B1); PG8_BAR; PG8_SCHED;
            PG8_LDA(At, 1, 1); PG8_STAGE(PG8_SB(1, 0), b3, voffB); PG8_STAGE(PG8_SB(1, 1), b3 + hstep, voffB); PG8_STAGE(PG8_SA(1, 0), a3, voffA);
            PG8_WAIT_V(8); PG8_WAIT_L(0); PG8_BAR; PG8_MMA(1, 0, At, B0); PG8_MMA(1, 1, At, B1); PG8_BAR; PG8_SCHED;
            } else {
            PG8_LDB(B0, 0, 0); PG8_SCHED; PG8_LDA(At, 0, 0); PG8_STAGE(PG8_SA(1, 1), a1 + hstepA, voffA);
            PG8_WAIT_L(8); PG8_BAR; PG8_WAIT_L(0); PG8_MMA(0, 0, At, B0); PG8_BAR; PG8_SCHED;
            PG8_LDB(B1, 0, 1); PG8_STAGE(PG8_SB(0, 0), b2, voffB);
            PG8_BAR; PG8_WAIT_L(0); PG8_MMA(0, 1, At, B1); PG8_BAR;
            PG8_LDA(At, 0, 1); PG8_STAGE(PG8_SA(0, 0), a2, voffA);
            PG8_BAR; PG8_WAIT_L(0); PG8_MMA(1, 0, At, B0); PG8_BAR; PG8_SCHED;
            PG8_STAGE(PG8_SB(0, 1), b2 + hstep, voffB);
            PG8_WAIT_V(6); PG8_BAR; PG8_MMA(1, 1, At, B1); PG8_BAR;
            PG8_LDB(B0, 1, 0); PG8_SCHED; PG8_LDA(At, 1, 0); PG8_STAGE(PG8_SA(0, 1), a2 + hstepA, voffA);
            PG8_WAIT_L(8); PG8_BAR; PG8_WAIT_L(0); PG8_MMA(0, 0, At, B0); PG8_BAR; PG8_SCHED;
            PG8_LDB(B1, 1, 1); PG8_STAGE(PG8_SB(1, 0), b3, voffB);
            PG8_BAR; PG8_WAIT_L(0); PG8_MMA(0, 1, At, B1); PG8_BAR;
            PG8_LDA(At, 1, 1); PG8_STAGE(PG8_SA(1, 0), a3, voffA);
            PG8_BAR; PG8_WAIT_L(0); PG8_MMA(1, 0, At, B0); PG8_BAR; PG8_SCHED;
            PG8_STAGE(PG8_SB(1, 1), b3 + hstep, voffB);
            PG8_WAIT_V(6); PG8_BAR; PG8_MMA(1, 1, At, B1); PG8_BAR;
            }
        }
        if constexpr (ALIGN_EPI) { if (wr == 0) PG8_BAR; }
        if constexpr (!Epi::AFTER_DRAIN) { E(acc, cur, wr, wc, fr, fq); S.done(cur); }
        if (!has_next) break;
#pragma unroll
        for (int a = 0; a < 2; ++a)
#pragma unroll
            for (int b = 0; b < 2; ++b)
#pragma unroll
                for (int m = 0; m < 4; ++m)
#pragma unroll
                    for (int n = 0; n < 2; ++n) acc[a][b][m][n] = (f32x4){0.f, 0.f, 0.f, 0.f};
        cur = nxt; cA = nA; cB = nB; ++ui;
        if constexpr (ALIGN_EPI) { if (wr == 1) PG8_BAR; }
    }
    PG8_WAIT_V(0);
    if constexpr (!ALIGN_EPI) { if (wr == 0) PG8_BAR; }
    PG8_BAR;
    if constexpr (Epi::AFTER_DRAIN) { E.fused(acc, cur, wr, wc, fr, fq, lds, wid, lane); S.done(cur); }
#undef PG8_SA
#undef PG8_SB
#undef PG8_STAGE
#undef PG8_LDA
#undef PG8_LDB
#undef PG8_MMA
#undef PG8_WAIT_V
#undef PG8_WAIT_L
#undef PG8_BAR
#undef PG8_SCHED
}
}
namespace att {
typedef unsigned short bf16;
using bf16x8 = __attribute__((ext_vector_type(8))) short;
using s16x4  = __attribute__((ext_vector_type(4))) short;
using f32x16 = __attribute__((ext_vector_type(16))) float;
using u32x4  = __attribute__((ext_vector_type(4))) unsigned;
constexpr int NW = 8, QBLK = 32, KVBLK = 64;
constexpr float THR = 8.f;
#define ATT_SBAR() __builtin_amdgcn_sched_barrier(0)
__device__ __forceinline__ int crow(int r, int hi) { return (r & 3) + 8 * (r >> 2) + 4 * hi; }
typedef float f32x2_t __attribute__((ext_vector_type(2))); typedef __bf16 bf16x2_t __attribute__((ext_vector_type(2)));
__device__ __forceinline__ unsigned cvtpk(float lo, float hi) { f32x2_t v = {lo, hi}; bf16x2_t b = __builtin_convertvector(v, bf16x2_t); return __builtin_bit_cast(unsigned, b); }
typedef short v4i16_t __attribute__((ext_vector_type(4)));
typedef __attribute__((address_space(3))) const char* lds_cptr;
__device__ __forceinline__ s16x4 vtr(lds_cptr p) { return __builtin_bit_cast(s16x4, __builtin_amdgcn_ds_read_tr16_b64_v4i16((__attribute__((address_space(3))) v4i16_t*)p)); }
__device__ __forceinline__ bf16x8 ld8(const bf16* p) { return *reinterpret_cast<const bf16x8*>(p); }

template <int DQK> struct Cfg {
  static constexpr float SCALE = (DQK == 128) ? 0.088388347648318440f : 0.072168783648703220f;
  static constexpr float C = SCALE * 1.4426950408889634f;
  static constexpr int KROWB = DQK * 2, SHM_K = KVBLK * KROWB, SHM_V = KVBLK * 128 * 2, ND0 = DQK / 16;
  static constexpr int QREG = (DQK > 128) ? MLA_QREG : 8;
  static constexpr int QXW = (ND0 - QREG) * 1024, SHM_QX = NW * QXW;
  static constexpr int SHM_TOTAL = 2 * SHM_V + 2 * SHM_K + NW * 64 * 4 + SHM_QX;
};

constexpr float TRIG = 65536.f;
__device__ __forceinline__ void firstSM(f32x16& p0, f32x16& p1, float& m_ref, f32x16& negm) {
  float pmax = p0[0];
#pragma unroll
  for (int r = 1; r < 16; ++r) pmax = fmaxf(pmax, p0[r]);
#pragma unroll
  for (int r = 0; r < 16; ++r) pmax = fmaxf(pmax, p1[r]);
  { auto rr = __builtin_amdgcn_permlane32_swap(__float_as_uint(pmax), __float_as_uint(pmax), false, false);
    pmax = fmaxf(__uint_as_float(rr[0]), __uint_as_float(rr[1])); }
  m_ref = pmax;
#pragma unroll
  for (int r = 0; r < 16; ++r) { p0[r] -= pmax; p1[r] -= pmax; negm[r] = -pmax; }
#pragma unroll
  for (int r = 0; r < 16; ++r) p0[r] = __builtin_amdgcn_exp2f(p0[r]);
  asm volatile("" : "+v"(p0), "+v"(p1), "+v"(negm));
}
__device__ __forceinline__ void firstSM0(f32x16& p0, f32x16& p1, float& m_ref, f32x16& negm) {
  float pmax = p0[0];
#pragma unroll
  for (int r = 1; r < 16; ++r) pmax = fmaxf(pmax, p0[r]);
#pragma unroll
  for (int r = 0; r < 16; ++r) pmax = fmaxf(pmax, p1[r]);
  { auto rr = __builtin_amdgcn_permlane32_swap(__float_as_uint(pmax), __float_as_uint(pmax), false, false);
    pmax = fmaxf(__uint_as_float(rr[0]), __uint_as_float(rr[1])); }
  m_ref = pmax;
#pragma unroll
  for (int r = 0; r < 16; ++r) { p0[r] -= pmax; p1[r] -= pmax; negm[r] = -pmax; }
  asm volatile("" : "+v"(p0), "+v"(p1), "+v"(negm));
}
__device__ __forceinline__ void partialSM(f32x16& p0, f32x16& p1) {
#pragma unroll
  for (int r = 0; r < 16; ++r) p0[r] = __builtin_amdgcn_exp2f(p0[r]);
  asm volatile("" : "+v"(p0), "+v"(p1));
}
__device__ __forceinline__ void finishSM(f32x16& p0, f32x16& p1, float& ps, float& l_reg, bf16x8& pa0, bf16x8& pa1, bf16x8& pa2, bf16x8& pa3) {
#pragma unroll
  for (int r = 0; r < 16; ++r) p1[r] = __builtin_amdgcn_exp2f(p1[r]);
  float s0 = 0, s1 = 0;
#pragma unroll
  for (int r = 0; r < 16; ++r) s0 += p0[r];
#pragma unroll
  for (int r = 0; r < 16; ++r) s1 += p1[r];
  ps = s0 + s1;
  { auto rr = __builtin_amdgcn_permlane32_swap(__float_as_uint(ps), __float_as_uint(ps), false, false);
    ps = __uint_as_float(rr[0]) + __uint_as_float(rr[1]); }
  l_reg += ps;
#define ATT_PK4(P, BASE, OUT) do { unsigned a0 = cvtpk(P[BASE + 0], P[BASE + 1]), a1 = cvtpk(P[BASE + 2], P[BASE + 3]);   \
    unsigned b0 = cvtpk(P[BASE + 4], P[BASE + 5]), b1 = cvtpk(P[BASE + 6], P[BASE + 7]);                              \
    auto r0 = __builtin_amdgcn_permlane32_swap(a0, b0, false, false); auto r1 = __builtin_amdgcn_permlane32_swap(a1, b1, false, false); \
    u32x4 w = {r0[0], r1[0], r0[1], r1[1]}; OUT = *reinterpret_cast<bf16x8*>(&w); } while (0)
  ATT_PK4(p0, 0, pa0); ATT_PK4(p0, 8, pa1); ATT_PK4(p1, 0, pa2); ATT_PK4(p1, 8, pa3);
#undef ATT_PK4
}
__device__ __forceinline__ void partialSM2(f32x16& p0, f32x16& p1, float& s0) {
#pragma unroll
  for (int r = 0; r < 16; ++r) p0[r] = __builtin_amdgcn_exp2f(p0[r]);
  float a = 0.f, b = 0.f;
#pragma unroll
  for (int r = 0; r < 16; r += 2) { a += p0[r]; b += p0[r + 1]; }
  s0 = a + b;
  asm volatile("" : "+v"(p0), "+v"(p1), "+v"(s0));
}
__device__ __forceinline__ void finishSM2(f32x16& p0, f32x16& p1, float s0, float& ps, float& l_reg, bf16x8& pa0, bf16x8& pa1, bf16x8& pa2, bf16x8& pa3) {
#pragma unroll
  for (int r = 0; r < 16; ++r) p1[r] = __builtin_amdgcn_exp2f(p1[r]);
  float s1 = 0;
#pragma unroll
  for (int r = 0; r < 16; ++r) s1 += p1[r];
  ps = s0 + s1;
  { auto rr = __builtin_amdgcn_permlane32_swap(__float_as_uint(ps), __float_as_uint(ps), false, false);
    ps = __uint_as_float(rr[0]) + __uint_as_float(rr[1]); }
  l_reg += ps;
#define ATT_PK4(P, BASE, OUT) do { unsigned a0 = cvtpk(P[BASE + 0], P[BASE + 1]), a1 = cvtpk(P[BASE + 2], P[BASE + 3]);   \
    unsigned b0 = cvtpk(P[BASE + 4], P[BASE + 5]), b1 = cvtpk(P[BASE + 6], P[BASE + 7]);                              \
    auto r0 = __builtin_amdgcn_permlane32_swap(a0, b0, false, false); auto r1 = __builtin_amdgcn_permlane32_swap(a1, b1, false, false); \
    u32x4 w = {r0[0], r1[0], r0[1], r1[1]}; OUT = *reinterpret_cast<bf16x8*>(&w); } while (0)
  ATT_PK4(p0, 0, pa0); ATT_PK4(p0, 8, pa1); ATT_PK4(p1, 0, pa2); ATT_PK4(p1, 8, pa3);
#undef ATT_PK4
}
#define ATT_PK4(P, BASE, OUT) do { unsigned a0 = cvtpk(P[BASE + 0], P[BASE + 1]), a1 = cvtpk(P[BASE + 2], P[BASE + 3]);   \
    unsigned b0 = cvtpk(P[BASE + 4], P[BASE + 5]), b1 = cvtpk(P[BASE + 6], P[BASE + 7]);                              \
    auto r0 = __builtin_amdgcn_permlane32_swap(a0, b0, false, false); auto r1 = __builtin_amdgcn_permlane32_swap(a1, b1, false, false); \
    u32x4 w = {r0[0], r1[0], r0[1], r1[1]}; OUT = *reinterpret_cast<bf16x8*>(&w); } while (0)
__device__ __forceinline__ void partialSM3(f32x16& p0, f32x16& p1, float& s0, bf16x8& pc0, bf16x8& pc1) {
#pragma unroll
  for (int r = 0; r < 16; ++r) p0[r] = __builtin_amdgcn_exp2f(p0[r]);
  float a = 0.f, b = 0.f;
#pragma unroll
  for (int r = 0; r < 16; r += 2) { a += p0[r]; b += p0[r + 1]; }
  s0 = a + b;
  ATT_PK4(p0, 0, pc0); ATT_PK4(p0, 8, pc1);
  asm volatile("" : "+v"(p1), "+v"(s0), "+v"(pc0), "+v"(pc1));
}
__device__ __forceinline__ void finishSM3(f32x16& p1, float s0, float& ps, float& l_reg, bf16x8& pa2, bf16x8& pa3) {
#pragma unroll
  for (int r = 0; r < 16; ++r) p1[r] = __builtin_amdgcn_exp2f(p1[r]);
  float s1 = 0;
#pragma unroll
  for (int r = 0; r < 16; ++r) s1 += p1[r];
  ps = s0 + s1;
  { auto rr = __builtin_amdgcn_permlane32_swap(__float_as_uint(ps), __float_as_uint(ps), false, false);
    ps = __uint_as_float(rr[0]) + __uint_as_float(rr[1]); }
  l_reg += ps;
  ATT_PK4(p1, 0, pa2); ATT_PK4(p1, 8, pa3);
}
#undef ATT_PK4
#define ATT_KEY(row) ((KROWB == 256) ? ((row) & ATT_KEYMASK128) : (((row) >> 1) & 7))
#define ATT_KSWZ(row, colB) ((row) * KROWB + ((colB) ^ (ATT_KEY(row) << 4)))
template <int DQK> __device__ __forceinline__ void qkt(f32x16& p0, f32x16& p1, const f32x16& negm, const char* Ks, const int* kb, const bf16x8* qr, const char* qx, int r32, int hi) {
  constexpr int KROWB = Cfg<DQK>::KROWB, ND0 = Cfg<DQK>::ND0, QREG = Cfg<DQK>::QREG;
  p0 = negm; p1 = negm;
  constexpr int NB = (KROWB == 256 && ATT_KEYMASK128 == 15) ? 8 : 4;
#pragma unroll
  for (int d0 = 0; d0 < ND0; ++d0) {
    bf16x8 b0 = *reinterpret_cast<const bf16x8*>(Ks + kb[d0 % NB] + (d0 / NB) * (NB * 32));
    bf16x8 b1 = *reinterpret_cast<const bf16x8*>(Ks + kb[d0 % NB] + (d0 / NB) * (NB * 32) + 32 * KROWB);
    bf16x8 q; if (d0 < QREG) q = qr[d0]; else q = *reinterpret_cast<const bf16x8*>(qx + (d0 - QREG) * 1024);
    p0 = __builtin_amdgcn_mfma_f32_32x32x16_bf16(b0, q, p0, 0, 0, 0);
    p1 = __builtin_amdgcn_mfma_f32_32x32x16_bf16(b1, q, p1, 0, 0, 0); }
}
__device__ __forceinline__ int v_st(int k, int c) { const int kk = (k & ~0xC) | ((k & 4) << 1) | ((k & 8) >> 1); return ((kk >> 3) * 4 + (c >> 5)) * 512 + ((kk & 7) * 32 + (c & 31)) * 2; }
__device__ __forceinline__ int v_rd_base(int lane) { return ((lane & 3) << 3) | (((lane >> 2) & 3) << 6) | (((lane >> 4) & 1) << 5) | (((lane >> 5) & 1) << 8); }
constexpr int v_rd_off(int d0, int ks, int half) { return d0 * 512 + ks * 4096 + half * 2048; }
template <int OFF> __device__ __forceinline__ s16x4 tr_read(int vb) {
  s16x4 r; asm volatile("ds_read_b64_tr_b16 %0, %1 offset:%2" : "=&v"(r) : "v"(vb), "i"(OFF) : "memory"); return r;
}
#define ATT_PK(L, H) (bf16x8){L[0], L[1], L[2], L[3], H[0], H[1], H[2], H[3]}
template <int D0> __device__ __forceinline__ void pv_one(f32x16& od, lds_cptr vp, bf16x8 pa0, bf16x8 pa1, bf16x8 pa2, bf16x8 pa3) {
  const s16x4 l0 = vtr(vp + v_rd_off(D0, 0, 0)), h0 = vtr(vp + v_rd_off(D0, 0, 1)), l1 = vtr(vp + v_rd_off(D0, 1, 0)), h1 = vtr(vp + v_rd_off(D0, 1, 1));
  const s16x4 l2 = vtr(vp + v_rd_off(D0, 2, 0)), h2 = vtr(vp + v_rd_off(D0, 2, 1)), l3 = vtr(vp + v_rd_off(D0, 3, 0)), h3 = vtr(vp + v_rd_off(D0, 3, 1));
  od = __builtin_amdgcn_mfma_f32_32x32x16_bf16(pa0, ATT_PK(l0, h0), od, 0, 0, 0);
  od = __builtin_amdgcn_mfma_f32_32x32x16_bf16(pa1, ATT_PK(l1, h1), od, 0, 0, 0);
  od = __builtin_amdgcn_mfma_f32_32x32x16_bf16(pa2, ATT_PK(l2, h2), od, 0, 0, 0);
  od = __builtin_amdgcn_mfma_f32_32x32x16_bf16(pa3, ATT_PK(l3, h3), od, 0, 0, 0);
}
__device__ __forceinline__ void pv_d0(f32x16* o, lds_cptr vp, bf16x8 pa0, bf16x8 pa1, bf16x8 pa2, bf16x8 pa3) {
  pv_one<0>(o[0], vp, pa0, pa1, pa2, pa3); pv_one<1>(o[1], vp, pa0, pa1, pa2, pa3); pv_one<2>(o[2], vp, pa0, pa1, pa2, pa3); pv_one<3>(o[3], vp, pa0, pa1, pa2, pa3);
}
template <int NGRP, int MG, int NVALU, int NDS, int NPRE, int NLEAD = 0, int NVALU2 = 0> __device__ __forceinline__ void sched_pipe() {
  __builtin_amdgcn_sched_group_barrier(0x100, NPRE, 0);
#pragma unroll
  for (int i = 0; i < NGRP; ++i) { __builtin_amdgcn_sched_group_barrier(0x008, MG, 0);
    if (i >= NLEAD) __builtin_amdgcn_sched_group_barrier(0x002, (NLEAD > 0) ? NVALU2 : NVALU, 0);
    __builtin_amdgcn_sched_group_barrier(0x100, NDS, 0); }
}

template <int DQK, int LDQ, int LDK, int LDV, int LDO, int SD>
__device__ __forceinline__ void attn_unit(const bf16* __restrict__ Qb, const bf16* __restrict__ Kh, const bf16* __restrict__ Kr, const bf16* __restrict__ Vh,
                                          bf16* __restrict__ Ob, int seq, char* lds, float* tmout = nullptr) {
  constexpr int KROWB = Cfg<DQK>::KROWB, SHM_K = Cfg<DQK>::SHM_K, SHM_V = Cfg<DQK>::SHM_V, ND0 = Cfg<DQK>::ND0;
  const int tid = threadIdx.x, wid = __builtin_amdgcn_readfirstlane(tid >> 6), lane = tid & 63, r32 = lane & 31, hi = lane >> 5;
  char* V_lds = lds; char* K_lds = lds + 2 * SHM_V;
  float* ws = (float*)(lds + 2 * SHM_V + 2 * SHM_K) + wid * 64; float* li_l = ws; float* al_l = ws + 32;
  float m_ref = 0.f, l_reg = 0; f32x16 o[4] = {}; f32x16 negm = {}; constexpr int QREG = Cfg<DQK>::QREG; bf16x8 qr[QREG];
  const bf16* Qw = Qb + (long)(wid * QBLK + r32) * LDQ + hi * 8;
  char* qx = lds + 2 * SHM_V + 2 * SHM_K + NW * 64 * 4 + wid * Cfg<DQK>::QXW + lane * 16;
#pragma unroll
  for (int d0 = 0; d0 < QREG; ++d0) qr[d0] = ld8(Qw + d0 * 16);
  if constexpr (QREG < ND0) {
#pragma unroll
    for (int d0 = QREG; d0 < ND0; ++d0) *(bf16x8*)(qx + (d0 - QREG) * 1024) = ld8(Qw + d0 * 16);
  }
  const int sr = tid >> 4, sc = (tid & 15) * 8, vst0 = v_st(sr, sc), vst1 = v_st(32 + sr, sc);
  const int krr = tid >> 3, krc = (tid & 7) * 8;
  const lds_cptr vb0 = (lds_cptr)V_lds + v_rd_base(lane);
  constexpr int NB = (KROWB == 256 && ATT_KEYMASK128 == 15) ? 8 : 4; int kb[NB];
#pragma unroll
  for (int dl = 0; dl < NB; ++dl) kb[dl] = r32 * KROWB + ((dl * 32 + hi * 16) ^ (ATT_KEY(r32) << 4));
  const unsigned boV = (unsigned)(sr * LDV + sc) * 2u, boK = (unsigned)(sr * LDK + sc) * 2u, boR = (unsigned)(krr * 64 + krc) * 2u;
  struct { bf16x8 vs0, vs1, ks0, ks1, kr; } sr_[SD];
#define SLOAD(i, k0) do { const char* vt_ = (const char*)(Vh + (long)(k0) * LDV); const char* kt_ = (const char*)(Kh + (long)(k0) * LDK); \
    sr_[i].vs0 = *(const bf16x8*)(vt_ + boV); sr_[i].vs1 = *(const bf16x8*)(vt_ + 32 * LDV * 2 + boV); \
    sr_[i].ks0 = *(const bf16x8*)(kt_ + boK); sr_[i].ks1 = *(const bf16x8*)(kt_ + 32 * LDK * 2 + boK); \
    if constexpr (DQK == 192) { const char* rt_ = (const char*)(Kr + (long)(k0) * 64); sr_[i].kr = *(const bf16x8*)(rt_ + boR); } } while (0)
#define SWRITE(b, i) do { *(bf16x8*)(V_lds + (b) * SHM_V + vst0) = sr_[i].vs0;          \
    *(bf16x8*)(V_lds + (b) * SHM_V + vst1) = sr_[i].vs1; int kc = sc * 2;               \
    *(bf16x8*)(K_lds + (b) * SHM_K + ATT_KSWZ(sr, kc)) = sr_[i].ks0;                       \
    *(bf16x8*)(K_lds + (b) * SHM_K + ATT_KSWZ(32 + sr, kc)) = sr_[i].ks1;                  \
    if constexpr (DQK == 192) *(bf16x8*)(K_lds + (b) * SHM_K + ATT_KSWZ(krr, 256 + krc * 2)) = sr_[i].kr; } while (0)
#define SWAIT() do { if constexpr (SD == 2) { if constexpr (DQK == 192) asm volatile("s_waitcnt vmcnt(5)" ::: "memory"); else asm volatile("s_waitcnt vmcnt(4)" ::: "memory"); } \
    else asm volatile("s_waitcnt vmcnt(0)" ::: "memory"); } while (0)
#define RESC_APPLY() do { l_reg *= alp; if (hi == 0) al_l[r32] = alp; asm volatile("s_waitcnt lgkmcnt(0)" ::: "memory"); \
    _Pragma("unroll") for (int d = 0; d < 4; ++d) _Pragma("unroll") for (int r = 0; r < 16; ++r) o[d][r] *= al_l[crow(r, hi)]; pend = false; } while (0)
#define RESCN(ps_) do { if (pend) { RESC_APPLY(); } else { const bool t_ = (ps_) > TRIG; const float d_ = t_ ? __builtin_amdgcn_logf(ps_) : 0.f; alp = __builtin_amdgcn_exp2f(-d_); m_ref += d_; pend = __any(t_); } \
    _Pragma("unroll") for (int r = 0; r < 16; ++r) negm[r] = -m_ref; } while (0)
  float alp = 1.f; bool pend = false;
  f32x16 pA0, pA1, pB0, pB1; float psA, psB; bf16x8 pa0, pa1, pa2, pa3; const int NT = seq / KVBLK;
  constexpr int SE = 0, SO = SD - 1;
  SLOAD(SE, 0); asm volatile("s_waitcnt vmcnt(0)" ::: "memory"); SWRITE(0, SE); __syncthreads();
  qkt<DQK>(pA0, pA1, negm, K_lds, kb, qr, qx, r32, hi); firstSM(pA0, pA1, m_ref, negm);
  SLOAD(SO, KVBLK); if constexpr (SD == 2) { if (2 < NT) SLOAD(SE, 2 * KVBLK); }
  SWAIT(); SWRITE(1, SO); __syncthreads();
#define SCHED_A() do { if constexpr (DQK == 128) sched_pipe<16, 1, ATT_NVA128, 1, ATT_PREA>(); else sched_pipe<24 / ATT_MG192, ATT_MG192, ATT_NVA192 * ATT_MG192, ATT_DS192, ATT_PREA>(); } while (0)
#define SCHED_B() sched_pipe<16, 1, ATT_NVB, 2, ATT_PREB>()
#if ATT_PRIOMODE == 2
#define PRIO_A() do { if (wid >= 4) __builtin_amdgcn_s_setprio(1); else __builtin_amdgcn_s_setprio(0); } while (0)
#define PRIO_B() do { if (wid >= 4) __builtin_amdgcn_s_setprio(0); else __builtin_amdgcn_s_setprio(1); } while (0)
#elif ATT_PRIOMODE == 3
#define PRIO_A() do { if (wid >= 4) __builtin_amdgcn_s_setprio(0); else __builtin_amdgcn_s_setprio(1); } while (0)
#define PRIO_B() do { if (wid >= 4) __builtin_amdgcn_s_setprio(1); else __builtin_amdgcn_s_setprio(0); } while (0)
#else
#define PRIO_A() ((void)0)
#define PRIO_B() ((void)0)
#endif
#ifdef ATT_TIMING
  unsigned long long tmA = 0, tmB = 0, tmW = 0, tmW1 = 0, tmS = 0, tmB2 = 0;
#define TMS() __builtin_readcyclecounter()
#else
#define TMS() 0ull
#endif
  for (int j = 1; j + 1 < NT; j += 2) {
    const unsigned long long t0_ = TMS();
    PRIO_A(); ATT_SBAR(); qkt<DQK>(pB0, pB1, negm, K_lds + SHM_K, kb, qr, qx, r32, hi);
    finishSM(pA0, pA1, psA, l_reg, pa0, pa1, pa2, pa3); SCHED_A(); ATT_SBAR();
    const unsigned long long t1_ = TMS();
    PRIO_B(); SLOAD(SO, (j + SD) * KVBLK); ATT_SBAR();
    pv_d0(o, vb0, pa0, pa1, pa2, pa3); partialSM(pB0, pB1); SCHED_B(); ATT_SBAR();
    const unsigned long long t2_ = TMS();
    __syncthreads(); const unsigned long long t3_ = TMS(); SWAIT(); const unsigned long long t3b_ = TMS(); SWRITE(0, SE);
    RESCN(psA); asm volatile("s_waitcnt lgkmcnt(0)" ::: "memory"); const unsigned long long t3c_ = TMS(); __syncthreads();
    const unsigned long long t4_ = TMS();
#ifdef ATT_TIMING
    tmA += t1_ - t0_; tmB += t2_ - t1_; tmW1 += t3_ - t2_; tmW += t4_ - t3_; tmS += t3b_ - t3_; tmB2 += t4_ - t3c_;
#endif
    PRIO_A(); ATT_SBAR(); qkt<DQK>(pA0, pA1, negm, K_lds, kb, qr, qx, r32, hi);
    finishSM(pB0, pB1, psB, l_reg, pa0, pa1, pa2, pa3); SCHED_A(); ATT_SBAR();
    PRIO_B(); if (SD == 1 || j + 3 < NT) SLOAD(SE, (j + 1 + SD) * KVBLK); ATT_SBAR();
    pv_d0(o, vb0 + SHM_V, pa0, pa1, pa2, pa3); partialSM(pA0, pA1); SCHED_B(); ATT_SBAR();
    __syncthreads(); SWAIT(); SWRITE(1, SO);
    RESCN(psB); __syncthreads();
  }
  ATT_SBAR(); qkt<DQK>(pB0, pB1, negm, K_lds + SHM_K, kb, qr, qx, r32, hi);
  finishSM(pA0, pA1, psA, l_reg, pa0, pa1, pa2, pa3); ATT_SBAR();
  pv_d0(o, vb0, pa0, pa1, pa2, pa3); partialSM(pB0, pB1);
  __syncthreads(); if (pend) { RESC_APPLY(); }
  finishSM(pB0, pB1, psB, l_reg, pa0, pa1, pa2, pa3); ATT_SBAR();
  pv_d0(o, vb0 + SHM_V, pa0, pa1, pa2, pa3);
#undef SCHED_A
#undef SCHED_B
  __builtin_amdgcn_s_setprio(0);
#ifdef ATT_TIMING
  if (tmout && blockIdx.x == 0 && tid == ATT_TWAVE * 64) { const float inv = 1.0f / (float)((NT - 2) / 2); tmout[0] = (float)tmA * inv; tmout[1] = (float)tmB * inv; tmout[2] = (float)tmW1 * inv; tmout[3] = (float)tmW * inv; tmout[4] = (float)tmS * inv; tmout[5] = (float)tmB2 * inv; }
#endif
  if (hi == 0) li_l[r32] = l_reg; asm volatile("s_waitcnt lgkmcnt(0)" ::: "memory");
  float rli[16];
#pragma unroll
  for (int r = 0; r < 16; ++r) rli[r] = __builtin_amdgcn_rcpf(li_l[crow(r, hi)]);
  { int r32e = r32, hie = hi; asm volatile("" : "+v"(r32e), "+v"(hie));
    char* Ow = (char*)(Ob + (long)(wid * QBLK) * LDO);
    const unsigned lo_ = (unsigned)(((r32e >> 5) + 4 * hie) * LDO + (r32e & 31)) * 2u;
#pragma unroll
    for (int r = 0; r < 16; ++r) {
#pragma unroll
      for (int d0 = 0; d0 < 4; ++d0) *(bf16*)(Ow + lo_ + (unsigned)((((r & 3) + 8 * (r >> 2)) * LDO + d0 * 32) * 2)) = (bf16)(cvtpk(o[d0][r] * rli[r], 0.f) & 0xffffu); } }
  asm volatile("s_waitcnt vmcnt(0) lgkmcnt(0)" ::: "memory"); __syncthreads();
#undef SLOAD
#undef SWRITE
#undef SWAIT
#undef RESCN
#undef RESC_APPLY
}
template <int DQK, int LDQ, int LDK, int LDV, int LDO>
__device__ __forceinline__ void attn_unit_dma(const bf16* __restrict__ Qb, const bf16* __restrict__ Kh, const bf16* __restrict__ Kr, const bf16* __restrict__ Vh,
                                              bf16* __restrict__ Ob, int seq, char* lds, int spos = 0, const float* __restrict__ qgain = nullptr) {
  constexpr int KROWB = Cfg<DQK>::KROWB, SHM_K = Cfg<DQK>::SHM_K, SHM_V = Cfg<DQK>::SHM_V, ND0 = Cfg<DQK>::ND0;
  typedef __attribute__((address_space(3))) unsigned lds_u32;
  int tid_ = threadIdx.x; asm volatile("" : "+v"(tid_));
  const int tid = tid_, wid = __builtin_amdgcn_readfirstlane(tid >> 6), lane = tid & 63, r32 = lane & 31, hi = lane >> 5;
  char* V_lds = lds; char* K_lds = lds + 2 * SHM_V;
  float* ws = (float*)(lds + 2 * SHM_V + 2 * SHM_K) + wid * 64; float* li_l = ws; float* al_l = ws + 32;
  float m_ref = 0.f, l_reg = 0; f32x16 o[4] = {}; f32x16 negm = {}; constexpr int QREG = Cfg<DQK>::QREG; bf16x8 qr[QREG];
  const bf16* Qw = Qb + (long)(wid * QBLK + r32) * LDQ + hi * 8;
  char* qx = lds + 2 * SHM_V + 2 * SHM_K + NW * 64 * 4 + wid * Cfg<DQK>::QXW + lane * 16;
  if constexpr (DQK == 128) {
    int hiq = hi; asm volatile("" : "+v"(hiq));
    u32x4 raw[8]; float ss = 0.f;
#pragma unroll
    for (int d0 = 0; d0 < 8; ++d0) { const bf16x8 t8 = ld8(Qw + d0 * 16); raw[d0] = *reinterpret_cast<const u32x4*>(&t8); }
#pragma unroll
    for (int d0 = 0; d0 < 8; ++d0)
#pragma unroll
      for (int e = 0; e < 4; ++e) { const float x1 = __uint_as_float(raw[d0][e] << 16), x2 = __uint_as_float(raw[d0][e] & 0xffff0000u); ss += x1 * x1 + x2 * x2; }
    { auto rr = __builtin_amdgcn_permlane32_swap(__float_as_uint(ss), __float_as_uint(ss), false, false); ss = __uint_as_float(rr[0]) + __uint_as_float(rr[1]); }
    const float rs = (1.0f / sqrtf(ss * (1.f / 128.f) + 1e-6f)) * Cfg<128>::C;
    int r32q = r32; asm volatile("" : "+v"(r32q));
    const int sq = spos + wid * QBLK + r32q; const float posr = (float)(sq >> 6), posc = (float)(sq & 63);
#pragma unroll
    for (int d0 = 0; d0 < 8; ++d0) { const float pos = (d0 < 4) ? posr : posc;
      const float* gp = qgain + d0 * 16 + hiq * 8; u32x4 w;
#pragma unroll
      for (int e = 0; e < 4; ++e) { const int j = (d0 & 3) * 8 + hiq * 4 + e; const float invf = __builtin_amdgcn_exp2f(-(float)j * (13.287712379549449f / 32.f));
        const float ang = pos * invf; double rev = (double)ang * 0.15915494309189535; rev -= __builtin_rint(rev); const float fr = (float)rev;
        const float c = __builtin_amdgcn_cosf(fr), sn = __builtin_amdgcn_sinf(fr);
        const float y1 = __uint_as_float(raw[d0][e] << 16) * rs * gp[2 * e], y2 = __uint_as_float(raw[d0][e] & 0xffff0000u) * rs * gp[2 * e + 1];
        w[e] = cvtpk(y1 * c - y2 * sn, y1 * sn + y2 * c); }
      qr[d0] = *reinterpret_cast<bf16x8*>(&w); }
  } else {
#pragma unroll
  for (int d0 = 0; d0 < QREG; ++d0) qr[d0] = ld8(Qw + d0 * 16);
  }
  if constexpr (QREG < ND0) {
#pragma unroll
    for (int d0 = QREG; d0 < ND0; ++d0) { bf16x8 qv = ld8(Qw + d0 * 16);
      if (DQK == 192 && d0 >= 8) {
        int hiq = hi; asm volatile("" : "+v"(hiq));
        const int sq = spos + wid * QBLK + r32; const float pos = (float)((d0 < 10) ? (sq >> 6) : (sq & 63));
        u32x4 w = *reinterpret_cast<u32x4*>(&qv);
#pragma unroll
        for (int e = 0; e < 4; ++e) { const int j = ((d0 - 8) & 1) * 8 + hiq * 4 + e; const float invf = __builtin_amdgcn_exp2f(-(float)j * (13.287712379549449f / 16.f));
          const float ang = pos * invf; double rev = (double)ang * 0.15915494309189535; rev -= __builtin_rint(rev); const float fr = (float)rev;
          const float c = __builtin_amdgcn_cosf(fr), sn = __builtin_amdgcn_sinf(fr);
          const float x1 = __uint_as_float(w[e] << 16), x2 = __uint_as_float(w[e] & 0xffff0000u); w[e] = cvtpk(x1 * c - x2 * sn, x1 * sn + x2 * c); }
        qv = *reinterpret_cast<bf16x8*>(&w); }
      *(bf16x8*)(qx + (d0 - QREG) * 1024) = qv; }
  }
  const lds_cptr vb0 = (lds_cptr)V_lds + v_rd_base(lane);
  constexpr int NB = (KROWB == 256 && ATT_KEYMASK128 == 15) ? 8 : 4; int kb[NB];
#pragma unroll
  for (int dl = 0; dl < NB; ++dl) kb[dl] = r32 * KROWB + ((dl * 32 + hi * 16) ^ (ATT_KEY(r32) << 4));
  constexpr int NKI = SHM_K / 8192, SPR = KROWB / 16;
  unsigned voV[2]; const char* kp[NKI]; unsigned kst[NKI];
#pragma unroll
  for (int i = 0; i < 2; ++i) { const int s = i * 512 + wid * 64 + lane; const int kk = (((s >> 7) & 7) << 3) | ((s >> 2) & 7);
    const int k = (kk & ~0xC) | ((kk & 4) << 1) | ((kk & 8) >> 1), c = ((s >> 5) & 3) * 32 + (s & 3) * 8; voV[i] = (unsigned)(k * LDV + c) * 2u; }
#pragma unroll
  for (int i = 0; i < NKI; ++i) { const int s = i * 512 + wid * 64 + lane; const int row = s / SPR, cs = (s % SPR) * 16, colB = cs ^ (ATT_KEY(row) << 4);
    if (DQK == 192 && colB >= 256) { kp[i] = (const char*)Kr + (size_t)row * 128 + (colB - 256); kst[i] = 64u * 128u; }
    else { kp[i] = (const char*)Kh + (size_t)row * (LDK * 2) + colB; kst[i] = 64u * (unsigned)(LDK * 2); } }
  lds_u32* const ldsV = (lds_u32*)((__attribute__((address_space(3))) char*)V_lds + wid * 1024);
  lds_u32* const ldsK = (lds_u32*)((__attribute__((address_space(3))) char*)K_lds + wid * 1024);
#define DMA_V(t_, b_) do { const char* vt_ = (const char*)Vh + (size_t)(t_) * (64u * LDV * 2u); _Pragma("unroll") for (int i = 0; i < 2; ++i) \
    __builtin_amdgcn_global_load_lds((const unsigned*)(vt_ + voV[i]), (lds_u32*)((__attribute__((address_space(3))) char*)ldsV + (b_) * SHM_V + i * 8192), 16, 0, 0); } while (0)
#define DMA_K(t_, b_) do { _Pragma("unroll") for (int i = 0; i < NKI; ++i) \
    __builtin_amdgcn_global_load_lds((const unsigned*)(kp[i] + (size_t)(t_) * kst[i]), (lds_u32*)((__attribute__((address_space(3))) char*)ldsK + (b_) * SHM_K + i * 8192), 16, 0, 0); } while (0)
#define VMW0() asm volatile("s_waitcnt vmcnt(0)" ::: "memory")
#define RESC_APPLY() do { l_reg *= alp; if (hi == 0) al_l[r32] = alp; asm volatile("s_waitcnt lgkmcnt(0)" ::: "memory"); \
    _Pragma("unroll") for (int d = 0; d < 4; ++d) _Pragma("unroll") for (int r = 0; r < 16; ++r) o[d][r] *= al_l[crow(r, hi)]; pend = false; } while (0)
#define RESCN(ps_) do { if (pend) { RESC_APPLY(); } else { const bool t_ = (ps_) > TRIG; const float d_ = t_ ? __builtin_amdgcn_logf(ps_) : 0.f; alp = __builtin_amdgcn_exp2f(-d_); m_ref += d_; pend = __any(t_); } \
    _Pragma("unroll") for (int r = 0; r < 16; ++r) negm[r] = -m_ref; } while (0)
  float alp = 1.f; bool pend = false;
  f32x16 pA0, pA1, pB0, pB1; float psA, psB; bf16x8 pa0, pa1, pa2, pa3; const int NT = seq / KVBLK;
#define SCHED_A() do { if constexpr (DQK == 128) sched_pipe<16, 1, ATT_NVA128, 1, ATT_PREA, ATT_LEAD128, ATT_NVL128>(); else sched_pipe<24 / ATT_MG192, ATT_MG192, ATT_NVA192 * ATT_MG192, ATT_DS192, ATT_PREA, ATT_LEAD192, ATT_NVL192>(); } while (0)
#define SCHED_B() sched_pipe<16, 1, ATT_NVB, 2, ATT_PREB>()
#define FIN(P0, P1, s0P, psP) do { if constexpr (DQK == 128) { finishSM3(P1, s0P, psP, l_reg, pa2, pa3); pa0 = pc0; pa1 = pc1; } else finishSM2(P0, P1, s0P, psP, l_reg, pa0, pa1, pa2, pa3); } while (0)
#define PAR(C0, C1, s0C) do { if constexpr (DQK == 128) partialSM3(C0, C1, s0C, pc0, pc1); else partialSM2(C0, C1, s0C); } while (0)
#define STEP(C0, C1, s0C, P0, P1, s0P, psP, t_, KB, VB, haveK) do { DMA_V(t_, VB); if (haveK) DMA_K((t_) + 1, 1 - (KB)); ATT_SBAR(); \
    qkt<DQK>(C0, C1, negm, K_lds + (KB) * SHM_K, kb, qr, qx, r32, hi); FIN(P0, P1, s0P, psP); SCHED_A(); ATT_SBAR(); \
    pv_d0(o, vb0 + (1 - (VB)) * SHM_V, pa0, pa1, pa2, pa3); PAR(C0, C1, s0C); SCHED_B(); ATT_SBAR(); \
    RESCN(psP); VMW0(); __syncthreads(); } while (0)
  bf16x8 pc0, pc1;
  float s0A = 0.f, s0B = 0.f;
  DMA_K(0, 0); VMW0(); __syncthreads();
  DMA_V(0, 0); DMA_K(1, 1);
  qkt<DQK>(pA0, pA1, negm, K_lds, kb, qr, qx, r32, hi); firstSM0(pA0, pA1, m_ref, negm); PAR(pA0, pA1, s0A);
  VMW0(); __syncthreads();
  for (int t = 1; t + 2 < NT; t += 2) {
    STEP(pB0, pB1, s0B, pA0, pA1, s0A, psA, t, 1, 1, true);
    STEP(pA0, pA1, s0A, pB0, pB1, s0B, psB, t + 1, 0, 0, true);
  }
  STEP(pB0, pB1, s0B, pA0, pA1, s0A, psA, NT - 1, 1, 1, false);
  FIN(pB0, pB1, s0B, psB); ATT_SBAR();
  pv_d0(o, vb0 + SHM_V, pa0, pa1, pa2, pa3);
#undef STEP
#undef FIN
#undef PAR
#undef SCHED_A
#undef SCHED_B
  if (hi == 0) li_l[r32] = l_reg; asm volatile("s_waitcnt lgkmcnt(0)" ::: "memory");
  float rli[16];
#pragma unroll
  for (int r = 0; r < 16; ++r) rli[r] = __builtin_amdgcn_rcpf(li_l[crow(r, hi)]);
  { int r32e = r32, hie = hi; asm volatile("" : "+v"(r32e), "+v"(hie));
    char* Ow = (char*)(Ob + (long)(wid * QBLK) * LDO);
    const unsigned lo_ = (unsigned)((4 * hie) * LDO + r32e) * 2u;
#pragma unroll
    for (int r = 0; r < 16; ++r) {
#pragma unroll
      for (int d0 = 0; d0 < 4; ++d0) *(bf16*)(Ow + lo_ + (unsigned)((((r & 3) + 8 * (r >> 2)) * LDO + d0 * 32) * 2)) = (bf16)(cvtpk(o[d0][r] * rli[r], 0.f) & 0xffffu); } }
  asm volatile("s_waitcnt vmcnt(0) lgkmcnt(0)" ::: "memory"); __syncthreads();
#undef DMA_V
#undef DMA_K
#undef VMW0
#undef RESCN
#undef RESC_APPLY
}
template <int DQK, int LDQ, int LDK, int LDV, int LDO>
__device__ __forceinline__ void attn_unit_dmas(const bf16* __restrict__ Qb, const bf16* __restrict__ Kh, const bf16* __restrict__ Kr, const bf16* __restrict__ Vh,
                                              bf16* __restrict__ Ob, int seq, char* lds, int spos = 0) {
  constexpr int KROWB = Cfg<DQK>::KROWB, SHM_K = Cfg<DQK>::SHM_K, SHM_V = Cfg<DQK>::SHM_V, ND0 = Cfg<DQK>::ND0;
  typedef __attribute__((address_space(3))) unsigned lds_u32;
  const int tid = threadIdx.x, wid = __builtin_amdgcn_readfirstlane(tid >> 6), lane = tid & 63, r32 = lane & 31, hi = lane >> 5;
  char* V_lds = lds; char* K_lds = lds + 3 * SHM_V;
  float* ws = (float*)(lds + 3 * SHM_V + 2 * SHM_K) + wid * 64; float* li_l = ws; float* al_l = ws + 32;
  float m_ref = 0.f, l_reg = 0; f32x16 o[4] = {}; f32x16 negm = {}; constexpr int QREG = Cfg<DQK>::QREG; bf16x8 qr[QREG];
  const bf16* Qw = Qb + (long)(wid * QBLK + r32) * LDQ + hi * 8;
  char* qx = lds + 3 * SHM_V + 2 * SHM_K + NW * 64 * 4 + wid * Cfg<DQK>::QXW + lane * 16;
#pragma unroll
  for (int d0 = 0; d0 < QREG; ++d0) qr[d0] = ld8(Qw + d0 * 16);
  if constexpr (QREG < ND0) {
#pragma unroll
    for (int d0 = QREG; d0 < ND0; ++d0) { bf16x8 qv = ld8(Qw + d0 * 16);
      if (DQK == 192 && d0 >= 8) {
        int hiq = hi; asm volatile("" : "+v"(hiq));
        const int sq = spos + wid * QBLK + r32; const float pos = (float)((d0 < 10) ? (sq >> 6) : (sq & 63));
        u32x4 w = *reinterpret_cast<u32x4*>(&qv);
#pragma unroll
        for (int e = 0; e < 4; ++e) { const int j = ((d0 - 8) & 1) * 8 + hiq * 4 + e; const float invf = __builtin_amdgcn_exp2f(-(float)j * (13.287712379549449f / 16.f));
          const float ang = pos * invf; double rev = (double)ang * 0.15915494309189535; rev -= __builtin_rint(rev); const float fr = (float)rev;
          const float c = __builtin_amdgcn_cosf(fr), sn = __builtin_amdgcn_sinf(fr);
          const float x1 = __uint_as_float(w[e] << 16), x2 = __uint_as_float(w[e] & 0xffff0000u); w[e] = cvtpk(x1 * c - x2 * sn, x1 * sn + x2 * c); }
        qv = *reinterpret_cast<bf16x8*>(&w); }
      *(bf16x8*)(qx + (d0 - QREG) * 1024) = qv; }
  }
  const lds_cptr vb0 = (lds_cptr)V_lds + v_rd_base(lane);
  constexpr int NB = (KROWB == 256 && ATT_KEYMASK128 == 15) ? 8 : 4; int kb[NB];
#pragma unroll
  for (int dl = 0; dl < NB; ++dl) kb[dl] = r32 * KROWB + ((dl * 32 + hi * 16) ^ (ATT_KEY(r32) << 4));
  constexpr int NKI = SHM_K / 8192, SPR = KROWB / 16;
  unsigned voV[2]; const char* kp[NKI]; unsigned kst[NKI];
#pragma unroll
  for (int i = 0; i < 2; ++i) { const int s = i * 512 + wid * 64 + lane; const int kk = (((s >> 7) & 7) << 3) | ((s >> 2) & 7);
    const int k = (kk & ~0xC) | ((kk & 4) << 1) | ((kk & 8) >> 1), c = ((s >> 5) & 3) * 32 + (s & 3) * 8; voV[i] = (unsigned)(k * LDV + c) * 2u; }
#pragma unroll
  for (int i = 0; i < NKI; ++i) { const int s = i * 512 + wid * 64 + lane; const int row = s / SPR, cs = (s % SPR) * 16, colB = cs ^ (ATT_KEY(row) << 4);
    if (DQK == 192 && colB >= 256) { kp[i] = (const char*)Kr + (size_t)row * 128 + (colB - 256); kst[i] = 64u * 128u; }
    else { kp[i] = (const char*)Kh + (size_t)row * (LDK * 2) + colB; kst[i] = 64u * (unsigned)(LDK * 2); } }
  lds_u32* const ldsV = (lds_u32*)((__attribute__((address_space(3))) char*)V_lds + wid * 1024);
  lds_u32* const ldsK = (lds_u32*)((__attribute__((address_space(3))) char*)K_lds + wid * 1024);
#define DMA_V(t_, b_) do { const char* vt_ = (const char*)Vh + (size_t)(t_) * (64u * LDV * 2u); _Pragma("unroll") for (int i = 0; i < 2; ++i) \
    __builtin_amdgcn_global_load_lds((const unsigned*)(vt_ + voV[i]), (lds_u32*)((__attribute__((address_space(3))) char*)ldsV + (b_) + i * 8192), 16, 0, 0); } while (0)
#define DMA_K(t_, b_) do { _Pragma("unroll") for (int i = 0; i < NKI; ++i) \
    __builtin_amdgcn_global_load_lds((const unsigned*)(kp[i] + (size_t)(t_) * kst[i]), (lds_u32*)((__attribute__((address_space(3))) char*)ldsK + (b_) * SHM_K + i * 8192), 16, 0, 0); } while (0)
#define VMW0() asm volatile("s_waitcnt vmcnt(0)" ::: "memory")
#define RESC_APPLY() do { l_reg *= alp; if (hi == 0) al_l[r32] = alp; asm volatile("s_waitcnt lgkmcnt(0)" ::: "memory"); \
    _Pragma("unroll") for (int d = 0; d < 4; ++d) _Pragma("unroll") for (int r = 0; r < 16; ++r) o[d][r] *= al_l[crow(r, hi)]; pend = false; } while (0)
#define RESCN(ps_) do { if (pend) { RESC_APPLY(); } else { const bool t_ = (ps_) > TRIG; const float d_ = t_ ? __builtin_amdgcn_logf(ps_) : 0.f; alp = __builtin_amdgcn_exp2f(-d_); m_ref += d_; pend = __any(t_); } \
    _Pragma("unroll") for (int r = 0; r < 16; ++r) negm[r] = -m_ref; } while (0)
  float alp = 1.f; bool pend = false;
  f32x16 pA0, pA1, pB0, pB1; float psA, psB; bf16x8 pa0, pa1, pa2, pa3; const int NT = seq / KVBLK;
#define SCHED_A() do { if constexpr (DQK == 128) sched_pipe<16, 1, ATT_NVA128, 1, ATT_PREA>(); else sched_pipe<24 / ATT_MG192, ATT_MG192, ATT_NVA192 * ATT_MG192, ATT_DS192, ATT_PREA>(); } while (0)
#define SCHED_B() sched_pipe<16, 1, ATT_NVB, 2, ATT_PREB>()
#define NEXTV(v_) (((v_) == 2 * SHM_V) ? 0 : (v_) + SHM_V)
#define STEPS(C0, C1, P0, P1, psP, psPrev, t_, KB, vo_t, vo_tm1, vo_tm2, haveK, havePV) do { DMA_V(t_, vo_t); if (haveK) DMA_K((t_) + 1, 1 - (KB)); ATT_SBAR(); \
    if (isY) { if (havePV) { pv_d0(o, vb0 + (vo_tm2), pa0, pa1, pa2, pa3); } partialSM(P0, P1); SCHED_B(); ATT_SBAR(); RESCN(psPrev); } \
    else { qkt<DQK>(C0, C1, negm, K_lds + (KB) * SHM_K, kb, qr, qx, r32, hi); finishSM(P0, P1, psP, l_reg, pa0, pa1, pa2, pa3); SCHED_A(); } \
    ATT_SBAR(); \
    if (isY) { qkt<DQK>(C0, C1, negm, K_lds + (KB) * SHM_K, kb, qr, qx, r32, hi); finishSM(P0, P1, psP, l_reg, pa0, pa1, pa2, pa3); SCHED_A(); } \
    else { pv_d0(o, vb0 + (vo_tm1), pa0, pa1, pa2, pa3); partialSM(C0, C1); SCHED_B(); ATT_SBAR(); RESCN(psP); } \
    ATT_SBAR(); VMW0(); __syncthreads(); } while (0)
  const bool isY = wid >= 4;
  DMA_K(0, 0); VMW0(); __syncthreads();
  DMA_V(0, 0); DMA_K(1, 1);
  qkt<DQK>(pA0, pA1, negm, K_lds, kb, qr, qx, r32, hi); firstSM0(pA0, pA1, m_ref, negm);
  if (!isY) partialSM(pA0, pA1);
  VMW0(); __syncthreads();
  psA = 0.f; psB = 0.f;
  int v2 = 0, v1 = 0, v0 = SHM_V;
  STEPS(pB0, pB1, pA0, pA1, psA, psB, 1, 1, v0, v1, v2, true, false); v2 = v1; v1 = v0; v0 = NEXTV(v0);
  for (int t = 2; t + 1 < NT; t += 2) {
    STEPS(pA0, pA1, pB0, pB1, psB, psA, t, 0, v0, v1, v2, true, true); v2 = v1; v1 = v0; v0 = NEXTV(v0);
    STEPS(pB0, pB1, pA0, pA1, psA, psB, t + 1, 1, v0, v1, v2, (t + 2 < NT), true); v2 = v1; v1 = v0; v0 = NEXTV(v0);
  }
  if (isY) { pv_d0(o, vb0 + v2, pa0, pa1, pa2, pa3); partialSM(pB0, pB1); ATT_SBAR(); if (pend) { RESC_APPLY(); } }
  finishSM(pB0, pB1, psB, l_reg, pa0, pa1, pa2, pa3); ATT_SBAR();
  pv_d0(o, vb0 + v1, pa0, pa1, pa2, pa3);
#undef STEPS
#undef NEXTV
#undef SCHED_A
#undef SCHED_B
  if (hi == 0) li_l[r32] = l_reg; asm volatile("s_waitcnt lgkmcnt(0)" ::: "memory");
  float rli[16];
#pragma unroll
  for (int r = 0; r < 16; ++r) rli[r] = __builtin_amdgcn_rcpf(li_l[crow(r, hi)]);
  { int r32e = r32, hie = hi; asm volatile("" : "+v"(r32e), "+v"(hie));
    char* Ow = (char*)(Ob + (long)(wid * QBLK) * LDO);
    const unsigned lo_ = (unsigned)((4 * hie) * LDO + r32e) * 2u;
#pragma unroll
    for (int r = 0; r < 16; ++r) {
#pragma unroll
      for (int d0 = 0; d0 < 4; ++d0) *(bf16*)(Ow + lo_ + (unsigned)((((r & 3) + 8 * (r >> 2)) * LDO + d0 * 32) * 2)) = (bf16)(cvtpk(o[d0][r] * rli[r], 0.f) & 0xffffu); } }
  asm volatile("s_waitcnt vmcnt(0) lgkmcnt(0)" ::: "memory"); __syncthreads();
#undef DMA_V
#undef DMA_K
#undef VMW0
#undef RESCN
#undef RESC_APPLY
}
#undef ATT_KSWZ
#undef ATT_KEY
#undef ATT_PK
#undef ATT_SBAR
}
#define LAS __attribute__((address_space(3)))
typedef unsigned short u16;
typedef float f32x4 __attribute__((ext_vector_type(4)));
typedef short bf16x8 __attribute__((ext_vector_type(8)));
typedef unsigned u32x4 __attribute__((ext_vector_type(4)));
typedef unsigned u32x2 __attribute__((ext_vector_type(2)));
constexpr int DM = 2048, BATCH = 2, SEQ = 16384, T = BATCH * SEQ;
constexpr int IN0 = 4608, NLAT = 1088, NLATP = 1280, NQ = 3072, NKV = 4096, DFF = 8192;
constexpr float EPS = 1e-6f;
constexpr int NWAVES = 8, NTHREADS = 512;
constexpr int LDS_BYTES = 155648;
constexpr float LOG2_THETA = 13.287712379549449f;

constexpr size_t MiB = 1u << 20;
constexpr size_t WS_WIN = 0, WS_WOUT = 18 * MiB, WS_WDOWN = 26 * MiB, WS_WUQ = 31 * MiB, WS_WUKV = 34 * MiB, WS_WO = 38 * MiB;
constexpr size_t WS_WUP = 46 * MiB  , WS_WDN = 110 * MiB  ;
constexpr size_t WS_XN = 176 * MiB;
constexpr size_t WS_HB = 304 * MiB;
constexpr size_t WS_BIG = 432 * MiB;
constexpr size_t WS_PROJ = WS_BIG, WS_MIX = WS_BIG + 288 * MiB;
constexpr size_t WS_HID = WS_BIG;
constexpr size_t WS_Q = WS_BIG, WS_KV = WS_BIG + 192 * MiB, WS_LAT = WS_BIG + 448 * MiB, WS_KROPE = WS_BIG + 528 * MiB;
constexpr size_t WS_CQN = WS_LAT, WS_CKVN = WS_LAT;
constexpr size_t WS_AO = WS_XN;
constexpr size_t WS_CTL = WS_BIG + 532 * MiB, CTL_BAR = 65536, WS_SS = WS_CTL + CTL_BAR, CTL_BYTES = CTL_BAR + 5 * 131072;
constexpr size_t WS_END = WS_CTL + CTL_BYTES;

__device__ __forceinline__ float bflo(unsigned u) { return __uint_as_float(u << 16); }
__device__ __forceinline__ float bfhi(unsigned u) { return __uint_as_float(u & 0xffff0000u); }
__device__ __forceinline__ unsigned pk2(float lo, float hi) { unsigned r; asm volatile("v_cvt_pk_bf16_f32 %0, %1, %2" : "=v"(r) : "v"(lo), "v"(hi)); return r; }
__device__ __forceinline__ float wave_sum(float v) {
#pragma unroll
    for (int o = 1; o < 64; o <<= 1) v += __shfl_xor(v, o);
    return v;
}
__device__ __forceinline__ void rope_cs(float pos, float invf, float& c, float& s) {
    const float a = pos * invf;
    double rev = (double)a * 0.15915494309189535;
    rev -= __builtin_rint(rev);
    const float fr = (float)rev;
    c = __builtin_amdgcn_cosf(fr); s = __builtin_amdgcn_sinf(fr);
}

__device__ __forceinline__ void transpose_item(const float* __restrict__ W, const float* __restrict__ gain, float mul, int K, int N, u16* __restrict__ WT, LAS float* scr, int item, int lane) {
    const int nblk = N / 32, kb = item / nblk, nb = item % nblk, k0 = 64 * kb, n0 = 32 * nb;
    float wv[32];
#pragma unroll
    for (int i = 0; i < 32; ++i) { const int kk = 2 * i + (lane >> 5); wv[i] = W[(size_t)(k0 + kk) * N + n0 + (lane & 31)]; }
    float gv = 1.f; if (gain) gv = gain[k0 + lane] * mul;
#pragma unroll
    for (int i = 0; i < 32; ++i) { const int kk = 2 * i + (lane >> 5); const float g = __shfl(gv, kk); scr[kk * 33 + (lane & 31)] = wv[i] * g; }
    asm volatile("s_waitcnt lgkmcnt(0)" ::: "memory");
    const int c = lane & 7;
#pragma unroll
    for (int j = 0; j < 4; ++j) { const int n = (lane >> 3) + 8 * j; const LAS float* s = scr + (8 * c) * 33 + n;
        u32x4 o; o.x = pk2(s[0 * 33], s[1 * 33]); o.y = pk2(s[2 * 33], s[3 * 33]); o.z = pk2(s[4 * 33], s[5 * 33]); o.w = pk2(s[6 * 33], s[7 * 33]);
        *(u32x4*)(WT + (size_t)(n0 + n) * K + k0 + 8 * c) = o; }
    asm volatile("s_waitcnt lgkmcnt(0)" ::: "memory");
}

__device__ __forceinline__ void norm_row_bf16(const float* __restrict__ xrow, u16* __restrict__ orow, int lane) {
    const f32x4* xr = (const f32x4*)xrow + lane;
    f32x4 v[8]; float s = 0.f;
#pragma unroll
    for (int j = 0; j < 8; ++j) { v[j] = xr[64 * j]; s += (v[j].x * v[j].x + v[j].y * v[j].y) + (v[j].z * v[j].z + v[j].w * v[j].w); }
    const float r = 1.0f / sqrtf(wave_sum(s) * (1.f / DM) + EPS);
    u32x2* o8 = (u32x2*)orow + lane;
#pragma unroll
    for (int j = 0; j < 8; ++j) { u32x2 w; w.x = pk2(v[j].x * r, v[j].y * r); w.y = pk2(v[j].z * r, v[j].w * r); o8[64 * j] = w; }
}
__device__ __forceinline__ void norm_row_b2b(const u16* __restrict__ hrow, u16* __restrict__ orow, int lane) {
    const u32x4* xr = (const u32x4*)hrow + lane;
    u32x4 w[4]; float s = 0.f;
#pragma unroll
    for (int j = 0; j < 4; ++j) { w[j] = xr[64 * j];
#pragma unroll
        for (int e = 0; e < 4; ++e) { const float a = bflo(w[j][e]), b = bfhi(w[j][e]); s += a * a + b * b; } }
    const float r = 1.0f / sqrtf(wave_sum(s) * (1.f / DM) + EPS);
    u32x4* o = (u32x4*)orow + lane;
#pragma unroll
    for (int j = 0; j < 4; ++j) { u32x4 v;
#pragma unroll
        for (int e = 0; e < 4; ++e) v[e] = pk2(bflo(w[j][e]) * r, bfhi(w[j][e]) * r);
        o[64 * j] = v; }
}
__device__ __forceinline__ void norm_row_final(const u16* __restrict__ hrow, float* __restrict__ orow, const float* __restrict__ g, int lane) {
    const u32x4* xr = (const u32x4*)hrow + lane;
    u32x4 w[4]; float s = 0.f;
#pragma unroll
    for (int j = 0; j < 4; ++j) { w[j] = xr[64 * j];
#pragma unroll
        for (int e = 0; e < 4; ++e) { const float a = bflo(w[j][e]), b = bfhi(w[j][e]); s += a * a + b * b; } }
    const float r = 1.0f / sqrtf(wave_sum(s) * (1.f / DM) + EPS);
#pragma unroll
    for (int j = 0; j < 4; ++j) { const int c = (64 * j + lane) * 8; const f32x4 g0 = *(const f32x4*)(g + c), g1 = *(const f32x4*)(g + c + 4);
        f32x4 o0 = {bflo(w[j][0]) * r * g0[0], bfhi(w[j][0]) * r * g0[1], bflo(w[j][1]) * r * g0[2], bfhi(w[j][1]) * r * g0[3]};
        f32x4 o1 = {bflo(w[j][2]) * r * g1[0], bfhi(w[j][2]) * r * g1[1], bflo(w[j][3]) * r * g1[2], bfhi(w[j][3]) * r * g1[3]};
        *(f32x4*)(orow + c) = o0; *(f32x4*)(orow + c + 4) = o1; }
}

__device__ __forceinline__ void ld8f(const u16* p, float* f) {
    const u32x4 w = *(const u32x4*)p;
    f[0] = bflo(w.x); f[1] = bfhi(w.x); f[2] = bflo(w.y); f[3] = bfhi(w.y); f[4] = bflo(w.z); f[5] = bfhi(w.z); f[6] = bflo(w.w); f[7] = bfhi(w.w);
}

__device__ __forceinline__ void ew0_token(int t, u16* __restrict__ PROJ, u16* __restrict__ MIX, const float* __restrict__ qg, const float* __restrict__ kg, const float* __restrict__ cw, int lane) {
    const int s = t & (SEQ - 1), row = s >> 6, col = s & 63;
    float c, sn; { const int j = lane & 31; const float invf = __builtin_amdgcn_exp2f(-(float)j * (LOG2_THETA / 32.f)); rope_cs((float)(lane < 32 ? row : col), invf, c, sn); }
    unsigned* pr = (unsigned*)(PROJ + (size_t)t * IN0);
    const float qg0 = qg[2 * lane], qg1 = qg[2 * lane + 1], kg0 = kg[2 * lane], kg1 = kg[2 * lane + 1];
#pragma unroll
    for (int h = 0; h < 10; ++h) {
        const unsigned u = pr[h * 64 + lane]; const float x1 = bflo(u), x2 = bfhi(u);
        const float ss = wave_sum(x1 * x1 + x2 * x2); const float r = 1.0f / sqrtf(ss * (1.f / 128.f) + EPS);
        const float y1 = x1 * r * (h < 8 ? qg0 * att::Cfg<128>::C : kg0), y2 = x2 * r * (h < 8 ? qg1 * att::Cfg<128>::C : kg1);
        pr[h * 64 + lane] = pk2(y1 * c - y2 * sn, y1 * sn + y2 * c);
    }
    const u16* p0 = PROJ + (size_t)t * IN0;
#pragma unroll
    for (int ch = 0; ch < 2; ++ch) {
        const int cc = ch * 512 + lane * 8;
        float gb[8], g0[8], u0[8], gm[8], um[8], gp[8], up[8];
        ld8f(p0 + 1536 + cc, gb); ld8f(p0 + 2560 + cc, g0); ld8f(p0 + 3584 + cc, u0);
        if (s > 0) { ld8f(p0 - IN0 + 2560 + cc, gm); ld8f(p0 - IN0 + 3584 + cc, um); } else {
#pragma unroll
            for (int e = 0; e < 8; ++e) { gm[e] = 0.f; um[e] = 0.f; } }
        if (s < SEQ - 1) { ld8f(p0 + IN0 + 2560 + cc, gp); ld8f(p0 + IN0 + 3584 + cc, up); } else {
#pragma unroll
            for (int e = 0; e < 8; ++e) { gp[e] = 0.f; up[e] = 0.f; } }
        float o[8];
#pragma unroll
        for (int e = 0; e < 8; ++e) o[e] = gb[e] * (cw[cc + e] * (gm[e] * um[e]) + cw[1024 + cc + e] * (g0[e] * u0[e]) + cw[2048 + cc + e] * (gp[e] * up[e]));
        u32x4 w; w.x = pk2(o[0], o[1]); w.y = pk2(o[2], o[3]); w.z = pk2(o[4], o[5]); w.w = pk2(o[6], o[7]);
        *(u32x4*)(MIX + (size_t)t * DM + 1024 + cc) = w;
    }
}
__device__ __forceinline__ void cv8f(const u32x4 w, float* f) {
    f[0] = bflo(w.x); f[1] = bfhi(w.x); f[2] = bflo(w.y); f[3] = bfhi(w.y); f[4] = bflo(w.z); f[5] = bfhi(w.z); f[6] = bflo(w.w); f[7] = bfhi(w.w);
}
__device__ __forceinline__ void ew0_pair(int t, u16* __restrict__ PROJ, u16* __restrict__ MIX, const float* __restrict__ qg, const float* __restrict__ kg, const float* __restrict__ cw, int lane) {
    const int s = t & (SEQ - 1), row = s >> 6, col = s & 63;
    unsigned* pr0 = (unsigned*)(PROJ + (size_t)t * IN0); unsigned* pr1 = pr0 + IN0 / 2;
    const u16* p0 = PROJ + (size_t)t * IN0;
    unsigned ua[10], ub[10];
#pragma unroll
    for (int h = 8; h < 10; ++h) { ua[h] = pr0[h * 64 + lane]; ub[h] = pr1[h * 64 + lane]; }
    u32x4 rgb[2][2], rg[2][4], ru[2][4];
    const bool hasm = s > 0, hasp = s + 1 < SEQ - 1; const u32x4 z4 = {0u, 0u, 0u, 0u};
#pragma unroll
    for (int ch = 0; ch < 2; ++ch) { const int cc = ch * 512 + lane * 8;
        rgb[ch][0] = *(const u32x4*)(p0 + 1536 + cc); rgb[ch][1] = *(const u32x4*)(p0 + IN0 + 1536 + cc);
        rg[ch][1] = *(const u32x4*)(p0 + 2560 + cc); ru[ch][1] = *(const u32x4*)(p0 + 3584 + cc);
        rg[ch][2] = *(const u32x4*)(p0 + IN0 + 2560 + cc); ru[ch][2] = *(const u32x4*)(p0 + IN0 + 3584 + cc);
        rg[ch][0] = hasm ? *(const u32x4*)(p0 - IN0 + 2560 + cc) : z4; ru[ch][0] = hasm ? *(const u32x4*)(p0 - IN0 + 3584 + cc) : z4;
        rg[ch][3] = hasp ? *(const u32x4*)(p0 + 2 * IN0 + 2560 + cc) : z4; ru[ch][3] = hasp ? *(const u32x4*)(p0 + 2 * IN0 + 3584 + cc) : z4; }
    float c0, s0, c1, s1; { const int j = lane & 31; const float invf = __builtin_amdgcn_exp2f(-(float)j * (LOG2_THETA / 32.f));
        rope_cs((float)(lane < 32 ? row : col), invf, c0, s0); rope_cs((float)(lane < 32 ? row : col + 1), invf, c1, s1); }
    const float qg0 = qg[2 * lane] * att::Cfg<128>::C, qg1 = qg[2 * lane + 1] * att::Cfg<128>::C, kg0 = kg[2 * lane], kg1 = kg[2 * lane + 1];
#pragma unroll
    for (int h = 8; h < 10; ++h) {
        const float a1 = bflo(ua[h]), a2 = bfhi(ua[h]), b1 = bflo(ub[h]), b2 = bfhi(ub[h]);
        const float ra = 1.0f / sqrtf(wave_sum(a1 * a1 + a2 * a2) * (1.f / 128.f) + EPS), rb = 1.0f / sqrtf(wave_sum(b1 * b1 + b2 * b2) * (1.f / 128.f) + EPS);
        const float g0 = (h < 8 ? qg0 : kg0), g1 = (h < 8 ? qg1 : kg1);
        const float ya1 = a1 * ra * g0, ya2 = a2 * ra * g1, yb1 = b1 * rb * g0, yb2 = b2 * rb * g1;
        pr0[h * 64 + lane] = pk2(ya1 * c0 - ya2 * s0, ya1 * s0 + ya2 * c0);
        pr1[h * 64 + lane] = pk2(yb1 * c1 - yb2 * s1, yb1 * s1 + yb2 * c1);
    }
#pragma unroll
    for (int ch = 0; ch < 2; ++ch) {
        const int cc = ch * 512 + lane * 8;
        float gbA[8], gbB[8], gm[8], um[8], g0[8], u0[8], g1[8], u1[8], g2[8], u2[8];
        cv8f(rgb[ch][0], gbA); cv8f(rgb[ch][1], gbB); cv8f(rg[ch][0], gm); cv8f(ru[ch][0], um); cv8f(rg[ch][1], g0); cv8f(ru[ch][1], u0);
        cv8f(rg[ch][2], g1); cv8f(ru[ch][2], u1); cv8f(rg[ch][3], g2); cv8f(ru[ch][3], u2);
        float oa[8], ob[8];
#pragma unroll
        for (int e = 0; e < 8; ++e) { const float w0 = cw[cc + e], w1 = cw[1024 + cc + e], w2 = cw[2048 + cc + e];
            const float xm = gm[e] * um[e], x0 = g0[e] * u0[e], x1 = g1[e] * u1[e], x2 = g2[e] * u2[e];
            oa[e] = gbA[e] * (w0 * xm + w1 * x0 + w2 * x1); ob[e] = gbB[e] * (w0 * x0 + w1 * x1 + w2 * x2); }
        u32x4 wa; wa.x = pk2(oa[0], oa[1]); wa.y = pk2(oa[2], oa[3]); wa.z = pk2(oa[4], oa[5]); wa.w = pk2(oa[6], oa[7]);
        u32x4 wb; wb.x = pk2(ob[0], ob[1]); wb.y = pk2(ob[2], ob[3]); wb.z = pk2(ob[4], ob[5]); wb.w = pk2(ob[6], ob[7]);
        *(u32x4*)(MIX + (size_t)t * DM + 1024 + cc) = wa; *(u32x4*)(MIX + (size_t)(t + 1) * DM + 1024 + cc) = wb;
    }
}
__device__ __forceinline__ void ew1_token(int t, const u16* __restrict__ LAT, u16* __restrict__ CQN, u16* __restrict__ CKVN, u16* __restrict__ KROPE, int lane) {
    const u16* p0 = LAT + (size_t)t * NLATP;
#pragma unroll
    for (int part = 0; part < 2; ++part) {
        float x[8]; ld8f(p0 + part * 512 + lane * 8, x);
        float ss = 0.f;
#pragma unroll
        for (int e = 0; e < 8; ++e) ss += x[e] * x[e];
        const float r = 1.0f / sqrtf(wave_sum(ss) * (1.f / 512.f) + EPS);
        u32x4 w; w.x = pk2(x[0] * r, x[1] * r); w.y = pk2(x[2] * r, x[3] * r); w.z = pk2(x[4] * r, x[5] * r); w.w = pk2(x[6] * r, x[7] * r);
        *(u32x4*)((part ? CKVN : CQN) + (size_t)t * 512 + lane * 8) = w;
    }
    if (lane < 32) {
        const int s = t & (SEQ - 1), row = s >> 6, col = s & 63; const int j = lane & 15;
        const float invf = __builtin_amdgcn_exp2f(-(float)j * (LOG2_THETA / 16.f)); float c, sn; rope_cs((float)(lane < 16 ? row : col), invf, c, sn);
        const unsigned u = *(const unsigned*)(p0 + 1024 + 2 * lane); const float x1 = bflo(u), x2 = bfhi(u);
        *(unsigned*)(KROPE + (size_t)t * 64 + 2 * lane) = pk2(x1 * c - x2 * sn, x1 * sn + x2 * c);
    }
}
__device__ __forceinline__ void ew2_token(int t, u16* __restrict__ Q, int lane) {
    const int s = t & (SEQ - 1), row = s >> 6, col = s & 63;
    const int h = lane >> 2, part = lane & 3; const float pos = (float)(part < 2 ? row : col);
    u16* p = Q + (size_t)t * NQ + h * 192 + 128 + part * 16;
    float x[16]; ld8f(p, x); ld8f(p + 8, x + 8);
    unsigned w[8];
#pragma unroll
    for (int i = 0; i < 8; ++i) { const int j = (part & 1) * 8 + i; const float invf = __builtin_amdgcn_exp2f(-(float)j * (LOG2_THETA / 16.f)); float c, sn; rope_cs(pos, invf, c, sn);
        w[i] = pk2(x[2 * i] * c - x[2 * i + 1] * sn, x[2 * i] * sn + x[2 * i + 1] * c); }
    *(u32x4*)p = (u32x4){w[0], w[1], w[2], w[3]}; *(u32x4*)(p + 8) = (u32x4){w[4], w[5], w[6], w[7]};
}

#define RLX_AGENT __ATOMIC_RELAXED, __HIP_MEMORY_SCOPE_AGENT
#define XB_TMO      128
#define XB_XCNT(j)  (256  + 64 * (j))
#define XB_XSUB(j)  (1280 + 64 * (j))
#define XB_XGEN(j)  (2304 + 64 * (j))
#define XB_TOP      3328
#define XB_TOPGEN   3392
#define XCD_BAR_WORDS 3456
#define XB_SPIN_CAP (1u << 22)

__device__ __forceinline__ unsigned xb_ld(unsigned* p)              { return __hip_atomic_load(p, __ATOMIC_RELAXED, __HIP_MEMORY_SCOPE_AGENT); }
__device__ __forceinline__ unsigned xb_add(unsigned* p, unsigned v) { return __hip_atomic_fetch_add(p, v, __ATOMIC_RELAXED, __HIP_MEMORY_SCOPE_AGENT); }
__device__ __forceinline__ unsigned xb_xcc_id() { return (unsigned)__builtin_amdgcn_s_getreg((3 << 11) | 20) & 0xFu; }
#define XB_SPIN(cond, bar) do { unsigned _sp = 0; while (cond) { __builtin_amdgcn_s_sleep(1); \
    if ((++_sp & 255u) == 0u) { if (xb_ld(&(bar)[XB_TMO])) break; if (_sp > XB_SPIN_CAP) { atomicAdd(&(bar)[XB_TMO], 1u); break; } } } } while (0)

struct XcdBarrier {
    unsigned* bar; unsigned x;
    volatile LAS unsigned* st;
};

__device__ __forceinline__ XcdBarrier xcd_barrier_post(unsigned* bar, volatile LAS unsigned* st) {
    XcdBarrier b; b.bar = bar; b.x = xb_xcc_id(); b.st = st;
    if (threadIdx.x == 0) (void)xb_add(&bar[XB_XCNT(b.x)], 1u);
    return b;
}
__device__ __forceinline__ void xcd_barrier_complete(unsigned* bar, unsigned x, unsigned& nloc, unsigned& nx) {
    const unsigned G = gridDim.x * gridDim.y * gridDim.z;
    unsigned sum, cnt, mine, sp = 0u;
    for (;;) {
        sum = 0u; cnt = 0u; mine = 0u;
#pragma unroll
        for (unsigned j = 0; j < 16; ++j) { const unsigned c = xb_ld(&bar[XB_XCNT(j)]); sum += c; cnt += (c > 0u) ? 1u : 0u; mine = (j == x) ? c : mine; }
        if (sum == G) break;
        __builtin_amdgcn_s_sleep(1);
        if ((++sp & 255u) == 0u) { if (xb_ld(&bar[XB_TMO])) break; if (sp > XB_SPIN_CAP) { atomicAdd(&bar[XB_TMO], 1u); break; } }
    }
    nloc = mine > 0u ? mine : 1u; nx = cnt > 0u ? cnt : 1u;
}

__device__ __forceinline__ void xcd_barrier(const XcdBarrier& b) {
    asm volatile("s_waitcnt vmcnt(0)" ::: "memory");
    __syncthreads();
    if (threadIdx.x == 0) {
        unsigned* bar = b.bar;
        __builtin_amdgcn_s_waitcnt(0);
        unsigned nloc = b.st[0], nx = b.st[1];
        if (nloc == 0u) { xcd_barrier_complete(bar, b.x, nloc, nx); b.st[0] = nloc; b.st[1] = nx; }
        const unsigned old = xb_add(&bar[XB_XSUB(b.x)], 1u);
        const unsigned gen = old / nloc;
        if (old + 1u == (gen + 1u) * nloc) {
            __builtin_amdgcn_fence(__ATOMIC_RELEASE, "agent");
            asm volatile("s_waitcnt vmcnt(0)" ::: "memory");
            const unsigned og = xb_add(&bar[XB_TOP], 1u);
            const unsigned tg = og / nx;
            if (og + 1u == (tg + 1u) * nx) xb_add(&bar[XB_TOPGEN], 1u);
            else XB_SPIN(xb_ld(&bar[XB_TOPGEN]) == tg, bar);
            __builtin_amdgcn_fence(__ATOMIC_ACQUIRE, "agent");
            xb_add(&bar[XB_XGEN(b.x)], 1u);
            asm volatile("s_waitcnt vmcnt(0)" ::: "memory");
        } else {
            XB_SPIN(xb_ld(&bar[XB_XGEN(b.x)]) == gen, bar);
            __builtin_amdgcn_fence(__ATOMIC_ACQUIRE, "agent");
            asm volatile("s_waitcnt vmcnt(0)" ::: "memory");
        }
    }
    __syncthreads();
}

struct Params { const float* in[18]; float* out; unsigned char* ws; int ph_lo, ph_hi; };
enum { I_X = 0, I_ENG, I_EWIN, I_EQG, I_EKG, I_ECW, I_EWOUT, I_ONG, I_OWDOWN, I_OQG, I_OKVG, I_OWUQ, I_OWUKV, I_OWO, I_MNG, I_MWUP, I_MWDN, I_FNG };
constexpr int NPHASE = 19;

template <int DQK> __device__ __forceinline__ bool attn_next(int i, int NU, int& unit) {
    const int G = gridDim.x, bx = blockIdx.x;
    if ((G & 7) == 0 && (NU & 7) == 0) { const int x = bx & 7, j = bx >> 3, per = G >> 3, upx = NU >> 3; const int k = i * per + j; if (k >= upx) return false; unit = x * upx + k; return true; }
    const int k = i * G + bx; if (k >= NU) return false; unit = k; return true;
}

__global__ void __launch_bounds__(NTHREADS, 2) fwd_mega(Params P) {
    extern __shared__ __attribute__((aligned(16))) unsigned char lds[];
    cg::grid_group grid = cg::this_grid();
    const int tid = threadIdx.x, lane = tid & 63, wave = __builtin_amdgcn_readfirstlane(tid >> 6);
    const int G = gridDim.x, gw = blockIdx.x * NWAVES + wave, NGW = G * NWAVES;
    unsigned char* ws = P.ws;
    u16* Win = (u16*)(ws + WS_WIN); u16* Wout = (u16*)(ws + WS_WOUT); u16* Wdown = (u16*)(ws + WS_WDOWN); u16* Wuq = (u16*)(ws + WS_WUQ); u16* Wukv = (u16*)(ws + WS_WUKV); u16* Wo = (u16*)(ws + WS_WO);
    u16* Wup = (u16*)(ws + WS_WUP); u16* Wdn = (u16*)(ws + WS_WDN);
    u16* XN = (u16*)(ws + WS_XN); u16* PROJ = (u16*)(ws + WS_PROJ); u16* MIX = (u16*)(ws + WS_MIX); u16* HID = (u16*)(ws + WS_HID);
    u16* LAT = (u16*)(ws + WS_LAT); u16* CQN = (u16*)(ws + WS_CQN); u16* CKVN = (u16*)(ws + WS_CKVN); u16* KROPE = (u16*)(ws + WS_KROPE);
    u16* Qm = (u16*)(ws + WS_Q); u16* KVm = (u16*)(ws + WS_KV); u16* AO = (u16*)(ws + WS_AO);
    u16* HB = (u16*)(ws + WS_HB); float* SS0 = (float*)(ws + WS_SS); float* SS1 = SS0 + T; float* SS2 = SS1 + T; float* SSQ = SS2 + T; float* SSKV = SSQ + T; const float* NOSS = nullptr; float* NOSSW = nullptr;
    LAS unsigned char* ldsl = (LAS unsigned char*)lds;
    const int lo = P.ph_lo, hi = P.ph_hi;
    volatile LAS unsigned* xst = (volatile LAS unsigned*)(ldsl + LDS_BYTES - 16);
    if (tid < 4) xst[tid] = 0u;
    __syncthreads();
    XcdBarrier xbar = xcd_barrier_post((unsigned*)(ws + WS_CTL), xst);
#define PH(k) if (lo <= (k) && (k) < hi) _Pragma("unroll") for (int rep_ = 0; rep_ <= (int)((REP_MASK >> (k)) & 1u); ++rep_)
#define SEAM(k) do { if (lo <= (k) && (k) + 1 < hi) { if ((k) == 0) grid.sync(); else xcd_barrier(xbar); } } while (0)
#define GEMM_BF16X(ACT, Aptr, ldav, Bptr, Mv, Nv, Kv, Optr, ldc, ssptr, sso0p, sso1p) do { pg8::Gemm g{Aptr, Bptr, Mv, Nv, Kv, ldav}; pg8::StaticOrder S; S.init(Mv, Nv, G, (int)blockIdx.x); \
        pg8::EpiBf16<ACT> E{Optr, ldc, ssptr, 1.0f / (float)(Kv), EPS, sso0p, sso1p}; pg8::gemm_phase<pg8::EpiBf16<ACT>, pg8::StaticOrder, true, true>(ldsl, g, S, E); } while (0)
#define GEMM_BF16(ACT, Aptr, Bptr, Mv, Nv, Kv, Optr, ldc, ssptr) GEMM_BF16X(ACT, Aptr, Kv, Bptr, Mv, Nv, Kv, Optr, ldc, ssptr, NOSSW, NOSSW)
#define GEMM_RES(F32B, Aptr, Bptr, Mv, Nv, Kv, baseptr, ssptr) do { pg8::Gemm g{Aptr, Bptr, Mv, Nv, Kv, Kv}; pg8::StaticOrder S; S.init(Mv, Nv, G, (int)blockIdx.x); \
        pg8::EpiResB<F32B> E{baseptr, HB, Nv, ssptr}; pg8::gemm_phase<pg8::EpiResB<F32B>, pg8::StaticOrder, true, true>(ldsl, g, S, E); } while (0)
#define NORM_PHASE() do { for (int m = gw; m < T; m += NGW) norm_row_b2b(HB + (size_t)m * DM, XN + (size_t)m * DM, lane); } while (0)

    PH(0) {
        LAS float* scr = (LAS float*)(ldsl + wave * 16384);
        constexpr int I0 = (DM / 64) * (IN0 / 32), I1 = (DM / 64) * (DM / 32), I2 = (DM / 64) * (NLAT / 32), I3 = (512 / 64) * (NQ / 32), I4 = (512 / 64) * (NKV / 32), I5 = I1;
        constexpr int I6 = (DM / 64) * (DFF / 32), I7 = (DFF / 64) * (DM / 32);
        constexpr int NITEMS = I0 + I1 + I2 + I3 + I4 + I5 + 2 * I6 + 2 * I7;
        for (int it = gw; it < NITEMS; it += NGW) {
            int r = it;
            if (r < I0) { transpose_item(P.in[I_EWIN], P.in[I_ENG], 1.f, DM, IN0, Win, scr, r, lane); continue; } r -= I0;
            if (r < I1) { transpose_item(P.in[I_EWOUT], nullptr, 1.f, DM, DM, Wout, scr, r, lane); continue; } r -= I1;
            if (r < I2) { transpose_item(P.in[I_OWDOWN], P.in[I_ONG], 1.f, DM, NLAT, Wdown, scr, r, lane); continue; } r -= I2;
            if (r < I3) { transpose_item(P.in[I_OWUQ], P.in[I_OQG], att::Cfg<192>::C, 512, NQ, Wuq, scr, r, lane); continue; } r -= I3;
            if (r < I4) { transpose_item(P.in[I_OWUKV], P.in[I_OKVG], 1.f, 512, NKV, Wukv, scr, r, lane); continue; } r -= I4;
            if (r < I5) { transpose_item(P.in[I_OWO], nullptr, 1.f, DM, DM, Wo, scr, r, lane); continue; } r -= I5;
            if (r < I6) { transpose_item(P.in[I_MWUP], P.in[I_MNG], 1.f, DM, DFF, Wup, scr, r, lane); continue; } r -= I6;
            if (r < I6) { transpose_item(P.in[I_MWUP] + (size_t)DM * DFF, P.in[I_MNG] + DM, 1.f, DM, DFF, Wup + (size_t)DM * DFF, scr, r, lane); continue; } r -= I6;
            if (r < I7) { transpose_item(P.in[I_MWDN], nullptr, 1.f, DFF, DM, Wdn, scr, r, lane); continue; } r -= I7;
            transpose_item(P.in[I_MWDN] + (size_t)DM * DFF, nullptr, 1.f, DFF, DM, Wdn + (size_t)DM * DFF, scr, r, lane);
        }
        { const size_t n16 = (size_t)(NLATP - NLAT) * DM * 2 / 16; u32x4* z = (u32x4*)(Wdown + (size_t)NLAT * DM);
          for (size_t i = (size_t)blockIdx.x * NTHREADS + tid; i < n16; i += (size_t)G * NTHREADS) z[i] = (u32x4){0u, 0u, 0u, 0u}; }
        for (int m = gw; m < T; m += NGW) norm_row_bf16(P.in[I_X] + (size_t)m * DM, XN + (size_t)m * DM, lane);
    }
    SEAM(0);
    PH(1) { GEMM_BF16(0, XN, Win, T, IN0, DM, PROJ, IN0, NOSS); }
    SEAM(1);
    PH(2) { const int per = ((T / 2 + NGW - 1) / NGW) * 2; const int t0 = gw * per; for (int t = t0; t < t0 + per && t < T; t += 2) ew0_pair(t, PROJ, MIX, P.in[I_EQG], P.in[I_EKG], P.in[I_ECW], lane); }
    SEAM(2);
    PH(3) {
        if (ATT_PRIO && wave >= 4) __builtin_amdgcn_s_setprio(1);
        constexpr int NU = BATCH * 8 * (SEQ / 256); int unit;
        for (int i = 0; attn_next<128>(i, NU, unit); ++i) {
            const int bh = unit / (SEQ / 256), qb = unit % (SEQ / 256), b = bh >> 3, hq = bh & 7, kvh = hq >> 2;
            const size_t tb = (size_t)b * SEQ;
#ifndef NO_GQA
            att::ATT_UNIT<128, IN0, IN0, IN0, DM>(PROJ + (tb + (size_t)qb * 256) * IN0 + hq * 128, PROJ + tb * IN0 + 1024 + kvh * 128, nullptr, PROJ + tb * IN0 + 1280 + kvh * 128,
                                                      MIX + (tb + (size_t)qb * 256) * DM + hq * 128, SEQ, (char*)lds, qb * 256, P.in[I_EQG]);
#endif
        }
    }
    if (ATT_PRIO) __builtin_amdgcn_s_setprio(0);
    SEAM(3);
    PH(4) { GEMM_RES(true, MIX, Wout, T, DM, DM, (const void*)P.in[I_X], SS0); }
    SEAM(4);
    PH(6) { GEMM_BF16(2, HB, Wup, T, DFF, DM, HID, DFF, (const float*)SS0); }
    SEAM(6);
    PH(7) { GEMM_RES(false, HID, Wdn, T, DM, DFF, (const void*)HB, SS1); }
    SEAM(7);
    PH(9) { GEMM_BF16X(0, HB, DM, Wdown, T, NLATP, DM, LAT, NLATP, (const float*)SS1, SSQ, SSKV); }
    SEAM(9);
    PH(11) {
        for (int tb_ = gw; tb_ < T; tb_ += 8 * NGW) {
            unsigned uu[8];
#pragma unroll
            for (int i = 0; i < 8; ++i) { const int t = tb_ + i * NGW; uu[i] = (t < T && lane < 32) ? *(const unsigned*)(LAT + (size_t)t * NLATP + 1024 + 2 * lane) : 0u; }
            const int j = lane & 15; const float invf = __builtin_amdgcn_exp2f(-(float)j * (LOG2_THETA / 16.f));
#pragma unroll
            for (int i = 0; i < 8; ++i) { const int t = tb_ + i * NGW; if (t < T && lane < 32) {
                const int s = t & (SEQ - 1), row = s >> 6, col = s & 63; float c, sn; rope_cs((float)(lane < 16 ? row : col), invf, c, sn);
                const float x1 = bflo(uu[i]), x2 = bfhi(uu[i]);
                *(unsigned*)(KROPE + (size_t)t * 64 + 2 * lane) = pk2(x1 * c - x2 * sn, x1 * sn + x2 * c); } } }
        GEMM_BF16X(0, LAT, NLATP, Wuq, T, NQ, 512, Qm, NQ, (const float*)SSQ, NOSSW, NOSSW);
        GEMM_BF16X(0, LAT + 512, NLATP, Wukv, T, NKV, 512, KVm, NKV, (const float*)SSKV, NOSSW, NOSSW); }
    SEAM(11);
    PH(13) {
        if (ATT_PRIO && wave >= 4) __builtin_amdgcn_s_setprio(1);
        constexpr int NU = BATCH * 16 * (SEQ / 256); int unit;
        for (int i = 0; attn_next<192>(i, NU, unit); ++i) {
            const int bh = unit / (SEQ / 256), qb = unit % (SEQ / 256), b = bh >> 4, h = bh & 15;
            const size_t tb = (size_t)b * SEQ;
#ifndef NO_MLA
            att::ATT_UNIT<192, NQ, NKV, NKV, DM>(Qm + (tb + (size_t)qb * 256) * NQ + h * 192, KVm + tb * NKV + h * 256, KROPE + tb * 64, KVm + tb * NKV + h * 256 + 128,
                                                          AO + (tb + (size_t)qb * 256) * DM + h * 128, SEQ, (char*)lds, qb * 256);
#endif
        }
    }
    if (ATT_PRIO) __builtin_amdgcn_s_setprio(0);
    SEAM(13);
    PH(14) { GEMM_RES(false, AO, Wo, T, DM, DM, (const void*)HB, SS2); }
    SEAM(14);
    PH(16) { GEMM_BF16(2, HB, Wup + (size_t)DM * DFF, T, DFF, DM, HID, DFF, (const float*)SS2); }
    SEAM(16);
    PH(17) { GEMM_RES(false, HID, Wdn + (size_t)DM * DFF, T, DM, DFF, (const void*)HB, NOSSW); }
    SEAM(17);
    PH(18) { for (int m = gw; m < T; m += NGW) norm_row_final(HB + (size_t)m * DM, P.out + (size_t)m * DM, P.in[I_FNG], lane);
#ifdef ATT_TIMING
        if (blockIdx.x == 0 && tid == 0) { asm volatile("s_waitcnt vmcnt(0)" ::: "memory"); P.out[0] = floorf(((float*)(ws + WS_CTL + 32768))[ATT_TIMING] * (1.f / 200.f) + 0.5f) * 200000.f; }
#endif
    }
#undef PH
#undef SEAM
}

extern "C" void kernel_launch(void* const* d_in, const int* in_sizes, int n_in, void* d_out, int out_size, void* d_ws, size_t ws_size, hipStream_t stream) {
    static int grid = 0;
    if (grid == 0) {
        if (n_in != 18 || in_sizes[0] != T * DM || out_size != T * DM || ws_size < WS_END) {
            fprintf(stderr, "kernel_launch: shape mismatch (n_in %d in0 %d out %d ws %zu need %zu)\n", n_in, n_in > 0 ? in_sizes[0] : -1, out_size, ws_size, (size_t)WS_END); grid = -1; return; }
        int dev = 0, cus = 0, per_cu = 0;
        hipGetDevice(&dev); hipDeviceGetAttribute(&cus, hipDeviceAttributeMultiprocessorCount, dev);
        if (hipFuncSetAttribute((const void*)fwd_mega, hipFuncAttributeMaxDynamicSharedMemorySize, LDS_BYTES) != hipSuccess) { fprintf(stderr, "kernel_launch: hipFuncSetAttribute failed\n"); grid = -1; return; }
        if (hipOccupancyMaxActiveBlocksPerMultiprocessor(&per_cu, (const void*)fwd_mega, NTHREADS, LDS_BYTES) != hipSuccess || per_cu < 1) { fprintf(stderr, "kernel_launch: occupancy query says %d\n", per_cu); per_cu = 1; }
        (void)hipGetLastError();
        grid = cus * per_cu;
        fprintf(stderr, "kernel_launch: grid %d (cus %d x %d)\n", grid, cus, per_cu);
    }
    if (grid < 0) return;
    if (hipMemsetAsync((char*)d_ws + WS_CTL, 0, CTL_BYTES, stream) != hipSuccess) { fprintf(stderr, "kernel_launch: memset failed\n"); return; }
    Params p{};
    for (int i = 0; i < 18; ++i) p.in[i] = (const float*)d_in[i];
    p.out = (float*)d_out; p.ws = (unsigned char*)d_ws;
#if N_LAUNCH_SPLIT
    for (int k = 0; k < NPHASE; ++k) { p.ph_lo = k; p.ph_hi = k + 1; void* args[] = {&p};
        hipError_t e = hipLaunchCooperativeKernel((const void*)fwd_mega, dim3(grid), dim3(NTHREADS), args, LDS_BYTES, stream);
        if (e != hipSuccess) { fprintf(stderr, "cooperative launch failed: %s (grid %d)\n", hipGetErrorString(e), grid); break; } }
#else
    p.ph_lo = 0; p.ph_hi = NPHASE; void* args[] = {&p};
    hipError_t e = hipLaunchCooperativeKernel((const void*)fwd_mega, dim3(grid), dim3(NTHREADS), args, LDS_BYTES, stream);
    if (e != hipSuccess) fprintf(stderr, "cooperative launch failed: %s (grid %d)\n", hipGetErrorString(e), grid);
#endif
}
```
